# Optimizing an MI355X kernel written in HIP

```python
import math
import jax
import jax.numpy as jnp
from jax import lax
import numpy as np

D_MODEL = 1024
BATCH = 2
SEQ = 8192
DEPTH = 2

GRID_W = 64
ROPE_THETA = 10000.0
Q_BLOCK = 128
NORM_EPS = 1e-6

BRANCH = D_MODEL // 2
D_MIX = 4 * BRANCH

SSM_HEAD = 64
SSM_HEADS = BRANCH // SSM_HEAD
SSM_GROUPS = 2
SSM_STATE = 128
SSM_CHUNK = 128
D_CONV = 5
SSM_CONV_CH = BRANCH + 2 * SSM_GROUPS * SSM_STATE

RWKV_HEAD = 64
RWKV_HEADS = BRANCH // RWKV_HEAD
RWKV_RANK = 64
RWKV_SHIFT_CH = 3 * BRANCH + 2 * RWKV_RANK
RWKV_GN_EPS = 64e-5

DIFF_HEADS = 4
DIFF_HEAD = BRANCH // (2 * DIFF_HEADS)

GQA_HEAD = 128
GQA_Q_HEADS = BRANCH // GQA_HEAD
GQA_KV_HEADS = 2

PROJ_SIZES = (
    BRANCH, SSM_CONV_CH, 2 * SSM_HEADS,
    RWKV_SHIFT_CH, BRANCH,
    BRANCH, BRANCH, BRANCH, BRANCH,
    BRANCH, GQA_KV_HEADS * GQA_HEAD, GQA_KV_HEADS * GQA_HEAD, BRANCH,
)
D_IN_PROJ = sum(PROJ_SIZES)

kernel_name = "hymba_style_bidir_ssd_rwkv7_diffattn_axialgqa"


def _split(u, sizes):
    idx, acc = [], 0
    for s in sizes[:-1]:
        acc += s
        idx.append(acc)
    return jnp.split(u, idx, axis=-1)


def _rms_norm(x, w, eps=NORM_EPS):
    xf = x.astype(jnp.float32)
    y = xf * lax.rsqrt(jnp.mean(xf * xf, axis=-1, keepdims=True) + eps)
    return (y * w.astype(jnp.float32)).astype(x.dtype)


def _rope(x, pos):
    d = x.shape[-1]
    half = d // 2
    inv = ROPE_THETA ** (-jnp.arange(half, dtype=jnp.float32) / half)
    ang = pos.astype(jnp.float32)[:, None] * inv[None, :]
    shape = (1, x.shape[1]) + (1,) * (x.ndim - 3) + (half,)
    cos, sin = jnp.cos(ang).reshape(shape), jnp.sin(ang).reshape(shape)
    xf = x.astype(jnp.float32)
    x1, x2 = xf[..., :half], xf[..., half:]
    return jnp.concatenate([x1 * cos - x2 * sin, x2 * cos + x1 * sin], axis=-1).astype(x.dtype)


def _axial_rope(x, row, col):
    half = x.shape[-1] // 2
    return jnp.concatenate([_rope(x[..., :half], row), _rope(x[..., half:], col)], axis=-1)


def _to_blocks(q):
    b, L = q.shape[:2]
    return jnp.moveaxis(q.reshape((b, L // Q_BLOCK, Q_BLOCK) + q.shape[2:]), 1, 0)


def _from_blocks(o):
    o = jnp.moveaxis(o, 0, 1)
    return o.reshape((o.shape[0], -1) + o.shape[3:])


def _centred_dwconv(u, w, bias):
    pad = D_CONV // 2
    out = lax.conv_general_dilated(
        u, w[:, None, :].astype(u.dtype), window_strides=(1,), padding=[(pad, pad)],
        dimension_numbers=("NWC", "WIO", "NWC"), feature_group_count=u.shape[-1])
    return out + bias.astype(u.dtype)


def _segsum(a):
    T = a.shape[-1]
    aa = jnp.broadcast_to(a[..., :, None], a.shape + (T,))
    aa = jnp.where(jnp.tril(jnp.ones((T, T), bool), -1), aa, 0.0)
    cs = jnp.cumsum(aa, axis=-2)
    return jnp.where(jnp.tril(jnp.ones((T, T), bool)), cs, -jnp.inf)


def _ssd(x, dt, A, bm, cm):
    b, L, h, p = x.shape
    nc = L // SSM_CHUNK
    chunk = lambda t: t.reshape((b, nc, SSM_CHUNK) + t.shape[2:])
    xdt = chunk(x * dt[..., None])
    bm, cm = chunk(bm), chunk(cm)
    a = jnp.moveaxis(chunk(dt * A), -1, 1)
    a_cum = jnp.cumsum(a, axis=-1)
    scores = jnp.einsum("bclhn,bcshn->bhcls", cm, bm) * jnp.exp(_segsum(a))
    y_diag = jnp.einsum("bhcls,bcshp->bclhp", scores, xdt)
    decay_states = jnp.moveaxis(jnp.exp(a_cum[..., -1:] - a_cum), 1, -1)
    states = jnp.einsum("bclhn,bclhp->bchpn", bm, xdt * decay_states[..., None])
    states = jnp.concatenate([jnp.zeros_like(states[:, :1]), states], axis=1)
    decay_chunk = jnp.exp(_segsum(jnp.pad(a_cum[..., -1], ((0, 0), (0, 0), (1, 0)))))
    states = jnp.einsum("bhzc,bchpn->bzhpn", decay_chunk, states)[:, :-1]
    state_decay_out = jnp.moveaxis(jnp.exp(a_cum), 1, -1)
    y_off = jnp.einsum("bclhn,bchpn->bclhp", cm, states) * state_decay_out[..., None]
    return (y_diag + y_off).reshape(b, L, h, p)


def _mamba_mixer(z, xbc, dt_raw, conv_w, conv_b, a_log, dt_bias, d_skip, norm_w):
    b, L, _ = z.shape
    xbc = jax.nn.silu(_centred_dwconv(xbc, conv_w, conv_b))
    xs, bm, cm = _split(xbc, (BRANCH, SSM_GROUPS * SSM_STATE, SSM_GROUPS * SSM_STATE))
    rep = SSM_HEADS // SSM_GROUPS
    xs = xs.reshape(b, L, SSM_HEADS, SSM_HEAD).astype(jnp.float32)
    bm = jnp.repeat(bm.reshape(b, L, SSM_GROUPS, SSM_STATE), rep, axis=2).astype(jnp.float32)
    cm = jnp.repeat(cm.reshape(b, L, SSM_GROUPS, SSM_STATE), rep, axis=2).astype(jnp.float32)
    dt = jax.nn.softplus(dt_raw.astype(jnp.float32).reshape(b, L, 2, SSM_HEADS) + dt_bias.astype(jnp.float32))
    A = -jnp.exp(a_log.astype(jnp.float32))
    flip = lambda t: jnp.flip(t, axis=1)
    y_f = _ssd(xs, dt[:, :, 0], A[0], bm, cm)
    y_b = flip(_ssd(flip(xs), flip(dt[:, :, 1]), A[1], flip(bm), flip(cm)))
    y = y_f + y_b + xs * d_skip.astype(jnp.float32)[:, None]
    y = y.reshape(b, L, BRANCH).astype(z.dtype)
    yg = (y * jax.nn.silu(z)).reshape(b, L, SSM_GROUPS, BRANCH // SSM_GROUPS)
    return _rms_norm(yg, norm_w.reshape(SSM_GROUPS, -1)).reshape(b, L, BRANCH)


def _token_shift_lerp(u, mu):
    prev = jnp.pad(u, ((0, 0), (1, 0), (0, 0)))[:, :-1]
    return u + (prev - u) * mu


def _wkv7_scan(r, w, k, v, a, bb):
    bsz, L, h, dk = r.shape
    tm = lambda t: jnp.moveaxis(t, 1, 0)

    def step(S, inp):
        r_t, w_t, k_t, v_t, a_t, b_t = inp
        sa = jnp.einsum("bhvk,bhk->bhv", S, a_t)
        S = S * w_t[:, :, None, :] + sa[..., None] * b_t[:, :, None, :] + v_t[..., None] * k_t[:, :, None, :]
        return S, jnp.einsum("bhvk,bhk->bhv", S, r_t)

    S0 = jnp.zeros((bsz, h, dk, dk), jnp.float32)
    _, y = lax.scan(step, S0, (tm(r), tm(w), tm(k), tm(v), tm(a), tm(bb)))
    return jnp.moveaxis(y, 0, 1)


def _rwkv_direction(u, mu, w0, w2, a0, a2, k_k, k_a, r_k):
    b, L, _ = u.shape
    u = _token_shift_lerp(u, mu)
    r, k, v, wd, ad = _split(u, (BRANCH, BRANCH, BRANCH, RWKV_RANK, RWKV_RANK))
    w = -jax.nn.softplus(-(w0 + jnp.tanh(wd) @ w2)) - 0.5
    decay = jnp.exp(-jnp.exp(w))
    a = jax.nn.sigmoid(a0 + ad @ a2)
    heads = lambda t: t.reshape(b, L, RWKV_HEADS, RWKV_HEAD)
    kk = heads(k * k_k)
    kk = kk / jnp.maximum(jnp.sqrt(jnp.sum(kk * kk, axis=-1, keepdims=True)), 1e-12)
    k = k * (1.0 + (a - 1.0) * k_a)
    r, k, v, decay, a = heads(r), heads(k), heads(v), heads(decay), heads(a)
    wkv = _wkv7_scan(r, decay, k, v, -kk, kk * a)
    bonus = jnp.sum(r * k * r_k, axis=-1, keepdims=True) * v
    return wkv, bonus


def _rwkv_mixer(u, mu, w0, w2, a0, a2, k_k, k_a, r_k, ln_w, ln_b):
    b, L, _ = u.shape
    f = lambda t: t.astype(jnp.float32)
    uf = f(u)
    shared = (f(a0), f(a2), f(k_k), f(k_a), f(r_k))
    flip = lambda t: jnp.flip(t, axis=1)
    wkv_f, bonus_f = _rwkv_direction(uf, f(mu[0]), f(w0[0]), f(w2[0]), *shared)
    wkv_b, bonus_b = _rwkv_direction(flip(uf), f(mu[1]), f(w0[1]), f(w2[1]), *shared)
    wkv = wkv_f + flip(wkv_b)
    m = jnp.mean(wkv, axis=-1, keepdims=True)
    var = jnp.mean(jnp.square(wkv - m), axis=-1, keepdims=True)
    gn = ((wkv - m) * lax.rsqrt(var + RWKV_GN_EPS)).reshape(b, L, BRANCH) * f(ln_w) + f(ln_b)
    y = gn + (bonus_f + flip(bonus_b)).reshape(b, L, BRANCH)
    return y.astype(u.dtype)


def _diff_mixer(q, k, v, lam_params, norm_w, pos, lambda_init):
    b, L, _ = q.shape
    q = _rope(q.reshape(b, L, DIFF_HEADS, 2, DIFF_HEAD), pos)
    k = _rope(k.reshape(b, L, DIFF_HEADS, 2, DIFF_HEAD), pos)
    v = v.reshape(b, L, DIFF_HEADS, 2 * DIFF_HEAD)
    lp = lam_params.astype(jnp.float32)
    lam = jnp.exp(jnp.sum(lp[0] * lp[1])) - jnp.exp(jnp.sum(lp[2] * lp[3])) + lambda_init
    scale = DIFF_HEAD ** -0.5

    def attend(qb):
        s = jnp.einsum("bqhcd,bkhcd->bhcqk", qb, k).astype(jnp.float32) * scale
        p = jax.nn.softmax(s, axis=-1)
        amap = (p[:, :, 0] - lam * p[:, :, 1]).astype(v.dtype)
        return jnp.einsum("bhqk,bkhe->bqhe", amap, v)

    o = _from_blocks(lax.map(attend, _to_blocks(q)))
    o = _rms_norm(o, norm_w) * (1.0 - lambda_init)
    return o.reshape(b, L, BRANCH)


def _gqa_mixer(q, k, v, q_norm_w, k_norm_w, row, col):
    b, L, _ = q.shape
    q = _axial_rope(_rms_norm(q.reshape(b, L, GQA_Q_HEADS, GQA_HEAD), q_norm_w), row, col)
    k = _axial_rope(_rms_norm(k.reshape(b, L, GQA_KV_HEADS, GQA_HEAD), k_norm_w), row, col)
    v = v.reshape(b, L, GQA_KV_HEADS, GQA_HEAD)
    q = q.reshape(b, L, GQA_KV_HEADS, GQA_Q_HEADS // GQA_KV_HEADS, GQA_HEAD)
    scale = GQA_HEAD ** -0.5

    def attend(qb):
        s = jnp.einsum("bqgrd,bkgd->bgrqk", qb, k).astype(jnp.float32) * scale
        p = jax.nn.softmax(s, axis=-1).astype(v.dtype)
        return jnp.einsum("bgrqk,bkgd->bqgrd", p, v)

    o = _from_blocks(lax.map(attend, _to_blocks(q)))
    return o.reshape(b, L, BRANCH)


def setup_inputs(seed: int = 0) -> dict:
    key = jax.random.key(seed)
    ks = iter(jax.random.split(key, 32))
    nrm = lambda shape, s: jax.random.normal(next(ks), shape, jnp.float32) * s
    uni = lambda shape, lo, hi: jax.random.uniform(next(ks), shape, jnp.float32, lo, hi)
    n = DEPTH
    x = nrm((BATCH, SEQ, D_MODEL), 1.0)
    pre_norm_w = 1.0 + nrm((n, D_MODEL), 0.02)
    post_norm_w = 1.0 + nrm((n, D_MODEL), 0.02)
    w_in = nrm((n, D_MODEL, D_IN_PROJ), D_MODEL ** -0.5)
    w_out = nrm((n, D_MIX, D_MODEL), D_MIX ** -0.5)
    conv_w = nrm((n, D_CONV, SSM_CONV_CH), D_CONV ** -0.5)
    conv_b = nrm((n, SSM_CONV_CH), 0.01)
    ssm_a_log = jnp.log(uni((n, 2, SSM_HEADS), 1.0, 16.0))
    dt0 = jnp.exp(uni((n, 2, SSM_HEADS), math.log(1e-3), math.log(1e-1)))
    ssm_dt_bias = dt0 + jnp.log(-jnp.expm1(-dt0))
    ssm_d = 1.0 + nrm((n, SSM_HEADS), 0.02)
    ssm_norm_w = 1.0 + nrm((n, BRANCH), 0.02)
    rwkv_mu = uni((n, 2, RWKV_SHIFT_CH), 0.0, 1.0)
    rwkv_w0 = uni((n, 2, BRANCH), -5.0, 0.0)
    rwkv_w2 = nrm((n, 2, RWKV_RANK, BRANCH), 0.1)
    rwkv_a0 = nrm((n, BRANCH), 0.1)
    rwkv_a2 = nrm((n, RWKV_RANK, BRANCH), 0.1)
    rwkv_k_k = 0.85 + nrm((n, BRANCH), 0.02)
    rwkv_k_a = 1.0 + nrm((n, BRANCH), 0.02)
    rwkv_r_k = nrm((n, RWKV_HEADS, RWKV_HEAD), 0.1)
    rwkv_ln_w = 1.0 + nrm((n, BRANCH), 0.02)
    rwkv_ln_b = nrm((n, BRANCH), 0.01)
    diff_lambda = nrm((n, 4, DIFF_HEAD), 0.1)
    diff_norm_w = 1.0 + nrm((n, 2 * DIFF_HEAD), 0.02)
    gqa_q_norm_w = 1.0 + nrm((n, GQA_HEAD), 0.02)
    gqa_k_norm_w = 1.0 + nrm((n, GQA_HEAD), 0.02)
    return {"x": x, "pre_norm_w": pre_norm_w, "post_norm_w": post_norm_w, "w_in": w_in, "w_out": w_out,
            "conv_w": conv_w, "conv_b": conv_b, "ssm_a_log": ssm_a_log, "ssm_dt_bias": ssm_dt_bias,
            "ssm_d": ssm_d, "ssm_norm_w": ssm_norm_w, "rwkv_mu": rwkv_mu, "rwkv_w0": rwkv_w0,
            "rwkv_w2": rwkv_w2, "rwkv_a0": rwkv_a0, "rwkv_a2": rwkv_a2, "rwkv_k_k": rwkv_k_k,
            "rwkv_k_a": rwkv_k_a, "rwkv_r_k": rwkv_r_k, "rwkv_ln_w": rwkv_ln_w, "rwkv_ln_b": rwkv_ln_b,
            "diff_lambda": diff_lambda, "diff_norm_w": diff_norm_w, "gqa_q_norm_w": gqa_q_norm_w,
            "gqa_k_norm_w": gqa_k_norm_w}


def reference(x, pre_norm_w, post_norm_w, w_in, w_out, conv_w, conv_b, ssm_a_log, ssm_dt_bias, ssm_d,
              ssm_norm_w, rwkv_mu, rwkv_w0, rwkv_w2, rwkv_a0, rwkv_a2, rwkv_k_k, rwkv_k_a, rwkv_r_k,
              rwkv_ln_w, rwkv_ln_b, diff_lambda, diff_norm_w, gqa_q_norm_w, gqa_k_norm_w):
    L = x.shape[1]
    rows = L // GRID_W
    pos = jnp.arange(L, dtype=jnp.int32)
    row = jnp.repeat(jnp.arange(rows, dtype=jnp.int32), GRID_W)
    col = jnp.tile(jnp.arange(GRID_W, dtype=jnp.int32), rows)
    for i in range(DEPTH):
        lambda_init = 0.8 - 0.6 * math.exp(-0.3 * i)
        h = _rms_norm(x, pre_norm_w[i])
        proj = jnp.einsum("bld,de->ble", h, w_in[i])
        (m_z, m_xbc, m_dt, r_u, r_g, d_q, d_k, d_v, d_g, g_q, g_k, g_v, g_g) = _split(proj, PROJ_SIZES)
        y_a = _mamba_mixer(m_z, m_xbc, m_dt, conv_w[i], conv_b[i], ssm_a_log[i], ssm_dt_bias[i],
                           ssm_d[i], ssm_norm_w[i])
        y_b = _rwkv_mixer(r_u, rwkv_mu[i], rwkv_w0[i], rwkv_w2[i], rwkv_a0[i], rwkv_a2[i], rwkv_k_k[i],
                          rwkv_k_a[i], rwkv_r_k[i], rwkv_ln_w[i], rwkv_ln_b[i]) * jax.nn.silu(r_g)
        y_c = _diff_mixer(d_q, d_k, d_v, diff_lambda[i], diff_norm_w[i], pos, lambda_init) * jax.nn.silu(d_g)
        y_d = _gqa_mixer(g_q, g_k, g_v, gqa_q_norm_w[i], gqa_k_norm_w[i], row, col) * jax.nn.silu(g_g)
        mix = jnp.einsum("ble,ed->bld", jnp.concatenate([y_a, y_b, y_c, y_d], axis=-1), w_out[i])
        x = x + _rms_norm(mix, post_norm_w[i])
    return x
```

```cpp
#include <hip/hip_runtime.h>
#include <hip/hip_bf16.h>
#include <hip/hip_cooperative_groups.h>
#include <cstdio>
#include <cstdint>
namespace cg = cooperative_groups;

constexpr int M_TOK = 16384, SEQ = 8192, DMODEL = 1024, NPROJ = 7424, NPB = 58, DIN_ORIG = 7312, DMIX = 2048;
constexpr float NORM_EPS = 1e-6f;
constexpr size_t MiB = 1u << 20;
constexpr int PB_Z = 0, PB_RG = 4, PB_DQ = 8, PB_GQ = 12, PB_XS = 16, PB_BM = 20, PB_CM = 22, PB_R = 24, PB_K = 28, PB_V = 32, PB_WA = 36,
              PB_DK = 37, PB_DV = 41, PB_DG = 45, PB_GK = 49, PB_GV = 51, PB_GG = 53, PB_DT = 57;
constexpr size_t PBLK_ELEMS = (size_t)M_TOK * 128;
constexpr size_t SCR_WIN = 0, SCR_WOUT = 30 * MiB, SCR_ROPE = 38 * MiB, SCR_DT = 40 * MiB, SCR_RS = 41 * MiB, SCR_CTL = 41 * MiB + 512 * 1024,
                 SCR_XB = 42 * MiB, SCR_WKV = 74 * MiB, SCR_BON = 106 * MiB, SCR_SSDY = 138 * MiB, SCR_BYTES = 170 * MiB;
constexpr size_t WS_MIX = 16 * PBLK_ELEMS * 2;
__device__ __attribute__((aligned(256))) unsigned char g_scr[SCR_BYTES];

typedef unsigned short bf16_t;
typedef short bf16x8 __attribute__((ext_vector_type(8)));
typedef float f32x4 __attribute__((ext_vector_type(4)));
typedef unsigned u32x4 __attribute__((ext_vector_type(4)));
typedef unsigned u32x2 __attribute__((ext_vector_type(2)));

struct Params {
    const float* in[25];
    float* out;
    unsigned char* ws;
    int layer; int pad;
};

__device__ __forceinline__ float bf2f(bf16_t v) { return __uint_as_float(((unsigned)v) << 16); }
__device__ __forceinline__ bf16_t f2bf(float f) { unsigned u = __float_as_uint(f); return (bf16_t)((u + 0x7fffu + ((u >> 16) & 1u)) >> 16); }
__device__ __forceinline__ unsigned pk2(float lo, float hi) { return (unsigned)f2bf(lo) | ((unsigned)f2bf(hi) << 16); }
__device__ __forceinline__ float wave_sum(float v) {
#pragma unroll
    for (int o = 1; o < 64; o <<= 1) v += __shfl_xor(v, o);
    return v;
}
__device__ __forceinline__ float siluf(float x) { return x / (1.f + __expf(-x)); }
__device__ __forceinline__ float softplusf(float x) { return fmaxf(x, 0.f) + log1pf(__expf(-fabsf(x))); }
__device__ __forceinline__ bf16_t* pblk(unsigned char* ws, int j) { return (bf16_t*)ws + (size_t)j * PBLK_ELEMS; }

namespace pg8 {
#define PG8_LAS __attribute__((address_space(3)))
constexpr int BM = 256, BK = 64, HALF = 128, HTB = HALF * BK * 2, STAGE_BYTES = 8 * HTB, NXCD = 8, WGM = 8;
__host__ __device__ __forceinline__ int lds_byte(int r, int c) { const int st = (r >> 4) * 2 + (c >> 5), rr = r & 15, cc = c & 31, ob = rr * 64 + cc * 2; return st * 1024 + (ob ^ (((ob >> 9) & 1) << 5)); }
__host__ __device__ __forceinline__ void stage_rc(int b, int& R, int& C) { const int st = b / 1024, sb = b % 1024, swz = sb ^ (((sb >> 9) & 1) << 5); R = (st >> 1) * 16 + swz / 64; C = (st & 1) * 32 + (swz % 64) / 2; }
__host__ __device__ __forceinline__ int perm32(int rho) { const int n = rho >> 4, i = rho & 15; return 8 * (i >> 2) + 4 * n + (i & 3); }
struct Unit { int pm, pn; };
struct Gemm { const bf16_t* A; const bf16_t* Bt; int M, N, K; int lda; size_t abig; };
struct StaticOrder {
    int nM, nN, nwg, G, c;
    __host__ __device__ void init(int M, int N, int G_, int c_) { nM = M / BM; nN = N / BM; nwg = nM * nN; G = G_; c = c_; }
    __host__ __device__ bool next(int i, Unit& u) const {
        const long L = (long)i * G + c; if (L >= nwg) return false;
        int wgid = (int)L; { const int q = nwg / NXCD, r = nwg % NXCD, xcd = wgid % NXCD, off = wgid / NXCD; wgid = (xcd < r ? xcd * (q + 1) : r * (q + 1) + (xcd - r) * q) + off; }
        const int nig = WGM * nN, gid = wgid / nig, fm = gid * WGM, gsz = (nM - fm) < WGM ? (nM - fm) : WGM;
        u.pm = fm + ((wgid % nig) % gsz); u.pn = (wgid % nig) / gsz; return true;
    }
};
template <class Epi, class Sched, bool ALIGN_EPI = false, bool SP2 = false>
__device__ __forceinline__ void gemm_phase(PG8_LAS unsigned char* lds, const Gemm g, const Sched& S, const Epi& E) {
    const int tid = threadIdx.x, wid = __builtin_amdgcn_readfirstlane(tid >> 6), lane = tid & 63, wr = wid >> 2, wc = wid & 3, fr = lane & 15, fq = lane >> 4;
    const int K = g.K, nt = K / BK;
    unsigned voffA[2], voffB[2];
#pragma unroll
    for (int i = 0; i < 2; ++i) { int R, C; stage_rc(tid * 16 + i * 8192, R, C); const int Rb = Epi::PERM ? ((R & ~31) + perm32(R & 31)) : R;
        voffA[i] = (unsigned)(R * g.lda + C) * 2u; voffB[i] = (unsigned)(Rb * K + C) * 2u; }
    const size_t kstep = (size_t)(BK * 2);
    const size_t abig = g.abig * 2;
    const size_t hstepA = (size_t)HALF * g.lda * 2, hstepB = (size_t)HALF * K * 2;
    const size_t tstepA = 2 * hstepA, tstepB = 2 * hstepB;
    const unsigned ldsw = (unsigned)wid * 1024u;
    const int aoff = lds_byte(wr * 64 + fr, fq * 8), boff = lds_byte(wc * 32 + fr, fq * 8);
#define PG8_SA(b, h) (((b) * 2 + (h)) * HTB)
#define PG8_SB(b, h) ((4 + (b) * 2 + (h)) * HTB)
#define PG8_STAGE(bufoff, gbase, voff) do { _Pragma("unroll") for (int _i = 0; _i < 2; ++_i) \
        __builtin_amdgcn_global_load_lds((const unsigned*)((const char*)(gbase) + (voff)[_i]), (PG8_LAS unsigned*)(lds + (bufoff) + ldsw + _i * 8192), 16, 0, 0); } while (0)
#define PG8_LDA(dst, b, h) do { _Pragma("unroll") for (int m = 0; m < 4; ++m) _Pragma("unroll") for (int k = 0; k < 2; ++k) dst[m][k] = *(const PG8_LAS bf16x8*)(lds + PG8_SA(b, h) + aoff + m * 2048 + k * 1024); } while (0)
#define PG8_LDB(dst, b, h) do { _Pragma("unroll") for (int n = 0; n < 2; ++n) _Pragma("unroll") for (int k = 0; k < 2; ++k) dst[n][k] = *(const PG8_LAS bf16x8*)(lds + PG8_SB(b, h) + boff + n * 2048 + k * 1024); } while (0)
#define PG8_MMA(ai, bj, At, Bt) do { __builtin_amdgcn_s_setprio(1); _Pragma("unroll") for (int m = 0; m < 4; ++m) _Pragma("unroll") for (int n = 0; n < 2; ++n) _Pragma("unroll") for (int k = 0; k < 2; ++k) \
        acc[ai][bj][m][n] = __builtin_amdgcn_mfma_f32_16x16x32_bf16(Bt[n][k], At[m][k], acc[ai][bj][m][n], 0, 0, 0); __builtin_amdgcn_s_setprio(0); } while (0)
#define PG8_WAIT_V(n) asm volatile("s_waitcnt vmcnt(" #n ")" ::: "memory")
#define PG8_WAIT_L(n) asm volatile("s_waitcnt lgkmcnt(" #n ")" ::: "memory")
#define PG8_BAR __builtin_amdgcn_s_barrier()
#define PG8_SCHED __builtin_amdgcn_sched_barrier(0)
    Unit cur, nxt; int ui = 0;
    if (!S.next(0, cur)) return;
    f32x4 acc[2][2][4][2];
#pragma unroll
    for (int a = 0; a < 2; ++a)
#pragma unroll
        for (int b = 0; b < 2; ++b)
#pragma unroll
            for (int m = 0; m < 4; ++m)
#pragma unroll
                for (int n = 0; n < 2; ++n) acc[a][b][m][n] = (f32x4){0.f, 0.f, 0.f, 0.f};
    bf16x8 At[4][2], B0[2][2], B1[2][2];
    const char* cA = (const char*)g.A + (size_t)cur.pm * tstepA; const char* cB = (const char*)g.Bt + (size_t)cur.pn * tstepB;
    if constexpr (SP2) {
        PG8_STAGE(PG8_SB(0, 0), cB, voffB); PG8_STAGE(PG8_SB(0, 1), cB + hstepB, voffB); PG8_STAGE(PG8_SA(0, 0), cA, voffA); PG8_STAGE(PG8_SA(0, 1), cA + hstepA, voffA);
        if (wr == 1) PG8_BAR;
        PG8_WAIT_V(2); PG8_BAR;
        PG8_STAGE(PG8_SB(1, 0), cB + kstep, voffB); PG8_STAGE(PG8_SA(1, 0), cA + kstep, voffA); PG8_STAGE(PG8_SB(1, 1), cB + hstepB + kstep, voffB);
        PG8_WAIT_V(6); PG8_BAR;
    } else {
        PG8_STAGE(PG8_SB(0, 0), cB, voffB); PG8_STAGE(PG8_SA(0, 0), cA, voffA); PG8_STAGE(PG8_SB(0, 1), cB + hstepB, voffB); PG8_STAGE(PG8_SA(0, 1), cA + hstepA, voffA);
        if (wr == 1) PG8_BAR;
        PG8_WAIT_V(4); PG8_BAR;
        PG8_STAGE(PG8_SB(1, 0), cB + kstep, voffB); PG8_STAGE(PG8_SA(1, 0), cA + kstep, voffA); PG8_STAGE(PG8_SB(1, 1), cB + hstepB + kstep, voffB);
        PG8_WAIT_V(6); PG8_BAR;
    }
    for (;;) {
        const bool has_next = S.next(ui + 1, nxt);
        const char* nA = has_next ? (const char*)g.A + (size_t)nxt.pm * tstepA : cA; const char* nB = has_next ? (const char*)g.Bt + (size_t)nxt.pn * tstepB : cB;
        for (int t = 0; t < nt; t += 2) {
            const bool last = (t == nt - 2);
            const char* a1 = cA + (size_t)(t >> 1) * abig + kstep;
            const char* a2 = last ? nA : cA + (size_t)((t >> 1) + 1) * abig; const char* b2 = last ? nB : cB + (size_t)(t + 2) * kstep;
            const char* a3 = a2 + kstep; const char* b3 = b2 + kstep;
            if constexpr (SP2) {
            PG8_LDB(B0, 0, 0); PG8_LDB(B1, 0, 1); PG8_SCHED; PG8_LDA(At, 0, 0); PG8_STAGE(PG8_SA(1, 1), a1 + hstepA, voffA);
            PG8_WAIT_V(8); PG8_WAIT_L(0); PG8_BAR; PG8_MMA(0, 0, At, B0); PG8_MMA(0, 1, At, B1); PG8_BAR; PG8_SCHED;
            PG8_LDA(At, 0, 1); PG8_STAGE(PG8_SB(0, 0), b2, voffB); PG8_STAGE(PG8_SB(0, 1), b2 + hstepB, voffB); PG8_STAGE(PG8_SA(0, 0), a2, voffA);
            PG8_WAIT_V(8); PG8_WAIT_L(0); PG8_BAR; PG8_MMA(1, 0, At, B0); PG8_MMA(1, 1, At, B1); PG8_BAR; PG8_SCHED;
            PG8_LDB(B0, 1, 0); PG8_LDB(B1, 1, 1); PG8_SCHED; PG8_LDA(At, 1, 0); PG8_STAGE(PG8_SA(0, 1), a2 + hstepA, voffA);
            PG8_WAIT_V(8); PG8_WAIT_L(0); PG8_BAR; PG8_MMA(0, 0, At, B0); PG8_MMA(0, 1, At, B1); PG8_BAR; PG8_SCHED;
            PG8_LDA(At, 1, 1); PG8_STAGE(PG8_SB(1, 0), b3, voffB); PG8_STAGE(PG8_SB(1, 1), b3 + hstepB, voffB); PG8_STAGE(PG8_SA(1, 0), a3, voffA);
            PG8_WAIT_V(8); PG8_WAIT_L(0); PG8_BAR; PG8_MMA(1, 0, At, B0); PG8_MMA(1, 1, At, B1); PG8_BAR; PG8_SCHED;
            } else {
            PG8_LDB(B0, 0, 0); PG8_SCHED; PG8_LDA(At, 0, 0); PG8_STAGE(PG8_SA(1, 1), a1 + hstepA, voffA);
            PG8_WAIT_L(8); PG8_BAR; PG8_WAIT_L(0); PG8_MMA(0, 0, At, B0); PG8_BAR; PG8_SCHED;
            PG8_LDB(B1, 0, 1); PG8_STAGE(PG8_SB(0, 0), b2, voffB);
            PG8_BAR; PG8_WAIT_L(0); PG8_MMA(0, 1, At, B1); PG8_BAR;
            PG8_LDA(At, 0, 1); PG8_STAGE(PG8_SA(0, 0), a2, voffA);
            PG8_BAR; PG8_WAIT_L(0); PG8_MMA(1, 0, At, B0); PG8_BAR; PG8_SCHED;
            PG8_STAGE(PG8_SB(0, 1), b2 + hstepB, voffB);
            PG8_WAIT_V(6); PG8_BAR; PG8_MMA(1, 1, At, B1); PG8_BAR;
            PG8_LDB(B0, 1, 0); PG8_SCHED; PG8_LDA(At, 1, 0); PG8_STAGE(PG8_SA(0, 1), a2 + hstepA, voffA);
            PG8_WAIT_L(8); PG8_BAR; PG8_WAIT_L(0); PG8_MMA(0, 0, At, B0); PG8_BAR; PG8_SCHED;
            PG8_LDB(B1, 1, 1); PG8_STAGE(PG8_SB(1, 0), b3, voffB);
            PG8_BAR; PG8_WAIT_L(0); PG8_MMA(0, 1, At, B1); PG8_BAR;
            PG8_LDA(At, 1, 1); PG8_STAGE(PG8_SA(1, 0), a3, voffA);
            PG8_BAR; PG8_WAIT_L(0); PG8_MMA(1, 0, At, B0); PG8_BAR; PG8_SCHED;
            PG8_STAGE(PG8_SB(1, 1), b3 + hstepB, voffB);
            PG8_WAIT_V(6); PG8_BAR; PG8_MMA(1, 1, At, B1); PG8_BAR;
            }
        }
        if constexpr (ALIGN_EPI) { if (wr == 0) PG8_BAR; }
        E(acc, cur, wr, wc, fr, fq);
        if (!has_next) break;
#pragma unroll
        for (int a = 0; a < 2; ++a)
#pragma unroll
            for (int b = 0; b < 2; ++b)
#pragma unroll
                for (int m = 0; m < 4; ++m)
#pragma unroll
                    for (int n = 0; n < 2; ++n) acc[a][b][m][n] = (f32x4){0.f, 0.f, 0.f, 0.f};
        cur = nxt; cA = nA; cB = nB; ++ui;
        if constexpr (ALIGN_EPI) { if (wr == 1) PG8_BAR; }
    }
    PG8_WAIT_V(0);
    if constexpr (!ALIGN_EPI) { if (wr == 0) PG8_BAR; }
    PG8_BAR;
#undef PG8_SA
#undef PG8_SB
#undef PG8_STAGE
#undef PG8_LDA
#undef PG8_LDB
#undef PG8_MMA
#undef PG8_WAIT_V
#undef PG8_WAIT_L
#undef PG8_BAR
#undef PG8_SCHED
}
struct EpiProj {
    static constexpr bool PERM = true;
    bf16_t* P; const float* rowscale; float* dtbuf;
    __device__ __forceinline__ void operator()(const f32x4 (&acc)[2][2][4][2], const Unit& u, int wr, int wc, int fr, int fq) const {
        const int row0 = u.pm * BM + wr * 64 + fr; const int col = wc * 32 + 8 * fq;
#pragma unroll
        for (int ai = 0; ai < 2; ++ai)
#pragma unroll
            for (int m = 0; m < 4; ++m) { const int row = row0 + ai * HALF + m * 16; const float sc = rowscale[row];
#pragma unroll
                for (int bj = 0; bj < 2; ++bj) { const int blk = u.pn * 2 + bj;
                    const f32x4 v0 = acc[ai][bj][m][0] * sc, v1 = acc[ai][bj][m][1] * sc;
                    u32x4 w; w.x = pk2(v0[0], v0[1]); w.y = pk2(v0[2], v0[3]); w.z = pk2(v1[0], v1[1]); w.w = pk2(v1[2], v1[3]);
                    *(u32x4*)(P + (size_t)blk * PBLK_ELEMS + (size_t)row * 128 + col) = w;
                    if (blk == PB_DT && col < 16) { float* d = dtbuf + (size_t)row * 16 + col; *(f32x4*)d = v0; *(f32x4*)(d + 4) = v1; } } }
    }
};
struct EpiMix {
    static constexpr bool PERM = true;
    float* O;
    __device__ __forceinline__ void operator()(const f32x4 (&acc)[2][2][4][2], const Unit& u, int wr, int wc, int fr, int fq) const {
        const int row0 = u.pm * BM + wr * 64 + fr; const int col0 = u.pn * BM + wc * 32 + 8 * fq;
#pragma unroll
        for (int ai = 0; ai < 2; ++ai)
#pragma unroll
            for (int m = 0; m < 4; ++m) { float* rp = O + (size_t)(row0 + ai * HALF + m * 16) * DMODEL + col0;
#pragma unroll
                for (int bj = 0; bj < 2; ++bj) { *(f32x4*)(rp + bj * HALF) = acc[ai][bj][m][0]; *(f32x4*)(rp + bj * HALF + 4) = acc[ai][bj][m][1]; } }
    }
};
}

__device__ __forceinline__ int orig_col(int n) {
    if (n < 512) return n;
    if (n < 1024) return 3216 + (n - 512);
    if (n < 1536) return 3728 + (n - 1024);
    if (n < 2048) return 5776 + (n - 1536);
    if (n < 3072) return 512 + (n - 2048);
    if (n < 4736) return 1552 + (n - 3072);
    if (n < 5248) return 4240 + (n - 4736);
    if (n < 5760) return 4752 + (n - 5248);
    if (n < 6272) return 5264 + (n - 5760);
    if (n < 6528) return 6288 + (n - 6272);
    if (n < 6784) return 6544 + (n - 6528);
    if (n < 7296) return 6800 + (n - 6784);
    if (n < 7312) return 1536 + (n - 7296);
    return -1;
}
template <bool MAPCOL>
__device__ __forceinline__ void transpose_item(const float* W, int K, int Nsrc, const float* ks, bf16_t* WT, float* scr  , int kb, int nb) {
    const int tid = threadIdx.x; const int k0 = kb * 64, n0 = nb * 64;
    {   const int nn = tid & 63; const int n = n0 + nn; const int oc = MAPCOL ? orig_col(n) : n;
#pragma unroll
        for (int i = 0; i < 8; ++i) { const int kk = (tid >> 6) + 8 * i; float v = 0.f; if (oc >= 0) v = W[(size_t)(k0 + kk) * Nsrc + oc] * (ks ? ks[k0 + kk] : 1.f); scr[kk * 65 + nn] = v; } }
    __syncthreads();
    {   const int n = tid >> 3, c = tid & 7; const float* s = scr + (8 * c) * 65 + n;
        u32x4 o; o.x = pk2(s[0], s[65]); o.y = pk2(s[2 * 65], s[3 * 65]); o.z = pk2(s[4 * 65], s[5 * 65]); o.w = pk2(s[6 * 65], s[7 * 65]);
        *(u32x4*)(WT + (size_t)(n0 + n) * K + k0 + 8 * c) = o; }
    __syncthreads();
}
__device__ __forceinline__ void rope_entry(int idx, float* tab) {
    const int pos = idx >> 5, i = idx & 31;
    const float inv = exp2f(-(float)i * (13.287712379549449f / 32.f));
    const float ang = (float)pos * inv;
    const double rev = (double)ang * 0.15915494309189535; const double fr = rev - floor(rev);
    const float a = (float)(fr * 6.283185307179586);
    tab[idx * 2] = cosf(a); tab[idx * 2 + 1] = sinf(a);
}
__device__ __forceinline__ void xrow_to_bf16(const float* xrow, bf16_t* orow, float* rs, int lane) {
    const f32x4* xr = (const f32x4*)xrow + lane; f32x4 v[4]; float s = 0.f;
#pragma unroll
    for (int j = 0; j < 4; ++j) { v[j] = xr[64 * j]; s += (v[j].x * v[j].x + v[j].y * v[j].y) + (v[j].z * v[j].z + v[j].w * v[j].w); }
    s = wave_sum(s);
    if (lane == 0) *rs = rsqrtf(s * (1.f / DMODEL) + NORM_EPS);
    u32x2* o8 = (u32x2*)orow + lane;
#pragma unroll
    for (int j = 0; j < 4; ++j) { u32x2 w; w.x = pk2(v[j].x, v[j].y); w.y = pk2(v[j].z, v[j].w); o8[64 * j] = w; }
}
__device__ __forceinline__ void phase_prologue(const Params& p, float* lds_f) {
    const int G = gridDim.x, bid = blockIdx.x, tid = threadIdx.x, lane = tid & 63, wave = tid >> 6;
    constexpr int I_IN = 16 * 116, I_OUT = 32 * 16;
    for (int it = bid; it < 2 * (I_IN + I_OUT); it += G) {
        int r = it; const int l = r / (I_IN + I_OUT); r -= l * (I_IN + I_OUT);
        if (r < I_IN) transpose_item<true>(p.in[3] + (size_t)l * DMODEL * DIN_ORIG, DMODEL, DIN_ORIG, p.in[1] + l * DMODEL, (bf16_t*)(g_scr + SCR_WIN + (size_t)l * 15 * MiB), lds_f, r / 116, r % 116);
        else { r -= I_IN; transpose_item<false>(p.in[4] + (size_t)l * DMIX * DMODEL, DMIX, DMODEL, nullptr, (bf16_t*)(g_scr + SCR_WOUT + (size_t)l * 4 * MiB), lds_f, r / 16, r % 16); }
    }
    for (int i = bid * 512 + tid; i < SEQ * 32; i += G * 512) rope_entry(i, (float*)(g_scr + SCR_ROPE));
    for (int m = bid * 8 + wave; m < M_TOK; m += G * 8) xrow_to_bf16(p.in[0] + (size_t)m * DMODEL, (bf16_t*)(g_scr + SCR_XB) + (size_t)m * DMODEL, (float*)(g_scr + SCR_RS) + m, lane);
}

__device__ __forceinline__ void phase_prep(const Params& p) {
    const int G = gridDim.x, tid = threadIdx.x, lane = tid & 63, wave = tid >> 6; const int l = p.layer;
    const float* tab = (const float*)(g_scr + SCR_ROPE);
    const float* qw = p.in[23] + l * 128; const float* kw = p.in[24] + l * 128;
    const int i32 = lane & 31; const bool lo = (lane & 32) == 0;
    for (int m = blockIdx.x * 8 + wave; m < M_TOK; m += G * 8) {
        const int t = m & (SEQ - 1);
        {   const float cs = tab[(t * 32 + i32) * 2], sn = tab[(t * 32 + i32) * 2 + 1];
#pragma unroll
            for (int h = 0; h < 8; ++h) { bf16_t* base = pblk(p.ws, (h < 4 ? PB_DQ + h : PB_DK + (h - 4))) + (size_t)m * 128;
#pragma unroll
                for (int c = 0; c < 2; ++c) { const float x = bf2f(base[c * 64 + lane]); const float o = __shfl_xor(x, 32);
                    const float r = lo ? (x * cs - o * sn) : (x * cs + o * sn); base[c * 64 + lane] = f2bf(r); } } }
        {   const int row = t >> 6, col = t & 63;
            const float cr = tab[(row * 32 + i32) * 2], sr = tab[(row * 32 + i32) * 2 + 1], cc = tab[(col * 32 + i32) * 2], sc = tab[(col * 32 + i32) * 2 + 1];
#pragma unroll
            for (int h = 0; h < 6; ++h) { bf16_t* base = pblk(p.ws, (h < 4 ? PB_GQ + h : PB_GK + (h - 4))) + (size_t)m * 128; const float* w = h < 4 ? qw : kw;
                float x0 = bf2f(base[lane]), x1 = bf2f(base[64 + lane]);
                const float ss = wave_sum(x0 * x0 + x1 * x1); const float rs = rsqrtf(ss * (1.f / 128.f) + NORM_EPS);
                x0 *= rs * w[lane]; x1 *= rs * w[64 + lane];
                const float o0 = __shfl_xor(x0, 32), o1 = __shfl_xor(x1, 32);
                const float r0 = lo ? (x0 * cr - o0 * sr) : (x0 * cr + o0 * sr);
                const float r1 = lo ? (x1 * cc - o1 * sc) : (x1 * cc + o1 * sc);
                base[lane] = f2bf(r0); base[64 + lane] = f2bf(r1); } }
    }
}

namespace att {
using s16x4 = __attribute__((ext_vector_type(4))) short;
using f32x16 = __attribute__((ext_vector_type(16))) float;
constexpr int D = 128, NW = 8, QBLK = 32, KVBLK = 64, LD = 128;
constexpr float THR = 8.f;
constexpr size_t SHM_V = KVBLK * D * 2, SHM_K = KVBLK * D * 2, SHM_ATTN = 2 * SHM_V + 2 * SHM_K + NW * 64 * 4;
#define KSWZ(row, colB) ((row) * 256 + ((colB) ^ (((row) & 7) << 4)))
#define SBAR() __builtin_amdgcn_sched_barrier(0)
__device__ __forceinline__ int crow(int r, int hi) { return (r & 3) + 8 * (r >> 2) + 4 * hi; }
__device__ __forceinline__ unsigned cvtpk(float lo, float hi) { unsigned r; asm volatile("v_cvt_pk_bf16_f32 %0, %1, %2" : "=v"(r) : "v"(lo), "v"(hi)); return r; }
template <int DIFF>
__device__ __forceinline__ void partialSM(f32x16& p0, f32x16& p1, float& m_reg, float& mn, float& alpha) {
  constexpr float SCALE = DIFF ? 0.125f : 0.088388347648318440f;
  constexpr float C = SCALE * 1.4426950408889634f;
  float pmax = p0[0]; for (int r = 1; r < 16; ++r) pmax = fmaxf(pmax, p0[r]); for (int r = 0; r < 16; ++r) pmax = fmaxf(pmax, p1[r]);
  { auto rr = __builtin_amdgcn_permlane32_swap(__float_as_uint(pmax), __float_as_uint(pmax), false, false);
    pmax = fmaxf(__uint_as_float(rr[0]), __uint_as_float(rr[1])); }
  if (__builtin_expect(__all(pmax - m_reg <= THR / SCALE), 1)) { mn = m_reg; alpha = 1.f; }
  else { mn = fmaxf(m_reg, pmax); alpha = __builtin_amdgcn_exp2f((m_reg - mn) * C); m_reg = mn; }
  float mnC = -mn * C;
  for (int r = 0; r < 16; ++r) p0[r] = fmaf(p0[r], C, mnC); for (int r = 0; r < 16; ++r) p1[r] = fmaf(p1[r], C, mnC);
  for (int r = 0; r < 16; ++r) p0[r] = __builtin_amdgcn_exp2f(p0[r]);
}
__device__ __forceinline__ void finishSM(f32x16& p0, f32x16& p1, float alpha, float& l_reg, bf16x8& pa0, bf16x8& pa1, bf16x8& pa2, bf16x8& pa3) {
  for (int r = 0; r < 16; ++r) p1[r] = __builtin_amdgcn_exp2f(p1[r]);
  float ps = 0; for (int r = 0; r < 16; ++r) ps += p0[r]; for (int r = 0; r < 16; ++r) ps += p1[r];
  { auto rr = __builtin_amdgcn_permlane32_swap(__float_as_uint(ps), __float_as_uint(ps), false, false);
    ps = __uint_as_float(rr[0]) + __uint_as_float(rr[1]); }
  l_reg = l_reg * alpha + ps;
#define PK4(P, BASE, OUT) do { unsigned a0 = cvtpk(P[BASE + 0], P[BASE + 1]), a1 = cvtpk(P[BASE + 2], P[BASE + 3]);   \
    unsigned b0 = cvtpk(P[BASE + 4], P[BASE + 5]), b1 = cvtpk(P[BASE + 6], P[BASE + 7]);                              \
    auto r0 = __builtin_amdgcn_permlane32_swap(a0, b0, false, false); auto r1 = __builtin_amdgcn_permlane32_swap(a1, b1, false, false); \
    u32x4 w = {r0[0], r1[0], r0[1], r1[1]}; OUT = *reinterpret_cast<bf16x8*>(&w); } while (0)
  PK4(p0, 0, pa0); PK4(p0, 8, pa1); PK4(p1, 0, pa2); PK4(p1, 8, pa3);
#undef PK4
}
template <int ND0>
__device__ __forceinline__ void qkt(f32x16& p0, f32x16& p1, const bf16_t* Ks, const bf16x8* qr, int r32, int hi, int db0) {
  p0 = f32x16{}; p1 = f32x16{};
#pragma unroll
  for (int d0 = 0; d0 < ND0; ++d0) { int cb = ((db0 + d0) * 16 + hi * 8) * 2;
    bf16x8 b0 = *reinterpret_cast<const bf16x8*>((const char*)Ks + KSWZ(r32, cb));
    bf16x8 b1 = *reinterpret_cast<const bf16x8*>((const char*)Ks + KSWZ(32 + r32, cb));
    p0 = __builtin_amdgcn_mfma_f32_32x32x16_bf16(b0, qr[d0], p0, 0, 0, 0);
    p1 = __builtin_amdgcn_mfma_f32_32x32x16_bf16(b1, qr[d0], p1, 0, 0, 0); }
}
__device__ __forceinline__ int v_st(int k, int c) { const int kk = (k & ~0xC) | ((k & 4) << 1) | ((k & 8) >> 1); return ((kk >> 3) * 4 + (c >> 5)) * 512 + ((kk & 7) * 32 + (c & 31)) * 2; }
__device__ __forceinline__ int v_rd_base(int lane) { return ((lane & 3) << 3) | (((lane >> 2) & 3) << 6) | (((lane >> 4) & 1) << 5) | (((lane >> 5) & 1) << 8); }
constexpr int v_rd_off(int d0, int ks, int half) { return d0 * 512 + ks * 4096 + half * 2048; }
template <int OFF> __device__ __forceinline__ s16x4 tr_read(int vb) {
  s16x4 r; asm volatile("ds_read_b64_tr_b16 %0, %1 offset:%2" : "=&v"(r) : "v"(vb), "i"(OFF) : "memory"); return r;
}
template <int D0> __device__ __forceinline__ void pv_one(f32x16& od, int vb, bf16x8 pa0, bf16x8 pa1, bf16x8 pa2, bf16x8 pa3) {
  const s16x4 l0 = tr_read<v_rd_off(D0, 0, 0)>(vb), h0 = tr_read<v_rd_off(D0, 0, 1)>(vb), l1 = tr_read<v_rd_off(D0, 1, 0)>(vb), h1 = tr_read<v_rd_off(D0, 1, 1)>(vb);
  const s16x4 l2 = tr_read<v_rd_off(D0, 2, 0)>(vb), h2 = tr_read<v_rd_off(D0, 2, 1)>(vb), l3 = tr_read<v_rd_off(D0, 3, 0)>(vb), h3 = tr_read<v_rd_off(D0, 3, 1)>(vb);
  asm volatile("s_waitcnt lgkmcnt(0)" ::: "memory"); SBAR();
#define PK(L, H) (bf16x8){L[0], L[1], L[2], L[3], H[0], H[1], H[2], H[3]}
  od = __builtin_amdgcn_mfma_f32_32x32x16_bf16(pa0, PK(l0, h0), od, 0, 0, 0);
  od = __builtin_amdgcn_mfma_f32_32x32x16_bf16(pa1, PK(l1, h1), od, 0, 0, 0);
  od = __builtin_amdgcn_mfma_f32_32x32x16_bf16(pa2, PK(l2, h2), od, 0, 0, 0);
  od = __builtin_amdgcn_mfma_f32_32x32x16_bf16(pa3, PK(l3, h3), od, 0, 0, 0);
#undef PK
}
__device__ __forceinline__ void pv_d0(f32x16* o, int vb, bf16x8 pa0, bf16x8 pa1, bf16x8 pa2, bf16x8 pa3) {
  pv_one<0>(o[0], vb, pa0, pa1, pa2, pa3); pv_one<1>(o[1], vb, pa0, pa1, pa2, pa3); pv_one<2>(o[2], vb, pa0, pa1, pa2, pa3); pv_one<3>(o[3], vb, pa0, pa1, pa2, pa3);
}
template <int DIFF>
__device__ __forceinline__ void attn_unit(const bf16_t* Qb, const bf16_t* __restrict__ Kh, const bf16_t* __restrict__ Vh, bf16_t* Ob, const bf16_t* gate,
                                          int seq, char* lds, float lam, float osc, const float* nw) {
  constexpr int ND0 = DIFF ? 4 : 8;
  const int tid = threadIdx.x, wid = tid >> 6, lane = tid & 63, r32 = lane & 31, hi = lane >> 5;
  const int wq = DIFF ? (wid & 3) : wid, mapc = DIFF ? (wid >> 2) : 0;
  bf16_t* V_lds = (bf16_t*)lds; bf16_t* K_lds = (bf16_t*)(lds + 2 * SHM_V);
  float* ws = (float*)(lds + 2 * SHM_V + 2 * SHM_K) + wid * 64; float* li_l = ws; float* al_l = ws + 32;
  float m_reg = -1e30f, l_reg = 0; f32x16 o[4] = {}; bf16x8 qr[ND0];
  const bf16_t* Qw = Qb + (long)(wq * QBLK + r32) * LD + mapc * 64 + hi * 8;
#pragma unroll
  for (int d0 = 0; d0 < ND0; ++d0) qr[d0] = *reinterpret_cast<const bf16x8*>(Qw + d0 * 16);
  const int sr = tid >> 4, sc = (tid & 15) * 8, vst0 = v_st(sr, sc), vst1 = v_st(32 + sr, sc);
  const int vb0 = (int)(uintptr_t)V_lds + v_rd_base(lane);
  struct { bf16x8 vs0, vs1, ks0, ks1; } sr_[2];
#define SLOAD(i, k0) do { sr_[i].vs0 = *reinterpret_cast<const bf16x8*>(&Vh[(long)((k0) + sr) * LD + sc]); sr_[i].vs1 = *reinterpret_cast<const bf16x8*>(&Vh[(long)((k0) + 32 + sr) * LD + sc]); \
    sr_[i].ks0 = *reinterpret_cast<const bf16x8*>(&Kh[(long)((k0) + sr) * LD + sc]); sr_[i].ks1 = *reinterpret_cast<const bf16x8*>(&Kh[(long)((k0) + 32 + sr) * LD + sc]); } while (0)
#define SWRITE(b, i) do { *(bf16x8*)((char*)V_lds + (b) * SHM_V + vst0) = sr_[i].vs0;          \
    *(bf16x8*)((char*)V_lds + (b) * SHM_V + vst1) = sr_[i].vs1; int kc = sc * 2;               \
    *(bf16x8*)((char*)K_lds + (b) * SHM_K + KSWZ(sr, kc)) = sr_[i].ks0;                       \
    *(bf16x8*)((char*)K_lds + (b) * SHM_K + KSWZ(32 + sr, kc)) = sr_[i].ks1; } while (0)
#define SWAIT() asm volatile("s_waitcnt vmcnt(4)" ::: "memory")
#define RESC(a) do { if (__any((a) < 1.f)) { if (hi == 0) al_l[r32] = (a); asm volatile("s_waitcnt lgkmcnt(0)" ::: "memory"); \
    for (int d = 0; d < 4; ++d) for (int r = 0; r < 16; ++r) o[d][r] *= al_l[crow(r, hi)]; } } while (0)
  f32x16 pA0, pA1, pB0, pB1; float mnA, mnB, alA, alB; bf16x8 pa0, pa1, pa2, pa3; int NT = seq / KVBLK; asm volatile("" : "+s"(NT));
  constexpr int SE = 0, SO = 1;
  SLOAD(SE, 0); asm volatile("s_waitcnt vmcnt(0)" ::: "memory"); SWRITE(0, SE); __syncthreads();
  qkt<ND0>(pA0, pA1, K_lds, qr, r32, hi, mapc * 4); partialSM<DIFF>(pA0, pA1, m_reg, mnA, alA);
  SLOAD(SO, KVBLK); if (2 < NT) SLOAD(SE, 2 * KVBLK);
  SWAIT(); SWRITE(1, SO); __syncthreads();
  for (int j = 1; j + 1 < NT; j += 2) {
    SBAR(); qkt<ND0>(pB0, pB1, (bf16_t*)((char*)K_lds + SHM_K), qr, r32, hi, mapc * 4);
    finishSM(pA0, pA1, alA, l_reg, pa0, pa1, pa2, pa3); SBAR();
    SLOAD(SO, (j + 2) * KVBLK); SBAR();
    pv_d0(o, vb0, pa0, pa1, pa2, pa3); partialSM<DIFF>(pB0, pB1, m_reg, mnB, alB);
    __syncthreads(); SWAIT(); SWRITE(0, SE);
    RESC(alB); __syncthreads();
    SBAR(); qkt<ND0>(pA0, pA1, K_lds, qr, r32, hi, mapc * 4);
    finishSM(pB0, pB1, alB, l_reg, pa0, pa1, pa2, pa3); SBAR();
    if (j + 3 < NT) SLOAD(SE, (j + 3) * KVBLK); SBAR();
    pv_d0(o, vb0 + (int)SHM_V, pa0, pa1, pa2, pa3); partialSM<DIFF>(pA0, pA1, m_reg, mnA, alA);
    __syncthreads(); SWAIT(); SWRITE(1, SO);
    RESC(alA); __syncthreads();
  }
  SBAR(); qkt<ND0>(pB0, pB1, (bf16_t*)((char*)K_lds + SHM_K), qr, r32, hi, mapc * 4);
  finishSM(pA0, pA1, alA, l_reg, pa0, pa1, pa2, pa3); SBAR();
  pv_d0(o, vb0, pa0, pa1, pa2, pa3); partialSM<DIFF>(pB0, pB1, m_reg, mnB, alB);
  __syncthreads(); RESC(alB);
  finishSM(pB0, pB1, alB, l_reg, pa0, pa1, pa2, pa3); SBAR();
  pv_d0(o, vb0 + (int)SHM_V, pa0, pa1, pa2, pa3);
  if (hi == 0) li_l[r32] = l_reg; asm volatile("s_waitcnt lgkmcnt(0)" ::: "memory");
  float rli[16];
#pragma unroll
  for (int r = 0; r < 16; ++r) rli[r] = __builtin_amdgcn_rcpf(li_l[crow(r, hi)]);
  if constexpr (!DIFF) {
    bf16_t* Ow = Ob + (long)(wid * QBLK) * LD; const bf16_t* Gw = gate + (long)(wid * QBLK) * LD;
#pragma unroll
    for (int r = 0; r < 16; ++r) { const int orow = crow(r, hi);
#pragma unroll
      for (int d0 = 0; d0 < 4; ++d0) { const float g = bf2f(Gw[(long)orow * LD + d0 * 32 + r32]); Ow[(long)orow * LD + d0 * 32 + r32] = f2bf(o[d0][r] * rli[r] * siluf(g)); }
      asm volatile("" ::: "memory"); }
    __syncthreads();
  } else {
    __syncthreads();
    float* X = (float*)lds;
    if (mapc == 1) {
#pragma unroll
      for (int r = 0; r < 16; ++r) { const int orow = wq * QBLK + crow(r, hi);
#pragma unroll
        for (int d0 = 0; d0 < 4; ++d0) X[orow * 128 + d0 * 32 + r32] = o[d0][r] * rli[r] * lam; }
    }
    __syncthreads();
    if (mapc == 0) {
      bf16_t* Ow = Ob + (long)(wq * QBLK) * LD; const bf16_t* Gw = gate + (long)(wq * QBLK) * LD;
#pragma unroll
      for (int r = 0; r < 16; ++r) { const int orow = crow(r, hi); float v[4]; float ss = 0.f;
#pragma unroll
        for (int d0 = 0; d0 < 4; ++d0) { v[d0] = o[d0][r] * rli[r] - X[(wq * QBLK + orow) * 128 + d0 * 32 + r32]; ss += v[d0] * v[d0]; }
        ss += __shfl_xor(ss, 1); ss += __shfl_xor(ss, 2); ss += __shfl_xor(ss, 4); ss += __shfl_xor(ss, 8); ss += __shfl_xor(ss, 16);
        const float rs = rsqrtf(ss * (1.f / 128.f) + NORM_EPS) * osc;
#pragma unroll
        for (int d0 = 0; d0 < 4; ++d0) { const int c = d0 * 32 + r32; const float g = bf2f(Gw[(long)orow * LD + c]); Ow[(long)orow * LD + c] = f2bf(v[d0] * rs * nw[c] * siluf(g)); } }
    }
    __syncthreads();
  }
#undef SLOAD
#undef SWRITE
#undef SWAIT
#undef RESC
}
#undef KSWZ
#undef SBAR
}

__device__ __forceinline__ void gqa_unit(const Params& p, int u, char* lds) {
    const int qb = u & 31, hq = (u >> 5) & 3, b = u >> 7; const size_t row0 = (size_t)b * SEQ + (size_t)qb * 256, k0 = (size_t)b * SEQ;
    bf16_t* Q = pblk(p.ws, PB_GQ + hq) + row0 * 128;
    att::attn_unit<0>(Q, pblk(p.ws, PB_GK + (hq >> 1)) + k0 * 128, pblk(p.ws, PB_GV + (hq >> 1)) + k0 * 128, Q, pblk(p.ws, PB_GG + hq) + row0 * 128, SEQ, lds, 0.f, 1.f, nullptr);
}
__device__ __forceinline__ void diff_unit(const Params& p, int u, char* lds) {
    const int qb = u & 63, h = (u >> 6) & 3, b = u >> 8; const size_t row0 = (size_t)b * SEQ + (size_t)qb * 128, k0 = (size_t)b * SEQ; const int l = p.layer;
    const float* lp = p.in[21] + l * 256;
    const int lane = threadIdx.x & 63;
    const float s1 = wave_sum(lp[lane] * lp[64 + lane]), s2 = wave_sum(lp[128 + lane] * lp[192 + lane]);
    const float lambda_init = 0.8f - 0.6f * expf(-0.3f * (float)l);
    const float lam = expf(s1) - expf(s2) + lambda_init;
    bf16_t* Q = pblk(p.ws, PB_DQ + h) + row0 * 128;
    att::attn_unit<1>(Q, pblk(p.ws, PB_DK + h) + k0 * 128, pblk(p.ws, PB_DV + h) + k0 * 128, Q, pblk(p.ws, PB_DG + h) + row0 * 128, SEQ, lds, lam, 1.f - lambda_init, p.in[22] + l * 128);
}

__device__ __forceinline__ void rwkv_naive_seq(const Params& p, int sid, float* lds) {
    const int j = threadIdx.x & 63; const int h = sid & 7, dir = (sid >> 3) & 1, b = sid >> 4; const int l = p.layer;
    float* w2s = lds; float* a2s = lds + 4096; float* tws = lds + 8192; float* ads = tws + 64; float* ops = ads + 64;
    const float* w2 = p.in[13] + ((size_t)(l * 2 + dir) * 64) * 512 + h * 64; const float* a2 = p.in[15] + ((size_t)l * 64) * 512 + h * 64;
    for (int i = 0; i < 64; ++i) { w2s[i * 64 + j] = w2[(size_t)i * 512 + j]; a2s[i * 64 + j] = a2[(size_t)i * 512 + j]; }
    const float* mu = p.in[11] + (size_t)(l * 2 + dir) * 1664;
    const float mu_r = mu[h * 64 + j], mu_k = mu[512 + h * 64 + j], mu_v = mu[1024 + h * 64 + j], mu_w = mu[1536 + j], mu_a = mu[1600 + j];
    const float w0 = p.in[12][(l * 2 + dir) * 512 + h * 64 + j], a0 = p.in[14][l * 512 + h * 64 + j];
    const float kkc = p.in[16][l * 512 + h * 64 + j], kac = p.in[17][l * 512 + h * 64 + j], rkc = p.in[18][l * 512 + h * 64 + j];
    const bf16_t* Pr = pblk(p.ws, PB_R + (h >> 1)) + (h & 1) * 64 + j; const bf16_t* Pk = pblk(p.ws, PB_K + (h >> 1)) + (h & 1) * 64 + j;
    const bf16_t* Pv = pblk(p.ws, PB_V + (h >> 1)) + (h & 1) * 64 + j; const bf16_t* Pw = pblk(p.ws, PB_WA) + j; const bf16_t* Pa = pblk(p.ws, PB_WA) + 64 + j;
    bf16_t* wkv = (bf16_t*)(g_scr + SCR_WKV) + (size_t)dir * M_TOK * 512 + h * 64 + j; bf16_t* bon = (bf16_t*)(g_scr + SCR_BON) + (size_t)dir * M_TOK * 512 + h * 64 + j;
    float S[64];
#pragma unroll
    for (int k = 0; k < 64; ++k) S[k] = 0.f;
    float pr = 0.f, pk = 0.f, pv = 0.f, pw = 0.f, pa = 0.f;
    __syncthreads();
    for (int s = 0; s < SEQ; ++s) {
        const int t = dir ? (SEQ - 1 - s) : s; const size_t m = (size_t)b * SEQ + t;
        const float xr = bf2f(Pr[m * 128]), xk = bf2f(Pk[m * 128]), xv = bf2f(Pv[m * 128]), xw = bf2f(Pw[m * 128]), xa = bf2f(Pa[m * 128]);
        const float r = xr + (pr - xr) * mu_r, k = xk + (pk - xk) * mu_k, v = xv + (pv - xv) * mu_v, wd = xw + (pw - xw) * mu_w, ad = xa + (pa - xa) * mu_a;
        pr = xr; pk = xk; pv = xv; pw = xw; pa = xa;
        tws[j] = tanhf(wd); ads[j] = ad;
        __syncthreads();
        float wv = w0, av = a0;
#pragma unroll 8
        for (int i = 0; i < 64; ++i) { wv += tws[i] * w2s[i * 64 + j]; av += ads[i] * a2s[i * 64 + j]; }
        wv = -softplusf(-wv) - 0.5f; const float dec = expf(-expf(wv));
        av = 1.f / (1.f + expf(-av));
        float kk = k * kkc; const float nrm = sqrtf(wave_sum(kk * kk)); kk = kk / fmaxf(nrm, 1e-12f);
        const float kp = k * (1.f + (av - 1.f) * kac);
        const float bsc = wave_sum(r * kp * rkc);
        ops[j] = -kk; ops[64 + j] = kk * av; ops[128 + j] = dec; ops[192 + j] = kp; ops[256 + j] = r;
        __syncthreads();
        float sa = 0.f;
#pragma unroll
        for (int k4 = 0; k4 < 16; ++k4) { const f32x4 a4 = *(const f32x4*)(ops + k4 * 4); sa += S[k4 * 4] * a4[0] + S[k4 * 4 + 1] * a4[1] + S[k4 * 4 + 2] * a4[2] + S[k4 * 4 + 3] * a4[3]; }
        float y = 0.f;
#pragma unroll
        for (int k4 = 0; k4 < 16; ++k4) { const f32x4 b4 = *(const f32x4*)(ops + 64 + k4 * 4), d4 = *(const f32x4*)(ops + 128 + k4 * 4), k4v = *(const f32x4*)(ops + 192 + k4 * 4), r4 = *(const f32x4*)(ops + 256 + k4 * 4);
#pragma unroll
            for (int e = 0; e < 4; ++e) { const float sn = S[k4 * 4 + e] * d4[e] + sa * b4[e] + v * k4v[e]; S[k4 * 4 + e] = sn; y += sn * r4[e]; } }
        wkv[m * 512] = f2bf(y); bon[m * 512] = f2bf(bsc * v);
        __syncthreads();
    }
}

__device__ __forceinline__ void ssd_naive_seq(const Params& p, int sid, float* lds) {
    const int tid = threadIdx.x; const int h = sid & 7, dir = (sid >> 3) & 1, b = sid >> 4; const int l = p.layer; const int g = h >> 2;
    float* xs = lds; float* Bs = lds + 2048; float* Cs = Bs + 4096; float* dts = Cs + 4096; float* das = dts + 32;
    const float* cw = p.in[5] + (size_t)l * 5 * 1024; const float* cb = p.in[6] + (size_t)l * 1024;
    const float A = -expf(p.in[7][(l * 2 + dir) * 8 + h]); const float dtb = p.in[8][(l * 2 + dir) * 8 + h]; const float Dh = p.in[9][l * 8 + h];
    const float* dtbuf = (const float*)(g_scr + SCR_DT);
    bf16_t* yout = (bf16_t*)(g_scr + SCR_SSDY) + (size_t)dir * M_TOK * 512 + h * 64;
    const int pp = tid >> 2, q = tid & 3;
    float hs[32];
#pragma unroll
    for (int n = 0; n < 32; ++n) hs[n] = 0.f;
    for (int s0 = 0; s0 < SEQ; s0 += 32) {
        __syncthreads();
        for (int idx = tid; idx < 32 * 320; idx += 256) {
            const int si = idx / 320, c = idx % 320; const int s = s0 + si; const int t = dir ? (SEQ - 1 - s) : s;
            int cch; const bf16_t* src;
            if (c < 64) { cch = h * 64 + c; src = pblk(p.ws, PB_XS + (h >> 1)) + (h & 1) * 64 + c; }
            else if (c < 192) { cch = 512 + g * 128 + (c - 64); src = pblk(p.ws, PB_BM + g) + (c - 64); }
            else { cch = 768 + g * 128 + (c - 192); src = pblk(p.ws, PB_CM + g) + (c - 192); }
            float acc = cb[cch];
#pragma unroll
            for (int jj = 0; jj < 5; ++jj) { const int tt = t + jj - 2; if (tt >= 0 && tt < SEQ) acc += cw[jj * 1024 + cch] * bf2f(src[((size_t)b * SEQ + tt) * 128]); }
            const float v = siluf(acc);
            if (c < 64) xs[si * 64 + c] = v; else if (c < 192) Bs[si * 128 + (c - 64)] = v; else Cs[si * 128 + (c - 192)] = v;
        }
        if (tid < 32) { const int s = s0 + tid; const int t = dir ? (SEQ - 1 - s) : s; const float dt = softplusf(dtbuf[((size_t)b * SEQ + t) * 16 + dir * 8 + h] + dtb); dts[tid] = dt; das[tid] = expf(dt * A); }
        __syncthreads();
        for (int si = 0; si < 32; ++si) {
            const int s = s0 + si; const int t = dir ? (SEQ - 1 - s) : s;
            const float x = xs[si * 64 + pp], dt = dts[si], da = das[si]; const float xdt = x * dt;
            float y = 0.f;
#pragma unroll
            for (int n4 = 0; n4 < 8; ++n4) { const f32x4 b4 = *(const f32x4*)(Bs + si * 128 + q * 32 + n4 * 4), c4 = *(const f32x4*)(Cs + si * 128 + q * 32 + n4 * 4);
#pragma unroll
                for (int e = 0; e < 4; ++e) { const float hn = hs[n4 * 4 + e] * da + xdt * b4[e]; hs[n4 * 4 + e] = hn; y += hn * c4[e]; } }
            y += __shfl_xor(y, 1); y += __shfl_xor(y, 2);
            if (dir == 0) y += Dh * x;
            if (q == 0) yout[((size_t)b * SEQ + t) * 512 + pp] = f2bf(y);
        }
    }
}

__device__ __forceinline__ void phase_combine(const Params& p) {
    const int G = gridDim.x, tid = threadIdx.x, lane = tid & 63, wave = tid >> 6; const int l = p.layer;
    const bf16_t* wkv = (const bf16_t*)(g_scr + SCR_WKV); const bf16_t* bon = (const bf16_t*)(g_scr + SCR_BON); const bf16_t* sy = (const bf16_t*)(g_scr + SCR_SSDY);
    const float* lnw = p.in[19] + l * 512; const float* lnb = p.in[20] + l * 512; const float* snw = p.in[10] + l * 512;
    for (int m = blockIdx.x * 8 + wave; m < M_TOK; m += G * 8) {
#pragma unroll
        for (int h = 0; h < 8; ++h) { const size_t o = (size_t)m * 512 + h * 64 + lane; const size_t o2 = o + (size_t)M_TOK * 512;
            const float w = bf2f(wkv[o]) + bf2f(wkv[o2]);
            const float mean = wave_sum(w) * (1.f / 64.f); const float d = w - mean; const float var = wave_sum(d * d) * (1.f / 64.f);
            const float gn = d * rsqrtf(var + 64e-5f) * lnw[h * 64 + lane] + lnb[h * 64 + lane];
            const float y = gn + bf2f(bon[o]) + bf2f(bon[o2]);
            bf16_t* gp = pblk(p.ws, PB_RG + (h >> 1)) + (size_t)m * 128 + (h & 1) * 64 + lane;
            *gp = f2bf(y * siluf(bf2f(*gp))); }
#pragma unroll
        for (int g = 0; g < 2; ++g) { float yg[4]; float ss = 0.f;
#pragma unroll
            for (int hh = 0; hh < 4; ++hh) { const int h = g * 4 + hh; const size_t o = (size_t)m * 512 + h * 64 + lane;
                const float y = bf2f(sy[o]) + bf2f(sy[o + (size_t)M_TOK * 512]);
                const float z = bf2f(pblk(p.ws, PB_Z + (h >> 1))[(size_t)m * 128 + (h & 1) * 64 + lane]);
                yg[hh] = y * siluf(z); ss += yg[hh] * yg[hh]; }
            ss = wave_sum(ss); const float rs = rsqrtf(ss * (1.f / 256.f) + NORM_EPS);
#pragma unroll
            for (int hh = 0; hh < 4; ++hh) { const int h = g * 4 + hh; pblk(p.ws, PB_Z + (h >> 1))[(size_t)m * 128 + (h & 1) * 64 + lane] = f2bf(yg[hh] * rs * snw[h * 64 + lane]); } }
    }
}

__device__ __forceinline__ void phase_post(const Params& p) {
    const int G = gridDim.x, tid = threadIdx.x, lane = tid & 63, wave = tid >> 6; const int l = p.layer;
    const float* mix = (const float*)(p.ws + WS_MIX); const float* xin = l == 0 ? p.in[0] : p.out; const float* pw = p.in[2] + l * DMODEL;
    for (int m = blockIdx.x * 8 + wave; m < M_TOK; m += G * 8) {
        const f32x4* mr = (const f32x4*)(mix + (size_t)m * DMODEL) + lane; const f32x4* xr = (const f32x4*)(xin + (size_t)m * DMODEL) + lane; const f32x4* wr = (const f32x4*)pw + lane;
        f32x4 v[4]; float s = 0.f;
#pragma unroll
        for (int j = 0; j < 4; ++j) { v[j] = mr[64 * j]; s += (v[j].x * v[j].x + v[j].y * v[j].y) + (v[j].z * v[j].z + v[j].w * v[j].w); }
        const float rs = rsqrtf(wave_sum(s) * (1.f / DMODEL) + NORM_EPS);
        float s2 = 0.f;
#pragma unroll
        for (int j = 0; j < 4; ++j) { v[j] = xr[64 * j] + v[j] * rs * wr[64 * j]; s2 += (v[j].x * v[j].x + v[j].y * v[j].y) + (v[j].z * v[j].z + v[j].w * v[j].w); }
        s2 = wave_sum(s2);
        f32x4* orow = (f32x4*)(p.out + (size_t)m * DMODEL) + lane;
#pragma unroll
        for (int j = 0; j < 4; ++j) orow[64 * j] = v[j];
        if (lane == 0) ((float*)(g_scr + SCR_RS))[m] = rsqrtf(s2 * (1.f / DMODEL) + NORM_EPS);
        u32x2* o8 = (u32x2*)((bf16_t*)(g_scr + SCR_XB) + (size_t)m * DMODEL) + lane;
#pragma unroll
        for (int j = 0; j < 4; ++j) { u32x2 w; w.x = pk2(v[j].x, v[j].y); w.y = pk2(v[j].z, v[j].w); o8[64 * j] = w; }
    }
}

constexpr int LDS_BYTES = 147456;
__global__ void __launch_bounds__(512) k_prologue(Params p) { extern __shared__ __attribute__((aligned(16))) unsigned char lds[]; phase_prologue(p, (float*)lds); }
__global__ void __launch_bounds__(512) k_gemm_in(Params p) {
    extern __shared__ __attribute__((aligned(16))) unsigned char lds[];
    pg8::Gemm g{(const bf16_t*)(g_scr + SCR_XB), (const bf16_t*)(g_scr + SCR_WIN + (size_t)p.layer * 15 * MiB), M_TOK, NPROJ, DMODEL, DMODEL, 128};
    pg8::StaticOrder S; S.init(M_TOK, NPROJ, gridDim.x, blockIdx.x);
    pg8::EpiProj E{(bf16_t*)p.ws, (const float*)(g_scr + SCR_RS), (float*)(g_scr + SCR_DT)};
    pg8::gemm_phase<pg8::EpiProj, pg8::StaticOrder, true, true>((PG8_LAS unsigned char*)lds, g, S, E);
}
__global__ void __launch_bounds__(512) k_prep(Params p) { phase_prep(p); }
__global__ void __launch_bounds__(512) k_gqa(Params p) { extern __shared__ __attribute__((aligned(16))) unsigned char lds[]; gqa_unit(p, blockIdx.x, (char*)lds); }
__global__ void __launch_bounds__(512) k_diff(Params p) { extern __shared__ __attribute__((aligned(16))) unsigned char lds[]; diff_unit(p, blockIdx.x, (char*)lds); }
__global__ void __launch_bounds__(64) k_rwkv(Params p) { extern __shared__ __attribute__((aligned(16))) unsigned char lds[]; rwkv_naive_seq(p, blockIdx.x, (float*)lds); }
__global__ void __launch_bounds__(256) k_ssd(Params p) { extern __shared__ __attribute__((aligned(16))) unsigned char lds[]; ssd_naive_seq(p, blockIdx.x, (float*)lds); }
__global__ void __launch_bounds__(512) k_combine(Params p) { phase_combine(p); }
__global__ void __launch_bounds__(512) k_gemm_out(Params p) {
    extern __shared__ __attribute__((aligned(16))) unsigned char lds[];
    pg8::Gemm g{(const bf16_t*)p.ws, (const bf16_t*)(g_scr + SCR_WOUT + (size_t)p.layer * 4 * MiB), M_TOK, DMODEL, DMIX, 128, PBLK_ELEMS};
    pg8::StaticOrder S; S.init(M_TOK, DMODEL, gridDim.x, blockIdx.x);
    pg8::EpiMix E{(float*)(p.ws + WS_MIX)};
    pg8::gemm_phase<pg8::EpiMix, pg8::StaticOrder, true, true>((PG8_LAS unsigned char*)lds, g, S, E);
}
__global__ void __launch_bounds__(512) k_post(Params p) { phase_post(p); }

extern "C" void kernel_launch(void* const* d_in, const int* in_sizes, int n_in, void* d_out, int out_size, void* d_ws, size_t ws_size, hipStream_t stream) {
    static int ok = 0;
    if (!ok) {
        hipFuncSetAttribute((const void*)k_prologue, hipFuncAttributeMaxDynamicSharedMemorySize, LDS_BYTES);
        hipFuncSetAttribute((const void*)k_gemm_in, hipFuncAttributeMaxDynamicSharedMemorySize, LDS_BYTES);
        hipFuncSetAttribute((const void*)k_gemm_out, hipFuncAttributeMaxDynamicSharedMemorySize, LDS_BYTES);
        hipFuncSetAttribute((const void*)k_gqa, hipFuncAttributeMaxDynamicSharedMemorySize, LDS_BYTES);
        hipFuncSetAttribute((const void*)k_diff, hipFuncAttributeMaxDynamicSharedMemorySize, LDS_BYTES);
        ok = 1;
    }
    Params p{};
    for (int i = 0; i < 25; ++i) p.in[i] = (const float*)d_in[i];
    p.out = (float*)d_out; p.ws = (unsigned char*)d_ws;
    hipLaunchKernelGGL(k_prologue, dim3(256), dim3(512), 32768, stream, p);
    for (int l = 0; l < 2; ++l) {
        p.layer = l;
        hipLaunchKernelGGL(k_gemm_in, dim3(256), dim3(512), LDS_BYTES, stream, p);
        hipLaunchKernelGGL(k_prep, dim3(256), dim3(512), 0, stream, p);
        hipLaunchKernelGGL(k_gqa, dim3(256), dim3(512), (int)att::SHM_ATTN, stream, p);
        hipLaunchKernelGGL(k_diff, dim3(512), dim3(512), (int)att::SHM_ATTN, stream, p);
        hipLaunchKernelGGL(k_rwkv, dim3(32), dim3(64), 40960, stream, p);
        hipLaunchKernelGGL(k_ssd, dim3(32), dim3(256), 49152, stream, p);
        hipLaunchKernelGGL(k_combine, dim3(256), dim3(512), 0, stream, p);
        hipLaunchKernelGGL(k_gemm_out, dim3(256), dim3(512), LDS_BYTES, stream, p);
        hipLaunchKernelGGL(k_post, dim3(256), dim3(512), 0, stream, p);
    }
}
```

```cpp
#include <hip/hip_runtime.h>
#include <hip/hip_bf16.h>
#include <hip/hip_cooperative_groups.h>
#include <cstdio>
#include <cstdint>
namespace cg = cooperative_groups;

constexpr int M_TOK = 16384, SEQ = 8192, DMODEL = 1024, NPROJ = 7424, NPB = 58, DIN_ORIG = 7312, DMIX = 2048;
constexpr float NORM_EPS = 1e-6f;
constexpr size_t MiB = 1u << 20;
constexpr int PB_Z = 0, PB_RG = 4, PB_DQ = 8, PB_GQ = 12, PB_XS = 16, PB_BM = 20, PB_CM = 22, PB_R = 24, PB_K = 28, PB_V = 32, PB_WA = 36,
              PB_DK = 37, PB_DV = 41, PB_DG = 45, PB_GK = 49, PB_GV = 51, PB_GG = 53, PB_DT = 57;
constexpr size_t PBLK_ELEMS = (size_t)M_TOK * 128;
constexpr size_t SCR_WIN = 0, SCR_WOUT = 30 * MiB, SCR_ROPE = 38 * MiB, SCR_DT = 40 * MiB, SCR_RS = 41 * MiB, SCR_CTL = 41 * MiB + 512 * 1024,
                 SCR_XB = 42 * MiB, SCR_WKV = 74 * MiB, SCR_BON = 106 * MiB, SCR_SSDY = 138 * MiB, SCR_BYTES = 170 * MiB;
constexpr size_t WS_MIX = 16 * PBLK_ELEMS * 2;
__device__ __attribute__((aligned(256))) unsigned char g_scr[SCR_BYTES];

typedef unsigned short bf16_t;
typedef short bf16x8 __attribute__((ext_vector_type(8)));
typedef float f32x4 __attribute__((ext_vector_type(4)));
typedef unsigned u32x4 __attribute__((ext_vector_type(4)));
typedef unsigned u32x2 __attribute__((ext_vector_type(2)));

struct Params {
    const float* in[25];
    float* out;
    unsigned char* ws;
};

__device__ __forceinline__ int otid() { int t = threadIdx.x; asm volatile("" : "+v"(t)); return t; }
__device__ __forceinline__ float bf2f(bf16_t v) { return __uint_as_float(((unsigned)v) << 16); }
__device__ __forceinline__ bf16_t f2bf(float f) { unsigned u = __float_as_uint(f); return (bf16_t)((u + 0x7fffu + ((u >> 16) & 1u)) >> 16); }
__device__ __forceinline__ unsigned pk2(float lo, float hi) { return (unsigned)f2bf(lo) | ((unsigned)f2bf(hi) << 16); }
__device__ __forceinline__ float wave_sum(float v) {
#pragma unroll
    for (int o = 1; o < 64; o <<= 1) v += __shfl_xor(v, o);
    return v;
}
__device__ __forceinline__ float siluf(float x) { return x / (1.f + __expf(-x)); }
__device__ __forceinline__ float softplusf(float x) { return fmaxf(x, 0.f) + log1pf(__expf(-fabsf(x))); }
__device__ __forceinline__ bf16_t* pblk(unsigned char* ws, int j) { return (bf16_t*)ws + (size_t)j * PBLK_ELEMS; }

namespace pg8 {
#define PG8_LAS __attribute__((address_space(3)))
constexpr int BM = 256, BK = 64, HALF = 128, HTB = HALF * BK * 2, STAGE_BYTES = 8 * HTB, NXCD = 8, WGM = 8;
__host__ __device__ __forceinline__ int lds_byte(int r, int c) { const int st = (r >> 4) * 2 + (c >> 5), rr = r & 15, cc = c & 31, ob = rr * 64 + cc * 2; return st * 1024 + (ob ^ (((ob >> 9) & 1) << 5)); }
__host__ __device__ __forceinline__ void stage_rc(int b, int& R, int& C) { const int st = b / 1024, sb = b % 1024, swz = sb ^ (((sb >> 9) & 1) << 5); R = (st >> 1) * 16 + swz / 64; C = (st & 1) * 32 + (swz % 64) / 2; }
__host__ __device__ __forceinline__ int perm32(int rho) { const int n = rho >> 4, i = rho & 15; return 8 * (i >> 2) + 4 * n + (i & 3); }
struct Unit { int pm, pn; };
struct Gemm { const bf16_t* A; const bf16_t* Bt; int M, N, K; int lda; size_t abig; };
struct StaticOrder {
    int nM, nN, nwg, G, c;
    __host__ __device__ void init(int M, int N, int G_, int c_) { nM = M / BM; nN = N / BM; nwg = nM * nN; G = G_; c = c_; }
    __host__ __device__ bool next(int i, Unit& u) const {
        const long L = (long)i * G + c; if (L >= nwg) return false;
        int wgid = (int)L; { const int q = nwg / NXCD, r = nwg % NXCD, xcd = wgid % NXCD, off = wgid / NXCD; wgid = (xcd < r ? xcd * (q + 1) : r * (q + 1) + (xcd - r) * q) + off; }
        const int nig = WGM * nN, gid = wgid / nig, fm = gid * WGM, gsz = (nM - fm) < WGM ? (nM - fm) : WGM;
        u.pm = fm + ((wgid % nig) % gsz); u.pn = (wgid % nig) / gsz; return true;
    }
};
template <class Epi, class Sched, bool ALIGN_EPI = false, bool SP2 = false>
__device__ __forceinline__ void gemm_phase(PG8_LAS unsigned char* lds, const Gemm g, const Sched& S, const Epi& E) {
    const int tid = otid(), wid = __builtin_amdgcn_readfirstlane(tid >> 6), lane = tid & 63, wr = wid >> 2, wc = wid & 3, fr = lane & 15, fq = lane >> 4;
    const int K = g.K, nt = K / BK;
    unsigned voffA[2], voffB[2];
#pragma unroll
    for (int i = 0; i < 2; ++i) { int R, C; stage_rc(tid * 16 + i * 8192, R, C); const int Rb = Epi::PERM ? ((R & ~31) + perm32(R & 31)) : R;
        voffA[i] = (unsigned)(R * g.lda + C) * 2u; voffB[i] = (unsigned)(Rb * K + C) * 2u; }
    const size_t kstep = (size_t)(BK * 2);
    const size_t abig = g.abig * 2;
    const size_t hstepA = (size_t)HALF * g.lda * 2, hstepB = (size_t)HALF * K * 2;
    const size_t tstepA = 2 * hstepA, tstepB = 2 * hstepB;
    const unsigned ldsw = (unsigned)wid * 1024u;
    const int aoff = lds_byte(wr * 64 + fr, fq * 8), boff = lds_byte(wc * 32 + fr, fq * 8);
#define PG8_SA(b, h) (((b) * 2 + (h)) * HTB)
#define PG8_SB(b, h) ((4 + (b) * 2 + (h)) * HTB)
#define PG8_STAGE(bufoff, gbase, voff) do { _Pragma("unroll") for (int _i = 0; _i < 2; ++_i) \
        __builtin_amdgcn_global_load_lds((const unsigned*)((const char*)(gbase) + (voff)[_i]), (PG8_LAS unsigned*)(lds + (bufoff) + ldsw + _i * 8192), 16, 0, 0); } while (0)
#define PG8_LDA(dst, b, h) do { _Pragma("unroll") for (int m = 0; m < 4; ++m) _Pragma("unroll") for (int k = 0; k < 2; ++k) dst[m][k] = *(const PG8_LAS bf16x8*)(lds + PG8_SA(b, h) + aoff + m * 2048 + k * 1024); } while (0)
#define PG8_LDB(dst, b, h) do { _Pragma("unroll") for (int n = 0; n < 2; ++n) _Pragma("unroll") for (int k = 0; k < 2; ++k) dst[n][k] = *(const PG8_LAS bf16x8*)(lds + PG8_SB(b, h) + boff + n * 2048 + k * 1024); } while (0)
#define PG8_MMA(ai, bj, At, Bt) do { __builtin_amdgcn_s_setprio(1); _Pragma("unroll") for (int m = 0; m < 4; ++m) _Pragma("unroll") for (int n = 0; n < 2; ++n) _Pragma("unroll") for (int k = 0; k < 2; ++k) \
        acc[ai][bj][m][n] = __builtin_amdgcn_mfma_f32_16x16x32_bf16(Bt[n][k], At[m][k], acc[ai][bj][m][n], 0, 0, 0); __builtin_amdgcn_s_setprio(0); } while (0)
#define PG8_WAIT_V(n) asm volatile("s_waitcnt vmcnt(" #n ")" ::: "memory")
#define PG8_WAIT_L(n) asm volatile("s_waitcnt lgkmcnt(" #n ")" ::: "memory")
#define PG8_BAR __builtin_amdgcn_s_barrier()
#define PG8_SCHED __builtin_amdgcn_sched_barrier(0)
    Unit cur, nxt; int ui = 0;
    if (!S.next(0, cur)) return;
    f32x4 acc[2][2][4][2];
#pragma unroll
    for (int a = 0; a < 2; ++a)
#pragma unroll
        for (int b = 0; b < 2; ++b)
#pragma unroll
            for (int m = 0; m < 4; ++m)
#pragma unroll
                for (int n = 0; n < 2; ++n) acc[a][b][m][n] = (f32x4){0.f, 0.f, 0.f, 0.f};
    bf16x8 At[4][2], B0[2][2], B1[2][2];
    const char* cA = (const char*)g.A + (size_t)cur.pm * tstepA; const char* cB = (const char*)g.Bt + (size_t)cur.pn * tstepB;
    if constexpr (SP2) {
        PG8_STAGE(PG8_SB(0, 0), cB, voffB); PG8_STAGE(PG8_SB(0, 1), cB + hstepB, voffB); PG8_STAGE(PG8_SA(0, 0), cA, voffA); PG8_STAGE(PG8_SA(0, 1), cA + hstepA, voffA);
        if (wr == 1) PG8_BAR;
        PG8_WAIT_V(2); PG8_BAR;
        PG8_STAGE(PG8_SB(1, 0), cB + kstep, voffB); PG8_STAGE(PG8_SA(1, 0), cA + kstep, voffA); PG8_STAGE(PG8_SB(1, 1), cB + hstepB + kstep, voffB);
        PG8_WAIT_V(6); PG8_BAR;
    } else {
        PG8_STAGE(PG8_SB(0, 0), cB, voffB); PG8_STAGE(PG8_SA(0, 0), cA, voffA); PG8_STAGE(PG8_SB(0, 1), cB + hstepB, voffB); PG8_STAGE(PG8_SA(0, 1), cA + hstepA, voffA);
        if (wr == 1) PG8_BAR;
        PG8_WAIT_V(4); PG8_BAR;
        PG8_STAGE(PG8_SB(1, 0), cB + kstep, voffB); PG8_STAGE(PG8_SA(1, 0), cA + kstep, voffA); PG8_STAGE(PG8_SB(1, 1), cB + hstepB + kstep, voffB);
        PG8_WAIT_V(6); PG8_BAR;
    }
    for (;;) {
        const bool has_next = S.next(ui + 1, nxt);
        const char* nA = has_next ? (const char*)g.A + (size_t)nxt.pm * tstepA : cA; const char* nB = has_next ? (const char*)g.Bt + (size_t)nxt.pn * tstepB : cB;
        for (int t = 0; t < nt; t += 2) {
            const bool last = (t == nt - 2);
            const char* a1 = cA + (size_t)(t >> 1) * abig + kstep;
            const char* a2 = last ? nA : cA + (size_t)((t >> 1) + 1) * abig; const char* b2 = last ? nB : cB + (size_t)(t + 2) * kstep;
            const char* a3 = a2 + kstep; const char* b3 = b2 + kstep;
            if constexpr (SP2) {
            PG8_LDB(B0, 0, 0); PG8_LDB(B1, 0, 1); PG8_SCHED; PG8_LDA(At, 0, 0); PG8_STAGE(PG8_SA(1, 1), a1 + hstepA, voffA);
            PG8_WAIT_V(8); PG8_WAIT_L(0); PG8_BAR; PG8_MMA(0, 0, At, B0); PG8_MMA(0, 1, At, B1); PG8_BAR; PG8_SCHED;
            PG8_LDA(At, 0, 1); PG8_STAGE(PG8_SB(0, 0), b2, voffB); PG8_STAGE(PG8_SB(0, 1), b2 + hstepB, voffB); PG8_STAGE(PG8_SA(0, 0), a2, voffA);
            PG8_WAIT_V(8); PG8_WAIT_L(0); PG8_BAR; PG8_MMA(1, 0, At, B0); PG8_MMA(1, 1, At, B1); PG8_BAR; PG8_SCHED;
            PG8_LDB(B0, 1, 0); PG8_LDB(B1, 1, 1); PG8_SCHED; PG8_LDA(At, 1, 0); PG8_STAGE(PG8_SA(0, 1), a2 + hstepA, voffA);
            PG8_WAIT_V(8); PG8_WAIT_L(0); PG8_BAR; PG8_MMA(0, 0, At, B0); PG8_MMA(0, 1, At, B1); PG8_BAR; PG8_SCHED;
            PG8_LDA(At, 1, 1); PG8_STAGE(PG8_SB(1, 0), b3, voffB); PG8_STAGE(PG8_SB(1, 1), b3 + hstepB, voffB); PG8_STAGE(PG8_SA(1, 0), a3, voffA);
            PG8_WAIT_V(8); PG8_WAIT_L(0); PG8_BAR; PG8_MMA(1, 0, At, B0); PG8_MMA(1, 1, At, B1); PG8_BAR; PG8_SCHED;
            } else {
            PG8_LDB(B0, 0, 0); PG8_SCHED; PG8_LDA(At, 0, 0); PG8_STAGE(PG8_SA(1, 1), a1 + hstepA, voffA);
            PG8_WAIT_L(8); PG8_BAR; PG8_WAIT_L(0); PG8_MMA(0, 0, At, B0); PG8_BAR; PG8_SCHED;
            PG8_LDB(B1, 0, 1); PG8_STAGE(PG8_SB(0, 0), b2, voffB);
            PG8_BAR; PG8_WAIT_L(0); PG8_MMA(0, 1, At, B1); PG8_BAR;
            PG8_LDA(At, 0, 1); PG8_STAGE(PG8_SA(0, 0), a2, voffA);
            PG8_BAR; PG8_WAIT_L(0); PG8_MMA(1, 0, At, B0); PG8_BAR; PG8_SCHED;
            PG8_STAGE(PG8_SB(0, 1), b2 + hstepB, voffB);
            PG8_WAIT_V(6); PG8_BAR; PG8_MMA(1, 1, At, B1); PG8_BAR;
            PG8_LDB(B0, 1, 0); PG8_SCHED; PG8_LDA(At, 1, 0); PG8_STAGE(PG8_SA(0, 1), a2 + hstepA, voffA);
            PG8_WAIT_L(8); PG8_BAR; PG8_WAIT_L(0); PG8_MMA(0, 0, At, B0); PG8_BAR; PG8_SCHED;
            PG8_LDB(B1, 1, 1); PG8_STAGE(PG8_SB(1, 0), b3, voffB);
            PG8_BAR; PG8_WAIT_L(0); PG8_MMA(0, 1, At, B1); PG8_BAR;
            PG8_LDA(At, 1, 1); PG8_STAGE(PG8_SA(1, 0), a3, voffA);
            PG8_BAR; PG8_WAIT_L(0); PG8_MMA(1, 0, At, B0); PG8_BAR; PG8_SCHED;
            PG8_STAGE(PG8_SB(1, 1), b3 + hstepB, voffB);
            PG8_WAIT_V(6); PG8_BAR; PG8_MMA(1, 1, At, B1); PG8_BAR;
            }
        }
        if constexpr (ALIGN_EPI) { if (wr == 0) PG8_BAR; }
        E(acc, cur, wr, wc, fr, fq);
        if (!has_next) break;
#pragma unroll
        for (int a = 0; a < 2; ++a)
#pragma unroll
            for (int b = 0; b < 2; ++b)
#pragma unroll
                for (int m = 0; m < 4; ++m)
#pragma unroll
                    for (int n = 0; n < 2; ++n) acc[a][b][m][n] = (f32x4){0.f, 0.f, 0.f, 0.f};
        cur = nxt; cA = nA; cB = nB; ++ui;
        if constexpr (ALIGN_EPI) { if (wr == 1) PG8_BAR; }
    }
    PG8_WAIT_V(0);
    if constexpr (!ALIGN_EPI) { if (wr == 0) PG8_BAR; }
    PG8_BAR;
#undef PG8_SA
#undef PG8_SB
#undef PG8_STAGE
#undef PG8_LDA
#undef PG8_LDB
#undef PG8_MMA
#undef PG8_WAIT_V
#undef PG8_WAIT_L
#undef PG8_BAR
#undef PG8_SCHED
}
struct EpiProj {
    static constexpr bool PERM = true;
    bf16_t* P; const float* rowscale; float* dtbuf;
    __device__ __forceinline__ void operator()(const f32x4 (&acc)[2][2][4][2], const Unit& u, int wr, int wc, int fr, int fq) const {
        const int row0 = u.pm * BM + wr * 64 + fr; const int col = wc * 32 + 8 * fq;
#pragma unroll
        for (int ai = 0; ai < 2; ++ai)
#pragma unroll
            for (int m = 0; m < 4; ++m) { const int row = row0 + ai * HALF + m * 16; const float sc = rowscale[row];
#pragma unroll
                for (int bj = 0; bj < 2; ++bj) { const int blk = u.pn * 2 + bj;
                    const f32x4 v0 = acc[ai][bj][m][0] * sc, v1 = acc[ai][bj][m][1] * sc;
                    u32x4 w; w.x = pk2(v0[0], v0[1]); w.y = pk2(v0[2], v0[3]); w.z = pk2(v1[0], v1[1]); w.w = pk2(v1[2], v1[3]);
                    *(u32x4*)(P + (size_t)blk * PBLK_ELEMS + (size_t)row * 128 + col) = w;
                    if (blk == PB_DT && col < 16) { float* d = dtbuf + (size_t)row * 16 + col; *(f32x4*)d = v0; *(f32x4*)(d + 4) = v1; } } }
    }
};
struct EpiMix {
    static constexpr bool PERM = true;
    float* O;
    __device__ __forceinline__ void operator()(const f32x4 (&acc)[2][2][4][2], const Unit& u, int wr, int wc, int fr, int fq) const {
        const int row0 = u.pm * BM + wr * 64 + fr; const int col0 = u.pn * BM + wc * 32 + 8 * fq;
#pragma unroll
        for (int ai = 0; ai < 2; ++ai)
#pragma unroll
            for (int m = 0; m < 4; ++m) { float* rp = O + (size_t)(row0 + ai * HALF + m * 16) * DMODEL + col0;
#pragma unroll
                for (int bj = 0; bj < 2; ++bj) { *(f32x4*)(rp + bj * HALF) = acc[ai][bj][m][0]; *(f32x4*)(rp + bj * HALF + 4) = acc[ai][bj][m][1]; } }
    }
};
}

__device__ __forceinline__ int orig_col(int n) {
    if (n < 512) return n;
    if (n < 1024) return 3216 + (n - 512);
    if (n < 1536) return 3728 + (n - 1024);
    if (n < 2048) return 5776 + (n - 1536);
    if (n < 3072) return 512 + (n - 2048);
    if (n < 4736) return 1552 + (n - 3072);
    if (n < 5248) return 4240 + (n - 4736);
    if (n < 5760) return 4752 + (n - 5248);
    if (n < 6272) return 5264 + (n - 5760);
    if (n < 6528) return 6288 + (n - 6272);
    if (n < 6784) return 6544 + (n - 6528);
    if (n < 7296) return 6800 + (n - 6784);
    if (n < 7312) return 1536 + (n - 7296);
    return -1;
}
template <bool MAPCOL>
__device__ __forceinline__ void transpose_item(const float* W, int K, int Nsrc, const float* ks, bf16_t* WT, float* scr  , int kb, int nb) {
    const int tid = otid(); const int k0 = kb * 64, n0 = nb * 64;
    {   const int nn = tid & 63; const int n = n0 + nn; const int oc = MAPCOL ? orig_col(n) : n;
#pragma unroll
        for (int i = 0; i < 8; ++i) { const int kk = (tid >> 6) + 8 * i; float v = 0.f; if (oc >= 0) v = W[(size_t)(k0 + kk) * Nsrc + oc] * (ks ? ks[k0 + kk] : 1.f); scr[kk * 65 + nn] = v; } }
    __syncthreads();
    {   const int n = tid >> 3, c = tid & 7; const float* s = scr + (8 * c) * 65 + n;
        u32x4 o; o.x = pk2(s[0], s[65]); o.y = pk2(s[2 * 65], s[3 * 65]); o.z = pk2(s[4 * 65], s[5 * 65]); o.w = pk2(s[6 * 65], s[7 * 65]);
        *(u32x4*)(WT + (size_t)(n0 + n) * K + k0 + 8 * c) = o; }
    __syncthreads();
}
__device__ __forceinline__ void rope_entry(int idx, float* tab) {
    const int pos = idx >> 5, i = idx & 31;
    const float inv = exp2f(-(float)i * (13.287712379549449f / 32.f));
    const float ang = (float)pos * inv;
    const double rev = (double)ang * 0.15915494309189535; const double fr = rev - floor(rev);
    const float a = (float)(fr * 6.283185307179586);
    tab[idx * 2] = cosf(a); tab[idx * 2 + 1] = sinf(a);
}
__device__ __forceinline__ void xrow_to_bf16(const float* xrow, bf16_t* orow, float* rs, int lane) {
    const f32x4* xr = (const f32x4*)xrow + lane; f32x4 v[4]; float s = 0.f;
#pragma unroll
    for (int j = 0; j < 4; ++j) { v[j] = xr[64 * j]; s += (v[j].x * v[j].x + v[j].y * v[j].y) + (v[j].z * v[j].z + v[j].w * v[j].w); }
    s = wave_sum(s);
    if (lane == 0) *rs = rsqrtf(s * (1.f / DMODEL) + NORM_EPS);
    u32x2* o8 = (u32x2*)orow + lane;
#pragma unroll
    for (int j = 0; j < 4; ++j) { u32x2 w; w.x = pk2(v[j].x, v[j].y); w.y = pk2(v[j].z, v[j].w); o8[64 * j] = w; }
}
__device__ __forceinline__ void phase_prologue(const Params& p, float* lds_f) {
    const int G = gridDim.x, bid = blockIdx.x, tid = otid(), lane = tid & 63, wave = tid >> 6;
    constexpr int I_IN = 16 * 116, I_OUT = 32 * 16;
    for (int it = bid; it < 2 * (I_IN + I_OUT); it += G) {
        int r = it; const int l = r / (I_IN + I_OUT); r -= l * (I_IN + I_OUT);
        if (r < I_IN) transpose_item<true>(p.in[3] + (size_t)l * DMODEL * DIN_ORIG, DMODEL, DIN_ORIG, p.in[1] + l * DMODEL, (bf16_t*)(g_scr + SCR_WIN + (size_t)l * 15 * MiB), lds_f, r / 116, r % 116);
        else { r -= I_IN; transpose_item<false>(p.in[4] + (size_t)l * DMIX * DMODEL, DMIX, DMODEL, nullptr, (bf16_t*)(g_scr + SCR_WOUT + (size_t)l * 4 * MiB), lds_f, r / 16, r % 16); }
    }
    for (int i = bid * 512 + tid; i < SEQ * 32; i += G * 512) rope_entry(i, (float*)(g_scr + SCR_ROPE));
    for (int m = bid * 8 + wave; m < M_TOK; m += G * 8) xrow_to_bf16(p.in[0] + (size_t)m * DMODEL, (bf16_t*)(g_scr + SCR_XB) + (size_t)m * DMODEL, (float*)(g_scr + SCR_RS) + m, lane);
}

__device__ __forceinline__ void phase_prep(const Params& p, const int l) {
    const int G = gridDim.x, tid = otid(), lane = tid & 63, wave = tid >> 6;
    const float* tab = (const float*)(g_scr + SCR_ROPE);
    const float* qw = p.in[23] + l * 128; const float* kw = p.in[24] + l * 128;
    const int i32 = lane & 31; const bool lo = (lane & 32) == 0;
    for (int m = blockIdx.x * 8 + wave; m < M_TOK; m += G * 8) {
        const int t = m & (SEQ - 1);
        {   const float cs = tab[(t * 32 + i32) * 2], sn = tab[(t * 32 + i32) * 2 + 1];
#pragma unroll
            for (int h = 0; h < 8; ++h) { bf16_t* base = pblk(p.ws, (h < 4 ? PB_DQ + h : PB_DK + (h - 4))) + (size_t)m * 128;
#pragma unroll
                for (int c = 0; c < 2; ++c) { const float x = bf2f(base[c * 64 + lane]); const float o = __shfl_xor(x, 32);
                    const float r = lo ? (x * cs - o * sn) : (x * cs + o * sn); base[c * 64 + lane] = f2bf(r); } } }
        {   const int row = t >> 6, col = t & 63;
            const float cr = tab[(row * 32 + i32) * 2], sr = tab[(row * 32 + i32) * 2 + 1], cc = tab[(col * 32 + i32) * 2], sc = tab[(col * 32 + i32) * 2 + 1];
#pragma unroll
            for (int h = 0; h < 6; ++h) { bf16_t* base = pblk(p.ws, (h < 4 ? PB_GQ + h : PB_GK + (h - 4))) + (size_t)m * 128; const float* w = h < 4 ? qw : kw;
                float x0 = bf2f(base[lane]), x1 = bf2f(base[64 + lane]);
                const float ss = wave_sum(x0 * x0 + x1 * x1); const float rs = rsqrtf(ss * (1.f / 128.f) + NORM_EPS);
                x0 *= rs * w[lane]; x1 *= rs * w[64 + lane];
                const float o0 = __shfl_xor(x0, 32), o1 = __shfl_xor(x1, 32);
                const float r0 = lo ? (x0 * cr - o0 * sr) : (x0 * cr + o0 * sr);
                const float r1 = lo ? (x1 * cc - o1 * sc) : (x1 * cc + o1 * sc);
                base[lane] = f2bf(r0); base[64 + lane] = f2bf(r1); } }
    }
}

namespace att {
using s16x4 = __attribute__((ext_vector_type(4))) short;
using f32x16 = __attribute__((ext_vector_type(16))) float;
constexpr int D = 128, NW = 8, QBLK = 32, KVBLK = 64, LD = 128;
constexpr float THR = 8.f;
constexpr size_t SHM_V = KVBLK * D * 2, SHM_K = KVBLK * D * 2, SHM_ATTN = 2 * SHM_V + 2 * SHM_K + NW * 64 * 4;
#define KSWZ(row, colB) ((row) * 256 + ((colB) ^ (((row) & 7) << 4)))
#define SBAR() __builtin_amdgcn_sched_barrier(0)
__device__ __forceinline__ int crow(int r, int hi) { return (r & 3) + 8 * (r >> 2) + 4 * hi; }
__device__ __forceinline__ unsigned cvtpk(float lo, float hi) { unsigned r; asm volatile("v_cvt_pk_bf16_f32 %0, %1, %2" : "=v"(r) : "v"(lo), "v"(hi)); return r; }
template <int DIFF>
__device__ __forceinline__ void partialSM(f32x16& p0, f32x16& p1, float& m_reg, float& mn, float& alpha) {
  constexpr float SCALE = DIFF ? 0.125f : 0.088388347648318440f;
  constexpr float C = SCALE * 1.4426950408889634f;
  float pmax = p0[0]; _Pragma("unroll") for (int r = 1; r < 16; ++r) pmax = fmaxf(pmax, p0[r]); _Pragma("unroll") for (int r = 0; r < 16; ++r) pmax = fmaxf(pmax, p1[r]);
  { auto rr = __builtin_amdgcn_permlane32_swap(__float_as_uint(pmax), __float_as_uint(pmax), false, false);
    pmax = fmaxf(__uint_as_float(rr[0]), __uint_as_float(rr[1])); }
  if (__builtin_expect(__all(pmax - m_reg <= THR / SCALE), 1)) { mn = m_reg; alpha = 1.f; }
  else { mn = fmaxf(m_reg, pmax); alpha = __builtin_amdgcn_exp2f((m_reg - mn) * C); m_reg = mn; }
  float mnC = -mn * C;
  _Pragma("unroll") for (int r = 0; r < 16; ++r) p0[r] = fmaf(p0[r], C, mnC); _Pragma("unroll") for (int r = 0; r < 16; ++r) p1[r] = fmaf(p1[r], C, mnC);
  _Pragma("unroll") for (int r = 0; r < 16; ++r) p0[r] = __builtin_amdgcn_exp2f(p0[r]);
}
__device__ __forceinline__ void finishSM(f32x16& p0, f32x16& p1, float alpha, float& l_reg, bf16x8& pa0, bf16x8& pa1, bf16x8& pa2, bf16x8& pa3) {
  _Pragma("unroll") for (int r = 0; r < 16; ++r) p1[r] = __builtin_amdgcn_exp2f(p1[r]);
  float ps = 0; _Pragma("unroll") for (int r = 0; r < 16; ++r) ps += p0[r]; _Pragma("unroll") for (int r = 0; r < 16; ++r) ps += p1[r];
  { auto rr = __builtin_amdgcn_permlane32_swap(__float_as_uint(ps), __float_as_uint(ps), false, false);
    ps = __uint_as_float(rr[0]) + __uint_as_float(rr[1]); }
  l_reg = l_reg * alpha + ps;
#define PK4(P, BASE, OUT) do { unsigned a0 = cvtpk(P[BASE + 0], P[BASE + 1]), a1 = cvtpk(P[BASE + 2], P[BASE + 3]);   \
    unsigned b0 = cvtpk(P[BASE + 4], P[BASE + 5]), b1 = cvtpk(P[BASE + 6], P[BASE + 7]);                              \
    auto r0 = __builtin_amdgcn_permlane32_swap(a0, b0, false, false); auto r1 = __builtin_amdgcn_permlane32_swap(a1, b1, false, false); \
    u32x4 w = {r0[0], r1[0], r0[1], r1[1]}; OUT = *reinterpret_cast<bf16x8*>(&w); } while (0)
  PK4(p0, 0, pa0); PK4(p0, 8, pa1); PK4(p1, 0, pa2); PK4(p1, 8, pa3);
#undef PK4
}
template <int ND0>
__device__ __forceinline__ void qkt(f32x16& p0, f32x16& p1, const bf16_t* Ks, const bf16x8* qr, int r32, int hi, int db0) {
  p0 = f32x16{}; p1 = f32x16{};
  _Pragma("unroll") for (int d0 = 0; d0 < ND0; ++d0) { int cb = ((db0 + d0) * 16 + hi * 8) * 2;
    bf16x8 b0 = *reinterpret_cast<const bf16x8*>((const char*)Ks + KSWZ(r32, cb));
    bf16x8 b1 = *reinterpret_cast<const bf16x8*>((const char*)Ks + KSWZ(32 + r32, cb));
    p0 = __builtin_amdgcn_mfma_f32_32x32x16_bf16(b0, qr[d0], p0, 0, 0, 0);
    p1 = __builtin_amdgcn_mfma_f32_32x32x16_bf16(b1, qr[d0], p1, 0, 0, 0); }
}
__device__ __forceinline__ int v_st(int k, int c) { const int kk = (k & ~0xC) | ((k & 4) << 1) | ((k & 8) >> 1); return ((kk >> 3) * 4 + (c >> 5)) * 512 + ((kk & 7) * 32 + (c & 31)) * 2; }
__device__ __forceinline__ int v_rd_base(int lane) { return ((lane & 3) << 3) | (((lane >> 2) & 3) << 6) | (((lane >> 4) & 1) << 5) | (((lane >> 5) & 1) << 8); }
constexpr int v_rd_off(int d0, int ks, int half) { return d0 * 512 + ks * 4096 + half * 2048; }
template <int OFF> __device__ __forceinline__ s16x4 tr_read(int vb) {
  s16x4 r; asm volatile("ds_read_b64_tr_b16 %0, %1 offset:%2" : "=&v"(r) : "v"(vb), "i"(OFF) : "memory"); return r;
}
template <int D0> __device__ __forceinline__ void pv_one(f32x16& od, int vb, bf16x8 pa0, bf16x8 pa1, bf16x8 pa2, bf16x8 pa3) {
  const s16x4 l0 = tr_read<v_rd_off(D0, 0, 0)>(vb), h0 = tr_read<v_rd_off(D0, 0, 1)>(vb), l1 = tr_read<v_rd_off(D0, 1, 0)>(vb), h1 = tr_read<v_rd_off(D0, 1, 1)>(vb);
  const s16x4 l2 = tr_read<v_rd_off(D0, 2, 0)>(vb), h2 = tr_read<v_rd_off(D0, 2, 1)>(vb), l3 = tr_read<v_rd_off(D0, 3, 0)>(vb), h3 = tr_read<v_rd_off(D0, 3, 1)>(vb);
  asm volatile("s_waitcnt lgkmcnt(0)" ::: "memory"); SBAR();
#define PK(L, H) (bf16x8){L[0], L[1], L[2], L[3], H[0], H[1], H[2], H[3]}
  od = __builtin_amdgcn_mfma_f32_32x32x16_bf16(pa0, PK(l0, h0), od, 0, 0, 0);
  od = __builtin_amdgcn_mfma_f32_32x32x16_bf16(pa1, PK(l1, h1), od, 0, 0, 0);
  od = __builtin_amdgcn_mfma_f32_32x32x16_bf16(pa2, PK(l2, h2), od, 0, 0, 0);
  od = __builtin_amdgcn_mfma_f32_32x32x16_bf16(pa3, PK(l3, h3), od, 0, 0, 0);
#undef PK
}
__device__ __forceinline__ void pv_d0(f32x16* o, int vb, bf16x8 pa0, bf16x8 pa1, bf16x8 pa2, bf16x8 pa3) {
  pv_one<0>(o[0], vb, pa0, pa1, pa2, pa3); pv_one<1>(o[1], vb, pa0, pa1, pa2, pa3); pv_one<2>(o[2], vb, pa0, pa1, pa2, pa3); pv_one<3>(o[3], vb, pa0, pa1, pa2, pa3);
}
template <int DIFF>
__device__ __forceinline__ void attn_unit(const bf16_t* Qb, const bf16_t* __restrict__ Kh, const bf16_t* __restrict__ Vh, bf16_t* Ob, const bf16_t* gate,
                                          int seq, char* lds, float lam, float osc, const float* nw) {
  constexpr int ND0 = DIFF ? 4 : 8;
  const int tid = otid(), wid = tid >> 6, lane = tid & 63, r32 = lane & 31, hi = lane >> 5;
  const int wq = DIFF ? (wid & 3) : wid, mapc = DIFF ? (wid >> 2) : 0;
  bf16_t* V_lds = (bf16_t*)lds; bf16_t* K_lds = (bf16_t*)(lds + 2 * SHM_V);
  float* ws = (float*)(lds + 2 * SHM_V + 2 * SHM_K) + wid * 64; float* li_l = ws; float* al_l = ws + 32;
  float m_reg = -1e30f, l_reg = 0; f32x16 o[4] = {}; bf16x8 qr[ND0];
  const bf16_t* Qw = Qb + (long)(wq * QBLK + r32) * LD + mapc * 64 + hi * 8;
  _Pragma("unroll") for (int d0 = 0; d0 < ND0; ++d0) qr[d0] = *reinterpret_cast<const bf16x8*>(Qw + d0 * 16);
  const int sr = tid >> 4, sc = (tid & 15) * 8, vst0 = v_st(sr, sc), vst1 = v_st(32 + sr, sc);
  const int vb0 = (int)(uintptr_t)V_lds + v_rd_base(lane);
  struct { bf16x8 vs0, vs1, ks0, ks1; } sr_[2];
#define SLOAD(i, k0) do { sr_[i].vs0 = *reinterpret_cast<const bf16x8*>(&Vh[(long)((k0) + sr) * LD + sc]); sr_[i].vs1 = *reinterpret_cast<const bf16x8*>(&Vh[(long)((k0) + 32 + sr) * LD + sc]); \
    sr_[i].ks0 = *reinterpret_cast<const bf16x8*>(&Kh[(long)((k0) + sr) * LD + sc]); sr_[i].ks1 = *reinterpret_cast<const bf16x8*>(&Kh[(long)((k0) + 32 + sr) * LD + sc]); } while (0)
#define SWRITE(b, i) do { *(bf16x8*)((char*)V_lds + (b) * SHM_V + vst0) = sr_[i].vs0;          \
    *(bf16x8*)((char*)V_lds + (b) * SHM_V + vst1) = sr_[i].vs1; int kc = sc * 2;               \
    *(bf16x8*)((char*)K_lds + (b) * SHM_K + KSWZ(sr, kc)) = sr_[i].ks0;                       \
    *(bf16x8*)((char*)K_lds + (b) * SHM_K + KSWZ(32 + sr, kc)) = sr_[i].ks1; } while (0)
#define SWAIT() asm volatile("s_waitcnt vmcnt(4)" ::: "memory")
#define RESC(a) do { if (__any((a) < 1.f)) { if (hi == 0) al_l[r32] = (a); asm volatile("s_waitcnt lgkmcnt(0)" ::: "memory"); \
    _Pragma("unroll") for (int d = 0; d < 4; ++d) _Pragma("unroll") for (int r = 0; r < 16; ++r) o[d][r] *= al_l[crow(r, hi)]; } } while (0)
  f32x16 pA0, pA1, pB0, pB1; float mnA, mnB, alA, alB; bf16x8 pa0, pa1, pa2, pa3; int NT = seq / KVBLK; asm volatile("" : "+s"(NT));
  constexpr int SE = 0, SO = 1;
  SLOAD(SE, 0); asm volatile("s_waitcnt vmcnt(0)" ::: "memory"); SWRITE(0, SE); __syncthreads();
  qkt<ND0>(pA0, pA1, K_lds, qr, r32, hi, mapc * 4); partialSM<DIFF>(pA0, pA1, m_reg, mnA, alA);
  SLOAD(SO, KVBLK); if (2 < NT) SLOAD(SE, 2 * KVBLK);
  SWAIT(); SWRITE(1, SO); __syncthreads();
  _Pragma("unroll 1") for (int j = 1; j + 1 < NT; j += 2) {
    SBAR(); qkt<ND0>(pB0, pB1, (bf16_t*)((char*)K_lds + SHM_K), qr, r32, hi, mapc * 4);
    finishSM(pA0, pA1, alA, l_reg, pa0, pa1, pa2, pa3); SBAR();
    SLOAD(SO, (j + 2) * KVBLK); SBAR();
    pv_d0(o, vb0, pa0, pa1, pa2, pa3); partialSM<DIFF>(pB0, pB1, m_reg, mnB, alB);
    __syncthreads(); SWAIT(); SWRITE(0, SE);
    RESC(alB); __syncthreads();
    SBAR(); qkt<ND0>(pA0, pA1, K_lds, qr, r32, hi, mapc * 4);
    finishSM(pB0, pB1, alB, l_reg, pa0, pa1, pa2, pa3); SBAR();
    if (j + 3 < NT) SLOAD(SE, (j + 3) * KVBLK); SBAR();
    pv_d0(o, vb0 + (int)SHM_V, pa0, pa1, pa2, pa3); partialSM<DIFF>(pA0, pA1, m_reg, mnA, alA);
    __syncthreads(); SWAIT(); SWRITE(1, SO);
    RESC(alA); __syncthreads();
  }
  SBAR(); qkt<ND0>(pB0, pB1, (bf16_t*)((char*)K_lds + SHM_K), qr, r32, hi, mapc * 4);
  finishSM(pA0, pA1, alA, l_reg, pa0, pa1, pa2, pa3); SBAR();
  pv_d0(o, vb0, pa0, pa1, pa2, pa3); partialSM<DIFF>(pB0, pB1, m_reg, mnB, alB);
  __syncthreads(); RESC(alB);
  finishSM(pB0, pB1, alB, l_reg, pa0, pa1, pa2, pa3); SBAR();
  pv_d0(o, vb0 + (int)SHM_V, pa0, pa1, pa2, pa3);
  if (hi == 0) li_l[r32] = l_reg; asm volatile("s_waitcnt lgkmcnt(0)" ::: "memory");
  float rli[16];
  _Pragma("unroll") for (int r = 0; r < 16; ++r) rli[r] = __builtin_amdgcn_rcpf(li_l[crow(r, hi)]);
  int r32e = r32; asm volatile("" : "+v"(r32e));
  if constexpr (!DIFF) {
    bf16_t* Ow = Ob + (long)(wid * QBLK) * LD; const bf16_t* Gw = gate + (long)(wid * QBLK) * LD;
    _Pragma("unroll") for (int r = 0; r < 16; ++r) { const int orow = crow(r, hi);
      _Pragma("unroll") for (int d0 = 0; d0 < 4; ++d0) { const float g = bf2f(Gw[(long)orow * LD + d0 * 32 + r32e]); Ow[(long)orow * LD + d0 * 32 + r32e] = f2bf(o[d0][r] * rli[r] * siluf(g)); }
      asm volatile("" ::: "memory"); }
    __syncthreads();
  } else {
    __syncthreads();
    float* X = (float*)lds;
    if (mapc == 1) {
      _Pragma("unroll") for (int r = 0; r < 16; ++r) { const int orow = wq * QBLK + crow(r, hi);
        _Pragma("unroll") for (int d0 = 0; d0 < 4; ++d0) X[orow * 128 + d0 * 32 + r32e] = o[d0][r] * rli[r] * lam; }
    }
    __syncthreads();
    if (mapc == 0) {
      bf16_t* Ow = Ob + (long)(wq * QBLK) * LD; const bf16_t* Gw = gate + (long)(wq * QBLK) * LD;
      _Pragma("unroll") for (int r = 0; r < 16; ++r) { const int orow = crow(r, hi); float v[4]; float ss = 0.f;
        _Pragma("unroll") for (int d0 = 0; d0 < 4; ++d0) { v[d0] = o[d0][r] * rli[r] - X[(wq * QBLK + orow) * 128 + d0 * 32 + r32e]; ss += v[d0] * v[d0]; }
        ss += __shfl_xor(ss, 1); ss += __shfl_xor(ss, 2); ss += __shfl_xor(ss, 4); ss += __shfl_xor(ss, 8); ss += __shfl_xor(ss, 16);
        const float rs = rsqrtf(ss * (1.f / 128.f) + NORM_EPS) * osc;
        _Pragma("unroll") for (int d0 = 0; d0 < 4; ++d0) { const int c = d0 * 32 + r32e; const float g = bf2f(Gw[(long)orow * LD + c]); Ow[(long)orow * LD + c] = f2bf(v[d0] * rs * nw[c] * siluf(g)); } }
    }
    __syncthreads();
  }
#undef SLOAD
#undef SWRITE
#undef SWAIT
#undef RESC
}
#undef KSWZ
#undef SBAR
}

__device__ __forceinline__ void gqa_unit(const Params& p, const int l, int u, char* lds) {
    const int qb = u & 31, hq = (u >> 5) & 3, b = u >> 7; const size_t row0 = (size_t)b * SEQ + (size_t)qb * 256, k0 = (size_t)b * SEQ;
    bf16_t* Q = pblk(p.ws, PB_GQ + hq) + row0 * 128;
    att::attn_unit<0>(Q, pblk(p.ws, PB_GK + (hq >> 1)) + k0 * 128, pblk(p.ws, PB_GV + (hq >> 1)) + k0 * 128, Q, pblk(p.ws, PB_GG + hq) + row0 * 128, SEQ, lds, 0.f, 1.f, nullptr);
}
__device__ __forceinline__ void diff_unit(const Params& p, const int l, int u, char* lds) {
    const int qb = u & 63, h = (u >> 6) & 3, b = u >> 8; const size_t row0 = (size_t)b * SEQ + (size_t)qb * 128, k0 = (size_t)b * SEQ;
    const float* lp = p.in[21] + l * 256;
    const int lane = otid() & 63;
    const float s1 = wave_sum(lp[lane] * lp[64 + lane]), s2 = wave_sum(lp[128 + lane] * lp[192 + lane]);
    const float lambda_init = 0.8f - 0.6f * expf(-0.3f * (float)l);
    const float lam = expf(s1) - expf(s2) + lambda_init;
    bf16_t* Q = pblk(p.ws, PB_DQ + h) + row0 * 128;
    att::attn_unit<1>(Q, pblk(p.ws, PB_DK + h) + k0 * 128, pblk(p.ws, PB_DV + h) + k0 * 128, Q, pblk(p.ws, PB_DG + h) + row0 * 128, SEQ, lds, lam, 1.f - lambda_init, p.in[22] + l * 128);
}

#define WAVE_FENCE() do { __builtin_amdgcn_fence(__ATOMIC_ACQ_REL, "workgroup"); __builtin_amdgcn_wave_barrier(); } while (0)
__device__ __forceinline__ void rwkv_naive_seq(const Params& p, const int l, int sid, float* lds) {
    const int j = otid() & 63; const int h = sid & 7, dir = (sid >> 3) & 1, b = sid >> 4;
    float* w2s = lds; float* a2s = lds + 4096; float* tws = lds + 8192; float* ads = tws + 64; float* ops = ads + 64;
    const float* w2 = p.in[13] + ((size_t)(l * 2 + dir) * 64) * 512 + h * 64; const float* a2 = p.in[15] + ((size_t)l * 64) * 512 + h * 64;
    for (int i = 0; i < 64; ++i) { w2s[i * 64 + j] = w2[(size_t)i * 512 + j]; a2s[i * 64 + j] = a2[(size_t)i * 512 + j]; }
    const float* mu = p.in[11] + (size_t)(l * 2 + dir) * 1664;
    const float mu_r = mu[h * 64 + j], mu_k = mu[512 + h * 64 + j], mu_v = mu[1024 + h * 64 + j], mu_w = mu[1536 + j], mu_a = mu[1600 + j];
    const float w0 = p.in[12][(l * 2 + dir) * 512 + h * 64 + j], a0 = p.in[14][l * 512 + h * 64 + j];
    const float kkc = p.in[16][l * 512 + h * 64 + j], kac = p.in[17][l * 512 + h * 64 + j], rkc = p.in[18][l * 512 + h * 64 + j];
    const bf16_t* Pr = pblk(p.ws, PB_R + (h >> 1)) + (h & 1) * 64 + j; const bf16_t* Pk = pblk(p.ws, PB_K + (h >> 1)) + (h & 1) * 64 + j;
    const bf16_t* Pv = pblk(p.ws, PB_V + (h >> 1)) + (h & 1) * 64 + j; const bf16_t* Pw = pblk(p.ws, PB_WA) + j; const bf16_t* Pa = pblk(p.ws, PB_WA) + 64 + j;
    bf16_t* wkv = (bf16_t*)(g_scr + SCR_WKV) + (size_t)dir * M_TOK * 512 + h * 64 + j; bf16_t* bon = (bf16_t*)(g_scr + SCR_BON) + (size_t)dir * M_TOK * 512 + h * 64 + j;
    float S[64];
#pragma unroll
    for (int k = 0; k < 64; ++k) S[k] = 0.f;
    float pr = 0.f, pk = 0.f, pv = 0.f, pw = 0.f, pa = 0.f;
    WAVE_FENCE();
    for (int s = 0; s < SEQ; ++s) {
        const int t = dir ? (SEQ - 1 - s) : s; const size_t m = (size_t)b * SEQ + t;
        const float xr = bf2f(Pr[m * 128]), xk = bf2f(Pk[m * 128]), xv = bf2f(Pv[m * 128]), xw = bf2f(Pw[m * 128]), xa = bf2f(Pa[m * 128]);
        const float r = xr + (pr - xr) * mu_r, k = xk + (pk - xk) * mu_k, v = xv + (pv - xv) * mu_v, wd = xw + (pw - xw) * mu_w, ad = xa + (pa - xa) * mu_a;
        pr = xr; pk = xk; pv = xv; pw = xw; pa = xa;
        tws[j] = tanhf(wd); ads[j] = ad;
        WAVE_FENCE();
        float wv = w0, av = a0;
#pragma unroll 8
        for (int i = 0; i < 64; ++i) { wv += tws[i] * w2s[i * 64 + j]; av += ads[i] * a2s[i * 64 + j]; }
        wv = -softplusf(-wv) - 0.5f; const float dec = expf(-expf(wv));
        av = 1.f / (1.f + expf(-av));
        float kk = k * kkc; const float nrm = sqrtf(wave_sum(kk * kk)); kk = kk / fmaxf(nrm, 1e-12f);
        const float kp = k * (1.f + (av - 1.f) * kac);
        const float bsc = wave_sum(r * kp * rkc);
        ops[j] = -kk; ops[64 + j] = kk * av; ops[128 + j] = dec; ops[192 + j] = kp; ops[256 + j] = r;
        WAVE_FENCE();
        float sa = 0.f;
#pragma unroll
        for (int k4 = 0; k4 < 16; ++k4) { const f32x4 a4 = *(const f32x4*)(ops + k4 * 4); sa += S[k4 * 4] * a4[0] + S[k4 * 4 + 1] * a4[1] + S[k4 * 4 + 2] * a4[2] + S[k4 * 4 + 3] * a4[3]; }
        float y = 0.f;
#pragma unroll
        for (int k4 = 0; k4 < 16; ++k4) { const f32x4 b4 = *(const f32x4*)(ops + 64 + k4 * 4), d4 = *(const f32x4*)(ops + 128 + k4 * 4), k4v = *(const f32x4*)(ops + 192 + k4 * 4), r4 = *(const f32x4*)(ops + 256 + k4 * 4);
#pragma unroll
            for (int e = 0; e < 4; ++e) { const float sn = S[k4 * 4 + e] * d4[e] + sa * b4[e] + v * k4v[e]; S[k4 * 4 + e] = sn; y += sn * r4[e]; } }
        wkv[m * 512] = f2bf(y); bon[m * 512] = f2bf(bsc * v);
        WAVE_FENCE();
    }
}

__device__ __forceinline__ void ssd_naive_seq(const Params& p, const int l, int sid, float* lds) {
    const int tid = otid(); const int h = sid & 7, dir = (sid >> 3) & 1, b = sid >> 4; const int g = h >> 2;
    float* xs = lds; float* Bs = lds + 2048; float* Cs = Bs + 4096; float* dts = Cs + 4096; float* das = dts + 32;
    const float* cw = p.in[5] + (size_t)l * 5 * 1024; const float* cb = p.in[6] + (size_t)l * 1024;
    const float A = -expf(p.in[7][(l * 2 + dir) * 8 + h]); const float dtb = p.in[8][(l * 2 + dir) * 8 + h]; const float Dh = p.in[9][l * 8 + h];
    const float* dtbuf = (const float*)(g_scr + SCR_DT);
    bf16_t* yout = (bf16_t*)(g_scr + SCR_SSDY) + (size_t)dir * M_TOK * 512 + h * 64;
    const int pp = tid >> 3, q = tid & 7;
    float hs[16];
#pragma unroll
    for (int n = 0; n < 16; ++n) hs[n] = 0.f;
    for (int s0 = 0; s0 < SEQ; s0 += 32) {
        __syncthreads();
        for (int idx = tid; idx < 32 * 320; idx += 512) {
            const int si = idx / 320, c = idx % 320; const int s = s0 + si; const int t = dir ? (SEQ - 1 - s) : s;
            int cch; const bf16_t* src;
            if (c < 64) { cch = h * 64 + c; src = pblk(p.ws, PB_XS + (h >> 1)) + (h & 1) * 64 + c; }
            else if (c < 192) { cch = 512 + g * 128 + (c - 64); src = pblk(p.ws, PB_BM + g) + (c - 64); }
            else { cch = 768 + g * 128 + (c - 192); src = pblk(p.ws, PB_CM + g) + (c - 192); }
            float acc = cb[cch];
#pragma unroll
            for (int jj = 0; jj < 5; ++jj) { const int tt = t + jj - 2; if (tt >= 0 && tt < SEQ) acc += cw[jj * 1024 + cch] * bf2f(src[((size_t)b * SEQ + tt) * 128]); }
            const float v = siluf(acc);
            if (c < 64) xs[si * 64 + c] = v; else if (c < 192) Bs[si * 128 + (c - 64)] = v; else Cs[si * 128 + (c - 192)] = v;
        }
        if (tid < 32) { const int s = s0 + tid; const int t = dir ? (SEQ - 1 - s) : s; const float dt = softplusf(dtbuf[((size_t)b * SEQ + t) * 16 + dir * 8 + h] + dtb); dts[tid] = dt; das[tid] = expf(dt * A); }
        __syncthreads();
        for (int si = 0; si < 32; ++si) {
            const int s = s0 + si; const int t = dir ? (SEQ - 1 - s) : s;
            const float x = xs[si * 64 + pp], dt = dts[si], da = das[si]; const float xdt = x * dt;
            float y = 0.f;
#pragma unroll
            for (int n4 = 0; n4 < 4; ++n4) { const f32x4 b4 = *(const f32x4*)(Bs + si * 128 + q * 16 + n4 * 4), c4 = *(const f32x4*)(Cs + si * 128 + q * 16 + n4 * 4);
#pragma unroll
                for (int e = 0; e < 4; ++e) { const float hn = hs[n4 * 4 + e] * da + xdt * b4[e]; hs[n4 * 4 + e] = hn; y += hn * c4[e]; } }
            y += __shfl_xor(y, 1); y += __shfl_xor(y, 2); y += __shfl_xor(y, 4);
            if (dir == 0) y += Dh * x;
            if (q == 0) yout[((size_t)b * SEQ + t) * 512 + pp] = f2bf(y);
        }
    }
}

__device__ __forceinline__ void phase_combine(const Params& p, const int l) {
    const int G = gridDim.x, tid = otid(), lane = tid & 63, wave = tid >> 6;
    const bf16_t* wkv = (const bf16_t*)(g_scr + SCR_WKV); const bf16_t* bon = (const bf16_t*)(g_scr + SCR_BON); const bf16_t* sy = (const bf16_t*)(g_scr + SCR_SSDY);
    const float* lnw = p.in[19] + l * 512; const float* lnb = p.in[20] + l * 512; const float* snw = p.in[10] + l * 512;
    for (int m = blockIdx.x * 8 + wave; m < M_TOK; m += G * 8) {
#pragma unroll
        for (int h = 0; h < 8; ++h) { const size_t o = (size_t)m * 512 + h * 64 + lane; const size_t o2 = o + (size_t)M_TOK * 512;
            const float w = bf2f(wkv[o]) + bf2f(wkv[o2]);
            const float mean = wave_sum(w) * (1.f / 64.f); const float d = w - mean; const float var = wave_sum(d * d) * (1.f / 64.f);
            const float gn = d * rsqrtf(var + 64e-5f) * lnw[h * 64 + lane] + lnb[h * 64 + lane];
            const float y = gn + bf2f(bon[o]) + bf2f(bon[o2]);
            bf16_t* gp = pblk(p.ws, PB_RG + (h >> 1)) + (size_t)m * 128 + (h & 1) * 64 + lane;
            *gp = f2bf(y * siluf(bf2f(*gp))); }
#pragma unroll
        for (int g = 0; g < 2; ++g) { float yg[4]; float ss = 0.f;
#pragma unroll
            for (int hh = 0; hh < 4; ++hh) { const int h = g * 4 + hh; const size_t o = (size_t)m * 512 + h * 64 + lane;
                const float y = bf2f(sy[o]) + bf2f(sy[o + (size_t)M_TOK * 512]);
                const float z = bf2f(pblk(p.ws, PB_Z + (h >> 1))[(size_t)m * 128 + (h & 1) * 64 + lane]);
                yg[hh] = y * siluf(z); ss += yg[hh] * yg[hh]; }
            ss = wave_sum(ss); const float rs = rsqrtf(ss * (1.f / 256.f) + NORM_EPS);
#pragma unroll
            for (int hh = 0; hh < 4; ++hh) { const int h = g * 4 + hh; pblk(p.ws, PB_Z + (h >> 1))[(size_t)m * 128 + (h & 1) * 64 + lane] = f2bf(yg[hh] * rs * snw[h * 64 + lane]); } }
    }
}

__device__ __forceinline__ void phase_post(const Params& p, const int l) {
    const int G = gridDim.x, tid = otid(), lane = tid & 63, wave = tid >> 6;
    const float* mix = (const float*)(p.ws + WS_MIX); const float* xin = l == 0 ? p.in[0] : p.out; const float* pw = p.in[2] + l * DMODEL;
    for (int m = blockIdx.x * 8 + wave; m < M_TOK; m += G * 8) {
        const f32x4* mr = (const f32x4*)(mix + (size_t)m * DMODEL) + lane; const f32x4* xr = (const f32x4*)(xin + (size_t)m * DMODEL) + lane; const f32x4* wr = (const f32x4*)pw + lane;
        f32x4 v[4]; float s = 0.f;
#pragma unroll
        for (int j = 0; j < 4; ++j) { v[j] = mr[64 * j]; s += (v[j].x * v[j].x + v[j].y * v[j].y) + (v[j].z * v[j].z + v[j].w * v[j].w); }
        const float rs = rsqrtf(wave_sum(s) * (1.f / DMODEL) + NORM_EPS);
        float s2 = 0.f;
#pragma unroll
        for (int j = 0; j < 4; ++j) { v[j] = xr[64 * j] + v[j] * rs * wr[64 * j]; s2 += (v[j].x * v[j].x + v[j].y * v[j].y) + (v[j].z * v[j].z + v[j].w * v[j].w); }
        s2 = wave_sum(s2);
        f32x4* orow = (f32x4*)(p.out + (size_t)m * DMODEL) + lane;
#pragma unroll
        for (int j = 0; j < 4; ++j) orow[64 * j] = v[j];
        if (lane == 0) ((float*)(g_scr + SCR_RS))[m] = rsqrtf(s2 * (1.f / DMODEL) + NORM_EPS);
        u32x2* o8 = (u32x2*)((bf16_t*)(g_scr + SCR_XB) + (size_t)m * DMODEL) + lane;
#pragma unroll
        for (int j = 0; j < 4; ++j) { u32x2 w; w.x = pk2(v[j].x, v[j].y); w.y = pk2(v[j].z, v[j].w); o8[64 * j] = w; }
    }
}

constexpr int LDS_BYTES = 147456;
__device__ __forceinline__ void phase_gemm_in(const Params& p, const int l, unsigned char* lds) {
    pg8::Gemm g{(const bf16_t*)(g_scr + SCR_XB), (const bf16_t*)(g_scr + SCR_WIN + (size_t)l * 15 * MiB), M_TOK, NPROJ, DMODEL, DMODEL, 128};
    pg8::StaticOrder S; S.init(M_TOK, NPROJ, gridDim.x, blockIdx.x);
    pg8::EpiProj E{(bf16_t*)p.ws, (const float*)(g_scr + SCR_RS), (float*)(g_scr + SCR_DT)};
    pg8::gemm_phase<pg8::EpiProj, pg8::StaticOrder, true, true>((PG8_LAS unsigned char*)lds, g, S, E);
}
__device__ __forceinline__ void phase_gemm_out(const Params& p, const int l, unsigned char* lds) {
    pg8::Gemm g{(const bf16_t*)p.ws, (const bf16_t*)(g_scr + SCR_WOUT + (size_t)l * 4 * MiB), M_TOK, DMODEL, DMIX, 128, PBLK_ELEMS};
    pg8::StaticOrder S; S.init(M_TOK, DMODEL, gridDim.x, blockIdx.x);
    pg8::EpiMix E{(float*)(p.ws + WS_MIX)};
    pg8::gemm_phase<pg8::EpiMix, pg8::StaticOrder, true, true>((PG8_LAS unsigned char*)lds, g, S, E);
}
__device__ __forceinline__ void phase_mixers(const Params& p, const int l, unsigned char* lds) {
    const int bid = blockIdx.x, G = gridDim.x;
    if (bid < 32) { if (threadIdx.x < 64) rwkv_naive_seq(p, l, bid, (float*)lds); }
    else if (bid < 64) ssd_naive_seq(p, l, bid - 32, (float*)lds);
    else { for (int u = bid - 64; u < 768; u += G - 64) { if (u < 256) gqa_unit(p, l, u, (char*)lds); else diff_unit(p, l, u - 256, (char*)lds); } }
}
__global__ void __launch_bounds__(512) mega(const Params p) {
    extern __shared__ __attribute__((aligned(16))) unsigned char lds[];
    cg::grid_group grid = cg::this_grid();
    phase_prologue(p, (float*)lds); grid.sync();
#pragma unroll 1
    for (int l = 0; l < 2; ++l) {
        phase_gemm_in(p, l, lds); grid.sync();
        phase_prep(p, l); grid.sync();
        phase_mixers(p, l, lds); grid.sync();
        phase_combine(p, l); grid.sync();
        phase_gemm_out(p, l, lds); grid.sync();
        phase_post(p, l); if (l == 0) grid.sync();
    }
}

extern "C" void kernel_launch(void* const* d_in, const int* in_sizes, int n_in, void* d_out, int out_size, void* d_ws, size_t ws_size, hipStream_t stream) {
    static int grid_blocks = 0;
    if (!grid_blocks) {
        int dev = 0, cus = 0, per_cu = 0;
        (void)hipGetDevice(&dev);
        (void)hipDeviceGetAttribute(&cus, hipDeviceAttributeMultiprocessorCount, dev);
        (void)hipFuncSetAttribute((const void*)mega, hipFuncAttributeMaxDynamicSharedMemorySize, LDS_BYTES);
        (void)hipOccupancyMaxActiveBlocksPerMultiprocessor(&per_cu, (const void*)mega, 512, LDS_BYTES);
        if (per_cu < 1) { fprintf(stderr, "kernel_launch: occupancy query says %d blocks/CU\n", per_cu); per_cu = 1; }
        grid_blocks = cus;
    }
    Params p{};
    for (int i = 0; i < 25; ++i) p.in[i] = (const float*)d_in[i];
    p.out = (float*)d_out; p.ws = (unsigned char*)d_ws;
    void* args[] = {&p};
    hipError_t e = hipLaunchCooperativeKernel((const void*)mega, dim3(grid_blocks), dim3(512), args, LDS_BYTES, stream);
    if (e != hipSuccess) fprintf(stderr, "cooperative launch failed: %s (grid %d)\n", hipGetErrorString(e), grid_blocks);
}
```

```cpp
#include <hip/hip_runtime.h>
#include <hip/hip_bf16.h>
#include <hip/hip_cooperative_groups.h>
#include <cstdio>
#include <cstdint>
namespace cg = cooperative_groups;

constexpr int M_TOK = 16384, SEQ = 8192, DMODEL = 1024, NPROJ = 7424, NPB = 58, DIN_ORIG = 7312, DMIX = 2048;
constexpr float NORM_EPS = 1e-6f;
constexpr size_t MiB = 1u << 20;
constexpr int PB_Z = 0, PB_RG = 4, PB_DQ = 8, PB_GQ = 12, PB_XS = 16, PB_BM = 20, PB_CM = 22, PB_R = 24, PB_K = 28, PB_V = 32, PB_WA = 36,
              PB_DK = 37, PB_DV = 41, PB_DG = 45, PB_GK = 49, PB_GV = 51, PB_GG = 53, PB_DT = 57;
constexpr size_t PBLK_ELEMS = (size_t)M_TOK * 128;
constexpr size_t SCR_WIN = 0, SCR_WOUT = 30 * MiB, SCR_ROPE = 38 * MiB, SCR_DT = 40 * MiB, SCR_RS = 41 * MiB, SCR_CTL = 41 * MiB + 512 * 1024,
                 SCR_XB = 42 * MiB, SCR_WKV = 74 * MiB, SCR_BON = 106 * MiB, SCR_SSDY = 138 * MiB, SCR_BYTES = 170 * MiB;
constexpr size_t WS_MIX = 16 * PBLK_ELEMS * 2;
__device__ __attribute__((aligned(256))) unsigned char g_scr[SCR_BYTES];

typedef unsigned short bf16_t;
typedef short bf16x8 __attribute__((ext_vector_type(8)));
typedef float f32x4 __attribute__((ext_vector_type(4)));
typedef unsigned u32x4 __attribute__((ext_vector_type(4)));
typedef unsigned u32x2 __attribute__((ext_vector_type(2)));

struct Params {
    const float* in[25];
    float* out;
    unsigned char* ws;
};

__device__ __forceinline__ int otid() { int t = threadIdx.x; asm volatile("" : "+v"(t)); return t; }
__device__ __forceinline__ float bf2f(bf16_t v) { return __uint_as_float(((unsigned)v) << 16); }
__device__ __forceinline__ bf16_t f2bf(float f) { unsigned u = __float_as_uint(f); return (bf16_t)((u + 0x7fffu + ((u >> 16) & 1u)) >> 16); }
__device__ __forceinline__ unsigned pk2(float lo, float hi) { return (unsigned)f2bf(lo) | ((unsigned)f2bf(hi) << 16); }
__device__ __forceinline__ float wave_sum(float v) {
#pragma unroll
    for (int o = 1; o < 64; o <<= 1) v += __shfl_xor(v, o);
    return v;
}
__device__ __forceinline__ float siluf(float x) { return x / (1.f + __expf(-x)); }
__device__ __forceinline__ float softplusf(float x) { return fmaxf(x, 0.f) + log1pf(__expf(-fabsf(x))); }
__device__ __forceinline__ bf16_t* pblk(unsigned char* ws, int j) { return (bf16_t*)ws + (size_t)j * PBLK_ELEMS; }

namespace pg8 {
#define PG8_LAS __attribute__((address_space(3)))
constexpr int BM = 256, BK = 64, HALF = 128, HTB = HALF * BK * 2, STAGE_BYTES = 8 * HTB, NXCD = 8, WGM = 8;
__host__ __device__ __forceinline__ int lds_byte(int r, int c) { const int st = (r >> 4) * 2 + (c >> 5), rr = r & 15, cc = c & 31, ob = rr * 64 + cc * 2; return st * 1024 + (ob ^ (((ob >> 9) & 1) << 5)); }
__host__ __device__ __forceinline__ void stage_rc(int b, int& R, int& C) { const int st = b / 1024, sb = b % 1024, swz = sb ^ (((sb >> 9) & 1) << 5); R = (st >> 1) * 16 + swz / 64; C = (st & 1) * 32 + (swz % 64) / 2; }
__host__ __device__ __forceinline__ int perm32(int rho) { const int n = rho >> 4, i = rho & 15; return 8 * (i >> 2) + 4 * n + (i & 3); }
struct Unit { int pm, pn; };
struct Gemm { const bf16_t* A; const bf16_t* Bt; int M, N, K; int lda; size_t abig; };
struct StaticOrder {
    int nM, nN, nwg, G, c;
    __host__ __device__ void init(int M, int N, int G_, int c_) { nM = M / BM; nN = N / BM; nwg = nM * nN; G = G_; c = c_; }
    __host__ __device__ bool next(int i, Unit& u) const {
        const long L = (long)i * G + c; if (L >= nwg) return false;
        int wgid = (int)L; { const int q = nwg / NXCD, r = nwg % NXCD, xcd = wgid % NXCD, off = wgid / NXCD; wgid = (xcd < r ? xcd * (q + 1) : r * (q + 1) + (xcd - r) * q) + off; }
        const int nig = WGM * nN, gid = wgid / nig, fm = gid * WGM, gsz = (nM - fm) < WGM ? (nM - fm) : WGM;
        u.pm = fm + ((wgid % nig) % gsz); u.pn = (wgid % nig) / gsz; return true;
    }
};
template <class Epi, class Sched, bool ALIGN_EPI = false, bool SP2 = false>
__device__ __forceinline__ void gemm_phase(PG8_LAS unsigned char* lds, const Gemm g, const Sched& S, const Epi& E) {
    const int tid = otid(), wid = __builtin_amdgcn_readfirstlane(tid >> 6), lane = tid & 63, wr = wid >> 2, wc = wid & 3, fr = lane & 15, fq = lane >> 4;
    const int K = g.K, nt = K / BK;
    unsigned voffA[2], voffB[2];
#pragma unroll
    for (int i = 0; i < 2; ++i) { int R, C; stage_rc(tid * 16 + i * 8192, R, C); const int Rb = Epi::PERM ? ((R & ~31) + perm32(R & 31)) : R;
        voffA[i] = (unsigned)(R * g.lda + C) * 2u; voffB[i] = (unsigned)(Rb * K + C) * 2u; }
    const size_t kstep = (size_t)(BK * 2);
    const size_t abig = g.abig * 2;
    const size_t hstepA = (size_t)HALF * g.lda * 2, hstepB = (size_t)HALF * K * 2;
    const size_t tstepA = 2 * hstepA, tstepB = 2 * hstepB;
    const unsigned ldsw = (unsigned)wid * 1024u;
    const int aoff = lds_byte(wr * 64 + fr, fq * 8), boff = lds_byte(wc * 32 + fr, fq * 8);
#define PG8_SA(b, h) (((b) * 2 + (h)) * HTB)
#define PG8_SB(b, h) ((4 + (b) * 2 + (h)) * HTB)
#define PG8_STAGE(bufoff, gbase, voff) do { _Pragma("unroll") for (int _i = 0; _i < 2; ++_i) \
        __builtin_amdgcn_global_load_lds((const unsigned*)((const char*)(gbase) + (voff)[_i]), (PG8_LAS unsigned*)(lds + (bufoff) + ldsw + _i * 8192), 16, 0, 0); } while (0)
#define PG8_LDA(dst, b, h) do { _Pragma("unroll") for (int m = 0; m < 4; ++m) _Pragma("unroll") for (int k = 0; k < 2; ++k) dst[m][k] = *(const PG8_LAS bf16x8*)(lds + PG8_SA(b, h) + aoff + m * 2048 + k * 1024); } while (0)
#define PG8_LDB(dst, b, h) do { _Pragma("unroll") for (int n = 0; n < 2; ++n) _Pragma("unroll") for (int k = 0; k < 2; ++k) dst[n][k] = *(const PG8_LAS bf16x8*)(lds + PG8_SB(b, h) + boff + n * 2048 + k * 1024); } while (0)
#define PG8_MMA(ai, bj, At, Bt) do { __builtin_amdgcn_s_setprio(1); _Pragma("unroll") for (int m = 0; m < 4; ++m) _Pragma("unroll") for (int n = 0; n < 2; ++n) _Pragma("unroll") for (int k = 0; k < 2; ++k) \
        acc[ai][bj][m][n] = __builtin_amdgcn_mfma_f32_16x16x32_bf16(Bt[n][k], At[m][k], acc[ai][bj][m][n], 0, 0, 0); __builtin_amdgcn_s_setprio(0); } while (0)
#define PG8_WAIT_V(n) asm volatile("s_waitcnt vmcnt(" #n ")" ::: "memory")
#define PG8_WAIT_L(n) asm volatile("s_waitcnt lgkmcnt(" #n ")" ::: "memory")
#define PG8_BAR __builtin_amdgcn_s_barrier()
#define PG8_SCHED __builtin_amdgcn_sched_barrier(0)
    Unit cur, nxt; int ui = 0;
    if (!S.next(0, cur)) return;
    f32x4 acc[2][2][4][2];
#pragma unroll
    for (int a = 0; a < 2; ++a)
#pragma unroll
        for (int b = 0; b < 2; ++b)
#pragma unroll
            for (int m = 0; m < 4; ++m)
#pragma unroll
                for (int n = 0; n < 2; ++n) acc[a][b][m][n] = (f32x4){0.f, 0.f, 0.f, 0.f};
    bf16x8 At[4][2], B0[2][2], B1[2][2];
    const char* cA = (const char*)g.A + (size_t)cur.pm * tstepA; const char* cB = (const char*)g.Bt + (size_t)cur.pn * tstepB;
    if constexpr (SP2) {
        PG8_STAGE(PG8_SB(0, 0), cB, voffB); PG8_STAGE(PG8_SB(0, 1), cB + hstepB, voffB); PG8_STAGE(PG8_SA(0, 0), cA, voffA); PG8_STAGE(PG8_SA(0, 1), cA + hstepA, voffA);
        if (wr == 1) PG8_BAR;
        PG8_WAIT_V(2); PG8_BAR;
        PG8_STAGE(PG8_SB(1, 0), cB + kstep, voffB); PG8_STAGE(PG8_SA(1, 0), cA + kstep, voffA); PG8_STAGE(PG8_SB(1, 1), cB + hstepB + kstep, voffB);
        PG8_WAIT_V(6); PG8_BAR;
    } else {
        PG8_STAGE(PG8_SB(0, 0), cB, voffB); PG8_STAGE(PG8_SA(0, 0), cA, voffA); PG8_STAGE(PG8_SB(0, 1), cB + hstepB, voffB); PG8_STAGE(PG8_SA(0, 1), cA + hstepA, voffA);
        if (wr == 1) PG8_BAR;
        PG8_WAIT_V(4); PG8_BAR;
        PG8_STAGE(PG8_SB(1, 0), cB + kstep, voffB); PG8_STAGE(PG8_SA(1, 0), cA + kstep, voffA); PG8_STAGE(PG8_SB(1, 1), cB + hstepB + kstep, voffB);
        PG8_WAIT_V(6); PG8_BAR;
    }
    for (;;) {
        const bool has_next = S.next(ui + 1, nxt);
        const char* nA = has_next ? (const char*)g.A + (size_t)nxt.pm * tstepA : cA; const char* nB = has_next ? (const char*)g.Bt + (size_t)nxt.pn * tstepB : cB;
        for (int t = 0; t < nt; t += 2) {
            const bool last = (t == nt - 2);
            const char* a1 = cA + (size_t)(t >> 1) * abig + kstep;
            const char* a2 = last ? nA : cA + (size_t)((t >> 1) + 1) * abig; const char* b2 = last ? nB : cB + (size_t)(t + 2) * kstep;
            const char* a3 = a2 + kstep; const char* b3 = b2 + kstep;
            if constexpr (SP2) {
            PG8_LDB(B0, 0, 0); PG8_LDB(B1, 0, 1); PG8_SCHED; PG8_LDA(At, 0, 0); PG8_STAGE(PG8_SA(1, 1), a1 + hstepA, voffA);
            PG8_WAIT_V(8); PG8_WAIT_L(0); PG8_BAR; PG8_MMA(0, 0, At, B0); PG8_MMA(0, 1, At, B1); PG8_BAR; PG8_SCHED;
            PG8_LDA(At, 0, 1); PG8_STAGE(PG8_SB(0, 0), b2, voffB); PG8_STAGE(PG8_SB(0, 1), b2 + hstepB, voffB); PG8_STAGE(PG8_SA(0, 0), a2, voffA);
            PG8_WAIT_V(8); PG8_WAIT_L(0); PG8_BAR; PG8_MMA(1, 0, At, B0); PG8_MMA(1, 1, At, B1); PG8_BAR; PG8_SCHED;
            PG8_LDB(B0, 1, 0); PG8_LDB(B1, 1, 1); PG8_SCHED; PG8_LDA(At, 1, 0); PG8_STAGE(PG8_SA(0, 1), a2 + hstepA, voffA);
            PG8_WAIT_V(8); PG8_WAIT_L(0); PG8_BAR; PG8_MMA(0, 0, At, B0); PG8_MMA(0, 1, At, B1); PG8_BAR; PG8_SCHED;
            PG8_LDA(At, 1, 1); PG8_STAGE(PG8_SB(1, 0), b3, voffB); PG8_STAGE(PG8_SB(1, 1), b3 + hstepB, voffB); PG8_STAGE(PG8_SA(1, 0), a3, voffA);
            PG8_WAIT_V(8); PG8_WAIT_L(0); PG8_BAR; PG8_MMA(1, 0, At, B0); PG8_MMA(1, 1, At, B1); PG8_BAR; PG8_SCHED;
            } else {
            PG8_LDB(B0, 0, 0); PG8_SCHED; PG8_LDA(At, 0, 0); PG8_STAGE(PG8_SA(1, 1), a1 + hstepA, voffA);
            PG8_WAIT_L(8); PG8_BAR; PG8_WAIT_L(0); PG8_MMA(0, 0, At, B0); PG8_BAR; PG8_SCHED;
            PG8_LDB(B1, 0, 1); PG8_STAGE(PG8_SB(0, 0), b2, voffB);
            PG8_BAR; PG8_WAIT_L(0); PG8_MMA(0, 1, At, B1); PG8_BAR;
            PG8_LDA(At, 0, 1); PG8_STAGE(PG8_SA(0, 0), a2, voffA);
            PG8_BAR; PG8_WAIT_L(0); PG8_MMA(1, 0, At, B0); PG8_BAR; PG8_SCHED;
            PG8_STAGE(PG8_SB(0, 1), b2 + hstepB, voffB);
            PG8_WAIT_V(6); PG8_BAR; PG8_MMA(1, 1, At, B1); PG8_BAR;
            PG8_LDB(B0, 1, 0); PG8_SCHED; PG8_LDA(At, 1, 0); PG8_STAGE(PG8_SA(0, 1), a2 + hstepA, voffA);
            PG8_WAIT_L(8); PG8_BAR; PG8_WAIT_L(0); PG8_MMA(0, 0, At, B0); PG8_BAR; PG8_SCHED;
            PG8_LDB(B1, 1, 1); PG8_STAGE(PG8_SB(1, 0), b3, voffB);
            PG8_BAR; PG8_WAIT_L(0); PG8_MMA(0, 1, At, B1); PG8_BAR;
            PG8_LDA(At, 1, 1); PG8_STAGE(PG8_SA(1, 0), a3, voffA);
            PG8_BAR; PG8_WAIT_L(0); PG8_MMA(1, 0, At, B0); PG8_BAR; PG8_SCHED;
            PG8_STAGE(PG8_SB(1, 1), b3 + hstepB, voffB);
            PG8_WAIT_V(6); PG8_BAR; PG8_MMA(1, 1, At, B1); PG8_BAR;
            }
        }
        if constexpr (ALIGN_EPI) { if (wr == 0) PG8_BAR; }
        E(acc, cur, wr, wc, fr, fq);
        if (!has_next) break;
#pragma unroll
        for (int a = 0; a < 2; ++a)
#pragma unroll
            for (int b = 0; b < 2; ++b)
#pragma unroll
                for (int m = 0; m < 4; ++m)
#pragma unroll
                    for (int n = 0; n < 2; ++n) acc[a][b][m][n] = (f32x4){0.f, 0.f, 0.f, 0.f};
        cur = nxt; cA = nA; cB = nB; ++ui;
        if constexpr (ALIGN_EPI) { if (wr == 1) PG8_BAR; }
    }
    PG8_WAIT_V(0);
    if constexpr (!ALIGN_EPI) { if (wr == 0) PG8_BAR; }
    PG8_BAR;
#undef PG8_SA
#undef PG8_SB
#undef PG8_STAGE
#undef PG8_LDA
#undef PG8_LDB
#undef PG8_MMA
#undef PG8_WAIT_V
#undef PG8_WAIT_L
#undef PG8_BAR
#undef PG8_SCHED
}
struct EpiProj {
    static constexpr bool PERM = true;
    bf16_t* P; const float* rowscale; float* dtbuf;
    __device__ __forceinline__ void operator()(const f32x4 (&acc)[2][2][4][2], const Unit& u, int wr, int wc, int fr, int fq) const {
        const int row0 = u.pm * BM + wr * 64 + fr; const int col = wc * 32 + 8 * fq;
#pragma unroll
        for (int ai = 0; ai < 2; ++ai)
#pragma unroll
            for (int m = 0; m < 4; ++m) { const int row = row0 + ai * HALF + m * 16; const float sc = rowscale[row];
#pragma unroll
                for (int bj = 0; bj < 2; ++bj) { const int blk = u.pn * 2 + bj;
                    const f32x4 v0 = acc[ai][bj][m][0] * sc, v1 = acc[ai][bj][m][1] * sc;
                    u32x4 w; w.x = pk2(v0[0], v0[1]); w.y = pk2(v0[2], v0[3]); w.z = pk2(v1[0], v1[1]); w.w = pk2(v1[2], v1[3]);
                    *(u32x4*)(P + (size_t)blk * PBLK_ELEMS + (size_t)row * 128 + col) = w;
                    if (blk == PB_DT && col < 16) { float* d = dtbuf + (size_t)row * 16 + col; *(f32x4*)d = v0; *(f32x4*)(d + 4) = v1; } } }
    }
};
struct EpiMix {
    static constexpr bool PERM = true;
    float* O;
    __device__ __forceinline__ void operator()(const f32x4 (&acc)[2][2][4][2], const Unit& u, int wr, int wc, int fr, int fq) const {
        const int row0 = u.pm * BM + wr * 64 + fr; const int col0 = u.pn * BM + wc * 32 + 8 * fq;
#pragma unroll
        for (int ai = 0; ai < 2; ++ai)
#pragma unroll
            for (int m = 0; m < 4; ++m) { float* rp = O + (size_t)(row0 + ai * HALF + m * 16) * DMODEL + col0;
#pragma unroll
                for (int bj = 0; bj < 2; ++bj) { *(f32x4*)(rp + bj * HALF) = acc[ai][bj][m][0]; *(f32x4*)(rp + bj * HALF + 4) = acc[ai][bj][m][1]; } }
    }
};
}

__device__ __forceinline__ int orig_col(int n) {
    if (n < 512) return n;
    if (n < 1024) return 3216 + (n - 512);
    if (n < 1536) return 3728 + (n - 1024);
    if (n < 2048) return 5776 + (n - 1536);
    if (n < 3072) return 512 + (n - 2048);
    if (n < 4736) return 1552 + (n - 3072);
    if (n < 5248) return 4240 + (n - 4736);
    if (n < 5760) return 4752 + (n - 5248);
    if (n < 6272) return 5264 + (n - 5760);
    if (n < 6528) return 6288 + (n - 6272);
    if (n < 6784) return 6544 + (n - 6528);
    if (n < 7296) return 6800 + (n - 6784);
    if (n < 7312) return 1536 + (n - 7296);
    return -1;
}
template <bool MAPCOL>
__device__ __forceinline__ void transpose_item(const float* W, int K, int Nsrc, const float* ks, bf16_t* WT, float* scr  , int kb, int nb) {
    const int tid = otid(); const int k0 = kb * 64, n0 = nb * 64;
    {   const int nn = tid & 63; const int n = n0 + nn; const int oc = MAPCOL ? orig_col(n) : n;
#pragma unroll
        for (int i = 0; i < 8; ++i) { const int kk = (tid >> 6) + 8 * i; float v = 0.f; if (oc >= 0) v = W[(size_t)(k0 + kk) * Nsrc + oc] * (ks ? ks[k0 + kk] : 1.f); scr[kk * 65 + nn] = v; } }
    __syncthreads();
    {   const int n = tid >> 3, c = tid & 7; const float* s = scr + (8 * c) * 65 + n;
        u32x4 o; o.x = pk2(s[0], s[65]); o.y = pk2(s[2 * 65], s[3 * 65]); o.z = pk2(s[4 * 65], s[5 * 65]); o.w = pk2(s[6 * 65], s[7 * 65]);
        *(u32x4*)(WT + (size_t)(n0 + n) * K + k0 + 8 * c) = o; }
    __syncthreads();
}
__device__ __forceinline__ void rope_entry(int idx, float* tab) {
    const int pos = idx >> 5, i = idx & 31;
    const float inv = exp2f(-(float)i * (13.287712379549449f / 32.f));
    const float ang = (float)pos * inv;
    const double rev = (double)ang * 0.15915494309189535; const double fr = rev - floor(rev);
    const float a = (float)(fr * 6.283185307179586);
    tab[idx * 2] = cosf(a); tab[idx * 2 + 1] = sinf(a);
}
__device__ __forceinline__ void xrow_to_bf16(const float* xrow, bf16_t* orow, float* rs, int lane) {
    const f32x4* xr = (const f32x4*)xrow + lane; f32x4 v[4]; float s = 0.f;
#pragma unroll
    for (int j = 0; j < 4; ++j) { v[j] = xr[64 * j]; s += (v[j].x * v[j].x + v[j].y * v[j].y) + (v[j].z * v[j].z + v[j].w * v[j].w); }
    s = wave_sum(s);
    if (lane == 0) *rs = rsqrtf(s * (1.f / DMODEL) + NORM_EPS);
    u32x2* o8 = (u32x2*)orow + lane;
#pragma unroll
    for (int j = 0; j < 4; ++j) { u32x2 w; w.x = pk2(v[j].x, v[j].y); w.y = pk2(v[j].z, v[j].w); o8[64 * j] = w; }
}
__device__ __forceinline__ void phase_prologue(const Params& p, float* lds_f) {
    const int G = gridDim.x, bid = blockIdx.x, tid = otid(), lane = tid & 63, wave = tid >> 6;
    constexpr int I_IN = 16 * 116, I_OUT = 32 * 16;
    for (int it = bid; it < 2 * (I_IN + I_OUT); it += G) {
        int r = it; const int l = r / (I_IN + I_OUT); r -= l * (I_IN + I_OUT);
        if (r < I_IN) transpose_item<true>(p.in[3] + (size_t)l * DMODEL * DIN_ORIG, DMODEL, DIN_ORIG, p.in[1] + l * DMODEL, (bf16_t*)(g_scr + SCR_WIN + (size_t)l * 15 * MiB), lds_f, r / 116, r % 116);
        else { r -= I_IN; transpose_item<false>(p.in[4] + (size_t)l * DMIX * DMODEL, DMIX, DMODEL, nullptr, (bf16_t*)(g_scr + SCR_WOUT + (size_t)l * 4 * MiB), lds_f, r / 16, r % 16); }
    }
    for (int i = bid * 512 + tid; i < SEQ * 32; i += G * 512) rope_entry(i, (float*)(g_scr + SCR_ROPE));
    for (int m = bid * 8 + wave; m < M_TOK; m += G * 8) xrow_to_bf16(p.in[0] + (size_t)m * DMODEL, (bf16_t*)(g_scr + SCR_XB) + (size_t)m * DMODEL, (float*)(g_scr + SCR_RS) + m, lane);
}

__device__ __forceinline__ void phase_prep(const Params& p, const int l) {
    const int G = gridDim.x, tid = otid(), lane = tid & 63, wave = tid >> 6;
    const float* tab = (const float*)(g_scr + SCR_ROPE);
    const float* qw = p.in[23] + l * 128; const float* kw = p.in[24] + l * 128;
    const int i32 = lane & 31; const bool lo = (lane & 32) == 0;
    for (int m = blockIdx.x * 8 + wave; m < M_TOK; m += G * 8) {
        const int t = m & (SEQ - 1);
        {   const float cs = tab[(t * 32 + i32) * 2], sn = tab[(t * 32 + i32) * 2 + 1];
#pragma unroll
            for (int h = 0; h < 8; ++h) { bf16_t* base = pblk(p.ws, (h < 4 ? PB_DQ + h : PB_DK + (h - 4))) + (size_t)m * 128;
#pragma unroll
                for (int c = 0; c < 2; ++c) { const float x = bf2f(base[c * 64 + lane]); const float o = __shfl_xor(x, 32);
                    const float r = lo ? (x * cs - o * sn) : (x * cs + o * sn); base[c * 64 + lane] = f2bf(r); } } }
        {   const int row = t >> 6, col = t & 63;
            const float cr = tab[(row * 32 + i32) * 2], sr = tab[(row * 32 + i32) * 2 + 1], cc = tab[(col * 32 + i32) * 2], sc = tab[(col * 32 + i32) * 2 + 1];
#pragma unroll
            for (int h = 0; h < 6; ++h) { bf16_t* base = pblk(p.ws, (h < 4 ? PB_GQ + h : PB_GK + (h - 4))) + (size_t)m * 128; const float* w = h < 4 ? qw : kw;
                float x0 = bf2f(base[lane]), x1 = bf2f(base[64 + lane]);
                const float ss = wave_sum(x0 * x0 + x1 * x1); const float rs = rsqrtf(ss * (1.f / 128.f) + NORM_EPS);
                x0 *= rs * w[lane]; x1 *= rs * w[64 + lane];
                const float o0 = __shfl_xor(x0, 32), o1 = __shfl_xor(x1, 32);
                const float r0 = lo ? (x0 * cr - o0 * sr) : (x0 * cr + o0 * sr);
                const float r1 = lo ? (x1 * cc - o1 * sc) : (x1 * cc + o1 * sc);
                base[lane] = f2bf(r0); base[64 + lane] = f2bf(r1); } }
    }
}

namespace att {
using s16x4 = __attribute__((ext_vector_type(4))) short;
using f32x16 = __attribute__((ext_vector_type(16))) float;
constexpr int D = 128, NW = 8, QBLK = 32, KVBLK = 64, LD = 128;
constexpr float THR = 8.f;
constexpr size_t SHM_V = KVBLK * D * 2, SHM_K = KVBLK * D * 2, SHM_ATTN = 2 * SHM_V + 2 * SHM_K + NW * 64 * 4;
#define KSWZ(row, colB) ((row) * 256 + ((colB) ^ (((row) & 7) << 4)))
#define SBAR() __builtin_amdgcn_sched_barrier(0)
__device__ __forceinline__ int crow(int r, int hi) { return (r & 3) + 8 * (r >> 2) + 4 * hi; }
__device__ __forceinline__ unsigned cvtpk(float lo, float hi) { unsigned r; asm volatile("v_cvt_pk_bf16_f32 %0, %1, %2" : "=v"(r) : "v"(lo), "v"(hi)); return r; }
template <int DIFF>
__device__ __forceinline__ void partialSM(f32x16& p0, f32x16& p1, float& m_reg, float& mn, float& alpha) {
  constexpr float SCALE = DIFF ? 0.125f : 0.088388347648318440f;
  constexpr float C = SCALE * 1.4426950408889634f;
  float pmax = p0[0]; _Pragma("unroll") for (int r = 1; r < 16; ++r) pmax = fmaxf(pmax, p0[r]); _Pragma("unroll") for (int r = 0; r < 16; ++r) pmax = fmaxf(pmax, p1[r]);
  { auto rr = __builtin_amdgcn_permlane32_swap(__float_as_uint(pmax), __float_as_uint(pmax), false, false);
    pmax = fmaxf(__uint_as_float(rr[0]), __uint_as_float(rr[1])); }
  if (__builtin_expect(__all(pmax - m_reg <= THR / SCALE), 1)) { mn = m_reg; alpha = 1.f; }
  else { mn = fmaxf(m_reg, pmax); alpha = __builtin_amdgcn_exp2f((m_reg - mn) * C); m_reg = mn; }
  float mnC = -mn * C;
  _Pragma("unroll") for (int r = 0; r < 16; ++r) p0[r] = fmaf(p0[r], C, mnC); _Pragma("unroll") for (int r = 0; r < 16; ++r) p1[r] = fmaf(p1[r], C, mnC);
  _Pragma("unroll") for (int r = 0; r < 16; ++r) p0[r] = __builtin_amdgcn_exp2f(p0[r]);
}
__device__ __forceinline__ void finishSM(f32x16& p0, f32x16& p1, float alpha, float& l_reg, bf16x8& pa0, bf16x8& pa1, bf16x8& pa2, bf16x8& pa3) {
  _Pragma("unroll") for (int r = 0; r < 16; ++r) p1[r] = __builtin_amdgcn_exp2f(p1[r]);
  float ps = 0; _Pragma("unroll") for (int r = 0; r < 16; ++r) ps += p0[r]; _Pragma("unroll") for (int r = 0; r < 16; ++r) ps += p1[r];
  { auto rr = __builtin_amdgcn_permlane32_swap(__float_as_uint(ps), __float_as_uint(ps), false, false);
    ps = __uint_as_float(rr[0]) + __uint_as_float(rr[1]); }
  l_reg = l_reg * alpha + ps;
#define PK4(P, BASE, OUT) do { unsigned a0 = cvtpk(P[BASE + 0], P[BASE + 1]), a1 = cvtpk(P[BASE + 2], P[BASE + 3]);   \
    unsigned b0 = cvtpk(P[BASE + 4], P[BASE + 5]), b1 = cvtpk(P[BASE + 6], P[BASE + 7]);                              \
    auto r0 = __builtin_amdgcn_permlane32_swap(a0, b0, false, false); auto r1 = __builtin_amdgcn_permlane32_swap(a1, b1, false, false); \
    u32x4 w = {r0[0], r1[0], r0[1], r1[1]}; OUT = *reinterpret_cast<bf16x8*>(&w); } while (0)
  PK4(p0, 0, pa0); PK4(p0, 8, pa1); PK4(p1, 0, pa2); PK4(p1, 8, pa3);
#undef PK4
}
template <int ND0>
__device__ __forceinline__ void qkt(f32x16& p0, f32x16& p1, const bf16_t* Ks, const bf16x8* qr, int r32, int hi, int db0) {
  p0 = f32x16{}; p1 = f32x16{};
  _Pragma("unroll") for (int d0 = 0; d0 < ND0; ++d0) { int cb = ((db0 + d0) * 16 + hi * 8) * 2;
    bf16x8 b0 = *reinterpret_cast<const bf16x8*>((const char*)Ks + KSWZ(r32, cb));
    bf16x8 b1 = *reinterpret_cast<const bf16x8*>((const char*)Ks + KSWZ(32 + r32, cb));
    p0 = __builtin_amdgcn_mfma_f32_32x32x16_bf16(b0, qr[d0], p0, 0, 0, 0);
    p1 = __builtin_amdgcn_mfma_f32_32x32x16_bf16(b1, qr[d0], p1, 0, 0, 0); }
}
__device__ __forceinline__ int v_st(int k, int c) { const int kk = (k & ~0xC) | ((k & 4) << 1) | ((k & 8) >> 1); return ((kk >> 3) * 4 + (c >> 5)) * 512 + ((kk & 7) * 32 + (c & 31)) * 2; }
__device__ __forceinline__ int v_rd_base(int lane) { return ((lane & 3) << 3) | (((lane >> 2) & 3) << 6) | (((lane >> 4) & 1) << 5) | (((lane >> 5) & 1) << 8); }
constexpr int v_rd_off(int d0, int ks, int half) { return d0 * 512 + ks * 4096 + half * 2048; }
template <int OFF> __device__ __forceinline__ s16x4 tr_read(int vb) {
  s16x4 r; asm volatile("ds_read_b64_tr_b16 %0, %1 offset:%2" : "=&v"(r) : "v"(vb), "i"(OFF) : "memory"); return r;
}
template <int D0> __device__ __forceinline__ void pv_one(f32x16& od, int vb, bf16x8 pa0, bf16x8 pa1, bf16x8 pa2, bf16x8 pa3) {
  const s16x4 l0 = tr_read<v_rd_off(D0, 0, 0)>(vb), h0 = tr_read<v_rd_off(D0, 0, 1)>(vb), l1 = tr_read<v_rd_off(D0, 1, 0)>(vb), h1 = tr_read<v_rd_off(D0, 1, 1)>(vb);
  const s16x4 l2 = tr_read<v_rd_off(D0, 2, 0)>(vb), h2 = tr_read<v_rd_off(D0, 2, 1)>(vb), l3 = tr_read<v_rd_off(D0, 3, 0)>(vb), h3 = tr_read<v_rd_off(D0, 3, 1)>(vb);
  asm volatile("s_waitcnt lgkmcnt(0)" ::: "memory"); SBAR();
#define PK(L, H) (bf16x8){L[0], L[1], L[2], L[3], H[0], H[1], H[2], H[3]}
  od = __builtin_amdgcn_mfma_f32_32x32x16_bf16(pa0, PK(l0, h0), od, 0, 0, 0);
  od = __builtin_amdgcn_mfma_f32_32x32x16_bf16(pa1, PK(l1, h1), od, 0, 0, 0);
  od = __builtin_amdgcn_mfma_f32_32x32x16_bf16(pa2, PK(l2, h2), od, 0, 0, 0);
  od = __builtin_amdgcn_mfma_f32_32x32x16_bf16(pa3, PK(l3, h3), od, 0, 0, 0);
#undef PK
}
__device__ __forceinline__ void pv_d0(f32x16* o, int vb, bf16x8 pa0, bf16x8 pa1, bf16x8 pa2, bf16x8 pa3) {
  pv_one<0>(o[0], vb, pa0, pa1, pa2, pa3); pv_one<1>(o[1], vb, pa0, pa1, pa2, pa3); pv_one<2>(o[2], vb, pa0, pa1, pa2, pa3); pv_one<3>(o[3], vb, pa0, pa1, pa2, pa3);
}
template <int DIFF>
__device__ __forceinline__ void attn_unit(const bf16_t* Qb, const bf16_t* __restrict__ Kh, const bf16_t* __restrict__ Vh, bf16_t* Ob, const bf16_t* gate,
                                          int seq, char* lds, const float* lamp, int layer, const float* nw) {
  constexpr int ND0 = DIFF ? 4 : 8;
  const int tid = otid(), wid = tid >> 6, lane = tid & 63, r32 = lane & 31, hi = lane >> 5;
  const int wq = DIFF ? (wid & 3) : wid, mapc = DIFF ? (wid >> 2) : 0;
  bf16_t* V_lds = (bf16_t*)lds; bf16_t* K_lds = (bf16_t*)(lds + 2 * SHM_V);
  float* ws = (float*)(lds + 2 * SHM_V + 2 * SHM_K) + wid * 64; float* li_l = ws; float* al_l = ws + 32;
  float m_reg = -1e30f, l_reg = 0; f32x16 o[4] = {}; bf16x8 qr[ND0];
  const bf16_t* Qw = Qb + (long)(wq * QBLK + r32) * LD + mapc * 64 + hi * 8;
  _Pragma("unroll") for (int d0 = 0; d0 < ND0; ++d0) qr[d0] = *reinterpret_cast<const bf16x8*>(Qw + d0 * 16);
  const int sr = tid >> 4, sc = (tid & 15) * 8, vst0 = v_st(sr, sc), vst1 = v_st(32 + sr, sc);
  const int vb0 = (int)(uintptr_t)V_lds + v_rd_base(lane);
  struct { bf16x8 vs0, vs1, ks0, ks1; } sr_[2];
#define SLOAD(i, k0) do { sr_[i].vs0 = *reinterpret_cast<const bf16x8*>(&Vh[(long)((k0) + sr) * LD + sc]); sr_[i].vs1 = *reinterpret_cast<const bf16x8*>(&Vh[(long)((k0) + 32 + sr) * LD + sc]); \
    sr_[i].ks0 = *reinterpret_cast<const bf16x8*>(&Kh[(long)((k0) + sr) * LD + sc]); sr_[i].ks1 = *reinterpret_cast<const bf16x8*>(&Kh[(long)((k0) + 32 + sr) * LD + sc]); } while (0)
#define SWRITE(b, i) do { *(bf16x8*)((char*)V_lds + (b) * SHM_V + vst0) = sr_[i].vs0;          \
    *(bf16x8*)((char*)V_lds + (b) * SHM_V + vst1) = sr_[i].vs1; int kc = sc * 2;               \
    *(bf16x8*)((char*)K_lds + (b) * SHM_K + KSWZ(sr, kc)) = sr_[i].ks0;                       \
    *(bf16x8*)((char*)K_lds + (b) * SHM_K + KSWZ(32 + sr, kc)) = sr_[i].ks1; } while (0)
#define SWAIT() asm volatile("s_waitcnt vmcnt(4)" ::: "memory")
#define RESC(a) do { if (__any((a) < 1.f)) { if (hi == 0) al_l[r32] = (a); asm volatile("s_waitcnt lgkmcnt(0)" ::: "memory"); \
    _Pragma("unroll") for (int d = 0; d < 4; ++d) _Pragma("unroll") for (int r = 0; r < 16; ++r) o[d][r] *= al_l[crow(r, hi)]; } } while (0)
  f32x16 pA0, pA1, pB0, pB1; float mnA, mnB, alA, alB; bf16x8 pa0, pa1, pa2, pa3; int NT = seq / KVBLK; asm volatile("" : "+s"(NT));
  constexpr int SE = 0, SO = 1;
  SLOAD(SE, 0); asm volatile("s_waitcnt vmcnt(0)" ::: "memory"); SWRITE(0, SE); __syncthreads();
  qkt<ND0>(pA0, pA1, K_lds, qr, r32, hi, mapc * 4); partialSM<DIFF>(pA0, pA1, m_reg, mnA, alA);
  SLOAD(SO, KVBLK); if (2 < NT) SLOAD(SE, 2 * KVBLK);
  SWAIT(); SWRITE(1, SO); __syncthreads();
  _Pragma("unroll 1") for (int j = 1; j + 1 < NT; j += 2) {
    SBAR(); qkt<ND0>(pB0, pB1, (bf16_t*)((char*)K_lds + SHM_K), qr, r32, hi, mapc * 4);
    finishSM(pA0, pA1, alA, l_reg, pa0, pa1, pa2, pa3); SBAR();
    SLOAD(SO, (j + 2) * KVBLK); SBAR();
    pv_d0(o, vb0, pa0, pa1, pa2, pa3); partialSM<DIFF>(pB0, pB1, m_reg, mnB, alB);
    __syncthreads(); SWAIT(); SWRITE(0, SE);
    RESC(alB); __syncthreads();
    SBAR(); qkt<ND0>(pA0, pA1, K_lds, qr, r32, hi, mapc * 4);
    finishSM(pB0, pB1, alB, l_reg, pa0, pa1, pa2, pa3); SBAR();
    if (j + 3 < NT) SLOAD(SE, (j + 3) * KVBLK); SBAR();
    pv_d0(o, vb0 + (int)SHM_V, pa0, pa1, pa2, pa3); partialSM<DIFF>(pA0, pA1, m_reg, mnA, alA);
    __syncthreads(); SWAIT(); SWRITE(1, SO);
    RESC(alA); __syncthreads();
  }
  SBAR(); qkt<ND0>(pB0, pB1, (bf16_t*)((char*)K_lds + SHM_K), qr, r32, hi, mapc * 4);
  finishSM(pA0, pA1, alA, l_reg, pa0, pa1, pa2, pa3); SBAR();
  pv_d0(o, vb0, pa0, pa1, pa2, pa3); partialSM<DIFF>(pB0, pB1, m_reg, mnB, alB);
  __syncthreads(); RESC(alB);
  finishSM(pB0, pB1, alB, l_reg, pa0, pa1, pa2, pa3); SBAR();
  pv_d0(o, vb0 + (int)SHM_V, pa0, pa1, pa2, pa3);
  if (hi == 0) li_l[r32] = l_reg; asm volatile("s_waitcnt lgkmcnt(0)" ::: "memory");
  float rli[16];
  _Pragma("unroll") for (int r = 0; r < 16; ++r) rli[r] = __builtin_amdgcn_rcpf(li_l[crow(r, hi)]);
  int r32e = r32; asm volatile("" : "+v"(r32e));
  if constexpr (!DIFF) {
    bf16_t* Ow = Ob + (long)(wid * QBLK) * LD; const bf16_t* Gw = gate + (long)(wid * QBLK) * LD;
    _Pragma("unroll") for (int r = 0; r < 16; ++r) { const int orow = crow(r, hi);
      _Pragma("unroll") for (int d0 = 0; d0 < 4; ++d0) { const float g = bf2f(Gw[(long)orow * LD + d0 * 32 + r32e]); Ow[(long)orow * LD + d0 * 32 + r32e] = f2bf(o[d0][r] * rli[r] * siluf(g)); }
      asm volatile("" ::: "memory"); }
    __syncthreads();
  } else {
    __syncthreads();
    const float s1 = wave_sum(lamp[lane] * lamp[64 + lane]), s2 = wave_sum(lamp[128 + lane] * lamp[192 + lane]);
    int ly = layer; asm volatile("" : "+s"(ly));
    const float lambda_init = 0.8f - 0.6f * expf(-0.3f * (float)ly);
    const float lam = expf(s1) - expf(s2) + lambda_init, osc = 1.f - lambda_init;
    float* X = (float*)lds;
    if (mapc == 1) {
      _Pragma("unroll") for (int r = 0; r < 16; ++r) { const int orow = wq * QBLK + crow(r, hi);
        _Pragma("unroll") for (int d0 = 0; d0 < 4; ++d0) X[orow * 128 + d0 * 32 + r32e] = o[d0][r] * rli[r] * lam; }
    }
    __syncthreads();
    if (mapc == 0) {
      bf16_t* Ow = Ob + (long)(wq * QBLK) * LD; const bf16_t* Gw = gate + (long)(wq * QBLK) * LD;
      _Pragma("unroll") for (int r = 0; r < 16; ++r) { const int orow = crow(r, hi); float v[4]; float ss = 0.f;
        _Pragma("unroll") for (int d0 = 0; d0 < 4; ++d0) { v[d0] = o[d0][r] * rli[r] - X[(wq * QBLK + orow) * 128 + d0 * 32 + r32e]; ss += v[d0] * v[d0]; }
        ss += __shfl_xor(ss, 1); ss += __shfl_xor(ss, 2); ss += __shfl_xor(ss, 4); ss += __shfl_xor(ss, 8); ss += __shfl_xor(ss, 16);
        const float rs = rsqrtf(ss * (1.f / 128.f) + NORM_EPS) * osc;
        _Pragma("unroll") for (int d0 = 0; d0 < 4; ++d0) { const int c = d0 * 32 + r32e; const float g = bf2f(Gw[(long)orow * LD + c]); Ow[(long)orow * LD + c] = f2bf(v[d0] * rs * nw[c] * siluf(g)); } }
    }
    __syncthreads();
  }
#undef SLOAD
#undef SWRITE
#undef SWAIT
#undef RESC
}
#undef KSWZ
#undef SBAR
}

__device__ __forceinline__ void gqa_unit(const Params& p, const int l, int u, char* lds) {
    const int qb = u & 31, hq = (u >> 5) & 3, b = u >> 7; const size_t row0 = (size_t)b * SEQ + (size_t)qb * 256, k0 = (size_t)b * SEQ;
    bf16_t* Q = pblk(p.ws, PB_GQ + hq) + row0 * 128;
    att::attn_unit<0>(Q, pblk(p.ws, PB_GK + (hq >> 1)) + k0 * 128, pblk(p.ws, PB_GV + (hq >> 1)) + k0 * 128, Q, pblk(p.ws, PB_GG + hq) + row0 * 128, SEQ, lds, nullptr, 0, nullptr);
}
__device__ __forceinline__ void diff_unit(const Params& p, const int l, int u, char* lds) {
    const int qb = u & 63, h = (u >> 6) & 3, b = u >> 8; const size_t row0 = (size_t)b * SEQ + (size_t)qb * 128, k0 = (size_t)b * SEQ;
    bf16_t* Q = pblk(p.ws, PB_DQ + h) + row0 * 128;
    att::attn_unit<1>(Q, pblk(p.ws, PB_DK + h) + k0 * 128, pblk(p.ws, PB_DV + h) + k0 * 128, Q, pblk(p.ws, PB_DG + h) + row0 * 128, SEQ, lds, p.in[21] + l * 256, l, p.in[22] + l * 128);
}

#define WAVE_FENCE() do { __builtin_amdgcn_fence(__ATOMIC_ACQ_REL, "workgroup"); __builtin_amdgcn_wave_barrier(); } while (0)
__device__ __forceinline__ void rwkv_naive_seq(const Params& p, const int l, int sid, float* lds) {
    const int j = otid() & 63; const int h = sid & 7, dir = (sid >> 3) & 1, b = sid >> 4;
    float* w2s = lds; float* a2s = lds + 4096; float* tws = lds + 8192; float* ads = tws + 64; float* ops = ads + 64;
    const float* w2 = p.in[13] + ((size_t)(l * 2 + dir) * 64) * 512 + h * 64; const float* a2 = p.in[15] + ((size_t)l * 64) * 512 + h * 64;
    for (int i = 0; i < 64; ++i) { w2s[i * 64 + j] = w2[(size_t)i * 512 + j]; a2s[i * 64 + j] = a2[(size_t)i * 512 + j]; }
    const float* mu = p.in[11] + (size_t)(l * 2 + dir) * 1664;
    const float mu_r = mu[h * 64 + j], mu_k = mu[512 + h * 64 + j], mu_v = mu[1024 + h * 64 + j], mu_w = mu[1536 + j], mu_a = mu[1600 + j];
    const float w0 = p.in[12][(l * 2 + dir) * 512 + h * 64 + j], a0 = p.in[14][l * 512 + h * 64 + j];
    const float kkc = p.in[16][l * 512 + h * 64 + j], kac = p.in[17][l * 512 + h * 64 + j], rkc = p.in[18][l * 512 + h * 64 + j];
    const bf16_t* Pr = pblk(p.ws, PB_R + (h >> 1)) + (h & 1) * 64 + j; const bf16_t* Pk = pblk(p.ws, PB_K + (h >> 1)) + (h & 1) * 64 + j;
    const bf16_t* Pv = pblk(p.ws, PB_V + (h >> 1)) + (h & 1) * 64 + j; const bf16_t* Pw = pblk(p.ws, PB_WA) + j; const bf16_t* Pa = pblk(p.ws, PB_WA) + 64 + j;
    bf16_t* wkv = (bf16_t*)(g_scr + SCR_WKV) + (size_t)dir * M_TOK * 512 + h * 64 + j; bf16_t* bon = (bf16_t*)(g_scr + SCR_BON) + (size_t)dir * M_TOK * 512 + h * 64 + j;
    float S[64];
#pragma unroll
    for (int k = 0; k < 64; ++k) S[k] = 0.f;
    float pr = 0.f, pk = 0.f, pv = 0.f, pw = 0.f, pa = 0.f;
    WAVE_FENCE();
    for (int s = 0; s < SEQ; ++s) {
        const int t = dir ? (SEQ - 1 - s) : s; const size_t m = (size_t)b * SEQ + t;
        const float xr = bf2f(Pr[m * 128]), xk = bf2f(Pk[m * 128]), xv = bf2f(Pv[m * 128]), xw = bf2f(Pw[m * 128]), xa = bf2f(Pa[m * 128]);
        const float r = xr + (pr - xr) * mu_r, k = xk + (pk - xk) * mu_k, v = xv + (pv - xv) * mu_v, wd = xw + (pw - xw) * mu_w, ad = xa + (pa - xa) * mu_a;
        pr = xr; pk = xk; pv = xv; pw = xw; pa = xa;
        tws[j] = tanhf(wd); ads[j] = ad;
        WAVE_FENCE();
        float wv = w0, av = a0;
#pragma unroll 8
        for (int i = 0; i < 64; ++i) { wv += tws[i] * w2s[i * 64 + j]; av += ads[i] * a2s[i * 64 + j]; }
        wv = -softplusf(-wv) - 0.5f; const float dec = expf(-expf(wv));
        av = 1.f / (1.f + expf(-av));
        float kk = k * kkc; const float nrm = sqrtf(wave_sum(kk * kk)); kk = kk / fmaxf(nrm, 1e-12f);
        const float kp = k * (1.f + (av - 1.f) * kac);
        const float bsc = wave_sum(r * kp * rkc);
        ops[j] = -kk; ops[64 + j] = kk * av; ops[128 + j] = dec; ops[192 + j] = kp; ops[256 + j] = r;
        WAVE_FENCE();
        float sa = 0.f;
#pragma unroll
        for (int k4 = 0; k4 < 16; ++k4) { const f32x4 a4 = *(const f32x4*)(ops + k4 * 4); sa += S[k4 * 4] * a4[0] + S[k4 * 4 + 1] * a4[1] + S[k4 * 4 + 2] * a4[2] + S[k4 * 4 + 3] * a4[3]; }
        float y = 0.f;
#pragma unroll
        for (int k4 = 0; k4 < 16; ++k4) { const f32x4 b4 = *(const f32x4*)(ops + 64 + k4 * 4), d4 = *(const f32x4*)(ops + 128 + k4 * 4), k4v = *(const f32x4*)(ops + 192 + k4 * 4), r4 = *(const f32x4*)(ops + 256 + k4 * 4);
#pragma unroll
            for (int e = 0; e < 4; ++e) { const float sn = S[k4 * 4 + e] * d4[e] + sa * b4[e] + v * k4v[e]; S[k4 * 4 + e] = sn; y += sn * r4[e]; } }
        wkv[m * 512] = f2bf(y); bon[m * 512] = f2bf(bsc * v);
        WAVE_FENCE();
    }
}

namespace rk {
using f32x16 = __attribute__((ext_vector_type(16))) float;
constexpr int PB = 144, MAT = 64 * PB;
constexpr int O_W2T = 0, O_A2T = MAT, O_SB = 2 * MAT, O_GAM = 3 * MAT, O_CONST = O_GAM + 256,
              O_T = O_CONST + 2560, O_TW = O_T, O_G1T = O_T + MAT, O_AD = O_G1T,
              O_R2 = O_G1T + MAT, O_CL = O_R2, O_AA = O_R2 + 16384, O_ABD = O_R2, O_AAB = O_R2 + 4096, O_AAK = O_AAB + MAT, O_ARB = O_AAK + MAT, O_ARK = O_ARB + MAT,
              O_R3 = O_ARK + MAT, O_AT = O_R3, O_RT = O_AT + MAT, O_BT = O_RT + MAT, O_DT = O_BT, O_UT = O_BT, O_KT = O_BT + MAT, O_PT = O_KT,
              O_BHT = O_KT + MAT, O_KHT = O_BHT + MAT, O_VT = O_KHT + MAT, O_END = O_VT + MAT;
__device__ __forceinline__ int crow(int r, int hi) { return (r & 3) + 8 * (r >> 2) + 4 * hi; }
#define RK_FENCE() do { asm volatile("s_waitcnt lgkmcnt(0)" ::: "memory"); __builtin_amdgcn_wave_barrier(); } while (0)
template <int NKS> __device__ __forceinline__ void mm32(f32x16& acc, const char* A, int m0, const char* B, int n0, int k0, int r32, int hi) {
#pragma unroll
    for (int ks = 0; ks < NKS; ++ks) {
        const bf16x8 a = *(const bf16x8*)(A + (m0 + r32) * PB + (k0 + ks * 16 + hi * 8) * 2);
        const bf16x8 b = *(const bf16x8*)(B + (n0 + r32) * PB + (k0 + ks * 16 + hi * 8) * 2);
        acc = __builtin_amdgcn_mfma_f32_32x32x16_bf16(a, b, acc, 0, 0, 0); }
}
__device__ __forceinline__ void st_T(const f32x16& acc, char* Z, int n0, int m0, int r32, int hi) {
#pragma unroll
    for (int g = 0; g < 4; ++g) { u32x2 w; w.x = pk2(acc[4 * g], acc[4 * g + 1]); w.y = pk2(acc[4 * g + 2], acc[4 * g + 3]);
        *(u32x2*)(Z + (n0 + r32) * PB + (m0 + 8 * g + 4 * hi) * 2) = w; }
}
__device__ __forceinline__ void seq(const Params& p, const int l, const int sid, unsigned char* lds) {
    const int tid = otid(), w = __builtin_amdgcn_readfirstlane(tid >> 6);
    const int h = sid & 7, dir = (sid >> 3) & 1, b = sid >> 4;
#define RK_LANE() int tq_ = tid; asm volatile("" : "+v"(tq_)); const int lane = tq_ & 63, r32 = lane & 31, hi = lane >> 5, tok = tq_ >> 3, c8 = (tq_ & 7) * 8; (void)lane; (void)r32; (void)hi; (void)tok; (void)c8
    char* L = (char*)lds; float* CF = (float*)(L + O_CONST);
    {   RK_LANE();
        const float* w2 = p.in[13] + ((size_t)(l * 2 + dir) * 64) * 512 + h * 64; const float* a2 = p.in[15] + ((size_t)l * 64) * 512 + h * 64;
        float t[8], u[8];
#pragma unroll
        for (int e = 0; e < 8; ++e) { t[e] = w2[(size_t)(c8 + e) * 512 + tok]; u[e] = a2[(size_t)(c8 + e) * 512 + tok]; }
        u32x4 ww, aa; ww.x = pk2(t[0], t[1]); ww.y = pk2(t[2], t[3]); ww.z = pk2(t[4], t[5]); ww.w = pk2(t[6], t[7]);
        aa.x = pk2(u[0], u[1]); aa.y = pk2(u[2], u[3]); aa.z = pk2(u[4], u[5]); aa.w = pk2(u[6], u[7]);
        *(u32x4*)(L + O_W2T + tok * PB + c8 * 2) = ww; *(u32x4*)(L + O_A2T + tok * PB + c8 * 2) = aa;
        { unsigned zz = 0u; asm volatile("" : "+v"(zz)); *(u32x4*)(L + O_SB + tok * PB + c8 * 2) = (u32x4){zz, zz, zz, zz}; }
        const float* mu = p.in[11] + (size_t)(l * 2 + dir) * 1664;
        for (int i = tid; i < 640; i += 512) { const int row = i >> 6, j = i & 63; float v;
            if (row == 0) v = p.in[12][(l * 2 + dir) * 512 + h * 64 + j]; else if (row == 1) v = p.in[14][l * 512 + h * 64 + j];
            else if (row == 2) v = p.in[16][l * 512 + h * 64 + j]; else if (row == 3) v = p.in[17][l * 512 + h * 64 + j]; else if (row == 4) v = p.in[18][l * 512 + h * 64 + j];
            else if (row == 5) v = mu[h * 64 + j]; else if (row == 6) v = mu[512 + h * 64 + j]; else if (row == 7) v = mu[1024 + h * 64 + j]; else if (row == 8) v = mu[1536 + j]; else v = mu[1600 + j];
            CF[i] = v; }
    }
    const bf16_t* Pr = pblk(p.ws, PB_R + (h >> 1)) + (h & 1) * 64; const bf16_t* Pk = pblk(p.ws, PB_K + (h >> 1)) + (h & 1) * 64;
    const bf16_t* Pv = pblk(p.ws, PB_V + (h >> 1)) + (h & 1) * 64; const bf16_t* Pw = pblk(p.ws, PB_WA); const bf16_t* Pa = pblk(p.ws, PB_WA) + 64;
    bf16_t* wkv = (bf16_t*)(g_scr + SCR_WKV) + (size_t)dir * M_TOK * 512 + h * 64; bf16_t* bon = (bf16_t*)(g_scr + SCR_BON) + (size_t)dir * M_TOK * 512 + h * 64;
    f32x16 sacc = {};
    bf16x8 cu[5], pv[5];
#define RK_LOAD(c) do { RK_LANE(); const int s_ = (c) * 64 + tok; const int t_ = dir ? (SEQ - 1 - s_) : s_; const size_t m_ = ((size_t)b * SEQ + t_) * 128 + c8; \
        cu[0] = *(const bf16x8*)(Pr + m_); cu[1] = *(const bf16x8*)(Pk + m_); cu[2] = *(const bf16x8*)(Pv + m_); cu[3] = *(const bf16x8*)(Pw + m_); cu[4] = *(const bf16x8*)(Pa + m_); \
        if (s_ > 0) { const size_t q_ = dir ? m_ + 128 : m_ - 128; pv[0] = *(const bf16x8*)(Pr + q_); pv[1] = *(const bf16x8*)(Pk + q_); pv[2] = *(const bf16x8*)(Pv + q_); pv[3] = *(const bf16x8*)(Pw + q_); pv[4] = *(const bf16x8*)(Pa + q_); } \
        else { _Pragma("unroll") for (int i_ = 0; i_ < 5; ++i_) pv[i_] = (bf16x8){0, 0, 0, 0, 0, 0, 0, 0}; } } while (0)
    RK_LOAD(0);
    __syncthreads();
#pragma unroll 1
    for (int c = 0; c < SEQ / 64; ++c) {
        float rr[8], kx[8], vv[8];
        {   RK_LANE(); float tw[8], ad[8];
#pragma unroll
            for (int e = 0; e < 8; ++e) {
                const float x0 = bf2f((bf16_t)cu[0][e]), x1 = bf2f((bf16_t)cu[1][e]), x2 = bf2f((bf16_t)cu[2][e]), x3 = bf2f((bf16_t)cu[3][e]), x4 = bf2f((bf16_t)cu[4][e]);
                const float p0 = bf2f((bf16_t)pv[0][e]), p1 = bf2f((bf16_t)pv[1][e]), p2 = bf2f((bf16_t)pv[2][e]), p3 = bf2f((bf16_t)pv[3][e]), p4 = bf2f((bf16_t)pv[4][e]);
                rr[e] = x0 + (p0 - x0) * CF[5 * 64 + (h * 0) + c8 + e]; kx[e] = x1 + (p1 - x1) * CF[6 * 64 + c8 + e]; vv[e] = x2 + (p2 - x2) * CF[7 * 64 + c8 + e];
                const float wd = x3 + (p3 - x3) * CF[8 * 64 + c8 + e]; ad[e] = x4 + (p4 - x4) * CF[9 * 64 + c8 + e];
                tw[e] = 1.f - 2.f / (1.f + __expf(2.f * wd)); }
            u32x4 a, d; a.x = pk2(tw[0], tw[1]); a.y = pk2(tw[2], tw[3]); a.z = pk2(tw[4], tw[5]); a.w = pk2(tw[6], tw[7]);
            d.x = pk2(ad[0], ad[1]); d.y = pk2(ad[2], ad[3]); d.z = pk2(ad[4], ad[5]); d.w = pk2(ad[6], ad[7]);
            *(u32x4*)(L + O_TW + tok * PB + c8 * 2) = a; *(u32x4*)(L + O_AD + tok * PB + c8 * 2) = d; }
        __syncthreads();
        if (w < 4) {
            RK_LANE(); const int n0 = (w & 1) * 32; const bool isA = w >= 2;
            const char* Aop = L + (isA ? O_AD : O_TW); const char* Bop = L + (isA ? O_A2T : O_W2T);
            f32x16 x0 = {}, x1 = {};
            mm32<4>(x0, Aop, 0, Bop, n0, 0, r32, hi); mm32<4>(x1, Aop, 32, Bop, n0, 0, r32, hi);
            const int ch = n0 + r32; const float c0 = CF[(isA ? 64 : 0) + ch];
            if (!isA) {
#pragma unroll
                for (int r = 0; r < 16; ++r) { float a = c0 + x0[r]; a = fminf(a, 0.f) - __logf(1.f + __expf(-fabsf(a))) - 0.5f; x0[r] = -__expf(a);
                                               float q = c0 + x1[r]; q = fminf(q, 0.f) - __logf(1.f + __expf(-fabsf(q))) - 0.5f; x1[r] = -__expf(q); }
                float run = 0.f;
#pragma unroll
                for (int g = 0; g < 4; ++g) { const float gs = (x0[4 * g] + x0[4 * g + 1]) + (x0[4 * g + 2] + x0[4 * g + 3]); const float ps = __shfl_xor(gs, 32);
                    float st = run + (hi ? ps : 0.f); x0[4 * g] += st; x0[4 * g + 1] += x0[4 * g]; x0[4 * g + 2] += x0[4 * g + 1]; x0[4 * g + 3] += x0[4 * g + 2]; run += gs + ps; }
#pragma unroll
                for (int g = 0; g < 4; ++g) { const float gs = (x1[4 * g] + x1[4 * g + 1]) + (x1[4 * g + 2] + x1[4 * g + 3]); const float ps = __shfl_xor(gs, 32);
                    float st = run + (hi ? ps : 0.f); x1[4 * g] += st; x1[4 * g + 1] += x1[4 * g]; x1[4 * g + 2] += x1[4 * g + 1]; x1[4 * g + 3] += x1[4 * g + 2]; run += gs + ps; }
            } else {
#pragma unroll
                for (int r = 0; r < 16; ++r) { x0[r] = 1.f / (1.f + __expf(-(c0 + x0[r]))); x1[r] = 1.f / (1.f + __expf(-(c0 + x1[r]))); }
            }
            float* O = (float*)(L + (isA ? O_AA : O_CL));
#pragma unroll
            for (int r = 0; r < 16; ++r) { O[crow(r, hi) * 64 + ch] = x0[r]; O[(32 + crow(r, hi)) * 64 + ch] = x1[r]; }
        }
        __syncthreads();
        {   RK_LANE(); const float* clp = (const float*)(L + O_CL + tok * 256 + c8 * 4); const float* cle = (const float*)(L + O_CL + (tok > 0 ? tok - 1 : 0) * 256 + c8 * 4);
            const float* cln = (const float*)(L + O_CL + 63 * 256 + c8 * 4); const float* aap = (const float*)(L + O_AA + tok * 256 + c8 * 4);
            float kk[8], kp[8]; float ss = 0.f, bs = 0.f;
#pragma unroll
            for (int e = 0; e < 8; ++e) { kk[e] = kx[e] * CF[2 * 64 + c8 + e]; ss += kk[e] * kk[e]; kp[e] = kx[e] * (1.f + (aap[e] - 1.f) * CF[3 * 64 + c8 + e]); bs += rr[e] * kp[e] * CF[4 * 64 + c8 + e]; }
            ss += __shfl_xor(ss, 1); ss += __shfl_xor(ss, 2); ss += __shfl_xor(ss, 4);
            bs += __shfl_xor(bs, 1); bs += __shfl_xor(bs, 2); bs += __shfl_xor(bs, 4);
            const float rn = 1.f / fmaxf(sqrtf(ss), 1e-12f);
#pragma unroll
            for (int e2 = 0; e2 < 4; ++e2) { float At[2], Rt[2], Bt[2], Kt[2];
#pragma unroll
                for (int q = 0; q < 2; ++q) { const int e = 2 * e2 + q; const float cl = clp[e], ce = (tok > 0) ? cle[e] : 0.f, cn = cln[e];
                    const float kn = kk[e] * rn; const float bb = kn * aap[e];
                    const float ein = __expf(cl), eex = __expf(ce), eng = __expf(-cl), een = __expf(cn - cl);
                    At[q] = -kn * eex; Rt[q] = rr[e] * ein; Bt[q] = bb * eng; Kt[q] = kp[e] * eng;
                    *(bf16_t*)(L + O_BHT + (c8 + e) * PB + tok * 2) = f2bf(bb * een); *(bf16_t*)(L + O_KHT + (c8 + e) * PB + tok * 2) = f2bf(kp[e] * een); *(bf16_t*)(L + O_VT + (c8 + e) * PB + tok * 2) = f2bf(vv[e]);
                    if (tok == 63) ((float*)(L + O_GAM))[c8 + e] = __expf(cn); }
                const int ob = tok * PB + (c8 + 2 * e2) * 2;
                *(unsigned*)(L + O_AT + ob) = pk2(At[0], At[1]); *(unsigned*)(L + O_RT + ob) = pk2(Rt[0], Rt[1]); *(unsigned*)(L + O_BT + ob) = pk2(Bt[0], Bt[1]); *(unsigned*)(L + O_KT + ob) = pk2(Kt[0], Kt[1]); }
            {   const int s_ = c * 64 + tok; const int t_ = dir ? (SEQ - 1 - s_) : s_;
                u32x4 w_; w_.x = pk2(bs * vv[0], bs * vv[1]); w_.y = pk2(bs * vv[2], bs * vv[3]); w_.z = pk2(bs * vv[4], bs * vv[5]); w_.w = pk2(bs * vv[6], bs * vv[7]);
                *(u32x4*)(bon + ((size_t)b * SEQ + t_) * 512 + c8) = w_; }
        }
        __syncthreads();
        if (c + 1 < SEQ / 64) RK_LOAD(c + 1);
        for (int idx = w; idx < 12; idx += 8) {
            RK_LANE(); const int pr = idx / 3, tl = idx - pr * 3; const int mi = (tl == 2) ? 32 : 0, nt = (tl >= 1) ? 32 : 0;
            const char* X = L + ((pr & 1) ? O_KT : O_BT); const char* Y = L + ((pr >= 2) ? O_RT : O_AT);
            f32x16 acc = {}; mm32<4>(acc, X, mi, Y, nt, 0, r32, hi);
            const int t = nt + r32;
            if (tl != 1) {
#pragma unroll
                for (int r = 0; r < 16; ++r) { const int i = mi + crow(r, hi); const bool keep = (pr < 2) ? (i < t) : (i <= t); if (!keep) acc[r] = 0.f; } }
            char* Z = L + (pr == 0 ? O_AAB : pr == 1 ? O_AAK : pr == 2 ? O_ARB : O_ARK);
            st_T(acc, Z, nt, mi, r32, hi);
            if (pr == 0 && tl != 1) { float* ABD = (float*)(L + O_ABD);
#pragma unroll
                for (int r = 0; r < 16; ++r) { const int i = mi + crow(r, hi); if ((i >> 4) == (t >> 4)) ABD[(t >> 4) * 256 + (t & 15) * 16 + (i & 15)] = acc[r]; } }
        }
        __syncthreads();
        f32x16 yacc = {};
        const int mt = (w & 2) ? 32 : 0, nv = (w & 1) ? 32 : 0;
        if (w < 4) {
            RK_LANE(); const float* GAM = (const float*)(L + O_GAM);
#pragma unroll
            for (int r = 0; r < 16; ++r) sacc[r] *= GAM[mt + crow(r, hi)];
            mm32<4>(sacc, L + O_KHT, mt, L + O_VT, nv, 0, r32, hi);
            f32x16 g = {}; mm32<4>(g, L + O_AT, mt, L + O_SB, nv, 0, r32, hi);
            if (mt) mm32<4>(g, L + O_AAK, mt, L + O_VT, nv, 0, r32, hi); else mm32<2>(g, L + O_AAK, mt, L + O_VT, nv, 0, r32, hi);
            st_T(g, L + O_G1T, nv, mt, r32, hi);
        } else if (w < 7) {
            RK_LANE(); mm32<4>(yacc, L + O_RT, mt, L + O_SB, nv, 0, r32, hi);
            if (mt) mm32<4>(yacc, L + O_ARK, mt, L + O_VT, nv, 0, r32, hi); else mm32<2>(yacc, L + O_ARK, mt, L + O_VT, nv, 0, r32, hi);
        } else {
            RK_LANE(); const int blk = lane >> 4, j = lane & 15; const float* A = (const float*)(L + O_ABD) + blk * 256;
            float x[16];
#pragma unroll
            for (int t = 0; t < 16; ++t) { float s = (t == j) ? 1.f : 0.f;
#pragma unroll
                for (int i = 0; i < t; ++i) s += A[t * 16 + i] * x[i];
                x[t] = s; asm volatile("" ::: "memory"); }
            char* Tm = L + O_T; char* Dm = L + O_DT;
#pragma unroll
            for (int t = 0; t < 16; ++t) *(bf16_t*)(Tm + (16 * blk + t) * PB + (16 * blk + j) * 2) = f2bf(x[t]);
            { u32x4 a, d; a.x = pk2(x[0], x[1]); a.y = pk2(x[2], x[3]); a.z = pk2(x[4], x[5]); a.w = pk2(x[6], x[7]); d.x = pk2(x[8], x[9]); d.y = pk2(x[10], x[11]); d.z = pk2(x[12], x[13]); d.w = pk2(x[14], x[15]);
              *(u32x4*)(Dm + (16 * blk + j) * PB + (16 * blk) * 2) = a; *(u32x4*)(Dm + (16 * blk + j) * PB + (16 * blk + 8) * 2) = d; }
            if ((blk & 1) == 0) {
#pragma unroll
                for (int t = 0; t < 16; ++t) *(bf16_t*)(Tm + (16 * blk + t) * PB + (16 * (blk + 1) + j) * 2) = 0;
            } else { *(u32x4*)(Dm + (16 * blk + j) * PB + (16 * (blk - 1)) * 2) = (u32x4){0u, 0u, 0u, 0u}; *(u32x4*)(Dm + (16 * blk + j) * PB + (16 * (blk - 1) + 8) * 2) = (u32x4){0u, 0u, 0u, 0u}; }
            RK_FENCE();
            const int m16 = lane & 15, kg = lane >> 4; const bf16x8 z8 = {0, 0, 0, 0, 0, 0, 0, 0};
#pragma unroll
            for (int pp = 0; pp < 2; ++pp) { const int o = 32 * pp;
                bf16x8 a = z8, bb = z8;
                if (kg < 2) { a = *(const bf16x8*)(L + O_AAB + (o + 16 + m16) * PB + (o + 8 * kg) * 2); bb = *(const bf16x8*)(Dm + (o + m16) * PB + (o + 8 * kg) * 2); }
                f32x4 pq = __builtin_amdgcn_mfma_f32_16x16x32_bf16(a, bb, (f32x4){0.f, 0.f, 0.f, 0.f}, 0, 0, 0);
                { u32x2 wv; wv.x = pk2(pq[0], pq[1]); wv.y = pk2(pq[2], pq[3]); *(u32x2*)(L + O_PT + (o + m16) * PB + (o + 16 + 4 * kg) * 2) = wv; } }
            RK_FENCE();
#pragma unroll
            for (int pp = 0; pp < 2; ++pp) { const int o = 32 * pp;
                bf16x8 a = z8, bb = z8;
                if (kg < 2) { a = *(const bf16x8*)(Tm + (o + 16 + m16) * PB + (o + 16 + 8 * kg) * 2); bb = *(const bf16x8*)(L + O_PT + (o + m16) * PB + (o + 16 + 8 * kg) * 2); }
                f32x4 tq = __builtin_amdgcn_mfma_f32_16x16x32_bf16(a, bb, (f32x4){0.f, 0.f, 0.f, 0.f}, 0, 0, 0);
#pragma unroll
                for (int e = 0; e < 4; ++e) *(bf16_t*)(Tm + (o + 16 + 4 * kg + e) * PB + (o + m16) * 2) = f2bf(tq[e]);
                { u32x2 wv; wv.x = pk2(tq[0], tq[1]); wv.y = pk2(tq[2], tq[3]); *(u32x2*)(Dm + (o + m16) * PB + (o + 16 + 4 * kg) * 2) = wv; } }
            RK_FENCE();
            { f32x16 q = {}; mm32<2>(q, L + O_AAB, 32, Dm, 0, 0, r32, hi); st_T(q, L + O_PT, 0, 32, r32, hi); }
            RK_FENCE();
            { f32x16 tc = {}; mm32<2>(tc, Tm, 32, L + O_PT, 0, 32, r32, hi);
#pragma unroll
              for (int r = 0; r < 16; ++r) *(bf16_t*)(Tm + (32 + crow(r, hi)) * PB + r32 * 2) = f2bf(tc[r]); }
        }
        __syncthreads();
        if (w < 4) {
            RK_LANE(); f32x16 u = {};
            if (mt) mm32<4>(u, L + O_T, mt, L + O_G1T, nv, 0, r32, hi); else mm32<2>(u, L + O_T, mt, L + O_G1T, nv, 0, r32, hi);
            st_T(u, L + O_UT, nv, mt, r32, hi);
        } else if (w == 7) {
            RK_LANE(); mm32<4>(yacc, L + O_RT, mt, L + O_SB, nv, 0, r32, hi);
            mm32<4>(yacc, L + O_ARK, mt, L + O_VT, nv, 0, r32, hi);
        }
        __syncthreads();
        if (w < 4) {
            RK_LANE(); mm32<4>(sacc, L + O_BHT, mt, L + O_UT, nv, 0, r32, hi);
            st_T(sacc, L + O_SB, nv, mt, r32, hi);
        } else {
            RK_LANE(); if (mt) mm32<4>(yacc, L + O_ARB, mt, L + O_UT, nv, 0, r32, hi); else mm32<2>(yacc, L + O_ARB, mt, L + O_UT, nv, 0, r32, hi);
#pragma unroll
            for (int r = 0; r < 16; ++r) { const int s_ = c * 64 + mt + crow(r, hi); const int t_ = dir ? (SEQ - 1 - s_) : s_;
                wkv[((size_t)b * SEQ + t_) * 512 + nv + r32] = f2bf(yacc[r]); }
        }
        __syncthreads();
    }
#undef RK_LOAD
#undef RK_LANE
}
}

__device__ __forceinline__ void ssd_naive_seq(const Params& p, const int l, int sid, float* lds) {
    const int tid = otid(); const int h = sid & 7, dir = (sid >> 3) & 1, b = sid >> 4; const int g = h >> 2;
    float* xs = lds; float* Bs = lds + 2048; float* Cs = Bs + 4096; float* dts = Cs + 4096; float* das = dts + 32;
    const float* cw = p.in[5] + (size_t)l * 5 * 1024; const float* cb = p.in[6] + (size_t)l * 1024;
    const float A = -expf(p.in[7][(l * 2 + dir) * 8 + h]); const float dtb = p.in[8][(l * 2 + dir) * 8 + h]; const float Dh = p.in[9][l * 8 + h];
    const float* dtbuf = (const float*)(g_scr + SCR_DT);
    bf16_t* yout = (bf16_t*)(g_scr + SCR_SSDY) + (size_t)dir * M_TOK * 512 + h * 64;
    const int pp = tid >> 3, q = tid & 7;
    float hs[16];
#pragma unroll
    for (int n = 0; n < 16; ++n) hs[n] = 0.f;
    for (int s0 = 0; s0 < SEQ; s0 += 32) {
        __syncthreads();
        for (int idx = tid; idx < 32 * 320; idx += 512) {
            const int si = idx / 320, c = idx % 320; const int s = s0 + si; const int t = dir ? (SEQ - 1 - s) : s;
            int cch; const bf16_t* src;
            if (c < 64) { cch = h * 64 + c; src = pblk(p.ws, PB_XS + (h >> 1)) + (h & 1) * 64 + c; }
            else if (c < 192) { cch = 512 + g * 128 + (c - 64); src = pblk(p.ws, PB_BM + g) + (c - 64); }
            else { cch = 768 + g * 128 + (c - 192); src = pblk(p.ws, PB_CM + g) + (c - 192); }
            float acc = cb[cch];
#pragma unroll
            for (int jj = 0; jj < 5; ++jj) { const int tt = t + jj - 2; if (tt >= 0 && tt < SEQ) acc += cw[jj * 1024 + cch] * bf2f(src[((size_t)b * SEQ + tt) * 128]); }
            const float v = siluf(acc);
            if (c < 64) xs[si * 64 + c] = v; else if (c < 192) Bs[si * 128 + (c - 64)] = v; else Cs[si * 128 + (c - 192)] = v;
        }
        if (tid < 32) { const int s = s0 + tid; const int t = dir ? (SEQ - 1 - s) : s; const float dt = softplusf(dtbuf[((size_t)b * SEQ + t) * 16 + dir * 8 + h] + dtb); dts[tid] = dt; das[tid] = expf(dt * A); }
        __syncthreads();
        for (int si = 0; si < 32; ++si) {
            const int s = s0 + si; const int t = dir ? (SEQ - 1 - s) : s;
            const float x = xs[si * 64 + pp], dt = dts[si], da = das[si]; const float xdt = x * dt;
            float y = 0.f;
#pragma unroll
            for (int n4 = 0; n4 < 4; ++n4) { const f32x4 b4 = *(const f32x4*)(Bs + si * 128 + q * 16 + n4 * 4), c4 = *(const f32x4*)(Cs + si * 128 + q * 16 + n4 * 4);
#pragma unroll
                for (int e = 0; e < 4; ++e) { const float hn = hs[n4 * 4 + e] * da + xdt * b4[e]; hs[n4 * 4 + e] = hn; y += hn * c4[e]; } }
            y += __shfl_xor(y, 1); y += __shfl_xor(y, 2); y += __shfl_xor(y, 4);
            if (dir == 0) y += Dh * x;
            if (q == 0) yout[((size_t)b * SEQ + t) * 512 + pp] = f2bf(y);
        }
    }
}

__device__ __forceinline__ void phase_combine(const Params& p, const int l) {
    const int G = gridDim.x, tid = otid(), lane = tid & 63, wave = tid >> 6;
    const bf16_t* wkv = (const bf16_t*)(g_scr + SCR_WKV); const bf16_t* bon = (const bf16_t*)(g_scr + SCR_BON); const bf16_t* sy = (const bf16_t*)(g_scr + SCR_SSDY);
    const float* lnw = p.in[19] + l * 512; const float* lnb = p.in[20] + l * 512; const float* snw = p.in[10] + l * 512;
    for (int m = blockIdx.x * 8 + wave; m < M_TOK; m += G * 8) {
#pragma unroll
        for (int h = 0; h < 8; ++h) { const size_t o = (size_t)m * 512 + h * 64 + lane; const size_t o2 = o + (size_t)M_TOK * 512;
            const float w = bf2f(wkv[o]) + bf2f(wkv[o2]);
            const float mean = wave_sum(w) * (1.f / 64.f); const float d = w - mean; const float var = wave_sum(d * d) * (1.f / 64.f);
            const float gn = d * rsqrtf(var + 64e-5f) * lnw[h * 64 + lane] + lnb[h * 64 + lane];
            const float y = gn + bf2f(bon[o]) + bf2f(bon[o2]);
            bf16_t* gp = pblk(p.ws, PB_RG + (h >> 1)) + (size_t)m * 128 + (h & 1) * 64 + lane;
            *gp = f2bf(y * siluf(bf2f(*gp))); }
#pragma unroll
        for (int g = 0; g < 2; ++g) { float yg[4]; float ss = 0.f;
#pragma unroll
            for (int hh = 0; hh < 4; ++hh) { const int h = g * 4 + hh; const size_t o = (size_t)m * 512 + h * 64 + lane;
                const float y = bf2f(sy[o]) + bf2f(sy[o + (size_t)M_TOK * 512]);
                const float z = bf2f(pblk(p.ws, PB_Z + (h >> 1))[(size_t)m * 128 + (h & 1) * 64 + lane]);
                yg[hh] = y * siluf(z); ss += yg[hh] * yg[hh]; }
            ss = wave_sum(ss); const float rs = rsqrtf(ss * (1.f / 256.f) + NORM_EPS);
#pragma unroll
            for (int hh = 0; hh < 4; ++hh) { const int h = g * 4 + hh; pblk(p.ws, PB_Z + (h >> 1))[(size_t)m * 128 + (h & 1) * 64 + lane] = f2bf(yg[hh] * rs * snw[h * 64 + lane]); } }
    }
}

__device__ __forceinline__ void phase_post(const Params& p, const int l) {
    const int G = gridDim.x, tid = otid(), lane = tid & 63, wave = tid >> 6;
    const float* mix = (const float*)(p.ws + WS_MIX); const float* xin = l == 0 ? p.in[0] : p.out; const float* pw = p.in[2] + l * DMODEL;
    for (int m = blockIdx.x * 8 + wave; m < M_TOK; m += G * 8) {
        const f32x4* mr = (const f32x4*)(mix + (size_t)m * DMODEL) + lane; const f32x4* xr = (const f32x4*)(xin + (size_t)m * DMODEL) + lane; const f32x4* wr = (const f32x4*)pw + lane;
        f32x4 v[4]; float s = 0.f;
#pragma unroll
        for (int j = 0; j < 4; ++j) { v[j] = mr[64 * j]; s += (v[j].x * v[j].x + v[j].y * v[j].y) + (v[j].z * v[j].z + v[j].w * v[j].w); }
        const float rs = rsqrtf(wave_sum(s) * (1.f / DMODEL) + NORM_EPS);
        float s2 = 0.f;
#pragma unroll
        for (int j = 0; j < 4; ++j) { v[j] = xr[64 * j] + v[j] * rs * wr[64 * j]; s2 += (v[j].x * v[j].x + v[j].y * v[j].y) + (v[j].z * v[j].z + v[j].w * v[j].w); }
        s2 = wave_sum(s2);
        f32x4* orow = (f32x4*)(p.out + (size_t)m * DMODEL) + lane;
#pragma unroll
        for (int j = 0; j < 4; ++j) orow[64 * j] = v[j];
        if (lane == 0) ((float*)(g_scr + SCR_RS))[m] = rsqrtf(s2 * (1.f / DMODEL) + NORM_EPS);
        u32x2* o8 = (u32x2*)((bf16_t*)(g_scr + SCR_XB) + (size_t)m * DMODEL) + lane;
#pragma unroll
        for (int j = 0; j < 4; ++j) { u32x2 w; w.x = pk2(v[j].x, v[j].y); w.y = pk2(v[j].z, v[j].w); o8[64 * j] = w; }
    }
}

constexpr int LDS_BYTES = 155648;
static_assert(rk::O_END <= LDS_BYTES, "rwkv LDS map");
__device__ __forceinline__ void phase_gemm_in(const Params& p, const int l, unsigned char* lds) {
    pg8::Gemm g{(const bf16_t*)(g_scr + SCR_XB), (const bf16_t*)(g_scr + SCR_WIN + (size_t)l * 15 * MiB), M_TOK, NPROJ, DMODEL, DMODEL, 128};
    pg8::StaticOrder S; S.init(M_TOK, NPROJ, gridDim.x, blockIdx.x);
    pg8::EpiProj E{(bf16_t*)p.ws, (const float*)(g_scr + SCR_RS), (float*)(g_scr + SCR_DT)};
    pg8::gemm_phase<pg8::EpiProj, pg8::StaticOrder, true, true>((PG8_LAS unsigned char*)lds, g, S, E);
}
__device__ __forceinline__ void phase_gemm_out(const Params& p, const int l, unsigned char* lds) {
    pg8::Gemm g{(const bf16_t*)p.ws, (const bf16_t*)(g_scr + SCR_WOUT + (size_t)l * 4 * MiB), M_TOK, DMODEL, DMIX, 128, PBLK_ELEMS};
    pg8::StaticOrder S; S.init(M_TOK, DMODEL, gridDim.x, blockIdx.x);
    pg8::EpiMix E{(float*)(p.ws + WS_MIX)};
    pg8::gemm_phase<pg8::EpiMix, pg8::StaticOrder, true, true>((PG8_LAS unsigned char*)lds, g, S, E);
}
__device__ __forceinline__ void phase_mixers(const Params& p, const int l, unsigned char* lds) {
    const int bid = blockIdx.x, G = gridDim.x;
    if (bid < 32) rk::seq(p, l, bid, lds);
    else if (bid < 64) ssd_naive_seq(p, l, bid - 32, (float*)lds);
    else { for (int u = bid - 64; u < 768; u += G - 64) { if (u < 256) gqa_unit(p, l, u, (char*)lds); else diff_unit(p, l, u - 256, (char*)lds); } }
}
__global__ void __launch_bounds__(512) mega(const Params p) {
    extern __shared__ __attribute__((aligned(16))) unsigned char lds[];
    cg::grid_group grid = cg::this_grid();
    phase_prologue(p, (float*)lds); grid.sync();
#pragma unroll 1
    for (int l = 0; l < 2; ++l) {
        phase_gemm_in(p, l, lds); grid.sync();
        phase_prep(p, l); grid.sync();
        phase_mixers(p, l, lds); grid.sync();
        phase_combine(p, l); grid.sync();
        phase_gemm_out(p, l, lds); grid.sync();
        phase_post(p, l); if (l == 0) grid.sync();
    }
}

extern "C" void kernel_launch(void* const* d_in, const int* in_sizes, int n_in, void* d_out, int out_size, void* d_ws, size_t ws_size, hipStream_t stream) {
    static int grid_blocks = 0;
    if (!grid_blocks) {
        int dev = 0, cus = 0, per_cu = 0;
        (void)hipGetDevice(&dev);
        (void)hipDeviceGetAttribute(&cus, hipDeviceAttributeMultiprocessorCount, dev);
        (void)hipFuncSetAttribute((const void*)mega, hipFuncAttributeMaxDynamicSharedMemorySize, LDS_BYTES);
        (void)hipOccupancyMaxActiveBlocksPerMultiprocessor(&per_cu, (const void*)mega, 512, LDS_BYTES);
        if (per_cu < 1) { fprintf(stderr, "kernel_launch: occupancy query says %d blocks/CU\n", per_cu); per_cu = 1; }
        grid_blocks = cus;
    }
    Params p{};
    for (int i = 0; i < 25; ++i) p.in[i] = (const float*)d_in[i];
    p.out = (float*)d_out; p.ws = (unsigned char*)d_ws;
    void* args[] = {&p};
    hipError_t e = hipLaunchCooperativeKernel((const void*)mega, dim3(grid_blocks), dim3(512), args, LDS_BYTES, stream);
    if (e != hipSuccess) fprintf(stderr, "cooperative launch failed: %s (grid %d)\n", hipGetErrorString(e), grid_blocks);
}
```

```cpp
#include <hip/hip_runtime.h>
#include <hip/hip_bf16.h>
#include <hip/hip_cooperative_groups.h>
#include <cstdio>
#include <cstdint>
namespace cg = cooperative_groups;

constexpr int M_TOK = 16384, SEQ = 8192, DMODEL = 1024, NPROJ = 7424, NPB = 58, DIN_ORIG = 7312, DMIX = 2048;
constexpr float NORM_EPS = 1e-6f;
constexpr size_t MiB = 1u << 20;
constexpr int PB_Z = 0, PB_RG = 4, PB_DQ = 8, PB_GQ = 12, PB_XS = 16, PB_BM = 20, PB_CM = 22, PB_R = 24, PB_K = 28, PB_V = 32, PB_WA = 36,
              PB_DK = 37, PB_DV = 41, PB_DG = 45, PB_GK = 49, PB_GV = 51, PB_GG = 53, PB_DT = 57;
constexpr size_t PBLK_ELEMS = (size_t)M_TOK * 128;
constexpr size_t SCR_WIN = 0, SCR_WOUT = 30 * MiB, SCR_ROPE = 38 * MiB, SCR_DT = 40 * MiB, SCR_RS = 41 * MiB, SCR_CTL = 41 * MiB + 512 * 1024,
                 SCR_XB = 42 * MiB, SCR_WKV = 74 * MiB, SCR_BON = 106 * MiB, SCR_SSDY = 138 * MiB, SCR_XACT = 170 * MiB, SCR_BYTES = 202 * MiB;
constexpr size_t WS_MIX = 16 * PBLK_ELEMS * 2;
__device__ __attribute__((aligned(256))) unsigned char g_scr[SCR_BYTES];

typedef unsigned short bf16_t;
typedef short bf16x8 __attribute__((ext_vector_type(8)));
typedef float f32x4 __attribute__((ext_vector_type(4)));
typedef unsigned u32x4 __attribute__((ext_vector_type(4)));
typedef unsigned u32x2 __attribute__((ext_vector_type(2)));

struct Params {
    const float* in[25];
    float* out;
    unsigned char* ws;
};

__device__ __forceinline__ int otid() { int t = threadIdx.x; asm volatile("" : "+v"(t)); return t; }
__device__ __forceinline__ float bf2f(bf16_t v) { return __uint_as_float(((unsigned)v) << 16); }
__device__ __forceinline__ bf16_t f2bf(float f) { unsigned u = __float_as_uint(f); return (bf16_t)((u + 0x7fffu + ((u >> 16) & 1u)) >> 16); }
__device__ __forceinline__ unsigned pk2(float lo, float hi) { return (unsigned)f2bf(lo) | ((unsigned)f2bf(hi) << 16); }
__device__ __forceinline__ float wave_sum(float v) {
#pragma unroll
    for (int o = 1; o < 64; o <<= 1) v += __shfl_xor(v, o);
    return v;
}
__device__ __forceinline__ float siluf(float x) { return x / (1.f + __expf(-x)); }
__device__ __forceinline__ float softplusf(float x) { return fmaxf(x, 0.f) + log1pf(__expf(-fabsf(x))); }
__device__ __forceinline__ bf16_t* pblk(unsigned char* ws, int j) { return (bf16_t*)ws + (size_t)j * PBLK_ELEMS; }

namespace pg8 {
#define PG8_LAS __attribute__((address_space(3)))
constexpr int BM = 256, BK = 64, HALF = 128, HTB = HALF * BK * 2, STAGE_BYTES = 8 * HTB, NXCD = 8, WGM = 8;
__host__ __device__ __forceinline__ int lds_byte(int r, int c) { const int st = (r >> 4) * 2 + (c >> 5), rr = r & 15, cc = c & 31, ob = rr * 64 + cc * 2; return st * 1024 + (ob ^ (((ob >> 9) & 1) << 5)); }
__host__ __device__ __forceinline__ void stage_rc(int b, int& R, int& C) { const int st = b / 1024, sb = b % 1024, swz = sb ^ (((sb >> 9) & 1) << 5); R = (st >> 1) * 16 + swz / 64; C = (st & 1) * 32 + (swz % 64) / 2; }
__host__ __device__ __forceinline__ int perm32(int rho) { const int n = rho >> 4, i = rho & 15; return 8 * (i >> 2) + 4 * n + (i & 3); }
struct Unit { int pm, pn; };
struct Gemm { const bf16_t* A; const bf16_t* Bt; int M, N, K; int lda; size_t abig; };
struct StaticOrder {
    int nM, nN, nwg, G, c;
    __host__ __device__ void init(int M, int N, int G_, int c_) { nM = M / BM; nN = N / BM; nwg = nM * nN; G = G_; c = c_; }
    __host__ __device__ bool next(int i, Unit& u) const {
        const long L = (long)i * G + c; if (L >= nwg) return false;
        int wgid = (int)L; { const int q = nwg / NXCD, r = nwg % NXCD, xcd = wgid % NXCD, off = wgid / NXCD; wgid = (xcd < r ? xcd * (q + 1) : r * (q + 1) + (xcd - r) * q) + off; }
        const int nig = WGM * nN, gid = wgid / nig, fm = gid * WGM, gsz = (nM - fm) < WGM ? (nM - fm) : WGM;
        u.pm = fm + ((wgid % nig) % gsz); u.pn = (wgid % nig) / gsz; return true;
    }
};
template <class Epi, class Sched, bool ALIGN_EPI = false, bool SP2 = false>
__device__ __forceinline__ void gemm_phase(PG8_LAS unsigned char* lds, const Gemm g, const Sched& S, const Epi& E) {
    const int tid = otid(), wid = __builtin_amdgcn_readfirstlane(tid >> 6), lane = tid & 63, wr = wid >> 2, wc = wid & 3, fr = lane & 15, fq = lane >> 4;
    const int K = g.K, nt = K / BK;
    unsigned voffA[2], voffB[2];
#pragma unroll
    for (int i = 0; i < 2; ++i) { int R, C; stage_rc(tid * 16 + i * 8192, R, C); const int Rb = Epi::PERM ? ((R & ~31) + perm32(R & 31)) : R;
        voffA[i] = (unsigned)(R * g.lda + C) * 2u; voffB[i] = (unsigned)(Rb * K + C) * 2u; }
    const size_t kstep = (size_t)(BK * 2);
    const size_t abig = g.abig * 2;
    const size_t hstepA = (size_t)HALF * g.lda * 2, hstepB = (size_t)HALF * K * 2;
    const size_t tstepA = 2 * hstepA, tstepB = 2 * hstepB;
    const unsigned ldsw = (unsigned)wid * 1024u;
    const int aoff = lds_byte(wr * 64 + fr, fq * 8), boff = lds_byte(wc * 32 + fr, fq * 8);
#define PG8_SA(b, h) (((b) * 2 + (h)) * HTB)
#define PG8_SB(b, h) ((4 + (b) * 2 + (h)) * HTB)
#define PG8_STAGE(bufoff, gbase, voff) do { _Pragma("unroll") for (int _i = 0; _i < 2; ++_i) \
        __builtin_amdgcn_global_load_lds((const unsigned*)((const char*)(gbase) + (voff)[_i]), (PG8_LAS unsigned*)(lds + (bufoff) + ldsw + _i * 8192), 16, 0, 0); } while (0)
#define PG8_LDA(dst, b, h) do { _Pragma("unroll") for (int m = 0; m < 4; ++m) _Pragma("unroll") for (int k = 0; k < 2; ++k) dst[m][k] = *(const PG8_LAS bf16x8*)(lds + PG8_SA(b, h) + aoff + m * 2048 + k * 1024); } while (0)
#define PG8_LDB(dst, b, h) do { _Pragma("unroll") for (int n = 0; n < 2; ++n) _Pragma("unroll") for (int k = 0; k < 2; ++k) dst[n][k] = *(const PG8_LAS bf16x8*)(lds + PG8_SB(b, h) + boff + n * 2048 + k * 1024); } while (0)
#define PG8_MMA(ai, bj, At, Bt) do { __builtin_amdgcn_s_setprio(1); _Pragma("unroll") for (int m = 0; m < 4; ++m) _Pragma("unroll") for (int n = 0; n < 2; ++n) _Pragma("unroll") for (int k = 0; k < 2; ++k) \
        acc[ai][bj][m][n] = __builtin_amdgcn_mfma_f32_16x16x32_bf16(Bt[n][k], At[m][k], acc[ai][bj][m][n], 0, 0, 0); __builtin_amdgcn_s_setprio(0); } while (0)
#define PG8_WAIT_V(n) asm volatile("s_waitcnt vmcnt(" #n ")" ::: "memory")
#define PG8_WAIT_L(n) asm volatile("s_waitcnt lgkmcnt(" #n ")" ::: "memory")
#define PG8_BAR __builtin_amdgcn_s_barrier()
#define PG8_SCHED __builtin_amdgcn_sched_barrier(0)
    Unit cur, nxt; int ui = 0;
    if (!S.next(0, cur)) return;
    f32x4 acc[2][2][4][2];
#pragma unroll
    for (int a = 0; a < 2; ++a)
#pragma unroll
        for (int b = 0; b < 2; ++b)
#pragma unroll
            for (int m = 0; m < 4; ++m)
#pragma unroll
                for (int n = 0; n < 2; ++n) acc[a][b][m][n] = (f32x4){0.f, 0.f, 0.f, 0.f};
    bf16x8 At[4][2], B0[2][2], B1[2][2];
    const char* cA = (const char*)g.A + (size_t)cur.pm * tstepA; const char* cB = (const char*)g.Bt + (size_t)cur.pn * tstepB;
    if constexpr (SP2) {
        PG8_STAGE(PG8_SB(0, 0), cB, voffB); PG8_STAGE(PG8_SB(0, 1), cB + hstepB, voffB); PG8_STAGE(PG8_SA(0, 0), cA, voffA); PG8_STAGE(PG8_SA(0, 1), cA + hstepA, voffA);
        if (wr == 1) PG8_BAR;
        PG8_WAIT_V(2); PG8_BAR;
        PG8_STAGE(PG8_SB(1, 0), cB + kstep, voffB); PG8_STAGE(PG8_SA(1, 0), cA + kstep, voffA); PG8_STAGE(PG8_SB(1, 1), cB + hstepB + kstep, voffB);
        PG8_WAIT_V(6); PG8_BAR;
    } else {
        PG8_STAGE(PG8_SB(0, 0), cB, voffB); PG8_STAGE(PG8_SA(0, 0), cA, voffA); PG8_STAGE(PG8_SB(0, 1), cB + hstepB, voffB); PG8_STAGE(PG8_SA(0, 1), cA + hstepA, voffA);
        if (wr == 1) PG8_BAR;
        PG8_WAIT_V(4); PG8_BAR;
        PG8_STAGE(PG8_SB(1, 0), cB + kstep, voffB); PG8_STAGE(PG8_SA(1, 0), cA + kstep, voffA); PG8_STAGE(PG8_SB(1, 1), cB + hstepB + kstep, voffB);
        PG8_WAIT_V(6); PG8_BAR;
    }
    for (;;) {
        const bool has_next = S.next(ui + 1, nxt);
        const char* nA = has_next ? (const char*)g.A + (size_t)nxt.pm * tstepA : cA; const char* nB = has_next ? (const char*)g.Bt + (size_t)nxt.pn * tstepB : cB;
        for (int t = 0; t < nt; t += 2) {
            const bool last = (t == nt - 2);
            const char* a1 = cA + (size_t)(t >> 1) * abig + kstep;
            const char* a2 = last ? nA : cA + (size_t)((t >> 1) + 1) * abig; const char* b2 = last ? nB : cB + (size_t)(t + 2) * kstep;
            const char* a3 = a2 + kstep; const char* b3 = b2 + kstep;
            if constexpr (SP2) {
            PG8_LDB(B0, 0, 0); PG8_LDB(B1, 0, 1); PG8_SCHED; PG8_LDA(At, 0, 0); PG8_STAGE(PG8_SA(1, 1), a1 + hstepA, voffA);
            PG8_WAIT_V(8); PG8_WAIT_L(0); PG8_BAR; PG8_MMA(0, 0, At, B0); PG8_MMA(0, 1, At, B1); PG8_BAR; PG8_SCHED;
            PG8_LDA(At, 0, 1); PG8_STAGE(PG8_SB(0, 0), b2, voffB); PG8_STAGE(PG8_SB(0, 1), b2 + hstepB, voffB); PG8_STAGE(PG8_SA(0, 0), a2, voffA);
            PG8_WAIT_V(8); PG8_WAIT_L(0); PG8_BAR; PG8_MMA(1, 0, At, B0); PG8_MMA(1, 1, At, B1); PG8_BAR; PG8_SCHED;
            PG8_LDB(B0, 1, 0); PG8_LDB(B1, 1, 1); PG8_SCHED; PG8_LDA(At, 1, 0); PG8_STAGE(PG8_SA(0, 1), a2 + hstepA, voffA);
            PG8_WAIT_V(8); PG8_WAIT_L(0); PG8_BAR; PG8_MMA(0, 0, At, B0); PG8_MMA(0, 1, At, B1); PG8_BAR; PG8_SCHED;
            PG8_LDA(At, 1, 1); PG8_STAGE(PG8_SB(1, 0), b3, voffB); PG8_STAGE(PG8_SB(1, 1), b3 + hstepB, voffB); PG8_STAGE(PG8_SA(1, 0), a3, voffA);
            PG8_WAIT_V(8); PG8_WAIT_L(0); PG8_BAR; PG8_MMA(1, 0, At, B0); PG8_MMA(1, 1, At, B1); PG8_BAR; PG8_SCHED;
            } else {
            PG8_LDB(B0, 0, 0); PG8_SCHED; PG8_LDA(At, 0, 0); PG8_STAGE(PG8_SA(1, 1), a1 + hstepA, voffA);
            PG8_WAIT_L(8); PG8_BAR; PG8_WAIT_L(0); PG8_MMA(0, 0, At, B0); PG8_BAR; PG8_SCHED;
            PG8_LDB(B1, 0, 1); PG8_STAGE(PG8_SB(0, 0), b2, voffB);
            PG8_BAR; PG8_WAIT_L(0); PG8_MMA(0, 1, At, B1); PG8_BAR;
            PG8_LDA(At, 0, 1); PG8_STAGE(PG8_SA(0, 0), a2, voffA);
            PG8_BAR; PG8_WAIT_L(0); PG8_MMA(1, 0, At, B0); PG8_BAR; PG8_SCHED;
            PG8_STAGE(PG8_SB(0, 1), b2 + hstepB, voffB);
            PG8_WAIT_V(6); PG8_BAR; PG8_MMA(1, 1, At, B1); PG8_BAR;
            PG8_LDB(B0, 1, 0); PG8_SCHED; PG8_LDA(At, 1, 0); PG8_STAGE(PG8_SA(0, 1), a2 + hstepA, voffA);
            PG8_WAIT_L(8); PG8_BAR; PG8_WAIT_L(0); PG8_MMA(0, 0, At, B0); PG8_BAR; PG8_SCHED;
            PG8_LDB(B1, 1, 1); PG8_STAGE(PG8_SB(1, 0), b3, voffB);
            PG8_BAR; PG8_WAIT_L(0); PG8_MMA(0, 1, At, B1); PG8_BAR;
            PG8_LDA(At, 1, 1); PG8_STAGE(PG8_SA(1, 0), a3, voffA);
            PG8_BAR; PG8_WAIT_L(0); PG8_MMA(1, 0, At, B0); PG8_BAR; PG8_SCHED;
            PG8_STAGE(PG8_SB(1, 1), b3 + hstepB, voffB);
            PG8_WAIT_V(6); PG8_BAR; PG8_MMA(1, 1, At, B1); PG8_BAR;
            }
        }
        if constexpr (ALIGN_EPI) { if (wr == 0) PG8_BAR; }
        E(acc, cur, wr, wc, fr, fq);
        if (!has_next) break;
#pragma unroll
        for (int a = 0; a < 2; ++a)
#pragma unroll
            for (int b = 0; b < 2; ++b)
#pragma unroll
                for (int m = 0; m < 4; ++m)
#pragma unroll
                    for (int n = 0; n < 2; ++n) acc[a][b][m][n] = (f32x4){0.f, 0.f, 0.f, 0.f};
        cur = nxt; cA = nA; cB = nB; ++ui;
        if constexpr (ALIGN_EPI) { if (wr == 1) PG8_BAR; }
    }
    PG8_WAIT_V(0);
    if constexpr (!ALIGN_EPI) { if (wr == 0) PG8_BAR; }
    PG8_BAR;
#undef PG8_SA
#undef PG8_SB
#undef PG8_STAGE
#undef PG8_LDA
#undef PG8_LDB
#undef PG8_MMA
#undef PG8_WAIT_V
#undef PG8_WAIT_L
#undef PG8_BAR
#undef PG8_SCHED
}
struct EpiProj {
    static constexpr bool PERM = true;
    bf16_t* P; const float* rowscale; float* dtbuf;
    __device__ __forceinline__ void operator()(const f32x4 (&acc)[2][2][4][2], const Unit& u, int wr, int wc, int fr, int fq) const {
        const int row0 = u.pm * BM + wr * 64 + fr; const int col = wc * 32 + 8 * fq;
#pragma unroll
        for (int ai = 0; ai < 2; ++ai)
#pragma unroll
            for (int m = 0; m < 4; ++m) { const int row = row0 + ai * HALF + m * 16; const float sc = rowscale[row];
#pragma unroll
                for (int bj = 0; bj < 2; ++bj) { const int blk = u.pn * 2 + bj;
                    const f32x4 v0 = acc[ai][bj][m][0] * sc, v1 = acc[ai][bj][m][1] * sc;
                    u32x4 w; w.x = pk2(v0[0], v0[1]); w.y = pk2(v0[2], v0[3]); w.z = pk2(v1[0], v1[1]); w.w = pk2(v1[2], v1[3]);
                    *(u32x4*)(P + (size_t)blk * PBLK_ELEMS + (size_t)row * 128 + col) = w;
                    if (blk == PB_DT && col < 16) { float* d = dtbuf + (size_t)row * 16 + col; *(f32x4*)d = v0; *(f32x4*)(d + 4) = v1; } } }
    }
};
struct EpiMix {
    static constexpr bool PERM = true;
    float* O;
    __device__ __forceinline__ void operator()(const f32x4 (&acc)[2][2][4][2], const Unit& u, int wr, int wc, int fr, int fq) const {
        const int row0 = u.pm * BM + wr * 64 + fr; const int col0 = u.pn * BM + wc * 32 + 8 * fq;
#pragma unroll
        for (int ai = 0; ai < 2; ++ai)
#pragma unroll
            for (int m = 0; m < 4; ++m) { float* rp = O + (size_t)(row0 + ai * HALF + m * 16) * DMODEL + col0;
#pragma unroll
                for (int bj = 0; bj < 2; ++bj) { *(f32x4*)(rp + bj * HALF) = acc[ai][bj][m][0]; *(f32x4*)(rp + bj * HALF + 4) = acc[ai][bj][m][1]; } }
    }
};
}

__device__ __forceinline__ int orig_col(int n) {
    if (n < 512) return n;
    if (n < 1024) return 3216 + (n - 512);
    if (n < 1536) return 3728 + (n - 1024);
    if (n < 2048) return 5776 + (n - 1536);
    if (n < 3072) return 512 + (n - 2048);
    if (n < 4736) return 1552 + (n - 3072);
    if (n < 5248) return 4240 + (n - 4736);
    if (n < 5760) return 4752 + (n - 5248);
    if (n < 6272) return 5264 + (n - 5760);
    if (n < 6528) return 6288 + (n - 6272);
    if (n < 6784) return 6544 + (n - 6528);
    if (n < 7296) return 6800 + (n - 6784);
    if (n < 7312) return 1536 + (n - 7296);
    return -1;
}
template <bool MAPCOL>
__device__ __forceinline__ void transpose_item(const float* W, int K, int Nsrc, const float* ks, bf16_t* WT, float* scr  , int kb, int nb) {
    const int tid = otid(); const int k0 = kb * 64, n0 = nb * 64;
    {   const int nn = tid & 63; const int n = n0 + nn; const int oc = MAPCOL ? orig_col(n) : n;
#pragma unroll
        for (int i = 0; i < 8; ++i) { const int kk = (tid >> 6) + 8 * i; float v = 0.f; if (oc >= 0) v = W[(size_t)(k0 + kk) * Nsrc + oc] * (ks ? ks[k0 + kk] : 1.f); scr[kk * 65 + nn] = v; } }
    __syncthreads();
    {   const int n = tid >> 3, c = tid & 7; const float* s = scr + (8 * c) * 65 + n;
        u32x4 o; o.x = pk2(s[0], s[65]); o.y = pk2(s[2 * 65], s[3 * 65]); o.z = pk2(s[4 * 65], s[5 * 65]); o.w = pk2(s[6 * 65], s[7 * 65]);
        *(u32x4*)(WT + (size_t)(n0 + n) * K + k0 + 8 * c) = o; }
    __syncthreads();
}
__device__ __forceinline__ void rope_entry(int idx, float* tab) {
    const int pos = idx >> 5, i = idx & 31;
    const float inv = exp2f(-(float)i * (13.287712379549449f / 32.f));
    const float ang = (float)pos * inv;
    const double rev = (double)ang * 0.15915494309189535; const double fr = rev - floor(rev);
    const float a = (float)(fr * 6.283185307179586);
    tab[idx * 2] = cosf(a); tab[idx * 2 + 1] = sinf(a);
}
__device__ __forceinline__ void xrow_to_bf16(const float* xrow, bf16_t* orow, float* rs, int lane) {
    const f32x4* xr = (const f32x4*)xrow + lane; f32x4 v[4]; float s = 0.f;
#pragma unroll
    for (int j = 0; j < 4; ++j) { v[j] = xr[64 * j]; s += (v[j].x * v[j].x + v[j].y * v[j].y) + (v[j].z * v[j].z + v[j].w * v[j].w); }
    s = wave_sum(s);
    if (lane == 0) *rs = rsqrtf(s * (1.f / DMODEL) + NORM_EPS);
    u32x2* o8 = (u32x2*)orow + lane;
#pragma unroll
    for (int j = 0; j < 4; ++j) { u32x2 w; w.x = pk2(v[j].x, v[j].y); w.y = pk2(v[j].z, v[j].w); o8[64 * j] = w; }
}
__device__ __forceinline__ void phase_prologue(const Params& p, float* lds_f) {
    const int G = gridDim.x, bid = blockIdx.x, tid = otid(), lane = tid & 63, wave = tid >> 6;
    constexpr int I_IN = 16 * 116, I_OUT = 32 * 16;
    for (int it = bid; it < 2 * (I_IN + I_OUT); it += G) {
        int r = it; const int l = r / (I_IN + I_OUT); r -= l * (I_IN + I_OUT);
        if (r < I_IN) transpose_item<true>(p.in[3] + (size_t)l * DMODEL * DIN_ORIG, DMODEL, DIN_ORIG, p.in[1] + l * DMODEL, (bf16_t*)(g_scr + SCR_WIN + (size_t)l * 15 * MiB), lds_f, r / 116, r % 116);
        else { r -= I_IN; transpose_item<false>(p.in[4] + (size_t)l * DMIX * DMODEL, DMIX, DMODEL, nullptr, (bf16_t*)(g_scr + SCR_WOUT + (size_t)l * 4 * MiB), lds_f, r / 16, r % 16); }
    }
    for (int i = bid * 512 + tid; i < SEQ * 32; i += G * 512) rope_entry(i, (float*)(g_scr + SCR_ROPE));
    for (int m = bid * 8 + wave; m < M_TOK; m += G * 8) xrow_to_bf16(p.in[0] + (size_t)m * DMODEL, (bf16_t*)(g_scr + SCR_XB) + (size_t)m * DMODEL, (float*)(g_scr + SCR_RS) + m, lane);
}

__device__ __forceinline__ void phase_prep(const Params& p, const int l) {
    const int G = gridDim.x, tid = otid(), lane = tid & 63, wave = tid >> 6;
    const float* tab = (const float*)(g_scr + SCR_ROPE);
    const float* qw = p.in[23] + l * 128; const float* kw = p.in[24] + l * 128;
    const int i32 = lane & 31; const bool lo = (lane & 32) == 0;
    for (int m = blockIdx.x * 8 + wave; m < M_TOK; m += G * 8) {
        const int t = m & (SEQ - 1);
        {   const float cs = tab[(t * 32 + i32) * 2], sn = tab[(t * 32 + i32) * 2 + 1];
#pragma unroll
            for (int h = 0; h < 8; ++h) { bf16_t* base = pblk(p.ws, (h < 4 ? PB_DQ + h : PB_DK + (h - 4))) + (size_t)m * 128;
#pragma unroll
                for (int c = 0; c < 2; ++c) { const float x = bf2f(base[c * 64 + lane]); const float o = __shfl_xor(x, 32);
                    const float r = lo ? (x * cs - o * sn) : (x * cs + o * sn); base[c * 64 + lane] = f2bf(r); } } }
#pragma unroll
        for (int half = 0; half < 2; ++half) { const int ch = half * 512 + lane * 8; const bf16_t* src = pblk(p.ws, PB_XS + (ch >> 7)) + (ch & 127);
            const float* cw = p.in[5] + (size_t)l * 5 * 1024 + ch; const float* cb = p.in[6] + (size_t)l * 1024 + ch;
            float acc[8]; { const f32x4 b0 = *(const f32x4*)cb, b1 = *(const f32x4*)(cb + 4);
#pragma unroll
              for (int e = 0; e < 4; ++e) { acc[e] = b0[e]; acc[4 + e] = b1[e]; } }
#pragma unroll
            for (int jj = 0; jj < 5; ++jj) { const int tt = t + jj - 2; if (tt >= 0 && tt < SEQ) {
                const bf16x8 x = *(const bf16x8*)(src + ((size_t)(m - t + tt)) * 128); const f32x4 w0 = *(const f32x4*)(cw + jj * 1024), w1 = *(const f32x4*)(cw + jj * 1024 + 4);
#pragma unroll
                for (int e = 0; e < 4; ++e) { acc[e] += w0[e] * bf2f((bf16_t)x[e]); acc[4 + e] += w1[e] * bf2f((bf16_t)x[4 + e]); } } }
            u32x4 o; o.x = pk2(siluf(acc[0]), siluf(acc[1])); o.y = pk2(siluf(acc[2]), siluf(acc[3])); o.z = pk2(siluf(acc[4]), siluf(acc[5])); o.w = pk2(siluf(acc[6]), siluf(acc[7]));
            *(u32x4*)((bf16_t*)(g_scr + SCR_XACT) + (size_t)m * 1024 + ch) = o; }
        {   const int row = t >> 6, col = t & 63;
            const float cr = tab[(row * 32 + i32) * 2], sr = tab[(row * 32 + i32) * 2 + 1], cc = tab[(col * 32 + i32) * 2], sc = tab[(col * 32 + i32) * 2 + 1];
#pragma unroll
            for (int h = 0; h < 6; ++h) { bf16_t* base = pblk(p.ws, (h < 4 ? PB_GQ + h : PB_GK + (h - 4))) + (size_t)m * 128; const float* w = h < 4 ? qw : kw;
                float x0 = bf2f(base[lane]), x1 = bf2f(base[64 + lane]);
                const float ss = wave_sum(x0 * x0 + x1 * x1); const float rs = rsqrtf(ss * (1.f / 128.f) + NORM_EPS);
                x0 *= rs * w[lane]; x1 *= rs * w[64 + lane];
                const float o0 = __shfl_xor(x0, 32), o1 = __shfl_xor(x1, 32);
                const float r0 = lo ? (x0 * cr - o0 * sr) : (x0 * cr + o0 * sr);
                const float r1 = lo ? (x1 * cc - o1 * sc) : (x1 * cc + o1 * sc);
                base[lane] = f2bf(r0); base[64 + lane] = f2bf(r1); } }
    }
}

namespace att {
using s16x4 = __attribute__((ext_vector_type(4))) short;
using f32x16 = __attribute__((ext_vector_type(16))) float;
constexpr int D = 128, NW = 8, QBLK = 32, KVBLK = 64, LD = 128;
constexpr float THR = 8.f;
constexpr size_t SHM_V = KVBLK * D * 2, SHM_K = KVBLK * D * 2, SHM_ATTN = 2 * SHM_V + 2 * SHM_K + NW * 64 * 4;
#define KSWZ(row, colB) ((row) * 256 + ((colB) ^ (((row) & 7) << 4)))
#define SBAR() __builtin_amdgcn_sched_barrier(0)
__device__ __forceinline__ int crow(int r, int hi) { return (r & 3) + 8 * (r >> 2) + 4 * hi; }
__device__ __forceinline__ unsigned cvtpk(float lo, float hi) { unsigned r; asm volatile("v_cvt_pk_bf16_f32 %0, %1, %2" : "=v"(r) : "v"(lo), "v"(hi)); return r; }
template <int DIFF>
__device__ __forceinline__ void partialSM(f32x16& p0, f32x16& p1, float& m_reg, float& mn, float& alpha) {
  constexpr float SCALE = DIFF ? 0.125f : 0.088388347648318440f;
  constexpr float C = SCALE * 1.4426950408889634f;
  float pmax = p0[0]; _Pragma("unroll") for (int r = 1; r < 16; ++r) pmax = fmaxf(pmax, p0[r]); _Pragma("unroll") for (int r = 0; r < 16; ++r) pmax = fmaxf(pmax, p1[r]);
  { auto rr = __builtin_amdgcn_permlane32_swap(__float_as_uint(pmax), __float_as_uint(pmax), false, false);
    pmax = fmaxf(__uint_as_float(rr[0]), __uint_as_float(rr[1])); }
  if (__builtin_expect(__all(pmax - m_reg <= THR / SCALE), 1)) { mn = m_reg; alpha = 1.f; }
  else { mn = fmaxf(m_reg, pmax); alpha = __builtin_amdgcn_exp2f((m_reg - mn) * C); m_reg = mn; }
  float mnC = -mn * C;
  _Pragma("unroll") for (int r = 0; r < 16; ++r) p0[r] = fmaf(p0[r], C, mnC); _Pragma("unroll") for (int r = 0; r < 16; ++r) p1[r] = fmaf(p1[r], C, mnC);
  _Pragma("unroll") for (int r = 0; r < 16; ++r) p0[r] = __builtin_amdgcn_exp2f(p0[r]);
}
__device__ __forceinline__ void finishSM(f32x16& p0, f32x16& p1, float alpha, float& l_reg, bf16x8& pa0, bf16x8& pa1, bf16x8& pa2, bf16x8& pa3) {
  _Pragma("unroll") for (int r = 0; r < 16; ++r) p1[r] = __builtin_amdgcn_exp2f(p1[r]);
  float ps = 0; _Pragma("unroll") for (int r = 0; r < 16; ++r) ps += p0[r]; _Pragma("unroll") for (int r = 0; r < 16; ++r) ps += p1[r];
  { auto rr = __builtin_amdgcn_permlane32_swap(__float_as_uint(ps), __float_as_uint(ps), false, false);
    ps = __uint_as_float(rr[0]) + __uint_as_float(rr[1]); }
  l_reg = l_reg * alpha + ps;
#define PK4(P, BASE, OUT) do { unsigned a0 = cvtpk(P[BASE + 0], P[BASE + 1]), a1 = cvtpk(P[BASE + 2], P[BASE + 3]);   \
    unsigned b0 = cvtpk(P[BASE + 4], P[BASE + 5]), b1 = cvtpk(P[BASE + 6], P[BASE + 7]);                              \
    auto r0 = __builtin_amdgcn_permlane32_swap(a0, b0, false, false); auto r1 = __builtin_amdgcn_permlane32_swap(a1, b1, false, false); \
    u32x4 w = {r0[0], r1[0], r0[1], r1[1]}; OUT = *reinterpret_cast<bf16x8*>(&w); } while (0)
  PK4(p0, 0, pa0); PK4(p0, 8, pa1); PK4(p1, 0, pa2); PK4(p1, 8, pa3);
#undef PK4
}
template <int ND0>
__device__ __forceinline__ void qkt(f32x16& p0, f32x16& p1, const bf16_t* Ks, const bf16x8* qr, int r32, int hi, int db0) {
  p0 = f32x16{}; p1 = f32x16{};
  _Pragma("unroll") for (int d0 = 0; d0 < ND0; ++d0) { int cb = ((db0 + d0) * 16 + hi * 8) * 2;
    bf16x8 b0 = *reinterpret_cast<const bf16x8*>((const char*)Ks + KSWZ(r32, cb));
    bf16x8 b1 = *reinterpret_cast<const bf16x8*>((const char*)Ks + KSWZ(32 + r32, cb));
    p0 = __builtin_amdgcn_mfma_f32_32x32x16_bf16(b0, qr[d0], p0, 0, 0, 0);
    p1 = __builtin_amdgcn_mfma_f32_32x32x16_bf16(b1, qr[d0], p1, 0, 0, 0); }
}
__device__ __forceinline__ int v_st(int k, int c) { const int kk = (k & ~0xC) | ((k & 4) << 1) | ((k & 8) >> 1); return ((kk >> 3) * 4 + (c >> 5)) * 512 + ((kk & 7) * 32 + (c & 31)) * 2; }
__device__ __forceinline__ int v_rd_base(int lane) { return ((lane & 3) << 3) | (((lane >> 2) & 3) << 6) | (((lane >> 4) & 1) << 5) | (((lane >> 5) & 1) << 8); }
constexpr int v_rd_off(int d0, int ks, int half) { return d0 * 512 + ks * 4096 + half * 2048; }
template <int OFF> __device__ __forceinline__ s16x4 tr_read(int vb) {
  s16x4 r; asm volatile("ds_read_b64_tr_b16 %0, %1 offset:%2" : "=&v"(r) : "v"(vb), "i"(OFF) : "memory"); return r;
}
template <int D0> __device__ __forceinline__ void pv_one(f32x16& od, int vb, bf16x8 pa0, bf16x8 pa1, bf16x8 pa2, bf16x8 pa3) {
  const s16x4 l0 = tr_read<v_rd_off(D0, 0, 0)>(vb), h0 = tr_read<v_rd_off(D0, 0, 1)>(vb), l1 = tr_read<v_rd_off(D0, 1, 0)>(vb), h1 = tr_read<v_rd_off(D0, 1, 1)>(vb);
  const s16x4 l2 = tr_read<v_rd_off(D0, 2, 0)>(vb), h2 = tr_read<v_rd_off(D0, 2, 1)>(vb), l3 = tr_read<v_rd_off(D0, 3, 0)>(vb), h3 = tr_read<v_rd_off(D0, 3, 1)>(vb);
  asm volatile("s_waitcnt lgkmcnt(0)" ::: "memory"); SBAR();
#define PK(L, H) (bf16x8){L[0], L[1], L[2], L[3], H[0], H[1], H[2], H[3]}
  od = __builtin_amdgcn_mfma_f32_32x32x16_bf16(pa0, PK(l0, h0), od, 0, 0, 0);
  od = __builtin_amdgcn_mfma_f32_32x32x16_bf16(pa1, PK(l1, h1), od, 0, 0, 0);
  od = __builtin_amdgcn_mfma_f32_32x32x16_bf16(pa2, PK(l2, h2), od, 0, 0, 0);
  od = __builtin_amdgcn_mfma_f32_32x32x16_bf16(pa3, PK(l3, h3), od, 0, 0, 0);
#undef PK
}
__device__ __forceinline__ void pv_d0(f32x16* o, int vb, bf16x8 pa0, bf16x8 pa1, bf16x8 pa2, bf16x8 pa3) {
  pv_one<0>(o[0], vb, pa0, pa1, pa2, pa3); pv_one<1>(o[1], vb, pa0, pa1, pa2, pa3); pv_one<2>(o[2], vb, pa0, pa1, pa2, pa3); pv_one<3>(o[3], vb, pa0, pa1, pa2, pa3);
}
template <int DIFF>
__device__ __forceinline__ void attn_unit(const bf16_t* Qb, const bf16_t* __restrict__ Kh, const bf16_t* __restrict__ Vh, bf16_t* Ob, const bf16_t* gate,
                                          int seq, char* lds, const float* lamp, int layer, const float* nw) {
  constexpr int ND0 = DIFF ? 4 : 8;
  const int tid = otid(), wid = tid >> 6, lane = tid & 63, r32 = lane & 31, hi = lane >> 5;
  const int wq = DIFF ? (wid & 3) : wid, mapc = DIFF ? (wid >> 2) : 0;
  bf16_t* V_lds = (bf16_t*)lds; bf16_t* K_lds = (bf16_t*)(lds + 2 * SHM_V);
  float* ws = (float*)(lds + 2 * SHM_V + 2 * SHM_K) + wid * 64; float* li_l = ws; float* al_l = ws + 32;
  float m_reg = -1e30f, l_reg = 0; f32x16 o[4] = {}; bf16x8 qr[ND0];
  const bf16_t* Qw = Qb + (long)(wq * QBLK + r32) * LD + mapc * 64 + hi * 8;
  _Pragma("unroll") for (int d0 = 0; d0 < ND0; ++d0) qr[d0] = *reinterpret_cast<const bf16x8*>(Qw + d0 * 16);
  const int sr = tid >> 4, sc = (tid & 15) * 8, vst0 = v_st(sr, sc), vst1 = v_st(32 + sr, sc);
  const int vb0 = (int)(uintptr_t)V_lds + v_rd_base(lane);
  struct { bf16x8 vs0, vs1, ks0, ks1; } sr_[2];
#define SLOAD(i, k0) do { sr_[i].vs0 = *reinterpret_cast<const bf16x8*>(&Vh[(long)((k0) + sr) * LD + sc]); sr_[i].vs1 = *reinterpret_cast<const bf16x8*>(&Vh[(long)((k0) + 32 + sr) * LD + sc]); \
    sr_[i].ks0 = *reinterpret_cast<const bf16x8*>(&Kh[(long)((k0) + sr) * LD + sc]); sr_[i].ks1 = *reinterpret_cast<const bf16x8*>(&Kh[(long)((k0) + 32 + sr) * LD + sc]); } while (0)
#define SWRITE(b, i) do { *(bf16x8*)((char*)V_lds + (b) * SHM_V + vst0) = sr_[i].vs0;          \
    *(bf16x8*)((char*)V_lds + (b) * SHM_V + vst1) = sr_[i].vs1; int kc = sc * 2;               \
    *(bf16x8*)((char*)K_lds + (b) * SHM_K + KSWZ(sr, kc)) = sr_[i].ks0;                       \
    *(bf16x8*)((char*)K_lds + (b) * SHM_K + KSWZ(32 + sr, kc)) = sr_[i].ks1; } while (0)
#define SWAIT() asm volatile("s_waitcnt vmcnt(4)" ::: "memory")
#define RESC(a) do { if (__any((a) < 1.f)) { if (hi == 0) al_l[r32] = (a); asm volatile("s_waitcnt lgkmcnt(0)" ::: "memory"); \
    _Pragma("unroll") for (int d = 0; d < 4; ++d) _Pragma("unroll") for (int r = 0; r < 16; ++r) o[d][r] *= al_l[crow(r, hi)]; } } while (0)
  f32x16 pA0, pA1, pB0, pB1; float mnA, mnB, alA, alB; bf16x8 pa0, pa1, pa2, pa3; int NT = seq / KVBLK; asm volatile("" : "+s"(NT));
  constexpr int SE = 0, SO = 1;
  SLOAD(SE, 0); asm volatile("s_waitcnt vmcnt(0)" ::: "memory"); SWRITE(0, SE); __syncthreads();
  qkt<ND0>(pA0, pA1, K_lds, qr, r32, hi, mapc * 4); partialSM<DIFF>(pA0, pA1, m_reg, mnA, alA);
  SLOAD(SO, KVBLK); if (2 < NT) SLOAD(SE, 2 * KVBLK);
  SWAIT(); SWRITE(1, SO); __syncthreads();
  _Pragma("unroll 1") for (int j = 1; j + 1 < NT; j += 2) {
    SBAR(); qkt<ND0>(pB0, pB1, (bf16_t*)((char*)K_lds + SHM_K), qr, r32, hi, mapc * 4);
    finishSM(pA0, pA1, alA, l_reg, pa0, pa1, pa2, pa3); SBAR();
    SLOAD(SO, (j + 2) * KVBLK); SBAR();
    pv_d0(o, vb0, pa0, pa1, pa2, pa3); partialSM<DIFF>(pB0, pB1, m_reg, mnB, alB);
    __syncthreads(); SWAIT(); SWRITE(0, SE);
    RESC(alB); __syncthreads();
    SBAR(); qkt<ND0>(pA0, pA1, K_lds, qr, r32, hi, mapc * 4);
    finishSM(pB0, pB1, alB, l_reg, pa0, pa1, pa2, pa3); SBAR();
    if (j + 3 < NT) SLOAD(SE, (j + 3) * KVBLK); SBAR();
    pv_d0(o, vb0 + (int)SHM_V, pa0, pa1, pa2, pa3); partialSM<DIFF>(pA0, pA1, m_reg, mnA, alA);
    __syncthreads(); SWAIT(); SWRITE(1, SO);
    RESC(alA); __syncthreads();
  }
  SBAR(); qkt<ND0>(pB0, pB1, (bf16_t*)((char*)K_lds + SHM_K), qr, r32, hi, mapc * 4);
  finishSM(pA0, pA1, alA, l_reg, pa0, pa1, pa2, pa3); SBAR();
  pv_d0(o, vb0, pa0, pa1, pa2, pa3); partialSM<DIFF>(pB0, pB1, m_reg, mnB, alB);
  __syncthreads(); RESC(alB);
  finishSM(pB0, pB1, alB, l_reg, pa0, pa1, pa2, pa3); SBAR();
  pv_d0(o, vb0 + (int)SHM_V, pa0, pa1, pa2, pa3);
  if (hi == 0) li_l[r32] = l_reg; asm volatile("s_waitcnt lgkmcnt(0)" ::: "memory");
  float rli[16];
  _Pragma("unroll") for (int r = 0; r < 16; ++r) rli[r] = __builtin_amdgcn_rcpf(li_l[crow(r, hi)]);
  int r32e = r32; asm volatile("" : "+v"(r32e));
  if constexpr (!DIFF) {
    bf16_t* Ow = Ob + (long)(wid * QBLK) * LD; const bf16_t* Gw = gate + (long)(wid * QBLK) * LD;
    _Pragma("unroll") for (int r = 0; r < 16; ++r) { const int orow = crow(r, hi);
      _Pragma("unroll") for (int d0 = 0; d0 < 4; ++d0) { const float g = bf2f(Gw[(long)orow * LD + d0 * 32 + r32e]); Ow[(long)orow * LD + d0 * 32 + r32e] = f2bf(o[d0][r] * rli[r] * siluf(g)); }
      asm volatile("" ::: "memory"); }
    __syncthreads();
  } else {
    __syncthreads();
    const float s1 = wave_sum(lamp[lane] * lamp[64 + lane]), s2 = wave_sum(lamp[128 + lane] * lamp[192 + lane]);
    int ly = layer; asm volatile("" : "+s"(ly));
    const float lambda_init = 0.8f - 0.6f * expf(-0.3f * (float)ly);
    const float lam = expf(s1) - expf(s2) + lambda_init, osc = 1.f - lambda_init;
    float* X = (float*)lds;
    if (mapc == 1) {
      _Pragma("unroll") for (int r = 0; r < 16; ++r) { const int orow = wq * QBLK + crow(r, hi);
        _Pragma("unroll") for (int d0 = 0; d0 < 4; ++d0) X[orow * 128 + d0 * 32 + r32e] = o[d0][r] * rli[r] * lam; }
    }
    __syncthreads();
    if (mapc == 0) {
      bf16_t* Ow = Ob + (long)(wq * QBLK) * LD; const bf16_t* Gw = gate + (long)(wq * QBLK) * LD;
      _Pragma("unroll") for (int r = 0; r < 16; ++r) { const int orow = crow(r, hi); float v[4]; float ss = 0.f;
        _Pragma("unroll") for (int d0 = 0; d0 < 4; ++d0) { v[d0] = o[d0][r] * rli[r] - X[(wq * QBLK + orow) * 128 + d0 * 32 + r32e]; ss += v[d0] * v[d0]; }
        ss += __shfl_xor(ss, 1); ss += __shfl_xor(ss, 2); ss += __shfl_xor(ss, 4); ss += __shfl_xor(ss, 8); ss += __shfl_xor(ss, 16);
        const float rs = rsqrtf(ss * (1.f / 128.f) + NORM_EPS) * osc;
        _Pragma("unroll") for (int d0 = 0; d0 < 4; ++d0) { const int c = d0 * 32 + r32e; const float g = bf2f(Gw[(long)orow * LD + c]); Ow[(long)orow * LD + c] = f2bf(v[d0] * rs * nw[c] * siluf(g)); } }
    }
    __syncthreads();
  }
#undef SLOAD
#undef SWRITE
#undef SWAIT
#undef RESC
}
#undef KSWZ
#undef SBAR
}

__device__ __forceinline__ void gqa_unit(const Params& p, const int l, int u, char* lds) {
    const int qb = u & 31, hq = (u >> 5) & 3, b = u >> 7; const size_t row0 = (size_t)b * SEQ + (size_t)qb * 256, k0 = (size_t)b * SEQ;
    bf16_t* Q = pblk(p.ws, PB_GQ + hq) + row0 * 128;
    att::attn_unit<0>(Q, pblk(p.ws, PB_GK + (hq >> 1)) + k0 * 128, pblk(p.ws, PB_GV + (hq >> 1)) + k0 * 128, Q, pblk(p.ws, PB_GG + hq) + row0 * 128, SEQ, lds, nullptr, 0, nullptr);
}
__device__ __forceinline__ void diff_unit(const Params& p, const int l, int u, char* lds) {
    const int qb = u & 63, h = (u >> 6) & 3, b = u >> 8; const size_t row0 = (size_t)b * SEQ + (size_t)qb * 128, k0 = (size_t)b * SEQ;
    bf16_t* Q = pblk(p.ws, PB_DQ + h) + row0 * 128;
    att::attn_unit<1>(Q, pblk(p.ws, PB_DK + h) + k0 * 128, pblk(p.ws, PB_DV + h) + k0 * 128, Q, pblk(p.ws, PB_DG + h) + row0 * 128, SEQ, lds, p.in[21] + l * 256, l, p.in[22] + l * 128);
}

#define WAVE_FENCE() do { __builtin_amdgcn_fence(__ATOMIC_ACQ_REL, "workgroup"); __builtin_amdgcn_wave_barrier(); } while (0)
__device__ __forceinline__ void rwkv_naive_seq(const Params& p, const int l, int sid, float* lds) {
    const int j = otid() & 63; const int h = sid & 7, dir = (sid >> 3) & 1, b = sid >> 4;
    float* w2s = lds; float* a2s = lds + 4096; float* tws = lds + 8192; float* ads = tws + 64; float* ops = ads + 64;
    const float* w2 = p.in[13] + ((size_t)(l * 2 + dir) * 64) * 512 + h * 64; const float* a2 = p.in[15] + ((size_t)l * 64) * 512 + h * 64;
    for (int i = 0; i < 64; ++i) { w2s[i * 64 + j] = w2[(size_t)i * 512 + j]; a2s[i * 64 + j] = a2[(size_t)i * 512 + j]; }
    const float* mu = p.in[11] + (size_t)(l * 2 + dir) * 1664;
    const float mu_r = mu[h * 64 + j], mu_k = mu[512 + h * 64 + j], mu_v = mu[1024 + h * 64 + j], mu_w = mu[1536 + j], mu_a = mu[1600 + j];
    const float w0 = p.in[12][(l * 2 + dir) * 512 + h * 64 + j], a0 = p.in[14][l * 512 + h * 64 + j];
    const float kkc = p.in[16][l * 512 + h * 64 + j], kac = p.in[17][l * 512 + h * 64 + j], rkc = p.in[18][l * 512 + h * 64 + j];
    const bf16_t* Pr = pblk(p.ws, PB_R + (h >> 1)) + (h & 1) * 64 + j; const bf16_t* Pk = pblk(p.ws, PB_K + (h >> 1)) + (h & 1) * 64 + j;
    const bf16_t* Pv = pblk(p.ws, PB_V + (h >> 1)) + (h & 1) * 64 + j; const bf16_t* Pw = pblk(p.ws, PB_WA) + j; const bf16_t* Pa = pblk(p.ws, PB_WA) + 64 + j;
    bf16_t* wkv = (bf16_t*)(g_scr + SCR_WKV) + (size_t)dir * M_TOK * 512 + h * 64 + j; bf16_t* bon = (bf16_t*)(g_scr + SCR_BON) + (size_t)dir * M_TOK * 512 + h * 64 + j;
    float S[64];
#pragma unroll
    for (int k = 0; k < 64; ++k) S[k] = 0.f;
    float pr = 0.f, pk = 0.f, pv = 0.f, pw = 0.f, pa = 0.f;
    WAVE_FENCE();
    for (int s = 0; s < SEQ; ++s) {
        const int t = dir ? (SEQ - 1 - s) : s; const size_t m = (size_t)b * SEQ + t;
        const float xr = bf2f(Pr[m * 128]), xk = bf2f(Pk[m * 128]), xv = bf2f(Pv[m * 128]), xw = bf2f(Pw[m * 128]), xa = bf2f(Pa[m * 128]);
        const float r = xr + (pr - xr) * mu_r, k = xk + (pk - xk) * mu_k, v = xv + (pv - xv) * mu_v, wd = xw + (pw - xw) * mu_w, ad = xa + (pa - xa) * mu_a;
        pr = xr; pk = xk; pv = xv; pw = xw; pa = xa;
        tws[j] = tanhf(wd); ads[j] = ad;
        WAVE_FENCE();
        float wv = w0, av = a0;
#pragma unroll 8
        for (int i = 0; i < 64; ++i) { wv += tws[i] * w2s[i * 64 + j]; av += ads[i] * a2s[i * 64 + j]; }
        wv = -softplusf(-wv) - 0.5f; const float dec = expf(-expf(wv));
        av = 1.f / (1.f + expf(-av));
        float kk = k * kkc; const float nrm = sqrtf(wave_sum(kk * kk)); kk = kk / fmaxf(nrm, 1e-12f);
        const float kp = k * (1.f + (av - 1.f) * kac);
        const float bsc = wave_sum(r * kp * rkc);
        ops[j] = -kk; ops[64 + j] = kk * av; ops[128 + j] = dec; ops[192 + j] = kp; ops[256 + j] = r;
        WAVE_FENCE();
        float sa = 0.f;
#pragma unroll
        for (int k4 = 0; k4 < 16; ++k4) { const f32x4 a4 = *(const f32x4*)(ops + k4 * 4); sa += S[k4 * 4] * a4[0] + S[k4 * 4 + 1] * a4[1] + S[k4 * 4 + 2] * a4[2] + S[k4 * 4 + 3] * a4[3]; }
        float y = 0.f;
#pragma unroll
        for (int k4 = 0; k4 < 16; ++k4) { const f32x4 b4 = *(const f32x4*)(ops + 64 + k4 * 4), d4 = *(const f32x4*)(ops + 128 + k4 * 4), k4v = *(const f32x4*)(ops + 192 + k4 * 4), r4 = *(const f32x4*)(ops + 256 + k4 * 4);
#pragma unroll
            for (int e = 0; e < 4; ++e) { const float sn = S[k4 * 4 + e] * d4[e] + sa * b4[e] + v * k4v[e]; S[k4 * 4 + e] = sn; y += sn * r4[e]; } }
        wkv[m * 512] = f2bf(y); bon[m * 512] = f2bf(bsc * v);
        WAVE_FENCE();
    }
}

namespace rk {
using f32x16 = __attribute__((ext_vector_type(16))) float;
constexpr int PB = 144, MAT = 64 * PB;
constexpr int O_W2T = 0, O_A2T = MAT, O_SB = 2 * MAT, O_GAM = 3 * MAT, O_CONST = O_GAM + 256,
              O_T = O_CONST + 2560, O_TW = O_T, O_G1T = O_T + MAT, O_AD = O_G1T,
              O_R2 = O_G1T + MAT, O_CL = O_R2, O_AA = O_R2 + 16384, O_ABD = O_R2, O_AAB = O_R2 + 4096, O_AAK = O_AAB + MAT, O_ARB = O_AAK + MAT, O_ARK = O_ARB + MAT,
              O_R3 = O_ARK + MAT, O_AT = O_R3, O_RT = O_AT + MAT, O_BT = O_RT + MAT, O_DT = O_BT, O_UT = O_BT, O_KT = O_BT + MAT, O_PT = O_KT,
              O_BHT = O_KT + MAT, O_KHT = O_BHT + MAT, O_VT = O_KHT + MAT, O_END = O_VT + MAT;
__device__ __forceinline__ int crow(int r, int hi) { return (r & 3) + 8 * (r >> 2) + 4 * hi; }
#define RK_FENCE() do { asm volatile("s_waitcnt lgkmcnt(0)" ::: "memory"); __builtin_amdgcn_wave_barrier(); } while (0)
template <int NKS> __device__ __forceinline__ void mm32(f32x16& acc, const char* A, int m0, const char* B, int n0, int k0, int r32, int hi) {
#pragma unroll
    for (int ks = 0; ks < NKS; ++ks) {
        const bf16x8 a = *(const bf16x8*)(A + (m0 + r32) * PB + (k0 + ks * 16 + hi * 8) * 2);
        const bf16x8 b = *(const bf16x8*)(B + (n0 + r32) * PB + (k0 + ks * 16 + hi * 8) * 2);
        acc = __builtin_amdgcn_mfma_f32_32x32x16_bf16(a, b, acc, 0, 0, 0); }
}
__device__ __forceinline__ void st_T(const f32x16& acc, char* Z, int n0, int m0, int r32, int hi) {
#pragma unroll
    for (int g = 0; g < 4; ++g) { u32x2 w; w.x = pk2(acc[4 * g], acc[4 * g + 1]); w.y = pk2(acc[4 * g + 2], acc[4 * g + 3]);
        *(u32x2*)(Z + (n0 + r32) * PB + (m0 + 8 * g + 4 * hi) * 2) = w; }
}
__device__ __forceinline__ void seq(const Params& p, const int l, const int sid, unsigned char* lds) {
    const int tid = otid(), w = __builtin_amdgcn_readfirstlane(tid >> 6);
    const int h = sid & 7, dir = (sid >> 3) & 1, b = sid >> 4;
#define RK_LANE() int tq_ = tid; asm volatile("" : "+v"(tq_)); const int lane = tq_ & 63, r32 = lane & 31, hi = lane >> 5, tok = tq_ >> 3, c8 = (tq_ & 7) * 8; (void)lane; (void)r32; (void)hi; (void)tok; (void)c8
    char* L = (char*)lds; float* CF = (float*)(L + O_CONST);
    {   RK_LANE();
        const float* w2 = p.in[13] + ((size_t)(l * 2 + dir) * 64) * 512 + h * 64; const float* a2 = p.in[15] + ((size_t)l * 64) * 512 + h * 64;
        float t[8], u[8];
#pragma unroll
        for (int e = 0; e < 8; ++e) { t[e] = w2[(size_t)(c8 + e) * 512 + tok]; u[e] = a2[(size_t)(c8 + e) * 512 + tok]; }
        u32x4 ww, aa; ww.x = pk2(t[0], t[1]); ww.y = pk2(t[2], t[3]); ww.z = pk2(t[4], t[5]); ww.w = pk2(t[6], t[7]);
        aa.x = pk2(u[0], u[1]); aa.y = pk2(u[2], u[3]); aa.z = pk2(u[4], u[5]); aa.w = pk2(u[6], u[7]);
        *(u32x4*)(L + O_W2T + tok * PB + c8 * 2) = ww; *(u32x4*)(L + O_A2T + tok * PB + c8 * 2) = aa;
        { unsigned zz = 0u; asm volatile("" : "+v"(zz)); *(u32x4*)(L + O_SB + tok * PB + c8 * 2) = (u32x4){zz, zz, zz, zz}; }
        const float* mu = p.in[11] + (size_t)(l * 2 + dir) * 1664;
        for (int i = tid; i < 640; i += 512) { const int row = i >> 6, j = i & 63; float v;
            if (row == 0) v = p.in[12][(l * 2 + dir) * 512 + h * 64 + j]; else if (row == 1) v = p.in[14][l * 512 + h * 64 + j];
            else if (row == 2) v = p.in[16][l * 512 + h * 64 + j]; else if (row == 3) v = p.in[17][l * 512 + h * 64 + j]; else if (row == 4) v = p.in[18][l * 512 + h * 64 + j];
            else if (row == 5) v = mu[h * 64 + j]; else if (row == 6) v = mu[512 + h * 64 + j]; else if (row == 7) v = mu[1024 + h * 64 + j]; else if (row == 8) v = mu[1536 + j]; else v = mu[1600 + j];
            CF[i] = v; }
    }
    const bf16_t* Pr = pblk(p.ws, PB_R + (h >> 1)) + (h & 1) * 64; const bf16_t* Pk = pblk(p.ws, PB_K + (h >> 1)) + (h & 1) * 64;
    const bf16_t* Pv = pblk(p.ws, PB_V + (h >> 1)) + (h & 1) * 64; const bf16_t* Pw = pblk(p.ws, PB_WA); const bf16_t* Pa = pblk(p.ws, PB_WA) + 64;
    bf16_t* wkv = (bf16_t*)(g_scr + SCR_WKV) + (size_t)dir * M_TOK * 512 + h * 64; bf16_t* bon = (bf16_t*)(g_scr + SCR_BON) + (size_t)dir * M_TOK * 512 + h * 64;
    f32x16 sacc = {};
    bf16x8 cu[5], pv[5];
#define RK_LOAD(c) do { RK_LANE(); const int s_ = (c) * 64 + tok; const int t_ = dir ? (SEQ - 1 - s_) : s_; const size_t m_ = ((size_t)b * SEQ + t_) * 128 + c8; \
        cu[0] = *(const bf16x8*)(Pr + m_); cu[1] = *(const bf16x8*)(Pk + m_); cu[2] = *(const bf16x8*)(Pv + m_); cu[3] = *(const bf16x8*)(Pw + m_); cu[4] = *(const bf16x8*)(Pa + m_); \
        if (s_ > 0) { const size_t q_ = dir ? m_ + 128 : m_ - 128; pv[0] = *(const bf16x8*)(Pr + q_); pv[1] = *(const bf16x8*)(Pk + q_); pv[2] = *(const bf16x8*)(Pv + q_); pv[3] = *(const bf16x8*)(Pw + q_); pv[4] = *(const bf16x8*)(Pa + q_); } \
        else { _Pragma("unroll") for (int i_ = 0; i_ < 5; ++i_) pv[i_] = (bf16x8){0, 0, 0, 0, 0, 0, 0, 0}; } } while (0)
    RK_LOAD(0);
    __syncthreads();
#pragma unroll 1
    for (int c = 0; c < SEQ / 64; ++c) {
        float rr[8], kx[8], vv[8];
        {   RK_LANE(); float tw[8], ad[8];
#pragma unroll
            for (int e = 0; e < 8; ++e) {
                const float x0 = bf2f((bf16_t)cu[0][e]), x1 = bf2f((bf16_t)cu[1][e]), x2 = bf2f((bf16_t)cu[2][e]), x3 = bf2f((bf16_t)cu[3][e]), x4 = bf2f((bf16_t)cu[4][e]);
                const float p0 = bf2f((bf16_t)pv[0][e]), p1 = bf2f((bf16_t)pv[1][e]), p2 = bf2f((bf16_t)pv[2][e]), p3 = bf2f((bf16_t)pv[3][e]), p4 = bf2f((bf16_t)pv[4][e]);
                rr[e] = x0 + (p0 - x0) * CF[5 * 64 + (h * 0) + c8 + e]; kx[e] = x1 + (p1 - x1) * CF[6 * 64 + c8 + e]; vv[e] = x2 + (p2 - x2) * CF[7 * 64 + c8 + e];
                const float wd = x3 + (p3 - x3) * CF[8 * 64 + c8 + e]; ad[e] = x4 + (p4 - x4) * CF[9 * 64 + c8 + e];
                tw[e] = 1.f - 2.f / (1.f + __expf(2.f * wd)); }
            u32x4 a, d; a.x = pk2(tw[0], tw[1]); a.y = pk2(tw[2], tw[3]); a.z = pk2(tw[4], tw[5]); a.w = pk2(tw[6], tw[7]);
            d.x = pk2(ad[0], ad[1]); d.y = pk2(ad[2], ad[3]); d.z = pk2(ad[4], ad[5]); d.w = pk2(ad[6], ad[7]);
            *(u32x4*)(L + O_TW + tok * PB + c8 * 2) = a; *(u32x4*)(L + O_AD + tok * PB + c8 * 2) = d; }
        __syncthreads();
        if (w < 4) {
            RK_LANE(); const int n0 = (w & 1) * 32; const bool isA = w >= 2;
            const char* Aop = L + (isA ? O_AD : O_TW); const char* Bop = L + (isA ? O_A2T : O_W2T);
            f32x16 x0 = {}, x1 = {};
            mm32<4>(x0, Aop, 0, Bop, n0, 0, r32, hi); mm32<4>(x1, Aop, 32, Bop, n0, 0, r32, hi);
            const int ch = n0 + r32; const float c0 = CF[(isA ? 64 : 0) + ch];
            if (!isA) {
#pragma unroll
                for (int r = 0; r < 16; ++r) { float a = c0 + x0[r]; a = fminf(a, 0.f) - __logf(1.f + __expf(-fabsf(a))) - 0.5f; x0[r] = -__expf(a);
                                               float q = c0 + x1[r]; q = fminf(q, 0.f) - __logf(1.f + __expf(-fabsf(q))) - 0.5f; x1[r] = -__expf(q); }
                float run = 0.f;
#pragma unroll
                for (int g = 0; g < 4; ++g) { const float gs = (x0[4 * g] + x0[4 * g + 1]) + (x0[4 * g + 2] + x0[4 * g + 3]); const float ps = __shfl_xor(gs, 32);
                    float st = run + (hi ? ps : 0.f); x0[4 * g] += st; x0[4 * g + 1] += x0[4 * g]; x0[4 * g + 2] += x0[4 * g + 1]; x0[4 * g + 3] += x0[4 * g + 2]; run += gs + ps; }
#pragma unroll
                for (int g = 0; g < 4; ++g) { const float gs = (x1[4 * g] + x1[4 * g + 1]) + (x1[4 * g + 2] + x1[4 * g + 3]); const float ps = __shfl_xor(gs, 32);
                    float st = run + (hi ? ps : 0.f); x1[4 * g] += st; x1[4 * g + 1] += x1[4 * g]; x1[4 * g + 2] += x1[4 * g + 1]; x1[4 * g + 3] += x1[4 * g + 2]; run += gs + ps; }
            } else {
#pragma unroll
                for (int r = 0; r < 16; ++r) { x0[r] = 1.f / (1.f + __expf(-(c0 + x0[r]))); x1[r] = 1.f / (1.f + __expf(-(c0 + x1[r]))); }
            }
            float* O = (float*)(L + (isA ? O_AA : O_CL));
#pragma unroll
            for (int r = 0; r < 16; ++r) { O[crow(r, hi) * 64 + ch] = x0[r]; O[(32 + crow(r, hi)) * 64 + ch] = x1[r]; }
        }
        __syncthreads();
        {   RK_LANE(); const float* clp = (const float*)(L + O_CL + tok * 256 + c8 * 4); const float* cle = (const float*)(L + O_CL + (tok > 0 ? tok - 1 : 0) * 256 + c8 * 4);
            const float* cln = (const float*)(L + O_CL + 63 * 256 + c8 * 4); const float* aap = (const float*)(L + O_AA + tok * 256 + c8 * 4);
            float kk[8], kp[8]; float ss = 0.f, bs = 0.f;
#pragma unroll
            for (int e = 0; e < 8; ++e) { kk[e] = kx[e] * CF[2 * 64 + c8 + e]; ss += kk[e] * kk[e]; kp[e] = kx[e] * (1.f + (aap[e] - 1.f) * CF[3 * 64 + c8 + e]); bs += rr[e] * kp[e] * CF[4 * 64 + c8 + e]; }
            ss += __shfl_xor(ss, 1); ss += __shfl_xor(ss, 2); ss += __shfl_xor(ss, 4);
            bs += __shfl_xor(bs, 1); bs += __shfl_xor(bs, 2); bs += __shfl_xor(bs, 4);
            const float rn = 1.f / fmaxf(sqrtf(ss), 1e-12f);
#pragma unroll
            for (int e2 = 0; e2 < 4; ++e2) { float At[2], Rt[2], Bt[2], Kt[2];
#pragma unroll
                for (int q = 0; q < 2; ++q) { const int e = 2 * e2 + q; const float cl = clp[e], ce = (tok > 0) ? cle[e] : 0.f, cn = cln[e];
                    const float kn = kk[e] * rn; const float bb = kn * aap[e];
                    const float ein = __expf(cl), eex = __expf(ce), eng = __expf(-cl), een = __expf(cn - cl);
                    At[q] = -kn * eex; Rt[q] = rr[e] * ein; Bt[q] = bb * eng; Kt[q] = kp[e] * eng;
                    *(bf16_t*)(L + O_BHT + (c8 + e) * PB + tok * 2) = f2bf(bb * een); *(bf16_t*)(L + O_KHT + (c8 + e) * PB + tok * 2) = f2bf(kp[e] * een); *(bf16_t*)(L + O_VT + (c8 + e) * PB + tok * 2) = f2bf(vv[e]);
                    if (tok == 63) ((float*)(L + O_GAM))[c8 + e] = __expf(cn); }
                const int ob = tok * PB + (c8 + 2 * e2) * 2;
                *(unsigned*)(L + O_AT + ob) = pk2(At[0], At[1]); *(unsigned*)(L + O_RT + ob) = pk2(Rt[0], Rt[1]); *(unsigned*)(L + O_BT + ob) = pk2(Bt[0], Bt[1]); *(unsigned*)(L + O_KT + ob) = pk2(Kt[0], Kt[1]); }
            {   const int s_ = c * 64 + tok; const int t_ = dir ? (SEQ - 1 - s_) : s_;
                u32x4 w_; w_.x = pk2(bs * vv[0], bs * vv[1]); w_.y = pk2(bs * vv[2], bs * vv[3]); w_.z = pk2(bs * vv[4], bs * vv[5]); w_.w = pk2(bs * vv[6], bs * vv[7]);
                *(u32x4*)(bon + ((size_t)b * SEQ + t_) * 512 + c8) = w_; }
        }
        __syncthreads();
        if (c + 1 < SEQ / 64) RK_LOAD(c + 1);
        for (int idx = w; idx < 12; idx += 8) {
            RK_LANE(); const int pr = idx / 3, tl = idx - pr * 3; const int mi = (tl == 2) ? 32 : 0, nt = (tl >= 1) ? 32 : 0;
            const char* X = L + ((pr & 1) ? O_KT : O_BT); const char* Y = L + ((pr >= 2) ? O_RT : O_AT);
            f32x16 acc = {}; mm32<4>(acc, X, mi, Y, nt, 0, r32, hi);
            const int t = nt + r32;
            if (tl != 1) {
#pragma unroll
                for (int r = 0; r < 16; ++r) { const int i = mi + crow(r, hi); const bool keep = (pr < 2) ? (i < t) : (i <= t); if (!keep) acc[r] = 0.f; } }
            char* Z = L + (pr == 0 ? O_AAB : pr == 1 ? O_AAK : pr == 2 ? O_ARB : O_ARK);
            st_T(acc, Z, nt, mi, r32, hi);
            if (pr == 0 && tl != 1) { float* ABD = (float*)(L + O_ABD);
#pragma unroll
                for (int r = 0; r < 16; ++r) { const int i = mi + crow(r, hi); if ((i >> 4) == (t >> 4)) ABD[(t >> 4) * 256 + (t & 15) * 16 + (i & 15)] = acc[r]; } }
        }
        __syncthreads();
        f32x16 yacc = {};
        const int mt = (w & 2) ? 32 : 0, nv = (w & 1) ? 32 : 0;
        if (w < 4) {
            RK_LANE(); const float* GAM = (const float*)(L + O_GAM);
#pragma unroll
            for (int r = 0; r < 16; ++r) sacc[r] *= GAM[mt + crow(r, hi)];
            mm32<4>(sacc, L + O_KHT, mt, L + O_VT, nv, 0, r32, hi);
            f32x16 g = {}; mm32<4>(g, L + O_AT, mt, L + O_SB, nv, 0, r32, hi);
            if (mt) mm32<4>(g, L + O_AAK, mt, L + O_VT, nv, 0, r32, hi); else mm32<2>(g, L + O_AAK, mt, L + O_VT, nv, 0, r32, hi);
            st_T(g, L + O_G1T, nv, mt, r32, hi);
        } else if (w < 7) {
            RK_LANE(); mm32<4>(yacc, L + O_RT, mt, L + O_SB, nv, 0, r32, hi);
            if (mt) mm32<4>(yacc, L + O_ARK, mt, L + O_VT, nv, 0, r32, hi); else mm32<2>(yacc, L + O_ARK, mt, L + O_VT, nv, 0, r32, hi);
        } else {
            RK_LANE(); const int blk = lane >> 4, j = lane & 15; const float* A = (const float*)(L + O_ABD) + blk * 256;
            float x[16];
#pragma unroll
            for (int t = 0; t < 16; ++t) { float s = (t == j) ? 1.f : 0.f;
#pragma unroll
                for (int i = 0; i < t; ++i) s += A[t * 16 + i] * x[i];
                x[t] = s; asm volatile("" ::: "memory"); }
            char* Tm = L + O_T; char* Dm = L + O_DT;
#pragma unroll
            for (int t = 0; t < 16; ++t) *(bf16_t*)(Tm + (16 * blk + t) * PB + (16 * blk + j) * 2) = f2bf(x[t]);
            { u32x4 a, d; a.x = pk2(x[0], x[1]); a.y = pk2(x[2], x[3]); a.z = pk2(x[4], x[5]); a.w = pk2(x[6], x[7]); d.x = pk2(x[8], x[9]); d.y = pk2(x[10], x[11]); d.z = pk2(x[12], x[13]); d.w = pk2(x[14], x[15]);
              *(u32x4*)(Dm + (16 * blk + j) * PB + (16 * blk) * 2) = a; *(u32x4*)(Dm + (16 * blk + j) * PB + (16 * blk + 8) * 2) = d; }
            if ((blk & 1) == 0) {
#pragma unroll
                for (int t = 0; t < 16; ++t) *(bf16_t*)(Tm + (16 * blk + t) * PB + (16 * (blk + 1) + j) * 2) = 0;
            } else { *(u32x4*)(Dm + (16 * blk + j) * PB + (16 * (blk - 1)) * 2) = (u32x4){0u, 0u, 0u, 0u}; *(u32x4*)(Dm + (16 * blk + j) * PB + (16 * (blk - 1) + 8) * 2) = (u32x4){0u, 0u, 0u, 0u}; }
            RK_FENCE();
            const int m16 = lane & 15, kg = lane >> 4; const bf16x8 z8 = {0, 0, 0, 0, 0, 0, 0, 0};
#pragma unroll
            for (int pp = 0; pp < 2; ++pp) { const int o = 32 * pp;
                bf16x8 a = z8, bb = z8;
                if (kg < 2) { a = *(const bf16x8*)(L + O_AAB + (o + 16 + m16) * PB + (o + 8 * kg) * 2); bb = *(const bf16x8*)(Dm + (o + m16) * PB + (o + 8 * kg) * 2); }
                f32x4 pq = __builtin_amdgcn_mfma_f32_16x16x32_bf16(a, bb, (f32x4){0.f, 0.f, 0.f, 0.f}, 0, 0, 0);
                { u32x2 wv; wv.x = pk2(pq[0], pq[1]); wv.y = pk2(pq[2], pq[3]); *(u32x2*)(L + O_PT + (o + m16) * PB + (o + 16 + 4 * kg) * 2) = wv; } }
            RK_FENCE();
#pragma unroll
            for (int pp = 0; pp < 2; ++pp) { const int o = 32 * pp;
                bf16x8 a = z8, bb = z8;
                if (kg < 2) { a = *(const bf16x8*)(Tm + (o + 16 + m16) * PB + (o + 16 + 8 * kg) * 2); bb = *(const bf16x8*)(L + O_PT + (o + m16) * PB + (o + 16 + 8 * kg) * 2); }
                f32x4 tq = __builtin_amdgcn_mfma_f32_16x16x32_bf16(a, bb, (f32x4){0.f, 0.f, 0.f, 0.f}, 0, 0, 0);
#pragma unroll
                for (int e = 0; e < 4; ++e) *(bf16_t*)(Tm + (o + 16 + 4 * kg + e) * PB + (o + m16) * 2) = f2bf(tq[e]);
                { u32x2 wv; wv.x = pk2(tq[0], tq[1]); wv.y = pk2(tq[2], tq[3]); *(u32x2*)(Dm + (o + m16) * PB + (o + 16 + 4 * kg) * 2) = wv; } }
            RK_FENCE();
            { f32x16 q = {}; mm32<2>(q, L + O_AAB, 32, Dm, 0, 0, r32, hi); st_T(q, L + O_PT, 0, 32, r32, hi); }
            RK_FENCE();
            { f32x16 tc = {}; mm32<2>(tc, Tm, 32, L + O_PT, 0, 32, r32, hi);
#pragma unroll
              for (int r = 0; r < 16; ++r) *(bf16_t*)(Tm + (32 + crow(r, hi)) * PB + r32 * 2) = f2bf(tc[r]); }
        }
        __syncthreads();
        if (w < 4) {
            RK_LANE(); f32x16 u = {};
            if (mt) mm32<4>(u, L + O_T, mt, L + O_G1T, nv, 0, r32, hi); else mm32<2>(u, L + O_T, mt, L + O_G1T, nv, 0, r32, hi);
            st_T(u, L + O_UT, nv, mt, r32, hi);
        } else if (w == 7) {
            RK_LANE(); mm32<4>(yacc, L + O_RT, mt, L + O_SB, nv, 0, r32, hi);
            mm32<4>(yacc, L + O_ARK, mt, L + O_VT, nv, 0, r32, hi);
        }
        __syncthreads();
        if (w < 4) {
            RK_LANE(); mm32<4>(sacc, L + O_BHT, mt, L + O_UT, nv, 0, r32, hi);
            st_T(sacc, L + O_SB, nv, mt, r32, hi);
        } else {
            RK_LANE(); if (mt) mm32<4>(yacc, L + O_ARB, mt, L + O_UT, nv, 0, r32, hi); else mm32<2>(yacc, L + O_ARB, mt, L + O_UT, nv, 0, r32, hi);
#pragma unroll
            for (int r = 0; r < 16; ++r) { const int s_ = c * 64 + mt + crow(r, hi); const int t_ = dir ? (SEQ - 1 - s_) : s_;
                wkv[((size_t)b * SEQ + t_) * 512 + nv + r32] = f2bf(yacc[r]); }
        }
        __syncthreads();
    }
#undef RK_LOAD
#undef RK_LANE
}
}

namespace sd {
using rk::f32x16; using rk::crow;
constexpr int PW = 272, PN = 144;
constexpr int O_CM = 0, O_BM = 64 * PW, O_HB = 2 * 64 * PW, O_BDT = 3 * 64 * PW, O_XDT = O_BDT + 128 * PN, O_XM = O_XDT + 64 * PN, O_MM = O_XM + 64 * PN, O_DTS = O_MM + 64 * PN, O_ACU = O_DTS + 256, O_END = O_ACU + 256;
template <int NKS, int PA, int PBB> __device__ __forceinline__ void mmx(f32x16& acc, const char* A, int m0, const char* B, int n0, int k0, int r32, int hi) {
#pragma unroll
    for (int ks = 0; ks < NKS; ++ks) {
        const bf16x8 a = *(const bf16x8*)(A + (m0 + r32) * PA + (k0 + ks * 16 + hi * 8) * 2);
        const bf16x8 b = *(const bf16x8*)(B + (n0 + r32) * PBB + (k0 + ks * 16 + hi * 8) * 2);
        acc = __builtin_amdgcn_mfma_f32_32x32x16_bf16(a, b, acc, 0, 0, 0); }
}
template <int PZ> __device__ __forceinline__ void stT(const f32x16& acc, char* Z, int n0, int m0, int r32, int hi) {
#pragma unroll
    for (int g = 0; g < 4; ++g) { u32x2 w; w.x = pk2(acc[4 * g], acc[4 * g + 1]); w.y = pk2(acc[4 * g + 2], acc[4 * g + 3]);
        *(u32x2*)(Z + (n0 + r32) * PZ + (m0 + 8 * g + 4 * hi) * 2) = w; }
}
__device__ __forceinline__ void seq(const Params& p, const int l, const int sid, unsigned char* lds) {
    const int tid = otid(), w = __builtin_amdgcn_readfirstlane(tid >> 6);
    const int h = sid & 7, dir = (sid >> 3) & 1, b = sid >> 4, g = h >> 2;
#define SD_LANE() int tq_ = tid; asm volatile("" : "+v"(tq_)); const int lane = tq_ & 63, r32 = lane & 31, hi = lane >> 5, tok = tq_ >> 3, q8 = tq_ & 7; (void)lane; (void)r32; (void)hi; (void)tok; (void)q8
    char* L = (char*)lds;
    const float Ah = -expf(p.in[7][(l * 2 + dir) * 8 + h]), dtb = p.in[8][(l * 2 + dir) * 8 + h], Dh = (dir == 0) ? p.in[9][l * 8 + h] : 0.f;
    const float* dtbuf = (const float*)(g_scr + SCR_DT) + dir * 8 + h;
    const bf16_t* xact = (const bf16_t*)(g_scr + SCR_XACT);
    bf16_t* yout = (bf16_t*)(g_scr + SCR_SSDY) + (size_t)dir * M_TOK * 512 + h * 64;
    {   SD_LANE(); unsigned zz = 0u; asm volatile("" : "+v"(zz));
        for (int i = tid; i < 64 * PW / 16; i += 512) *(u32x4*)(L + O_HB + i * 16) = (u32x4){zz, zz, zz, zz}; }
    f32x16 hacc = {};
    bf16x8 rc[2], rb[2], rx; float dtr = 0.f;
#define SD_LOAD(c) do { SD_LANE(); const int s_ = (c) * 64 + tok; const int t_ = dir ? (SEQ - 1 - s_) : s_; const bf16_t* row_ = xact + ((size_t)b * SEQ + t_) * 1024; \
        rc[0] = *(const bf16x8*)(row_ + 768 + g * 128 + q8 * 16); rc[1] = *(const bf16x8*)(row_ + 768 + g * 128 + q8 * 16 + 8); \
        rb[0] = *(const bf16x8*)(row_ + 512 + g * 128 + q8 * 16); rb[1] = *(const bf16x8*)(row_ + 512 + g * 128 + q8 * 16 + 8); \
        rx = *(const bf16x8*)(row_ + h * 64 + q8 * 8); \
        if (w == 0) { const int s2_ = (c) * 64 + lane; const int t2_ = dir ? (SEQ - 1 - s2_) : s2_; dtr = dtbuf[((size_t)b * SEQ + t2_) * 16]; } } while (0)
    SD_LOAD(0);
    __syncthreads();
    const int mt = (w & 2) ? 32 : 0, nv = (w & 1) ? 32 : 0;
#pragma unroll 1
    for (int c = 0; c < SEQ / 64; ++c) {
        if (w == 0) { SD_LANE(); const float dt = softplusf(dtr + dtb); float ac = dt * Ah;
#pragma unroll
            for (int o = 1; o < 64; o <<= 1) { const float v = __shfl_up(ac, o); if (lane >= o) ac += v; }
            ((float*)(L + O_DTS))[lane] = dt; ((float*)(L + O_ACU))[lane] = ac; }
        __syncthreads();
        {   SD_LANE(); const float dt = ((const float*)(L + O_DTS))[tok]; const float ac = ((const float*)(L + O_ACU))[tok], ae = ((const float*)(L + O_ACU))[63];
            const float dend = __expf(ae - ac);
            *(bf16x8*)(L + O_CM + tok * PW + q8 * 32) = rc[0]; *(bf16x8*)(L + O_CM + tok * PW + q8 * 32 + 16) = rc[1];
            *(bf16x8*)(L + O_BM + tok * PW + q8 * 32) = rb[0]; *(bf16x8*)(L + O_BM + tok * PW + q8 * 32 + 16) = rb[1];
            *(bf16x8*)(L + O_XM + tok * PN + q8 * 16) = rx;
#pragma unroll
            for (int e = 0; e < 8; ++e) { *(bf16_t*)(L + O_BDT + (q8 * 16 + e) * PN + tok * 2) = f2bf(bf2f((bf16_t)rb[0][e]) * dend); *(bf16_t*)(L + O_BDT + (q8 * 16 + 8 + e) * PN + tok * 2) = f2bf(bf2f((bf16_t)rb[1][e]) * dend);
                *(bf16_t*)(L + O_XDT + (q8 * 8 + e) * PN + tok * 2) = f2bf(bf2f((bf16_t)rx[e]) * dt); } }
        __syncthreads();
        if (c + 1 < SEQ / 64) SD_LOAD(c + 1);
        f32x16 yoff = {};
        const int ml = ((w - 3) & 2) ? 32 : 0, np = ((w - 3) & 1) ? 32 : 0;
        if (w < 3) { SD_LANE(); const int ms = (w == 2) ? 32 : 0, nl = (w >= 1) ? 32 : 0;
            f32x16 gq = {}; mmx<8, PW, PW>(gq, L + O_BM, ms, L + O_CM, nl, 0, r32, hi);
            const float* ACU = (const float*)(L + O_ACU); const int lq = nl + r32; const float al = ACU[lq];
#pragma unroll
            for (int r = 0; r < 16; ++r) { const int s = ms + crow(r, hi); gq[r] = (s <= lq) ? gq[r] * __expf(al - ACU[s]) : 0.f; }
            stT<PN>(gq, L + O_MM, nl, ms, r32, hi);
        } else if (w < 7) { SD_LANE(); mmx<8, PW, PW>(yoff, L + O_CM, ml, L + O_HB, np, 0, r32, hi); }
        {   SD_LANE(); const float eend = __expf(((const float*)(L + O_ACU))[63]);
#pragma unroll
            for (int r = 0; r < 16; ++r) hacc[r] *= eend;
            mmx<4, PN, PN>(hacc, L + O_BDT, (w >> 1) * 32, L + O_XDT, nv, 0, r32, hi); }
        __syncthreads();
        {   SD_LANE(); stT<PW>(hacc, L + O_HB, nv, (w >> 1) * 32, r32, hi); }
        if (w >= 3 && w < 7) { SD_LANE(); f32x16 yd = {};
            if (ml) mmx<4, PN, PN>(yd, L + O_MM, ml, L + O_XDT, np, 0, r32, hi); else mmx<2, PN, PN>(yd, L + O_MM, ml, L + O_XDT, np, 0, r32, hi);
            const float* ACU = (const float*)(L + O_ACU);
#pragma unroll
            for (int r = 0; r < 16; ++r) { const int lq = ml + crow(r, hi); const int s_ = c * 64 + lq; const int t_ = dir ? (SEQ - 1 - s_) : s_;
                const float x = bf2f(*(const bf16_t*)(L + O_XM + lq * PN + (np + r32) * 2));
                yout[((size_t)b * SEQ + t_) * 512 + np + r32] = f2bf(yd[r] + __expf(ACU[lq]) * yoff[r] + Dh * x); } }
        __syncthreads();
    }
#undef SD_LOAD
#undef SD_LANE
}
}

__device__ __forceinline__ void ssd_naive_seq(const Params& p, const int l, int sid, float* lds) {
    const int tid = otid(); const int h = sid & 7, dir = (sid >> 3) & 1, b = sid >> 4; const int g = h >> 2;
    float* xs = lds; float* Bs = lds + 2048; float* Cs = Bs + 4096; float* dts = Cs + 4096; float* das = dts + 32;
    const float* cw = p.in[5] + (size_t)l * 5 * 1024; const float* cb = p.in[6] + (size_t)l * 1024;
    const float A = -expf(p.in[7][(l * 2 + dir) * 8 + h]); const float dtb = p.in[8][(l * 2 + dir) * 8 + h]; const float Dh = p.in[9][l * 8 + h];
    const float* dtbuf = (const float*)(g_scr + SCR_DT);
    bf16_t* yout = (bf16_t*)(g_scr + SCR_SSDY) + (size_t)dir * M_TOK * 512 + h * 64;
    const int pp = tid >> 3, q = tid & 7;
    float hs[16];
#pragma unroll
    for (int n = 0; n < 16; ++n) hs[n] = 0.f;
    for (int s0 = 0; s0 < SEQ; s0 += 32) {
        __syncthreads();
        for (int idx = tid; idx < 32 * 320; idx += 512) {
            const int si = idx / 320, c = idx % 320; const int s = s0 + si; const int t = dir ? (SEQ - 1 - s) : s;
            int cch; const bf16_t* src;
            if (c < 64) { cch = h * 64 + c; src = pblk(p.ws, PB_XS + (h >> 1)) + (h & 1) * 64 + c; }
            else if (c < 192) { cch = 512 + g * 128 + (c - 64); src = pblk(p.ws, PB_BM + g) + (c - 64); }
            else { cch = 768 + g * 128 + (c - 192); src = pblk(p.ws, PB_CM + g) + (c - 192); }
            float acc = cb[cch];
#pragma unroll
            for (int jj = 0; jj < 5; ++jj) { const int tt = t + jj - 2; if (tt >= 0 && tt < SEQ) acc += cw[jj * 1024 + cch] * bf2f(src[((size_t)b * SEQ + tt) * 128]); }
            const float v = siluf(acc);
            if (c < 64) xs[si * 64 + c] = v; else if (c < 192) Bs[si * 128 + (c - 64)] = v; else Cs[si * 128 + (c - 192)] = v;
        }
        if (tid < 32) { const int s = s0 + tid; const int t = dir ? (SEQ - 1 - s) : s; const float dt = softplusf(dtbuf[((size_t)b * SEQ + t) * 16 + dir * 8 + h] + dtb); dts[tid] = dt; das[tid] = expf(dt * A); }
        __syncthreads();
        for (int si = 0; si < 32; ++si) {
            const int s = s0 + si; const int t = dir ? (SEQ - 1 - s) : s;
            const float x = xs[si * 64 + pp], dt = dts[si], da = das[si]; const float xdt = x * dt;
            float y = 0.f;
#pragma unroll
            for (int n4 = 0; n4 < 4; ++n4) { const f32x4 b4 = *(const f32x4*)(Bs + si * 128 + q * 16 + n4 * 4), c4 = *(const f32x4*)(Cs + si * 128 + q * 16 + n4 * 4);
#pragma unroll
                for (int e = 0; e < 4; ++e) { const float hn = hs[n4 * 4 + e] * da + xdt * b4[e]; hs[n4 * 4 + e] = hn; y += hn * c4[e]; } }
            y += __shfl_xor(y, 1); y += __shfl_xor(y, 2); y += __shfl_xor(y, 4);
            if (dir == 0) y += Dh * x;
            if (q == 0) yout[((size_t)b * SEQ + t) * 512 + pp] = f2bf(y);
        }
    }
}

__device__ __forceinline__ void phase_combine(const Params& p, const int l) {
    const int G = gridDim.x, tid = otid(), lane = tid & 63, wave = tid >> 6;
    const bf16_t* wkv = (const bf16_t*)(g_scr + SCR_WKV); const bf16_t* bon = (const bf16_t*)(g_scr + SCR_BON); const bf16_t* sy = (const bf16_t*)(g_scr + SCR_SSDY);
    const float* lnw = p.in[19] + l * 512; const float* lnb = p.in[20] + l * 512; const float* snw = p.in[10] + l * 512;
    for (int m = blockIdx.x * 8 + wave; m < M_TOK; m += G * 8) {
#pragma unroll
        for (int h = 0; h < 8; ++h) { const size_t o = (size_t)m * 512 + h * 64 + lane; const size_t o2 = o + (size_t)M_TOK * 512;
            const float w = bf2f(wkv[o]) + bf2f(wkv[o2]);
            const float mean = wave_sum(w) * (1.f / 64.f); const float d = w - mean; const float var = wave_sum(d * d) * (1.f / 64.f);
            const float gn = d * rsqrtf(var + 64e-5f) * lnw[h * 64 + lane] + lnb[h * 64 + lane];
            const float y = gn + bf2f(bon[o]) + bf2f(bon[o2]);
            bf16_t* gp = pblk(p.ws, PB_RG + (h >> 1)) + (size_t)m * 128 + (h & 1) * 64 + lane;
            *gp = f2bf(y * siluf(bf2f(*gp))); }
#pragma unroll
        for (int g = 0; g < 2; ++g) { float yg[4]; float ss = 0.f;
#pragma unroll
            for (int hh = 0; hh < 4; ++hh) { const int h = g * 4 + hh; const size_t o = (size_t)m * 512 + h * 64 + lane;
                const float y = bf2f(sy[o]) + bf2f(sy[o + (size_t)M_TOK * 512]);
                const float z = bf2f(pblk(p.ws, PB_Z + (h >> 1))[(size_t)m * 128 + (h & 1) * 64 + lane]);
                yg[hh] = y * siluf(z); ss += yg[hh] * yg[hh]; }
            ss = wave_sum(ss); const float rs = rsqrtf(ss * (1.f / 256.f) + NORM_EPS);
#pragma unroll
            for (int hh = 0; hh < 4; ++hh) { const int h = g * 4 + hh; pblk(p.ws, PB_Z + (h >> 1))[(size_t)m * 128 + (h & 1) * 64 + lane] = f2bf(yg[hh] * rs * snw[h * 64 + lane]); } }
    }
}

__device__ __forceinline__ void phase_post(const Params& p, const int l) {
    const int G = gridDim.x, tid = otid(), lane = tid & 63, wave = tid >> 6;
    const float* mix = (const float*)(p.ws + WS_MIX); const float* xin = l == 0 ? p.in[0] : p.out; const float* pw = p.in[2] + l * DMODEL;
    for (int m = blockIdx.x * 8 + wave; m < M_TOK; m += G * 8) {
        const f32x4* mr = (const f32x4*)(mix + (size_t)m * DMODEL) + lane; const f32x4* xr = (const f32x4*)(xin + (size_t)m * DMODEL) + lane; const f32x4* wr = (const f32x4*)pw + lane;
        f32x4 v[4]; float s = 0.f;
#pragma unroll
        for (int j = 0; j < 4; ++j) { v[j] = mr[64 * j]; s += (v[j].x * v[j].x + v[j].y * v[j].y) + (v[j].z * v[j].z + v[j].w * v[j].w); }
        const float rs = rsqrtf(wave_sum(s) * (1.f / DMODEL) + NORM_EPS);
        float s2 = 0.f;
#pragma unroll
        for (int j = 0; j < 4; ++j) { v[j] = xr[64 * j] + v[j] * rs * wr[64 * j]; s2 += (v[j].x * v[j].x + v[j].y * v[j].y) + (v[j].z * v[j].z + v[j].w * v[j].w); }
        s2 = wave_sum(s2);
        f32x4* orow = (f32x4*)(p.out + (size_t)m * DMODEL) + lane;
#pragma unroll
        for (int j = 0; j < 4; ++j) orow[64 * j] = v[j];
        if (lane == 0) ((float*)(g_scr + SCR_RS))[m] = rsqrtf(s2 * (1.f / DMODEL) + NORM_EPS);
        u32x2* o8 = (u32x2*)((bf16_t*)(g_scr + SCR_XB) + (size_t)m * DMODEL) + lane;
#pragma unroll
        for (int j = 0; j < 4; ++j) { u32x2 w; w.x = pk2(v[j].x, v[j].y); w.y = pk2(v[j].z, v[j].w); o8[64 * j] = w; }
    }
}

constexpr int LDS_BYTES = 155648;
static_assert(rk::O_END <= LDS_BYTES, "rwkv LDS map");
__device__ __forceinline__ void phase_gemm_in(const Params& p, const int l, unsigned char* lds) {
    pg8::Gemm g{(const bf16_t*)(g_scr + SCR_XB), (const bf16_t*)(g_scr + SCR_WIN + (size_t)l * 15 * MiB), M_TOK, NPROJ, DMODEL, DMODEL, 128};
    pg8::StaticOrder S; S.init(M_TOK, NPROJ, gridDim.x, blockIdx.x);
    pg8::EpiProj E{(bf16_t*)p.ws, (const float*)(g_scr + SCR_RS), (float*)(g_scr + SCR_DT)};
    pg8::gemm_phase<pg8::EpiProj, pg8::StaticOrder, true, true>((PG8_LAS unsigned char*)lds, g, S, E);
}
__device__ __forceinline__ void phase_gemm_out(const Params& p, const int l, unsigned char* lds) {
    pg8::Gemm g{(const bf16_t*)p.ws, (const bf16_t*)(g_scr + SCR_WOUT + (size_t)l * 4 * MiB), M_TOK, DMODEL, DMIX, 128, PBLK_ELEMS};
    pg8::StaticOrder S; S.init(M_TOK, DMODEL, gridDim.x, blockIdx.x);
    pg8::EpiMix E{(float*)(p.ws + WS_MIX)};
    pg8::gemm_phase<pg8::EpiMix, pg8::StaticOrder, true, true>((PG8_LAS unsigned char*)lds, g, S, E);
}
__device__ __forceinline__ void phase_mixers(const Params& p, const int l, unsigned char* lds) {
    const int bid = blockIdx.x, G = gridDim.x;
    if (bid < 32) rk::seq(p, l, bid, lds);
    else if (bid < 64) sd::seq(p, l, bid - 32, lds);
    else { for (int u = bid - 64; u < 768; u += G - 64) { if (u < 256) gqa_unit(p, l, u, (char*)lds); else diff_unit(p, l, u - 256, (char*)lds); } }
}
__global__ void __launch_bounds__(512) mega(const Params p) {
    extern __shared__ __attribute__((aligned(16))) unsigned char lds[];
    cg::grid_group grid = cg::this_grid();
    phase_prologue(p, (float*)lds); grid.sync();
#pragma unroll 1
    for (int l = 0; l < 2; ++l) {
        phase_gemm_in(p, l, lds); grid.sync();
        phase_prep(p, l); grid.sync();
        phase_mixers(p, l, lds); grid.sync();
        phase_combine(p, l); grid.sync();
        phase_gemm_out(p, l, lds); grid.sync();
        phase_post(p, l); if (l == 0) grid.sync();
    }
}

extern "C" void kernel_launch(void* const* d_in, const int* in_sizes, int n_in, void* d_out, int out_size, void* d_ws, size_t ws_size, hipStream_t stream) {
    static int grid_blocks = 0;
    if (!grid_blocks) {
        int dev = 0, cus = 0, per_cu = 0;
        (void)hipGetDevice(&dev);
        (void)hipDeviceGetAttribute(&cus, hipDeviceAttributeMultiprocessorCount, dev);
        (void)hipFuncSetAttribute((const void*)mega, hipFuncAttributeMaxDynamicSharedMemorySize, LDS_BYTES);
        (void)hipOccupancyMaxActiveBlocksPerMultiprocessor(&per_cu, (const void*)mega, 512, LDS_BYTES);
        if (per_cu < 1) { fprintf(stderr, "kernel_launch: occupancy query says %d blocks/CU\n", per_cu); per_cu = 1; }
        grid_blocks = cus;
    }
    Params p{};
    for (int i = 0; i < 25; ++i) p.in[i] = (const float*)d_in[i];
    p.out = (float*)d_out; p.ws = (unsigned char*)d_ws;
    void* args[] = {&p};
    hipError_t e = hipLaunchCooperativeKernel((const void*)mega, dim3(grid_blocks), dim3(512), args, LDS_BYTES, stream);
    if (e != hipSuccess) fprintf(stderr, "cooperative launch failed: %s (grid %d)\n", hipGetErrorString(e), grid_blocks);
}
```

```cpp
#include <hip/hip_runtime.h>
#include <hip/hip_bf16.h>
#include <hip/hip_cooperative_groups.h>
#include <cstdio>
#include <cstdint>
namespace cg = cooperative_groups;

constexpr int M_TOK = 16384, SEQ = 8192, DMODEL = 1024, NPROJ = 7424, NPB = 58, DIN_ORIG = 7312, DMIX = 2048;
constexpr float NORM_EPS = 1e-6f;
constexpr size_t MiB = 1u << 20;
constexpr int PB_Z = 0, PB_RG = 4, PB_DQ = 8, PB_GQ = 12, PB_XS = 16, PB_BM = 20, PB_CM = 22, PB_R = 24, PB_K = 28, PB_V = 32, PB_WA = 36,
              PB_DK = 37, PB_DV = 41, PB_DG = 45, PB_GK = 49, PB_GV = 51, PB_GG = 53, PB_DT = 57;
constexpr size_t PBLK_ELEMS = (size_t)M_TOK * 128;
constexpr size_t SCR_WIN = 0, SCR_WOUT = 30 * MiB, SCR_ROPE = 38 * MiB, SCR_DT = 40 * MiB, SCR_RS = 41 * MiB, SCR_CTL = 41 * MiB + 512 * 1024,
                 SCR_BAR = 41 * MiB + 768 * 1024, SCR_XB = 42 * MiB, SCR_WKV = 74 * MiB, SCR_BON = 106 * MiB, SCR_SSDY = 138 * MiB, SCR_XACT = 170 * MiB, SCR_NN2 = 202 * MiB, SCR_SPL = 210 * MiB, SCR_BYTES = 228 * MiB;
constexpr size_t SCR_KPART = 41 * MiB + 64 * 1024;
constexpr size_t WS_MM = 16 * PBLK_ELEMS * 2;
constexpr size_t WS_NN = 58 * PBLK_ELEMS * 2;
constexpr size_t WS_MIX = 16 * PBLK_ELEMS * 2;
__device__ __attribute__((aligned(256))) unsigned char g_scr[SCR_BYTES];

typedef unsigned short bf16_t;
typedef short bf16x8 __attribute__((ext_vector_type(8)));
typedef float f32x4 __attribute__((ext_vector_type(4)));
typedef unsigned u32x4 __attribute__((ext_vector_type(4)));
typedef unsigned u32x2 __attribute__((ext_vector_type(2)));

struct Params {
    const float* in[25];
    float* out;
    unsigned char* ws;
};

__device__ __forceinline__ int otid() { int t = threadIdx.x; asm volatile("" : "+v"(t)); return t; }
__device__ __forceinline__ float bf2f(bf16_t v) { return __uint_as_float(((unsigned)v) << 16); }
typedef float f32x2_t __attribute__((ext_vector_type(2))); typedef __bf16 bf16x2_t __attribute__((ext_vector_type(2)));
__device__ __forceinline__ unsigned pk2(float lo, float hi) { f32x2_t v = {lo, hi}; bf16x2_t b = __builtin_convertvector(v, bf16x2_t); return __builtin_bit_cast(unsigned, b); }
__device__ __forceinline__ bf16_t f2bf(float f) { return (bf16_t)(pk2(f, 0.f) & 0xffffu); }
__device__ __forceinline__ float wave_sum(float v) {
#pragma unroll
    for (int o = 1; o < 64; o <<= 1) v += __shfl_xor(v, o);
    return v;
}
__device__ __forceinline__ float siluf(float x) { return x / (1.f + __expf(-x)); }
__device__ __forceinline__ float softplusf(float x) { return fmaxf(x, 0.f) + log1pf(__expf(-fabsf(x))); }
__device__ __forceinline__ bf16_t* pblk(unsigned char* ws, int j) { return (bf16_t*)ws + (size_t)j * PBLK_ELEMS; }

namespace pg8 {
#define PG8_LAS __attribute__((address_space(3)))
constexpr int BM = 256, BK = 64, HALF = 128, HTB = HALF * BK * 2, STAGE_BYTES = 8 * HTB, NXCD = 8, WGM = 8;
__host__ __device__ __forceinline__ int lds_byte(int r, int c) { const int st = (r >> 4) * 2 + (c >> 5), rr = r & 15, cc = c & 31, ob = rr * 64 + cc * 2; return st * 1024 + (ob ^ (((ob >> 9) & 1) << 5)); }
__host__ __device__ __forceinline__ void stage_rc(int b, int& R, int& C) { const int st = b / 1024, sb = b % 1024, swz = sb ^ (((sb >> 9) & 1) << 5); R = (st >> 1) * 16 + swz / 64; C = (st & 1) * 32 + (swz % 64) / 2; }
__host__ __device__ __forceinline__ int perm32(int rho) { const int n = rho >> 4, i = rho & 15; return 8 * (i >> 2) + 4 * n + (i & 3); }
struct Unit { int pm, pn; };
struct Gemm { const bf16_t* A; const bf16_t* Bt; int M, N, K; int lda; size_t abig; };
struct StaticOrder {
    int nM, nN, nwg, G, c;
    __host__ __device__ void init(int M, int N, int G_, int c_) { nM = M / BM; nN = N / BM; nwg = nM * nN; G = G_; c = c_; }
    __host__ __device__ bool next(int i, Unit& u) const {
        const long L = (long)i * G + c; if (L >= nwg) return false;
        int wgid = (int)L; { const int q = nwg / NXCD, r = nwg % NXCD, xcd = wgid % NXCD, off = wgid / NXCD; wgid = (xcd < r ? xcd * (q + 1) : r * (q + 1) + (xcd - r) * q) + off; }
        const int nig = WGM * nN, gid = wgid / nig, fm = gid * WGM, gsz = (nM - fm) < WGM ? (nM - fm) : WGM;
        u.pm = fm + ((wgid % nig) % gsz); u.pn = (wgid % nig) / gsz; return true;
    }
};
template <class Epi, class Sched, bool ALIGN_EPI = false, bool SP2 = false>
__device__ __forceinline__ void gemm_phase(PG8_LAS unsigned char* lds, const Gemm g, const Sched& S, const Epi& E) {
    const int tid = otid(), wid = __builtin_amdgcn_readfirstlane(tid >> 6), lane = tid & 63, wr = wid >> 2, wc = wid & 3, fr = lane & 15, fq = lane >> 4;
    const int K = g.K, nt = K / BK;
    unsigned voffA[2], voffB[2];
#pragma unroll
    for (int i = 0; i < 2; ++i) { int R, C; stage_rc(tid * 16 + i * 8192, R, C); const int Rb = Epi::PERM ? ((R & ~31) + perm32(R & 31)) : R;
        voffA[i] = (unsigned)(R * g.lda + C) * 2u; voffB[i] = (unsigned)(Rb * K + C) * 2u; }
    const size_t kstep = (size_t)(BK * 2);
    const size_t abig = g.abig * 2;
    const size_t hstepA = (size_t)HALF * g.lda * 2, hstepB = (size_t)HALF * K * 2;
    const size_t tstepA = 2 * hstepA, tstepB = 2 * hstepB;
    const unsigned ldsw = (unsigned)wid * 1024u;
    const int aoff = lds_byte(wr * 64 + fr, fq * 8), boff = lds_byte(wc * 32 + fr, fq * 8);
#define PG8_SA(b, h) (((b) * 2 + (h)) * HTB)
#define PG8_SB(b, h) ((4 + (b) * 2 + (h)) * HTB)
#define PG8_STAGE(bufoff, gbase, voff) do { _Pragma("unroll") for (int _i = 0; _i < 2; ++_i) \
        __builtin_amdgcn_global_load_lds((const unsigned*)((const char*)(gbase) + (voff)[_i]), (PG8_LAS unsigned*)(lds + (bufoff) + ldsw + _i * 8192), 16, 0, 0); } while (0)
#define PG8_LDA(dst, b, h) do { _Pragma("unroll") for (int m = 0; m < 4; ++m) _Pragma("unroll") for (int k = 0; k < 2; ++k) dst[m][k] = *(const PG8_LAS bf16x8*)(lds + PG8_SA(b, h) + aoff + m * 2048 + k * 1024); } while (0)
#define PG8_LDB(dst, b, h) do { _Pragma("unroll") for (int n = 0; n < 2; ++n) _Pragma("unroll") for (int k = 0; k < 2; ++k) dst[n][k] = *(const PG8_LAS bf16x8*)(lds + PG8_SB(b, h) + boff + n * 2048 + k * 1024); } while (0)
#define PG8_MMA(ai, bj, At, Bt) do { __builtin_amdgcn_s_setprio(1); _Pragma("unroll") for (int m = 0; m < 4; ++m) _Pragma("unroll") for (int n = 0; n < 2; ++n) _Pragma("unroll") for (int k = 0; k < 2; ++k) \
        acc[ai][bj][m][n] = __builtin_amdgcn_mfma_f32_16x16x32_bf16(Bt[n][k], At[m][k], acc[ai][bj][m][n], 0, 0, 0); __builtin_amdgcn_s_setprio(0); } while (0)
#define PG8_WAIT_V(n) asm volatile("s_waitcnt vmcnt(" #n ")" ::: "memory")
#define PG8_WAIT_L(n) asm volatile("s_waitcnt lgkmcnt(" #n ")" ::: "memory")
#define PG8_BAR __builtin_amdgcn_s_barrier()
#define PG8_SCHED __builtin_amdgcn_sched_barrier(0)
    Unit cur, nxt; int ui = 0;
    if (!S.next(0, cur)) return;
    f32x4 acc[2][2][4][2];
#pragma unroll
    for (int a = 0; a < 2; ++a)
#pragma unroll
        for (int b = 0; b < 2; ++b)
#pragma unroll
            for (int m = 0; m < 4; ++m)
#pragma unroll
                for (int n = 0; n < 2; ++n) acc[a][b][m][n] = (f32x4){0.f, 0.f, 0.f, 0.f};
    bf16x8 At[4][2], B0[2][2], B1[2][2];
    const char* cA = (const char*)g.A + (size_t)cur.pm * tstepA; const char* cB = (const char*)g.Bt + (size_t)cur.pn * tstepB;
    if constexpr (SP2) {
        PG8_STAGE(PG8_SB(0, 0), cB, voffB); PG8_STAGE(PG8_SB(0, 1), cB + hstepB, voffB); PG8_STAGE(PG8_SA(0, 0), cA, voffA); PG8_STAGE(PG8_SA(0, 1), cA + hstepA, voffA);
        if (wr == 1) PG8_BAR;
        PG8_WAIT_V(2); PG8_BAR;
        PG8_STAGE(PG8_SB(1, 0), cB + kstep, voffB); PG8_STAGE(PG8_SA(1, 0), cA + kstep, voffA); PG8_STAGE(PG8_SB(1, 1), cB + hstepB + kstep, voffB);
        PG8_WAIT_V(6); PG8_BAR;
    } else {
        PG8_STAGE(PG8_SB(0, 0), cB, voffB); PG8_STAGE(PG8_SA(0, 0), cA, voffA); PG8_STAGE(PG8_SB(0, 1), cB + hstepB, voffB); PG8_STAGE(PG8_SA(0, 1), cA + hstepA, voffA);
        if (wr == 1) PG8_BAR;
        PG8_WAIT_V(4); PG8_BAR;
        PG8_STAGE(PG8_SB(1, 0), cB + kstep, voffB); PG8_STAGE(PG8_SA(1, 0), cA + kstep, voffA); PG8_STAGE(PG8_SB(1, 1), cB + hstepB + kstep, voffB);
        PG8_WAIT_V(6); PG8_BAR;
    }
    for (;;) {
        const bool has_next = S.next(ui + 1, nxt);
        const char* nA = has_next ? (const char*)g.A + (size_t)nxt.pm * tstepA : cA; const char* nB = has_next ? (const char*)g.Bt + (size_t)nxt.pn * tstepB : cB;
        for (int t = 0; t < nt; t += 2) {
            const bool last = (t == nt - 2);
            const char* a1 = cA + (size_t)(t >> 1) * abig + kstep;
            const char* a2 = last ? nA : cA + (size_t)((t >> 1) + 1) * abig; const char* b2 = last ? nB : cB + (size_t)(t + 2) * kstep;
            const char* a3 = a2 + kstep; const char* b3 = b2 + kstep;
            if constexpr (SP2) {
            PG8_LDB(B0, 0, 0); PG8_LDB(B1, 0, 1); PG8_SCHED; PG8_LDA(At, 0, 0); PG8_STAGE(PG8_SA(1, 1), a1 + hstepA, voffA);
            PG8_WAIT_V(8); PG8_WAIT_L(0); PG8_BAR; PG8_MMA(0, 0, At, B0); PG8_MMA(0, 1, At, B1); PG8_BAR; PG8_SCHED;
            PG8_LDA(At, 0, 1); PG8_STAGE(PG8_SB(0, 0), b2, voffB); PG8_STAGE(PG8_SB(0, 1), b2 + hstepB, voffB); PG8_STAGE(PG8_SA(0, 0), a2, voffA);
            PG8_WAIT_V(8); PG8_WAIT_L(0); PG8_BAR; PG8_MMA(1, 0, At, B0); PG8_MMA(1, 1, At, B1); PG8_BAR; PG8_SCHED;
            PG8_LDB(B0, 1, 0); PG8_LDB(B1, 1, 1); PG8_SCHED; PG8_LDA(At, 1, 0); PG8_STAGE(PG8_SA(0, 1), a2 + hstepA, voffA);
            PG8_WAIT_V(8); PG8_WAIT_L(0); PG8_BAR; PG8_MMA(0, 0, At, B0); PG8_MMA(0, 1, At, B1); PG8_BAR; PG8_SCHED;
            PG8_LDA(At, 1, 1); PG8_STAGE(PG8_SB(1, 0), b3, voffB); PG8_STAGE(PG8_SB(1, 1), b3 + hstepB, voffB); PG8_STAGE(PG8_SA(1, 0), a3, voffA);
            PG8_WAIT_V(8); PG8_WAIT_L(0); PG8_BAR; PG8_MMA(1, 0, At, B0); PG8_MMA(1, 1, At, B1); PG8_BAR; PG8_SCHED;
            } else {
            PG8_LDB(B0, 0, 0); PG8_SCHED; PG8_LDA(At, 0, 0); PG8_STAGE(PG8_SA(1, 1), a1 + hstepA, voffA);
            PG8_WAIT_L(8); PG8_BAR; PG8_WAIT_L(0); PG8_MMA(0, 0, At, B0); PG8_BAR; PG8_SCHED;
            PG8_LDB(B1, 0, 1); PG8_STAGE(PG8_SB(0, 0), b2, voffB);
            PG8_BAR; PG8_WAIT_L(0); PG8_MMA(0, 1, At, B1); PG8_BAR;
            PG8_LDA(At, 0, 1); PG8_STAGE(PG8_SA(0, 0), a2, voffA);
            PG8_BAR; PG8_WAIT_L(0); PG8_MMA(1, 0, At, B0); PG8_BAR; PG8_SCHED;
            PG8_STAGE(PG8_SB(0, 1), b2 + hstepB, voffB);
            PG8_WAIT_V(6); PG8_BAR; PG8_MMA(1, 1, At, B1); PG8_BAR;
            PG8_LDB(B0, 1, 0); PG8_SCHED; PG8_LDA(At, 1, 0); PG8_STAGE(PG8_SA(0, 1), a2 + hstepA, voffA);
            PG8_WAIT_L(8); PG8_BAR; PG8_WAIT_L(0); PG8_MMA(0, 0, At, B0); PG8_BAR; PG8_SCHED;
            PG8_LDB(B1, 1, 1); PG8_STAGE(PG8_SB(1, 0), b3, voffB);
            PG8_BAR; PG8_WAIT_L(0); PG8_MMA(0, 1, At, B1); PG8_BAR;
            PG8_LDA(At, 1, 1); PG8_STAGE(PG8_SA(1, 0), a3, voffA);
            PG8_BAR; PG8_WAIT_L(0); PG8_MMA(1, 0, At, B0); PG8_BAR; PG8_SCHED;
            PG8_STAGE(PG8_SB(1, 1), b3 + hstepB, voffB);
            PG8_WAIT_V(6); PG8_BAR; PG8_MMA(1, 1, At, B1); PG8_BAR;
            }
        }
        if constexpr (ALIGN_EPI) { if (wr == 0) PG8_BAR; }
        E(acc, cur, wr, wc, fr, fq);
        if (!has_next) break;
#pragma unroll
        for (int a = 0; a < 2; ++a)
#pragma unroll
            for (int b = 0; b < 2; ++b)
#pragma unroll
                for (int m = 0; m < 4; ++m)
#pragma unroll
                    for (int n = 0; n < 2; ++n) acc[a][b][m][n] = (f32x4){0.f, 0.f, 0.f, 0.f};
        cur = nxt; cA = nA; cB = nB; ++ui;
        if constexpr (ALIGN_EPI) { if (wr == 1) PG8_BAR; }
    }
    PG8_WAIT_V(0);
    if constexpr (!ALIGN_EPI) { if (wr == 0) PG8_BAR; }
    PG8_BAR;
#undef PG8_SA
#undef PG8_SB
#undef PG8_STAGE
#undef PG8_LDA
#undef PG8_LDB
#undef PG8_MMA
#undef PG8_WAIT_V
#undef PG8_WAIT_L
#undef PG8_BAR
#undef PG8_SCHED
}
struct EpiProj {
    static constexpr bool PERM = true;
    bf16_t* P; const float* rowscale; float* dtbuf;
    __device__ __forceinline__ void operator()(const f32x4 (&acc)[2][2][4][2], const Unit& u, int wr, int wc, int fr, int fq) const {
        const int row0 = u.pm * BM + wr * 64 + fr; const int col = wc * 32 + 8 * fq;
#pragma unroll
        for (int ai = 0; ai < 2; ++ai)
#pragma unroll
            for (int m = 0; m < 4; ++m) { const int row = row0 + ai * HALF + m * 16; const float sc = rowscale[row];
#pragma unroll
                for (int bj = 0; bj < 2; ++bj) { const int blk = u.pn * 2 + bj;
                    const f32x4 v0 = acc[ai][bj][m][0] * sc, v1 = acc[ai][bj][m][1] * sc;
                    u32x4 w; w.x = pk2(v0[0], v0[1]); w.y = pk2(v0[2], v0[3]); w.z = pk2(v1[0], v1[1]); w.w = pk2(v1[2], v1[3]);
                    *(u32x4*)(P + (size_t)blk * PBLK_ELEMS + (size_t)row * 128 + col) = w;
                    if (blk == PB_DT && col < 16) { float* d = dtbuf + (size_t)row * 16 + col; *(f32x4*)d = v0; *(f32x4*)(d + 4) = v1; } } }
    }
};
struct EpiMix {
    static constexpr bool PERM = true;
    float* O;
    __device__ __forceinline__ void operator()(const f32x4 (&acc)[2][2][4][2], const Unit& u, int wr, int wc, int fr, int fq) const {
        const int row0 = u.pm * BM + wr * 64 + fr; const int col0 = u.pn * BM + wc * 32 + 8 * fq;
#pragma unroll
        for (int ai = 0; ai < 2; ++ai)
#pragma unroll
            for (int m = 0; m < 4; ++m) { float* rp = O + (size_t)(row0 + ai * HALF + m * 16) * DMODEL + col0;
#pragma unroll
                for (int bj = 0; bj < 2; ++bj) { *(f32x4*)(rp + bj * HALF) = acc[ai][bj][m][0]; *(f32x4*)(rp + bj * HALF + 4) = acc[ai][bj][m][1]; } }
    }
};
}

__device__ __forceinline__ int orig_col(int n) {
    if (n < 512) return n;
    if (n < 1024) return 3216 + (n - 512);
    if (n < 1536) return 3728 + (n - 1024);
    if (n < 2048) return 5776 + (n - 1536);
    if (n < 3072) return 512 + (n - 2048);
    if (n < 4736) return 1552 + (n - 3072);
    if (n < 5248) return 4240 + (n - 4736);
    if (n < 5760) return 4752 + (n - 5248);
    if (n < 6272) return 5264 + (n - 5760);
    if (n < 6528) return 6288 + (n - 6272);
    if (n < 6784) return 6544 + (n - 6528);
    if (n < 7296) return 6800 + (n - 6784);
    if (n < 7312) return 1536 + (n - 7296);
    return -1;
}
struct TrItem { const float* W; const float* ks; bf16_t* WT; int K, Nsrc, k0, n0; bool mapcol; };
__device__ __forceinline__ TrItem tr_item(const Params& p, int it) {
    constexpr int I_IN = 16 * 29, I_OUT = 32 * 4;
    TrItem t; int r = it; const int l = r / (I_IN + I_OUT); r -= l * (I_IN + I_OUT);
    if (r < I_IN) { t.W = p.in[3] + (size_t)l * DMODEL * DIN_ORIG; t.ks = p.in[1] + l * DMODEL; t.WT = (bf16_t*)(g_scr + SCR_WIN + (size_t)l * 15 * MiB); t.K = DMODEL; t.Nsrc = DIN_ORIG; t.k0 = (r / 29) * 64; t.n0 = (r % 29) * 256; t.mapcol = true; }
    else { r -= I_IN; t.W = p.in[4] + (size_t)l * DMIX * DMODEL; t.ks = nullptr; t.WT = (bf16_t*)(g_scr + SCR_WOUT + (size_t)l * 4 * MiB); t.K = DMIX; t.Nsrc = DMODEL; t.k0 = (r / 4) * 64; t.n0 = (r % 4) * 256; t.mapcol = false; }
    return t;
}
__device__ __forceinline__ void tr_load(const TrItem& t, int tid, float* v) {
    const int nn = tid & 63;
#pragma unroll
    for (int q = 0; q < 4; ++q) { const int n = t.n0 + 64 * q + nn; const int oc = t.mapcol ? orig_col(n) : n;
#pragma unroll
        for (int i = 0; i < 8; ++i) { const int kk = (tid >> 6) + 8 * i; v[q * 8 + i] = (oc >= 0) ? t.W[(size_t)(t.k0 + kk) * t.Nsrc + oc] * (t.ks ? t.ks[t.k0 + kk] : 1.f) : 0.f; } }
}
__device__ __forceinline__ void rope_entry(int idx, float* tab) {
    const int pos = idx >> 5, i = idx & 31;
    const float inv = exp2f(-(float)i * (13.287712379549449f / 32.f));
    const float ang = (float)pos * inv;
    const double rev = (double)ang * 0.15915494309189535; const double fr = rev - floor(rev);
    const float a = (float)(fr * 6.283185307179586);
    tab[idx * 2] = cosf(a); tab[idx * 2 + 1] = sinf(a);
}
__device__ __forceinline__ void xrow_to_bf16(const float* xrow, bf16_t* orow, float* rs, int lane) {
    const f32x4* xr = (const f32x4*)xrow + lane; f32x4 v[4]; float s = 0.f;
#pragma unroll
    for (int j = 0; j < 4; ++j) { v[j] = xr[64 * j]; s += (v[j].x * v[j].x + v[j].y * v[j].y) + (v[j].z * v[j].z + v[j].w * v[j].w); }
    s = wave_sum(s);
    if (lane == 0) *rs = rsqrtf(s * (1.f / DMODEL) + NORM_EPS);
    u32x2* o8 = (u32x2*)orow + lane;
#pragma unroll
    for (int j = 0; j < 4; ++j) { u32x2 w; w.x = pk2(v[j].x, v[j].y); w.y = pk2(v[j].z, v[j].w); o8[64 * j] = w; }
}
__device__ __forceinline__ void phase_prologue(const Params& p, float* lds_f) {
    const int G = gridDim.x, bid = blockIdx.x, tid = otid(), lane = tid & 63, wave = tid >> 6;
    {   constexpr int NIT = 2 * (16 * 29 + 32 * 4);
        float v[32], v2[32]; int it = bid; TrItem cur = tr_item(p, it < NIT ? it : 0);
        if (it < NIT) tr_load(cur, tid, v);
        while (it < NIT) {
            const int nn = tid & 63;
#pragma unroll
            for (int q = 0; q < 4; ++q)
#pragma unroll
                for (int i = 0; i < 8; ++i) lds_f[q * 4160 + ((tid >> 6) + 8 * i) * 65 + nn] = v[q * 8 + i];
            const int nx = it + G; TrItem nxt = tr_item(p, nx < NIT ? nx : 0);
            if (nx < NIT) tr_load(nxt, tid, v2);
            __syncthreads();
#pragma unroll
            for (int q = 0; q < 4; ++q) { const int n = tid >> 3, c = tid & 7; const float* s = lds_f + q * 4160 + (8 * c) * 65 + n;
                u32x4 o; o.x = pk2(s[0], s[65]); o.y = pk2(s[2 * 65], s[3 * 65]); o.z = pk2(s[4 * 65], s[5 * 65]); o.w = pk2(s[6 * 65], s[7 * 65]);
                *(u32x4*)(cur.WT + (size_t)(cur.n0 + 64 * q + n) * cur.K + cur.k0 + 8 * c) = o; }
            __syncthreads();
#pragma unroll
            for (int i = 0; i < 32; ++i) v[i] = v2[i];
            cur = nxt; it = nx;
        }
    }
    if (bid == 0) { ((unsigned*)(g_scr + SCR_CTL))[tid] = 0u; ((unsigned*)(g_scr + SCR_CTL))[512 + tid] = 0u; }
    for (int i = bid * 512 + tid; i < SEQ * 32; i += G * 512) rope_entry(i, (float*)(g_scr + SCR_ROPE));
    for (int m = bid * 8 + wave; m < M_TOK; m += G * 8) xrow_to_bf16(p.in[0] + (size_t)m * DMODEL, (bf16_t*)(g_scr + SCR_XB) + (size_t)m * DMODEL, (float*)(g_scr + SCR_RS) + m, lane);
}

__device__ __forceinline__ void unpack8(const bf16x8 v, float* x) {
#pragma unroll
    for (int e = 0; e < 8; ++e) x[e] = bf2f((bf16_t)v[e]);
}
__device__ __forceinline__ u32x4 pack8(const float* x) { u32x4 o; o.x = pk2(x[0], x[1]); o.y = pk2(x[2], x[3]); o.z = pk2(x[4], x[5]); o.w = pk2(x[6], x[7]); return o; }
__device__ __forceinline__ void rope8(float* x, const float* cs, const bool upper) {
#pragma unroll
    for (int e = 0; e < 8; ++e) { const float o = __shfl_xor(x[e], 4); x[e] = upper ? (x[e] * cs[2 * e] + o * cs[2 * e + 1]) : (x[e] * cs[2 * e] - o * cs[2 * e + 1]); }
}
__device__ __forceinline__ void phase_prep(const Params& p, const int l) {
    const int G = gridDim.x;
    {   const int tid = otid(), lane = tid & 63, wave = tid >> 6;
        bf16x8 cv[5], nv_[5];
#define CONV_LOAD(dst, it_) do { const int m_ = (it_) >> 1, t_ = m_ & (SEQ - 1); const int ch_ = ((it_) & 1) * 512 + lane * 8; const bf16_t* src_ = pblk(p.ws, PB_XS + (ch_ >> 7)) + (ch_ & 127); \
            _Pragma("unroll") for (int jj = 0; jj < 5; ++jj) { const int tt = t_ + jj - 2; const bool ok = tt >= 0 && tt < SEQ; dst[jj] = ok ? *(const bf16x8*)(src_ + ((size_t)(m_ - t_ + tt)) * 128) : (bf16x8){0, 0, 0, 0, 0, 0, 0, 0}; } } while (0)
        int it = blockIdx.x * 8 + wave;
        if (it < M_TOK * 2) CONV_LOAD(cv, it);
        for (; it < M_TOK * 2; it += G * 8) {
            const int m = it >> 1, half = it & 1;
            const int ch = half * 512 + lane * 8;
            const float* cw = p.in[5] + (size_t)l * 5 * 1024 + ch; const float* cb = p.in[6] + (size_t)l * 1024 + ch;
            if (it + G * 8 < M_TOK * 2) CONV_LOAD(nv_, it + G * 8);
            float acc[8]; { const f32x4 b0 = *(const f32x4*)cb, b1 = *(const f32x4*)(cb + 4);
#pragma unroll
              for (int e = 0; e < 4; ++e) { acc[e] = b0[e]; acc[4 + e] = b1[e]; } }
#pragma unroll
            for (int jj = 0; jj < 5; ++jj) { const f32x4 w0 = *(const f32x4*)(cw + jj * 1024), w1 = *(const f32x4*)(cw + jj * 1024 + 4);
#pragma unroll
                for (int e = 0; e < 4; ++e) { acc[e] += w0[e] * bf2f((bf16_t)cv[jj][e]); acc[4 + e] += w1[e] * bf2f((bf16_t)cv[jj][4 + e]); } }
#pragma unroll
            for (int e = 0; e < 8; ++e) acc[e] = siluf(acc[e]);
            *(u32x4*)((bf16_t*)(g_scr + SCR_XACT) + (size_t)m * 1024 + ch) = pack8(acc);
#pragma unroll
            for (int jj = 0; jj < 5; ++jj) cv[jj] = nv_[jj];
        }
#undef CONV_LOAD
    }
    const int tid = otid(), lane = tid & 63, wave = tid >> 6;
    const float* tab = (const float*)(g_scr + SCR_ROPE);
    const int hh = lane >> 4, c16 = lane & 15, j8 = (c16 & 7) * 8, fi = j8 & 31; const bool upper = j8 >= 32, second = c16 >= 8;
    float kw[8];
#pragma unroll
    for (int e = 0; e < 8; ++e) kw[e] = p.in[24][l * 128 + c16 * 8 + e];
    float* kpart = (float*)(g_scr + SCR_KPART); const int gwv = blockIdx.x * 8 + wave;
    float mxd = 0.f, mxg = 0.f; int curb = (blockIdx.x * 8 + wave) >> 13;
    bf16x8 vdk, vgk, ndk, ngk; float cst[16], csa[16], nst[16], nsa[16];
#define QK_LOAD(m_, dk_, gk_, st_, sa_) do { const int t_ = (m_) & (SEQ - 1); const int row_ = t_ >> 6, col_ = t_ & 63; \
        dk_ = *(const bf16x8*)(pblk(p.ws, PB_DK + hh) + (size_t)(m_) * 128 + c16 * 8); gk_ = *(const bf16x8*)(pblk(p.ws, PB_GK + (hh & 1)) + (size_t)(m_) * 128 + c16 * 8); \
        const f32x4* a_ = (const f32x4*)(tab + ((size_t)t_ * 32 + fi) * 2); const f32x4* b_ = (const f32x4*)(tab + ((size_t)(second ? col_ : row_) * 32 + fi) * 2); \
        _Pragma("unroll") for (int i_ = 0; i_ < 4; ++i_) { const f32x4 u_ = a_[i_], v_ = b_[i_]; _Pragma("unroll") for (int e_ = 0; e_ < 4; ++e_) { st_[4 * i_ + e_] = u_[e_]; sa_[4 * i_ + e_] = v_[e_]; } } } while (0)
    {   const int m0 = blockIdx.x * 8 + wave; if (m0 < M_TOK) QK_LOAD(m0, vdk, vgk, cst, csa); }
    for (int m = blockIdx.x * 8 + wave; m < M_TOK; m += G * 8) {
        if ((m >> 13) != curb) {
            if ((lane & 7) == 0) { kpart[((size_t)(l * 2 + curb) * 10 + hh * 2 + (c16 >> 3)) * 2048 + gwv] = mxd; if (lane < 32 && c16 == 0) kpart[((size_t)(l * 2 + curb) * 10 + 8 + hh) * 2048 + gwv] = mxg; }
            mxd = 0.f; mxg = 0.f; curb = m >> 13; }
        bf16_t* pdk = pblk(p.ws, PB_DK + hh) + (size_t)m * 128 + c16 * 8; bf16_t* pgk = pblk(p.ws, PB_GK + (hh & 1)) + (size_t)m * 128 + c16 * 8;
        if (m + G * 8 < M_TOK) QK_LOAD(m + G * 8, ndk, ngk, nst, nsa);
        float x[8];
        unpack8(vdk, x);
        { float s2 = 0.f;
#pragma unroll
          for (int e = 0; e < 8; ++e) s2 += x[e] * x[e];
          s2 += __shfl_xor(s2, 1); s2 += __shfl_xor(s2, 2); s2 += __shfl_xor(s2, 4); mxd = fmaxf(mxd, s2); }
        rope8(x, cst, upper); const u32x4 odk = pack8(x);
        float ss;
        unpack8(vgk, x); ss = 0.f;
#pragma unroll
        for (int e = 0; e < 8; ++e) ss += x[e] * x[e];
        ss += __shfl_xor(ss, 1); ss += __shfl_xor(ss, 2); ss += __shfl_xor(ss, 4); ss += __shfl_xor(ss, 8);
        { const float rs = rsqrtf(ss * (1.f / 128.f) + NORM_EPS);
#pragma unroll
          for (int e = 0; e < 8; ++e) x[e] *= rs * kw[e]; }
        { float s2 = 0.f;
#pragma unroll
          for (int e = 0; e < 8; ++e) s2 += x[e] * x[e];
          s2 += __shfl_xor(s2, 1); s2 += __shfl_xor(s2, 2); s2 += __shfl_xor(s2, 4); s2 += __shfl_xor(s2, 8); mxg = fmaxf(mxg, s2); }
        rope8(x, csa, upper); const u32x4 ogk = pack8(x);
        *(u32x4*)pdk = odk; if (lane < 32) *(u32x4*)pgk = ogk;
        vdk = ndk; vgk = ngk;
#pragma unroll
        for (int e = 0; e < 16; ++e) { cst[e] = nst[e]; csa[e] = nsa[e]; }
    }
#undef QK_LOAD
    if ((lane & 7) == 0) { kpart[((size_t)(l * 2 + curb) * 10 + hh * 2 + (c16 >> 3)) * 2048 + gwv] = mxd; if (lane < 32 && c16 == 0) kpart[((size_t)(l * 2 + curb) * 10 + 8 + hh) * 2048 + gwv] = mxg; }
}

__device__ __forceinline__ void kmax_reduce(const int l, float* lds_f) {
    if (blockIdx.x < 20) {
        const int b = blockIdx.x / 10, slot = blockIdx.x % 10, tid = threadIdx.x;
        const float* src = (const float*)(g_scr + SCR_KPART) + ((size_t)(l * 2 + b) * 10 + slot) * 2048;
        float v = fmaxf(fmaxf(src[tid], src[512 + tid]), fmaxf(src[1024 + tid], src[1536 + tid]));
#pragma unroll
        for (int o = 1; o < 64; o <<= 1) v = fmaxf(v, __shfl_xor(v, o));
        if ((tid & 63) == 0) lds_f[tid >> 6] = v;
        __syncthreads();
        if (tid == 0) { float m = lds_f[0];
#pragma unroll
            for (int i = 1; i < 8; ++i) m = fmaxf(m, lds_f[i]);
            ((float*)(g_scr + SCR_CTL))[256 + 64 * l + (slot < 8 ? b * 8 + slot : 16 + b * 2 + (slot - 8))] = m; }
        __syncthreads();
    }
}

namespace att {
using s16x4 = __attribute__((ext_vector_type(4))) short;
using f32x16 = __attribute__((ext_vector_type(16))) float;
constexpr int D = 128, NW = 8, QBLK = 32, KVBLK = 64, LD = 128;
constexpr float THR = 8.f;
constexpr size_t SHM_V = KVBLK * D * 2, SHM_K = KVBLK * D * 2, SHM_ATTN = 2 * SHM_V + 2 * SHM_K + NW * 64 * 4;
#define KSWZ(row, colB) ((row) * 256 + ((colB) ^ (((row) & 7) << 4)))
#define SBAR() __builtin_amdgcn_sched_barrier(0)
__device__ __forceinline__ int crow(int r, int hi) { return (r & 3) + 8 * (r >> 2) + 4 * hi; }
__device__ __forceinline__ unsigned cvtpk(float lo, float hi) { unsigned r; asm volatile("v_cvt_pk_bf16_f32 %0, %1, %2" : "=v"(r) : "v"(lo), "v"(hi)); return r; }
__device__ __forceinline__ void glds16(const void* gsrc, unsigned lds_dst) { unsigned keep;
  asm volatile("s_mov_b32 %0, m0\n\ts_mov_b32 m0, %2\n\ts_nop 0\n\tglobal_load_lds_dwordx4 %1, off\n\ts_mov_b32 m0, %0" : "=&s"(keep) : "v"(gsrc), "s"(lds_dst) : "memory"); }
template <int DIFF>
__device__ __forceinline__ void partialSM(f32x16& p0, f32x16& p1, const float mnC) {
  constexpr float SCALE = DIFF ? 0.125f : 0.088388347648318440f;
  constexpr float C = SCALE * 1.4426950408889634f;
  _Pragma("unroll") for (int r = 0; r < 16; ++r) p0[r] = fmaf(p0[r], C, mnC); _Pragma("unroll") for (int r = 0; r < 16; ++r) p1[r] = fmaf(p1[r], C, mnC);
  _Pragma("unroll") for (int r = 0; r < 16; ++r) p0[r] = __builtin_amdgcn_exp2f(p0[r]);
}
__device__ __forceinline__ void finishSM(f32x16& p0, f32x16& p1, float& l_reg, bf16x8& pa0, bf16x8& pa1, bf16x8& pa2, bf16x8& pa3) {
  _Pragma("unroll") for (int r = 0; r < 16; ++r) p1[r] = __builtin_amdgcn_exp2f(p1[r]);
  float ps = 0; _Pragma("unroll") for (int r = 0; r < 16; ++r) ps += p0[r]; _Pragma("unroll") for (int r = 0; r < 16; ++r) ps += p1[r];
  { auto rr = __builtin_amdgcn_permlane32_swap(__float_as_uint(ps), __float_as_uint(ps), false, false);
    ps = __uint_as_float(rr[0]) + __uint_as_float(rr[1]); }
  l_reg += ps;
#define PK4(P, BASE, OUT) do { unsigned a0 = cvtpk(P[BASE + 0], P[BASE + 1]), a1 = cvtpk(P[BASE + 2], P[BASE + 3]);   \
    unsigned b0 = cvtpk(P[BASE + 4], P[BASE + 5]), b1 = cvtpk(P[BASE + 6], P[BASE + 7]);                              \
    auto r0 = __builtin_amdgcn_permlane32_swap(a0, b0, false, false); auto r1 = __builtin_amdgcn_permlane32_swap(a1, b1, false, false); \
    u32x4 w = {r0[0], r1[0], r0[1], r1[1]}; OUT = *reinterpret_cast<bf16x8*>(&w); } while (0)
  PK4(p0, 0, pa0); PK4(p0, 8, pa1); PK4(p1, 0, pa2); PK4(p1, 8, pa3);
#undef PK4
}
template <int ND0>
__device__ __forceinline__ void qkt(f32x16& p0, f32x16& p1, const bf16_t* Ks, const bf16x8* qr, int r32, int hi, int db0) {
  p0 = f32x16{}; p1 = f32x16{};
  _Pragma("unroll") for (int d0 = 0; d0 < ND0; ++d0) { int cb = ((db0 + d0) * 16 + hi * 8) * 2;
    bf16x8 b0 = *reinterpret_cast<const bf16x8*>((const char*)Ks + KSWZ(r32, cb));
    bf16x8 b1 = *reinterpret_cast<const bf16x8*>((const char*)Ks + KSWZ(32 + r32, cb));
    p0 = __builtin_amdgcn_mfma_f32_32x32x16_bf16(b0, qr[d0], p0, 0, 0, 0);
    p1 = __builtin_amdgcn_mfma_f32_32x32x16_bf16(b1, qr[d0], p1, 0, 0, 0); }
}
__device__ __forceinline__ int v_st(int k, int c) { const int kk = (k & ~0xC) | ((k & 4) << 1) | ((k & 8) >> 1); return ((kk >> 3) * 4 + (c >> 5)) * 512 + ((kk & 7) * 32 + (c & 31)) * 2; }
__device__ __forceinline__ int v_rd_base(int lane) { return ((lane & 3) << 3) | (((lane >> 2) & 3) << 6) | (((lane >> 4) & 1) << 5) | (((lane >> 5) & 1) << 8); }
constexpr int v_rd_off(int d0, int ks, int half) { return d0 * 512 + ks * 4096 + half * 2048; }
template <int OFF> __device__ __forceinline__ s16x4 tr_read(int vb) {
  s16x4 r; asm volatile("ds_read_b64_tr_b16 %0, %1 offset:%2" : "=&v"(r) : "v"(vb), "i"(OFF) : "memory"); return r;
}
template <int D0> __device__ __forceinline__ void pv_one(f32x16& od, int vb, bf16x8 pa0, bf16x8 pa1, bf16x8 pa2, bf16x8 pa3) {
  const s16x4 l0 = tr_read<v_rd_off(D0, 0, 0)>(vb), h0 = tr_read<v_rd_off(D0, 0, 1)>(vb), l1 = tr_read<v_rd_off(D0, 1, 0)>(vb), h1 = tr_read<v_rd_off(D0, 1, 1)>(vb);
  const s16x4 l2 = tr_read<v_rd_off(D0, 2, 0)>(vb), h2 = tr_read<v_rd_off(D0, 2, 1)>(vb), l3 = tr_read<v_rd_off(D0, 3, 0)>(vb), h3 = tr_read<v_rd_off(D0, 3, 1)>(vb);
  asm volatile("s_waitcnt lgkmcnt(0)" ::: "memory"); SBAR();
#define PK(L, H) (bf16x8){L[0], L[1], L[2], L[3], H[0], H[1], H[2], H[3]}
  od = __builtin_amdgcn_mfma_f32_32x32x16_bf16(pa0, PK(l0, h0), od, 0, 0, 0);
  od = __builtin_amdgcn_mfma_f32_32x32x16_bf16(pa1, PK(l1, h1), od, 0, 0, 0);
  od = __builtin_amdgcn_mfma_f32_32x32x16_bf16(pa2, PK(l2, h2), od, 0, 0, 0);
  od = __builtin_amdgcn_mfma_f32_32x32x16_bf16(pa3, PK(l3, h3), od, 0, 0, 0);
#undef PK
}
__device__ __forceinline__ void pv_d0(f32x16* o, int vb, bf16x8 pa0, bf16x8 pa1, bf16x8 pa2, bf16x8 pa3) {
  pv_one<0>(o[0], vb, pa0, pa1, pa2, pa3); pv_one<1>(o[1], vb, pa0, pa1, pa2, pa3); pv_one<2>(o[2], vb, pa0, pa1, pa2, pa3); pv_one<3>(o[3], vb, pa0, pa1, pa2, pa3);
}
template <int DIFF>
__device__ __forceinline__ void attn_unit(const bf16_t* Qb, const bf16_t* __restrict__ Kh, const bf16_t* __restrict__ Vh, bf16_t* Ob, const bf16_t* gate,
                                          int seq, char* lds, const float* lamp, int layer, const float* nw, const float* kmax2p, const int tpos0, const float* qnw, unsigned* splc = nullptr, float* splp = nullptr) {
  constexpr int ND0 = DIFF ? 4 : 8;
  const int tid = otid(), wid = tid >> 6, lane = tid & 63, r32 = lane & 31, hi = lane >> 5;
  const int wq = DIFF ? (wid & 3) : wid, mapc = DIFF ? (wid >> 2) : 0;
  constexpr int RSTG = 32768, RK = 16384, E_ST = 67584, E_WS = 137216;
  float* li_l = (float*)(lds + E_WS) + wid * 64;
  float l_reg = 0; f32x16 o[4] = {}; bf16x8 qr[ND0];
  const bf16_t* Qw = Qb + (long)(wq * QBLK + r32) * LD + mapc * 64 + hi * 8;
  {
      const float* tab = (const float*)(g_scr + SCR_ROPE);
      const int trow = tpos0 + wq * QBLK + r32;
      float qf[ND0][8];
      _Pragma("unroll") for (int d0 = 0; d0 < ND0; ++d0) { const bf16x8 raw = *reinterpret_cast<const bf16x8*>(Qw + d0 * 16); _Pragma("unroll") for (int e = 0; e < 8; ++e) qf[d0][e] = bf2f((bf16_t)raw[e]); }
      if constexpr (!DIFF) {
        float ss = 0.f;
        _Pragma("unroll") for (int d0 = 0; d0 < ND0; ++d0) _Pragma("unroll") for (int e = 0; e < 8; ++e) ss += qf[d0][e] * qf[d0][e];
        { auto rr = __builtin_amdgcn_permlane32_swap(__float_as_uint(ss), __float_as_uint(ss), false, false); ss = __uint_as_float(rr[0]) + __uint_as_float(rr[1]); }
        const float rs = rsqrtf(ss * (1.f / 128.f) + NORM_EPS);
        _Pragma("unroll") for (int d0 = 0; d0 < ND0; ++d0) { const f32x4 w0 = *(const f32x4*)(qnw + d0 * 16 + hi * 8), w1 = *(const f32x4*)(qnw + d0 * 16 + hi * 8 + 4);
          _Pragma("unroll") for (int e = 0; e < 4; ++e) { qf[d0][e] *= rs * w0[e]; qf[d0][4 + e] *= rs * w1[e]; } }
      }
      _Pragma("unroll") for (int hb = 0; hb < ND0 / 4; ++hb) {
        const int pos = DIFF ? trow : (hb == 0 ? (trow >> 6) : (trow & 63));
        _Pragma("unroll") for (int dl = 0; dl < 2; ++dl) { const int d0 = hb * 4 + dl; const float* cp = tab + ((size_t)pos * 32 + dl * 16 + hi * 8) * 2; float cs[16];
          _Pragma("unroll") for (int i = 0; i < 4; ++i) { const f32x4 u_ = ((const f32x4*)cp)[i]; _Pragma("unroll") for (int e = 0; e < 4; ++e) cs[4 * i + e] = u_[e]; }
          _Pragma("unroll") for (int e = 0; e < 8; ++e) { const float x1 = qf[d0][e], x2 = qf[d0 + 2][e]; qf[d0][e] = x1 * cs[2 * e] - x2 * cs[2 * e + 1]; qf[d0 + 2][e] = x2 * cs[2 * e] + x1 * cs[2 * e + 1]; } } }
      _Pragma("unroll") for (int d0 = 0; d0 < ND0; ++d0) { u32x4 w_; w_.x = pk2(qf[d0][0], qf[d0][1]); w_.y = pk2(qf[d0][2], qf[d0][3]); w_.z = pk2(qf[d0][4], qf[d0][5]); w_.w = pk2(qf[d0][6], qf[d0][7]); qr[d0] = *reinterpret_cast<bf16x8*>(&w_); }
  }
  float mnC;
  { float qn2 = 0.f;
    _Pragma("unroll") for (int d0 = 0; d0 < ND0; ++d0) _Pragma("unroll") for (int e = 0; e < 8; ++e) { const float q = bf2f((bf16_t)qr[d0][e]); qn2 += q * q; }
    { auto rr = __builtin_amdgcn_permlane32_swap(__float_as_uint(qn2), __float_as_uint(qn2), false, false); qn2 = __uint_as_float(rr[0]) + __uint_as_float(rr[1]); }
    const float km2 = kmax2p[DIFF ? mapc : 0];
    mnC = -(sqrtf(qn2 * km2) * 1.02f + 1e-3f) * ((DIFF ? 0.125f : 0.088388347648318440f) * 1.4426950408889634f); }
  unsigned ksrc[2], vsrc[2];
  _Pragma("unroll") for (int i = 0; i < 2; ++i) { const int pc = 2 * wid + i;
    { const int row = 4 * pc + (lane >> 4); ksrc[i] = (unsigned)(row * 256 + (((lane & 15) ^ (row & 7)) << 4)); }
    { const int st = 2 * pc + (lane >> 5), l5 = lane & 31, kk = (st >> 2) * 8 + (l5 >> 2), k = (kk & ~0xC) | ((kk & 4) << 1) | ((kk & 8) >> 1); vsrc[i] = (unsigned)(k * 256 + ((st & 3) * 32 + (l5 & 3) * 8) * 2); } }
  const unsigned ldsb = (unsigned)(uintptr_t)lds + (unsigned)__builtin_amdgcn_readfirstlane(wid) * 2048u;
  const int vb0 = (int)(uintptr_t)lds + v_rd_base(lane);
#define DMA(k0, so) do { const char* kt_ = (const char*)Kh + (size_t)(k0) * 256; const char* vt_ = (const char*)Vh + (size_t)(k0) * 256; const unsigned d_ = ldsb + (unsigned)(so); \
    glds16(vt_ + vsrc[0], (unsigned)__builtin_amdgcn_readfirstlane(d_)); glds16(vt_ + vsrc[1], (unsigned)__builtin_amdgcn_readfirstlane(d_ + 1024u)); \
    glds16(kt_ + ksrc[0], (unsigned)__builtin_amdgcn_readfirstlane(d_ + (unsigned)RK)); glds16(kt_ + ksrc[1], (unsigned)__builtin_amdgcn_readfirstlane(d_ + (unsigned)RK + 1024u)); } while (0)
#define DWAIT() asm volatile("s_waitcnt vmcnt(0)" ::: "memory")
  f32x16 pA0, pA1, pB0, pB1; bf16x8 pa0, pa1, pa2, pa3; int NT = seq / KVBLK; asm volatile("" : "+s"(NT));
  int oP = 0, oC = 0, oN = RSTG;
#define ROT() do { const int t_ = oP; oP = oC; oC = oN; oN = (oN == 2 * RSTG) ? 0 : oN + RSTG; (void)t_; } while (0)
  DMA(0, 0); DMA(KVBLK, RSTG); asm volatile("s_waitcnt vmcnt(4)" ::: "memory"); __syncthreads();
  qkt<ND0>(pA0, pA1, (const bf16_t*)(lds + RK), qr, r32, hi, mapc * 4); partialSM<DIFF>(pA0, pA1, mnC);
  DWAIT(); __syncthreads();
  oP = 0; oC = RSTG; oN = 2 * RSTG;
  _Pragma("unroll 1") for (int j = 1; j + 1 < NT; j += 2) {
    DMA((j + 1) * KVBLK, oN);
    SBAR(); qkt<ND0>(pB0, pB1, (const bf16_t*)(lds + RK + oC), qr, r32, hi, mapc * 4);
    finishSM(pA0, pA1, l_reg, pa0, pa1, pa2, pa3); SBAR();
    pv_d0(o, vb0 + oP, pa0, pa1, pa2, pa3); partialSM<DIFF>(pB0, pB1, mnC);
    DWAIT(); __syncthreads(); ROT();
    DMA((j + 2) * KVBLK, oN);
    SBAR(); qkt<ND0>(pA0, pA1, (const bf16_t*)(lds + RK + oC), qr, r32, hi, mapc * 4);
    finishSM(pB0, pB1, l_reg, pa0, pa1, pa2, pa3); SBAR();
    pv_d0(o, vb0 + oP, pa0, pa1, pa2, pa3); partialSM<DIFF>(pA0, pA1, mnC);
    DWAIT(); __syncthreads(); ROT();
  }
  SBAR(); qkt<ND0>(pB0, pB1, (const bf16_t*)(lds + RK + oC), qr, r32, hi, mapc * 4);
  finishSM(pA0, pA1, l_reg, pa0, pa1, pa2, pa3); SBAR();
  pv_d0(o, vb0 + oP, pa0, pa1, pa2, pa3); partialSM<DIFF>(pB0, pB1, mnC);
  finishSM(pB0, pB1, l_reg, pa0, pa1, pa2, pa3); SBAR();
  pv_d0(o, vb0 + oC, pa0, pa1, pa2, pa3);
#undef DMA
#undef DWAIT
#undef ROT
  __syncthreads();
  if (splc) {
    unsigned* xs_ = (unsigned*)(lds + 140000);
    if (threadIdx.x == 0) *xs_ = __hip_atomic_fetch_add(splc, 1u, __ATOMIC_RELAXED, __HIP_MEMORY_SCOPE_AGENT);
    __syncthreads();
    const unsigned ord = *xs_;
    float* mine = splp + (size_t)(wid * 65) * 64 + lane;
    if (ord == 0u) {
      _Pragma("unroll") for (int d0 = 0; d0 < 4; ++d0) _Pragma("unroll") for (int r = 0; r < 16; ++r) mine[(d0 * 16 + r) * 64] = o[d0][r];
      mine[64 * 64] = l_reg;
      asm volatile("s_waitcnt vmcnt(0)" ::: "memory"); __syncthreads();
      if (threadIdx.x == 0) { __builtin_amdgcn_fence(__ATOMIC_RELEASE, "agent"); asm volatile("s_waitcnt vmcnt(0)" ::: "memory"); __hip_atomic_store(splc + 1, 1u, __ATOMIC_RELAXED, __HIP_MEMORY_SCOPE_AGENT); }
      __syncthreads();
      return;
    }
    if (threadIdx.x == 0) { unsigned sp = 0; while (__hip_atomic_load(splc + 1, __ATOMIC_RELAXED, __HIP_MEMORY_SCOPE_AGENT) == 0u) { __builtin_amdgcn_s_sleep(4); if (++sp > (1u << 22)) break; } }
    __syncthreads();
    __builtin_amdgcn_fence(__ATOMIC_ACQUIRE, "agent"); asm volatile("s_waitcnt vmcnt(0)" ::: "memory");
    _Pragma("unroll") for (int d0 = 0; d0 < 4; ++d0) _Pragma("unroll") for (int r = 0; r < 16; ++r) o[d0][r] += mine[(d0 * 16 + r) * 64];
    l_reg += mine[64 * 64];
  }
  if (hi == 0) li_l[r32] = l_reg; asm volatile("s_waitcnt lgkmcnt(0)" ::: "memory");
  float rli[16];
  _Pragma("unroll") for (int r = 0; r < 16; ++r) rli[r] = __builtin_amdgcn_rcpf(li_l[crow(r, hi)]);
  int r32e = r32; asm volatile("" : "+v"(r32e));
  char* ST = lds + E_ST + wid * 8704;
  if constexpr (!DIFF) {
    _Pragma("unroll") for (int r = 0; r < 16; ++r) { const int orow = crow(r, hi);
      _Pragma("unroll") for (int d0 = 0; d0 < 4; ++d0) *(bf16_t*)(ST + orow * 272 + (d0 * 32 + r32e) * 2) = f2bf(o[d0][r] * rli[r]); }
  } else {
    const float s1 = wave_sum(lamp[lane] * lamp[64 + lane]), s2 = wave_sum(lamp[128 + lane] * lamp[192 + lane]);
    int ly = layer; asm volatile("" : "+s"(ly));
    const float lambda_init = 0.8f - 0.6f * expf(-0.3f * (float)ly);
    const float lam = expf(s1) - expf(s2) + lambda_init, osc = 1.f - lambda_init;
    float* X = (float*)lds;
    if (mapc == 1) {
      _Pragma("unroll") for (int r = 0; r < 16; ++r) { const int orow = wq * QBLK + crow(r, hi);
        _Pragma("unroll") for (int d0 = 0; d0 < 4; ++d0) X[orow * 128 + d0 * 32 + r32e] = o[d0][r] * rli[r] * lam; }
    }
    __syncthreads();
    if (mapc == 0) {
      float nwv[4];
      _Pragma("unroll") for (int d0 = 0; d0 < 4; ++d0) nwv[d0] = nw[d0 * 32 + r32e] * osc;
      _Pragma("unroll") for (int r = 0; r < 16; ++r) { const int orow = crow(r, hi); float v[4]; float ss = 0.f;
        _Pragma("unroll") for (int d0 = 0; d0 < 4; ++d0) { v[d0] = o[d0][r] * rli[r] - X[(wq * QBLK + orow) * 128 + d0 * 32 + r32e]; ss += v[d0] * v[d0]; }
        ss += __shfl_xor(ss, 1); ss += __shfl_xor(ss, 2); ss += __shfl_xor(ss, 4); ss += __shfl_xor(ss, 8); ss += __shfl_xor(ss, 16);
        const float rs = rsqrtf(ss * (1.f / 128.f) + NORM_EPS);
        _Pragma("unroll") for (int d0 = 0; d0 < 4; ++d0) *(bf16_t*)(ST + orow * 272 + (d0 * 32 + r32e) * 2) = f2bf(v[d0] * rs * nwv[d0]); }
    }
  }
  if (!DIFF || mapc == 0) {
    asm volatile("s_waitcnt lgkmcnt(0)" ::: "memory");
    bf16_t* Ow = Ob + (long)(wq * QBLK) * LD; const bf16_t* Gw = gate + (long)(wq * QBLK) * LD;
    const int er = lane >> 4, ec = (lane & 15) * 8; bf16x8 gv[8];
    _Pragma("unroll") for (int it = 0; it < 8; ++it) gv[it] = *reinterpret_cast<const bf16x8*>(Gw + (long)(it * 4 + er) * LD + ec);
    _Pragma("unroll") for (int it = 0; it < 8; ++it) { const bf16x8 sv = *reinterpret_cast<const bf16x8*>(ST + (it * 4 + er) * 272 + ec * 2); u32x4 ov;
      float f[8]; _Pragma("unroll") for (int e = 0; e < 8; ++e) f[e] = bf2f((bf16_t)sv[e]) * siluf(bf2f((bf16_t)gv[it][e]));
      ov.x = pk2(f[0], f[1]); ov.y = pk2(f[2], f[3]); ov.z = pk2(f[4], f[5]); ov.w = pk2(f[6], f[7]);
      *reinterpret_cast<u32x4*>(Ow + (long)(it * 4 + er) * LD + ec) = ov; }
  }
  __syncthreads();
}
#undef KSWZ
#undef SBAR
}

__device__ __forceinline__ void gqa_unit(const Params& p, const int l, int u, char* lds, int half = -1, int rec = 0) {
    const int qb = u & 31, hq = (u >> 5) & 3, b = u >> 7; const size_t row0 = (size_t)b * SEQ + (size_t)qb * 256, k0 = (size_t)b * SEQ + (half > 0 ? SEQ / 2 : 0);
    bf16_t* Q = pblk(p.ws, PB_GQ + hq) + row0 * 128;
    att::attn_unit<0>(Q, pblk(p.ws, PB_GK + (hq >> 1)) + k0 * 128, pblk(p.ws, PB_GV + (hq >> 1)) + k0 * 128, Q, pblk(p.ws, PB_GG + hq) + row0 * 128, half >= 0 ? SEQ / 2 : SEQ, lds, nullptr, 0, nullptr,
                      (const float*)(g_scr + SCR_CTL) + 256 + 64 * l + 16 + b * 2 + (hq >> 1),
                      qb * 256, p.in[23] + l * 128,
                      half >= 0 ? (unsigned*)(g_scr + SCR_CTL) + 384 + l * 256 + rec * 2 : nullptr, half >= 0 ? (float*)(g_scr + SCR_SPL + (size_t)rec * 133120) : nullptr);
}
__device__ __forceinline__ void diff_unit(const Params& p, const int l, int u, char* lds, int half = -1, int rec = 0) {
    const int qb = u & 63, h = (u >> 6) & 3, b = u >> 8; const size_t row0 = (size_t)b * SEQ + (size_t)qb * 128, k0 = (size_t)b * SEQ + (half > 0 ? SEQ / 2 : 0);
    bf16_t* Q = pblk(p.ws, PB_DQ + h) + row0 * 128;
    att::attn_unit<1>(Q, pblk(p.ws, PB_DK + h) + k0 * 128, pblk(p.ws, PB_DV + h) + k0 * 128, Q, pblk(p.ws, PB_DG + h) + row0 * 128, half >= 0 ? SEQ / 2 : SEQ, lds, p.in[21] + l * 256, l, p.in[22] + l * 128,
                      (const float*)(g_scr + SCR_CTL) + 256 + 64 * l + b * 8 + h * 2,
                      qb * 128, nullptr,
                      half >= 0 ? (unsigned*)(g_scr + SCR_CTL) + 384 + l * 256 + rec * 2 : nullptr, half >= 0 ? (float*)(g_scr + SCR_SPL + (size_t)rec * 133120) : nullptr);
}

#define LDS_BAR() asm volatile("s_waitcnt lgkmcnt(0)\n\ts_barrier" ::: "memory")
namespace rk {
using f32x16 = __attribute__((ext_vector_type(16))) float;
constexpr int PB = 144, MAT = 64 * PB;
constexpr int O_W2T = 0, O_A2T = MAT, O_SB = 2 * MAT, O_GAM = 3 * MAT, O_CONST = O_GAM + 256,
              O_T = O_CONST + 2560, O_TW = O_T, O_G1T = O_T + MAT, O_AD = O_G1T,
              O_R2 = O_G1T + MAT, O_CL = O_R2, O_AA = O_R2 + 16384, O_ABD = O_R2, O_AAB = O_R2 + 4096, O_AAK = O_AAB + MAT, O_ARB = O_AAK + MAT, O_ARK = O_ARB + MAT,
              O_R3 = O_ARK + MAT, O_AT = O_R3, O_RT = O_AT + MAT, O_BT = O_RT + MAT, O_DT = O_BT, O_UT = O_BT, O_KT = O_BT + MAT, O_PT = O_KT,
              O_BHT = O_KT + MAT, O_KHT = O_BHT + MAT, O_VT = O_KHT + MAT, O_END = O_VT + MAT;
__device__ __forceinline__ int crow(int r, int hi) { return (r & 3) + 8 * (r >> 2) + 4 * hi; }
#define RK_FENCE() do { asm volatile("s_waitcnt lgkmcnt(0)" ::: "memory"); __builtin_amdgcn_wave_barrier(); } while (0)
template <int NKS> __device__ __forceinline__ void mm32(f32x16& acc, const char* A, int m0, const char* B, int n0, int k0, int r32, int hi) {
#pragma unroll
    for (int ks = 0; ks < NKS; ++ks) {
        const bf16x8 a = *(const bf16x8*)(A + (m0 + r32) * PB + (k0 + ks * 16 + hi * 8) * 2);
        const bf16x8 b = *(const bf16x8*)(B + (n0 + r32) * PB + (k0 + ks * 16 + hi * 8) * 2);
        acc = __builtin_amdgcn_mfma_f32_32x32x16_bf16(a, b, acc, 0, 0, 0); }
}
template <int NKS, bool SA, bool SB> __device__ __forceinline__ void mm32s(f32x16& acc, const char* A, int m0, const char* B, int n0, int r32, int hi) {
    const int ra = m0 + r32, rb = n0 + r32; const int fa = SA ? ((ra >> 3) & 7) : 0, fb = SB ? ((rb >> 3) & 7) : 0;
#pragma unroll
    for (int ks = 0; ks < NKS; ++ks) { const int q = ks * 2 + hi;
        const bf16x8 a = *(const bf16x8*)(A + ra * PB + ((q ^ fa) << 4));
        const bf16x8 b = *(const bf16x8*)(B + rb * PB + ((q ^ fb) << 4));
        acc = __builtin_amdgcn_mfma_f32_32x32x16_bf16(a, b, acc, 0, 0, 0); }
}
__device__ __forceinline__ void st_T(const f32x16& acc, char* Z, int n0, int m0, int r32, int hi) {
#pragma unroll
    for (int g = 0; g < 4; ++g) { u32x2 w; w.x = pk2(acc[4 * g], acc[4 * g + 1]); w.y = pk2(acc[4 * g + 2], acc[4 * g + 3]);
        *(u32x2*)(Z + (n0 + r32) * PB + (m0 + 8 * g + 4 * hi) * 2) = w; }
}
__device__ __forceinline__ unsigned long long pass1(const Params& p, const int l, unsigned char* lds) {
    const int sid = blockIdx.x >> 3, c_first = blockIdx.x & 7;
    const int tid = otid(), w = __builtin_amdgcn_readfirstlane(tid >> 6);
    const int h = sid & 7, dir = (sid >> 3) & 1, b = sid >> 4;
    unsigned long long pacc = 0, ptt = 0; (void)ptt;
#ifdef PRB_IV
#define RKP0(i) do { if ((PRB_IV >> (i)) & 1) ptt = __builtin_amdgcn_s_memrealtime(); } while (0)
#define RKP1(i) do { if ((PRB_IV >> (i)) & 1) pacc += __builtin_amdgcn_s_memrealtime() - ptt; } while (0)
#else
#define RKP0(i) do {} while (0)
#define RKP1(i) do {} while (0)
#endif
#define RK_LANE() int tq_ = tid; asm volatile("" : "+v"(tq_)); const int lane = tq_ & 63, r32 = lane & 31, hi = lane >> 5, tok = tq_ >> 3, c8 = (tq_ & 7) * 8; (void)lane; (void)r32; (void)hi; (void)tok; (void)c8
    char* L = (char*)lds; float* CF = (float*)(L + O_CONST);
    {   RK_LANE();
        const float* w2 = p.in[13] + ((size_t)(l * 2 + dir) * 64) * 512 + h * 64; const float* a2 = p.in[15] + ((size_t)l * 64) * 512 + h * 64;
        float t[8], u[8];
#pragma unroll
        for (int e = 0; e < 8; ++e) { t[e] = w2[(size_t)(c8 + e) * 512 + tok]; u[e] = a2[(size_t)(c8 + e) * 512 + tok]; }
        u32x4 ww, aa; ww.x = pk2(t[0], t[1]); ww.y = pk2(t[2], t[3]); ww.z = pk2(t[4], t[5]); ww.w = pk2(t[6], t[7]);
        aa.x = pk2(u[0], u[1]); aa.y = pk2(u[2], u[3]); aa.z = pk2(u[4], u[5]); aa.w = pk2(u[6], u[7]);
        *(u32x4*)(L + O_W2T + tok * PB + c8 * 2) = ww; *(u32x4*)(L + O_A2T + tok * PB + c8 * 2) = aa;
        { unsigned zz = 0u; asm volatile("" : "+v"(zz)); *(u32x4*)(L + O_SB + tok * PB + c8 * 2) = (u32x4){zz, zz, zz, zz}; }
        const float* mu = p.in[11] + (size_t)(l * 2 + dir) * 1664;
        for (int i = tid; i < 640; i += 512) { const int row = i >> 6, j = i & 63; float v;
            if (row == 0) v = p.in[12][(l * 2 + dir) * 512 + h * 64 + j]; else if (row == 1) v = p.in[14][l * 512 + h * 64 + j];
            else if (row == 2) v = p.in[16][l * 512 + h * 64 + j]; else if (row == 3) v = p.in[17][l * 512 + h * 64 + j]; else if (row == 4) v = p.in[18][l * 512 + h * 64 + j];
            else if (row == 5) v = mu[h * 64 + j]; else if (row == 6) v = mu[512 + h * 64 + j]; else if (row == 7) v = mu[1024 + h * 64 + j]; else if (row == 8) v = mu[1536 + j]; else v = mu[1600 + j];
            CF[i] = v; }
    }
    const bf16_t* Pr = pblk(p.ws, PB_R + (h >> 1)) + (h & 1) * 64; const bf16_t* Pk = pblk(p.ws, PB_K + (h >> 1)) + (h & 1) * 64;
    const bf16_t* Pv = pblk(p.ws, PB_V + (h >> 1)) + (h & 1) * 64; const bf16_t* Pw = pblk(p.ws, PB_WA); const bf16_t* Pa = pblk(p.ws, PB_WA) + 64;
    bf16_t* wkv = (bf16_t*)(g_scr + SCR_WKV) + (size_t)sid * SEQ * 64; bf16_t* bon = (bf16_t*)(g_scr + SCR_BON) + (size_t)dir * M_TOK * 512 + h * 64;
    bf16x8 cu[5], pv[5];
#define RK_LOAD(c) do { RK_LANE(); const int s_ = (c) * 64 + tok; const int t_ = dir ? (SEQ - 1 - s_) : s_; const size_t m_ = ((size_t)b * SEQ + t_) * 128 + c8; \
        cu[0] = *(const bf16x8*)(Pr + m_); cu[1] = *(const bf16x8*)(Pk + m_); cu[2] = *(const bf16x8*)(Pv + m_); cu[3] = *(const bf16x8*)(Pw + m_); cu[4] = *(const bf16x8*)(Pa + m_); \
        if (s_ > 0) { const size_t q_ = dir ? m_ + 128 : m_ - 128; pv[0] = *(const bf16x8*)(Pr + q_); pv[1] = *(const bf16x8*)(Pk + q_); pv[2] = *(const bf16x8*)(Pv + q_); pv[3] = *(const bf16x8*)(Pw + q_); pv[4] = *(const bf16x8*)(Pa + q_); } \
        else { _Pragma("unroll") for (int i_ = 0; i_ < 5; ++i_) pv[i_] = (bf16x8){0, 0, 0, 0, 0, 0, 0, 0}; } } while (0)
    RK_LOAD(c_first);
    LDS_BAR();
#pragma unroll 1
    for (int c = c_first; c < SEQ / 64; c += 8) {
        RKP0(1);
        float rr[8], kx[8], vv[8];
        {   RK_LANE(); float tw[8], ad[8];
#pragma unroll
            for (int e = 0; e < 8; ++e) {
                const float x0 = bf2f((bf16_t)cu[0][e]), x1 = bf2f((bf16_t)cu[1][e]), x2 = bf2f((bf16_t)cu[2][e]), x3 = bf2f((bf16_t)cu[3][e]), x4 = bf2f((bf16_t)cu[4][e]);
                const float p0 = bf2f((bf16_t)pv[0][e]), p1 = bf2f((bf16_t)pv[1][e]), p2 = bf2f((bf16_t)pv[2][e]), p3 = bf2f((bf16_t)pv[3][e]), p4 = bf2f((bf16_t)pv[4][e]);
                rr[e] = x0 + (p0 - x0) * CF[5 * 64 + (h * 0) + c8 + e]; kx[e] = x1 + (p1 - x1) * CF[6 * 64 + c8 + e]; vv[e] = x2 + (p2 - x2) * CF[7 * 64 + c8 + e];
                const float wd = x3 + (p3 - x3) * CF[8 * 64 + c8 + e]; ad[e] = x4 + (p4 - x4) * CF[9 * 64 + c8 + e];
                tw[e] = 1.f - 2.f / (1.f + __expf(2.f * wd)); }
            u32x4 a, d; a.x = pk2(tw[0], tw[1]); a.y = pk2(tw[2], tw[3]); a.z = pk2(tw[4], tw[5]); a.w = pk2(tw[6], tw[7]);
            d.x = pk2(ad[0], ad[1]); d.y = pk2(ad[2], ad[3]); d.z = pk2(ad[4], ad[5]); d.w = pk2(ad[6], ad[7]);
            *(u32x4*)(L + O_TW + tok * PB + c8 * 2) = a; *(u32x4*)(L + O_AD + tok * PB + c8 * 2) = d; }
        LDS_BAR(); RKP1(1); RKP0(2);
        {   RK_LANE(); const bool isA = w >= 4; const int mt2 = (w & 2) ? 32 : 0, n0 = (w & 1) * 32;
            const char* Aop = L + (isA ? O_AD : O_TW); const char* Bop = L + (isA ? O_A2T : O_W2T);
            f32x16 x0 = {};
            mm32<4>(x0, Aop, mt2, Bop, n0, 0, r32, hi);
            const int ch = n0 + r32; const float c0 = CF[(isA ? 64 : 0) + ch];
            float* TOT = (float*)(L + O_GAM);
            if (!isA) {
#pragma unroll
                for (int r = 0; r < 16; ++r) x0[r] = -0.6065306597126334f / (1.f + __expf(-(c0 + x0[r])));
                float run = 0.f;
#pragma unroll
                for (int g = 0; g < 4; ++g) { const float gs = (x0[4 * g] + x0[4 * g + 1]) + (x0[4 * g + 2] + x0[4 * g + 3]); const float ps = __shfl_xor(gs, 32);
                    float st = run + (hi ? ps : 0.f); x0[4 * g] += st; x0[4 * g + 1] += x0[4 * g]; x0[4 * g + 2] += x0[4 * g + 1]; x0[4 * g + 3] += x0[4 * g + 2]; run += gs + ps; }
                if (mt2 == 0 && hi == 0) TOT[ch] = run;
            } else {
#pragma unroll
                for (int r = 0; r < 16; ++r) x0[r] = 1.f / (1.f + __expf(-(c0 + x0[r])));
            }
            LDS_BAR();
            if (!isA && mt2) { const float t0 = TOT[ch];
#pragma unroll
                for (int r = 0; r < 16; ++r) x0[r] += t0; }
            float* O = (float*)(L + (isA ? O_AA : O_CL));
#pragma unroll
            for (int r = 0; r < 16; ++r) O[(mt2 + crow(r, hi)) * 64 + ch] = x0[r];
        }
        LDS_BAR(); RKP1(2); RKP0(3);
        {   RK_LANE(); const float* clp = (const float*)(L + O_CL + tok * 256 + c8 * 4); const float* cle = (const float*)(L + O_CL + (tok > 0 ? tok - 1 : 0) * 256 + c8 * 4);
            const float* cln = (const float*)(L + O_CL + 63 * 256 + c8 * 4); const float* aap = (const float*)(L + O_AA + tok * 256 + c8 * 4);
            float kk[8], kp[8]; float ss = 0.f, bs = 0.f;
#pragma unroll
            for (int e = 0; e < 8; ++e) { kk[e] = kx[e] * CF[2 * 64 + c8 + e]; ss += kk[e] * kk[e]; kp[e] = kx[e] * (1.f + (aap[e] - 1.f) * CF[3 * 64 + c8 + e]); bs += rr[e] * kp[e] * CF[4 * 64 + c8 + e]; }
            ss += __shfl_xor(ss, 1); ss += __shfl_xor(ss, 2); ss += __shfl_xor(ss, 4);
            bs += __shfl_xor(bs, 1); bs += __shfl_xor(bs, 2); bs += __shfl_xor(bs, 4);
            const float rn = 1.f / fmaxf(sqrtf(ss), 1e-12f);
            const int tsw = ((((tok >> 3) ^ (c8 >> 3)) << 3) + (tok & 7)) * 2;
#pragma unroll
            for (int e2 = 0; e2 < 4; ++e2) { float At[2], Rt[2], Bt[2], Kt[2];
#pragma unroll
                for (int q = 0; q < 2; ++q) { const int e = 2 * e2 + q; const float cl = clp[e], ce = (tok > 0) ? cle[e] : 0.f, cn = cln[e];
                    const float kn = kk[e] * rn; const float bb = kn * aap[e];
                    const float ein = __expf(cl), eex = __expf(ce), eng = __expf(-cl), een = __expf(cn - cl);
                    At[q] = -kn * eex; Rt[q] = rr[e] * ein; Bt[q] = bb * eng; Kt[q] = kp[e] * eng;
                    *(bf16_t*)(L + O_BHT + (c8 + e) * PB + tsw) = f2bf(bb * een); *(bf16_t*)(L + O_KHT + (c8 + e) * PB + tsw) = f2bf(kp[e] * een); *(bf16_t*)(L + O_VT + (c8 + e) * PB + tsw) = f2bf(vv[e]); *(bf16_t*)(L + O_SB + (c8 + e) * PB + tsw) = f2bf(At[q]);
                    if (tok == 63) ((float*)(L + O_GAM))[c8 + e] = __expf(cn); }
                const int ob = tok * PB + (c8 + 2 * e2) * 2;
                *(unsigned*)(L + O_AT + ob) = pk2(At[0], At[1]); *(unsigned*)(L + O_RT + ob) = pk2(Rt[0], Rt[1]); *(unsigned*)(L + O_BT + ob) = pk2(Bt[0], Bt[1]); *(unsigned*)(L + O_KT + ob) = pk2(Kt[0], Kt[1]); }
            {   const int s_ = c * 64 + tok; const int t_ = dir ? (SEQ - 1 - s_) : s_;
                u32x4 w_; w_.x = pk2(bs * vv[0], bs * vv[1]); w_.y = pk2(bs * vv[2], bs * vv[3]); w_.z = pk2(bs * vv[4], bs * vv[5]); w_.w = pk2(bs * vv[6], bs * vv[7]);
                *(u32x4*)(bon + ((size_t)b * SEQ + t_) * 512 + c8) = w_; }
        }
        LDS_BAR(); RKP1(3); RKP0(4);
        if (c + 8 < SEQ / 64) RK_LOAD(c + 8);
        for (int idx = w; idx < 12; idx += 8) {
            RK_LANE(); const int pr = idx / 3, tl = idx - pr * 3; const int mi = (tl == 2) ? 32 : 0, nt = (tl >= 1) ? 32 : 0;
            const char* X = L + ((pr & 1) ? O_KT : O_BT); const char* Y = L + ((pr >= 2) ? O_RT : O_AT);
            f32x16 acc = {}; mm32<4>(acc, X, mi, Y, nt, 0, r32, hi);
            const int t = nt + r32;
            if (tl != 1) {
#pragma unroll
                for (int r = 0; r < 16; ++r) { const int i = mi + crow(r, hi); const bool keep = (pr < 2) ? (i < t) : (i <= t); if (!keep) acc[r] = 0.f; } }
            char* Z = L + (pr == 0 ? O_AAB : pr == 1 ? O_AAK : pr == 2 ? O_ARB : O_ARK);
            st_T(acc, Z, nt, mi, r32, hi);
            if (pr == 0 && tl != 1) { float* ABD = (float*)(L + O_ABD);
#pragma unroll
                for (int g = 0; g < 4; ++g) if ((g >> 1) == (r32 >> 4)) *(f32x4*)(ABD + (t >> 4) * 256 + (t & 15) * 16 + 8 * (g & 1) + 4 * hi) = (f32x4){acc[4 * g], acc[4 * g + 1], acc[4 * g + 2], acc[4 * g + 3]}; }
        }
        LDS_BAR(); RKP1(4); RKP0(5);
        f32x16 yacc = {}, nacc = {};
        const int mt = (w & 2) ? 32 : 0, nv = (w & 1) ? 32 : 0;
        if (w < 4) {
            RK_LANE(); f32x16 xq = {};
            if (mt) mm32s<4, false, true>(xq, L + O_AAK, mt, L + O_VT, nv, r32, hi); else mm32s<2, false, true>(xq, L + O_AAK, mt, L + O_VT, nv, r32, hi);
            st_T(xq, L + O_G1T, nv, mt, r32, hi);
            mm32s<4, true, true>(nacc, L + O_KHT, mt, L + O_VT, nv, r32, hi);
        } else if (w < 7) {
            RK_LANE(); if (mt) mm32s<4, false, true>(yacc, L + O_ARK, mt, L + O_VT, nv, r32, hi); else mm32s<2, false, true>(yacc, L + O_ARK, mt, L + O_VT, nv, r32, hi);
        } else {
            RK_LANE(); const int blk = lane >> 4, j = lane & 15; const float* A = (const float*)(L + O_ABD) + blk * 256;
            float x[16];
#pragma unroll
            for (int t = 0; t < 16; ++t) { float s = (t == j) ? 1.f : 0.f;
#pragma unroll
                for (int i = 0; i < t; ++i) s += A[t * 16 + i] * x[i];
                x[t] = s; asm volatile("" ::: "memory"); }
            char* Tm = L + O_T; char* Dm = L + O_DT;
#pragma unroll
            for (int t = 0; t < 16; ++t) *(bf16_t*)(Tm + (16 * blk + t) * PB + (16 * blk + j) * 2) = f2bf(x[t]);
            { u32x4 a, d; a.x = pk2(x[0], x[1]); a.y = pk2(x[2], x[3]); a.z = pk2(x[4], x[5]); a.w = pk2(x[6], x[7]); d.x = pk2(x[8], x[9]); d.y = pk2(x[10], x[11]); d.z = pk2(x[12], x[13]); d.w = pk2(x[14], x[15]);
              *(u32x4*)(Dm + (16 * blk + j) * PB + (16 * blk) * 2) = a; *(u32x4*)(Dm + (16 * blk + j) * PB + (16 * blk + 8) * 2) = d; }
            if ((blk & 1) == 0) {
#pragma unroll
                for (int t = 0; t < 16; ++t) *(bf16_t*)(Tm + (16 * blk + t) * PB + (16 * (blk + 1) + j) * 2) = 0;
            } else { *(u32x4*)(Dm + (16 * blk + j) * PB + (16 * (blk - 1)) * 2) = (u32x4){0u, 0u, 0u, 0u}; *(u32x4*)(Dm + (16 * blk + j) * PB + (16 * (blk - 1) + 8) * 2) = (u32x4){0u, 0u, 0u, 0u}; }
            RK_FENCE();
            const int m16 = lane & 15, kg = lane >> 4; const bf16x8 z8 = {0, 0, 0, 0, 0, 0, 0, 0};
#pragma unroll
            for (int pp = 0; pp < 2; ++pp) { const int o = 32 * pp;
                bf16x8 a = z8, bb = z8;
                if (kg < 2) { a = *(const bf16x8*)(L + O_AAB + (o + 16 + m16) * PB + (o + 8 * kg) * 2); bb = *(const bf16x8*)(Dm + (o + m16) * PB + (o + 8 * kg) * 2); }
                f32x4 pq = __builtin_amdgcn_mfma_f32_16x16x32_bf16(a, bb, (f32x4){0.f, 0.f, 0.f, 0.f}, 0, 0, 0);
                { u32x2 wv; wv.x = pk2(pq[0], pq[1]); wv.y = pk2(pq[2], pq[3]); *(u32x2*)(L + O_PT + (o + m16) * PB + (o + 16 + 4 * kg) * 2) = wv; } }
            RK_FENCE();
#pragma unroll
            for (int pp = 0; pp < 2; ++pp) { const int o = 32 * pp;
                bf16x8 a = z8, bb = z8;
                if (kg < 2) { a = *(const bf16x8*)(Tm + (o + 16 + m16) * PB + (o + 16 + 8 * kg) * 2); bb = *(const bf16x8*)(L + O_PT + (o + m16) * PB + (o + 16 + 8 * kg) * 2); }
                f32x4 tq = __builtin_amdgcn_mfma_f32_16x16x32_bf16(a, bb, (f32x4){0.f, 0.f, 0.f, 0.f}, 0, 0, 0);
#pragma unroll
                for (int e = 0; e < 4; ++e) *(bf16_t*)(Tm + (o + 16 + 4 * kg + e) * PB + (o + m16) * 2) = f2bf(tq[e]);
                { u32x2 wv; wv.x = pk2(tq[0], tq[1]); wv.y = pk2(tq[2], tq[3]); *(u32x2*)(Dm + (o + m16) * PB + (o + 16 + 4 * kg) * 2) = wv; } }
            RK_FENCE();
            { f32x16 q = {}; mm32<2>(q, L + O_AAB, 32, Dm, 0, 0, r32, hi); st_T(q, L + O_PT, 0, 32, r32, hi); }
            RK_FENCE();
            { f32x16 tc = {}; mm32<2>(tc, Tm, 32, L + O_PT, 0, 32, r32, hi);
#pragma unroll
              for (int r = 0; r < 16; ++r) *(bf16_t*)(Tm + (32 + crow(r, hi)) * PB + r32 * 2) = f2bf(tc[r]); }
        }
        LDS_BAR(); RKP1(5); RKP0(6);
        if (w < 4) {
            RK_LANE(); f32x16 q = {};
            if (mt) mm32s<4, false, true>(q, L + O_T, mt, L + O_SB, nv, r32, hi); else mm32s<2, false, true>(q, L + O_T, mt, L + O_SB, nv, r32, hi);
            st_T(q, L + O_PT, nv, mt, r32, hi);
        } else {
            RK_LANE(); if (w == 7) mm32s<4, false, true>(yacc, L + O_ARK, mt, L + O_VT, nv, r32, hi);
            f32x16 q = {};
            if (mt) mm32<4>(q, L + O_T, mt, L + O_G1T, nv, 0, r32, hi); else mm32<2>(q, L + O_T, mt, L + O_G1T, nv, 0, r32, hi);
            st_T(q, L + O_UT, nv, mt, r32, hi);
        }
        LDS_BAR(); RKP1(6); RKP0(7);
        {   const size_t ci = (size_t)sid * (SEQ / 64) + c;
            if (w < 4) {
                RK_LANE(); mm32s<4, true, false>(nacc, L + O_BHT, mt, L + O_UT, nv, r32, hi);
                {   bf16_t* NN = (sid < 24 ? (bf16_t*)(p.ws + WS_NN) : (bf16_t*)(g_scr + SCR_NN2) - (size_t)24 * 128 * 4096) + ci * 4096 + ((size_t)(w * 64 + lane)) * 16;
                    u32x4 a, d; a.x = pk2(nacc[0], nacc[1]); a.y = pk2(nacc[2], nacc[3]); a.z = pk2(nacc[4], nacc[5]); a.w = pk2(nacc[6], nacc[7]);
                    d.x = pk2(nacc[8], nacc[9]); d.y = pk2(nacc[10], nacc[11]); d.z = pk2(nacc[12], nacc[13]); d.w = pk2(nacc[14], nacc[15]);
                    *(u32x4*)NN = a; *(u32x4*)(NN + 8) = d; }
                f32x16 mq = {}; mm32s<4, false, true>(mq, L + O_PT, mt, L + O_BHT, nv, r32, hi);
                const int kq = nv + r32; const float gk = ((const float*)(L + O_GAM))[kq];
#pragma unroll
                for (int r = 0; r < 16; ++r) if (mt + crow(r, hi) == kq) mq[r] += gk;
                bf16_t* MM = (bf16_t*)(p.ws + WS_MM) + ci * 4096 + (size_t)kq * 64 + mt + 4 * hi;
#pragma unroll
                for (int g = 0; g < 4; ++g) { u32x2 wv; wv.x = pk2(mq[4 * g], mq[4 * g + 1]); wv.y = pk2(mq[4 * g + 2], mq[4 * g + 3]); *(u32x2*)(MM + 8 * g) = wv; }
            } else {
                RK_LANE(); if (mt) mm32<4>(yacc, L + O_ARB, mt, L + O_UT, nv, 0, r32, hi); else mm32<2>(yacc, L + O_ARB, mt, L + O_UT, nv, 0, r32, hi);
                {
                    bf16_t* yp = wkv + (size_t)c * 4096 + (size_t)((w - 4) * 64 + lane) * 16;
                    u32x4 a_, d_; a_.x = pk2(yacc[0], yacc[1]); a_.y = pk2(yacc[2], yacc[3]); a_.z = pk2(yacc[4], yacc[5]); a_.w = pk2(yacc[6], yacc[7]);
                    d_.x = pk2(yacc[8], yacc[9]); d_.y = pk2(yacc[10], yacc[11]); d_.z = pk2(yacc[12], yacc[13]); d_.w = pk2(yacc[14], yacc[15]);
                    *(u32x4*)yp = a_; *(u32x4*)(yp + 8) = d_; }
                f32x16 qq = {};
                if (nv) mm32<4>(qq, L + O_PT, mt, L + O_ARB, nv, 0, r32, hi); else mm32<2>(qq, L + O_PT, mt, L + O_ARB, nv, 0, r32, hi);
                const int tq = nv + r32;
                bf16_t* QQ = (bf16_t*)(g_scr + SCR_XB) + ci * 4096 + (size_t)tq * 64 + mt + 4 * hi;
#pragma unroll
                for (int g = 0; g < 4; ++g) { const u32x2 rw = *(const u32x2*)(L + O_RT + tq * PB + (mt + 8 * g + 4 * hi) * 2);
                    const float r0 = __uint_as_float(rw.x << 16), r1 = __uint_as_float(rw.x & 0xffff0000u), r2 = __uint_as_float(rw.y << 16), r3 = __uint_as_float(rw.y & 0xffff0000u);
                    u32x2 wv; wv.x = pk2(qq[4 * g] + r0, qq[4 * g + 1] + r1); wv.y = pk2(qq[4 * g + 2] + r2, qq[4 * g + 3] + r3); *(u32x2*)(QQ + 8 * g) = wv; }
            }
        }
        LDS_BAR(); RKP1(7);
    }
#undef RK_LOAD
#undef RK_LANE
    return pacc;
}

__device__ __forceinline__ void chain(const Params& p, const int sid, unsigned char* lds) {
    const int tid = otid(), w = __builtin_amdgcn_readfirstlane(tid >> 6);
    constexpr int C_MT = 0, C_QT = MAT, C_SB = 2 * MAT;
#define RK_LANE() int tq_ = tid; asm volatile("" : "+v"(tq_)); const int lane = tq_ & 63, r32 = lane & 31, hi = lane >> 5, row = tq_ >> 3, c8 = (tq_ & 7) * 8; (void)lane; (void)r32; (void)hi; (void)row; (void)c8
    char* L = (char*)lds;
    const bf16_t* MMg = (const bf16_t*)(p.ws + WS_MM) + (size_t)sid * 128 * 4096; const bf16_t* QQg = (const bf16_t*)(g_scr + SCR_XB) + (size_t)sid * 128 * 4096;
    const bf16_t* NNg = (sid < 24 ? (const bf16_t*)(p.ws + WS_NN) : (const bf16_t*)(g_scr + SCR_NN2) - (size_t)24 * 128 * 4096) + (size_t)sid * 128 * 4096;
    bf16_t* wkv = (bf16_t*)(g_scr + SCR_WKV) + (size_t)sid * SEQ * 64;
    const int mt = (w & 2) ? 32 : 0, nv = (w & 1) ? 32 : 0;
    {   RK_LANE(); unsigned zz = 0u; asm volatile("" : "+v"(zz)); *(u32x4*)(L + C_SB + row * PB + c8 * 2) = (u32x4){zz, zz, zz, zz}; }
    f32x16 sacc = {};
    bf16x8 rm, rq, rn0, rn1;
#define CH_LOAD(c) do { RK_LANE(); rm = *(const bf16x8*)(MMg + (size_t)(c) * 4096 + row * 64 + c8); rq = *(const bf16x8*)(QQg + (size_t)(c) * 4096 + row * 64 + c8); \
        if (w < 4) { const bf16_t* n_ = NNg + (size_t)(c) * 4096 + (size_t)(w * 64 + lane) * 16; rn0 = *(const bf16x8*)n_; rn1 = *(const bf16x8*)(n_ + 8); } \
        else { const bf16_t* y_ = wkv + (size_t)(c) * 4096 + (size_t)((w - 4) * 64 + lane) * 16; rn0 = *(const bf16x8*)y_; rn1 = *(const bf16x8*)(y_ + 8); } } while (0)
    CH_LOAD(0);
#pragma unroll 1
    for (int c = 0; c < SEQ / 64; ++c) {
        {   RK_LANE(); *(bf16x8*)(L + C_MT + row * PB + c8 * 2) = rm; *(bf16x8*)(L + C_QT + row * PB + c8 * 2) = rq; }
        f32x16 acc;
#pragma unroll
        for (int r = 0; r < 8; ++r) { acc[r] = bf2f((bf16_t)rn0[r]); acc[8 + r] = bf2f((bf16_t)rn1[r]); }
        LDS_BAR();
        if (c + 1 < SEQ / 64) CH_LOAD(c + 1);
        {   RK_LANE();
            if (w < 4) { mm32<4>(acc, L + C_MT, mt, L + C_SB, nv, 0, r32, hi); sacc = acc; }
            else { mm32<4>(acc, L + C_QT, mt, L + C_SB, nv, 0, r32, hi);
#pragma unroll
                for (int r = 0; r < 16; ++r) wkv[((size_t)c * 64 + mt + crow(r, hi)) * 64 + nv + r32] = f2bf(acc[r]); } }
        LDS_BAR();
        if (w < 4) { RK_LANE(); st_T(sacc, L + C_SB, nv, mt, r32, hi); }
    }
#undef CH_LOAD
#undef RK_LANE
}

}

namespace sd {
using rk::f32x16; using rk::crow;
constexpr int PW = 272, PN = 144;
constexpr int O_CM = 0, O_BM = 64 * PW, O_HB = 2 * 64 * PW, O_BDT = 3 * 64 * PW, O_XDT = O_BDT + 128 * PN, O_XM = O_XDT + 64 * PN, O_MM = O_XM + 64 * PN, O_DTS = O_MM + 64 * PN, O_ACU = O_DTS + 512, O_END = O_ACU + 512;
template <int NKS, int PA, int PBB, int SA = -1, int SBW = -1> __device__ __forceinline__ void mmx(f32x16& acc, const char* A, int m0, const char* B, int n0, int k0, int r32, int hi) {
    const int ra = m0 + r32, rb = n0 + r32; const int fa = SA >= 0 ? ((ra >> (SA >= 0 ? SA : 0)) & 7) : 0, fb = SBW >= 0 ? ((rb >> (SBW >= 0 ? SBW : 0)) & 7) : 0;
#pragma unroll
    for (int ks = 0; ks < NKS; ++ks) { const int q = (k0 >> 3) + ks * 2 + hi;
        const bf16x8 a = *(const bf16x8*)(A + ra * PA + ((q ^ fa) << 4));
        const bf16x8 b = *(const bf16x8*)(B + rb * PBB + ((q ^ fb) << 4));
        acc = __builtin_amdgcn_mfma_f32_32x32x16_bf16(a, b, acc, 0, 0, 0); }
}
template <int PZ> __device__ __forceinline__ void stT(const f32x16& acc, char* Z, int n0, int m0, int r32, int hi) {
#pragma unroll
    for (int g = 0; g < 4; ++g) { u32x2 w; w.x = pk2(acc[4 * g], acc[4 * g + 1]); w.y = pk2(acc[4 * g + 2], acc[4 * g + 3]);
        *(u32x2*)(Z + (n0 + r32) * PZ + (m0 + 8 * g + 4 * hi) * 2) = w; }
}
__device__ __forceinline__ unsigned long long seq(const Params& p, const int l, const int sid, unsigned char* lds) {
    const int tid = otid(), w = __builtin_amdgcn_readfirstlane(tid >> 6);
    const int h = sid & 7, dir = (sid >> 3) & 1, b = sid >> 4, g = h >> 2;
    unsigned long long pacc = 0, ptt = 0; (void)ptt;
#ifdef PRB_SDIV
#define SDP0(i) do { if ((PRB_SDIV >> (i)) & 1) ptt = __builtin_amdgcn_s_memrealtime(); } while (0)
#define SDP1(i) do { if ((PRB_SDIV >> (i)) & 1) pacc += __builtin_amdgcn_s_memrealtime() - ptt; } while (0)
#else
#define SDP0(i) do {} while (0)
#define SDP1(i) do {} while (0)
#endif
#define SD_LANE() int tq_ = tid; asm volatile("" : "+v"(tq_)); const int lane = tq_ & 63, r32 = lane & 31, hi = lane >> 5, tok = tq_ >> 3, q8 = tq_ & 7; (void)lane; (void)r32; (void)hi; (void)tok; (void)q8
    char* L = (char*)lds;
    const float Ah = -expf(p.in[7][(l * 2 + dir) * 8 + h]), dtb = p.in[8][(l * 2 + dir) * 8 + h], Dh = (dir == 0) ? p.in[9][l * 8 + h] : 0.f;
    const float* dtbuf = (const float*)(g_scr + SCR_DT) + dir * 8 + h;
    const bf16_t* xact = (const bf16_t*)(g_scr + SCR_XACT);
    bf16_t* yout = (bf16_t*)(g_scr + SCR_SSDY) + (size_t)dir * M_TOK * 512 + h * 64;
    {   SD_LANE(); unsigned zz = 0u; asm volatile("" : "+v"(zz));
        for (int i = tid; i < 64 * PW / 16; i += 512) *(u32x4*)(L + O_HB + i * 16) = (u32x4){zz, zz, zz, zz}; }
    f32x16 hacc = {};
    bf16x8 rc[2], rb[2], rx; float dtr = 0.f;
#define SD_LOAD(c) do { SD_LANE(); const int s_ = (c) * 64 + tok; const int t_ = dir ? (SEQ - 1 - s_) : s_; const bf16_t* row_ = xact + ((size_t)b * SEQ + t_) * 1024; \
        rc[0] = *(const bf16x8*)(row_ + 768 + g * 128 + q8 * 16); rc[1] = *(const bf16x8*)(row_ + 768 + g * 128 + q8 * 16 + 8); \
        rb[0] = *(const bf16x8*)(row_ + 512 + g * 128 + q8 * 16); rb[1] = *(const bf16x8*)(row_ + 512 + g * 128 + q8 * 16 + 8); \
        rx = *(const bf16x8*)(row_ + h * 64 + q8 * 8); } while (0)
#define SD_DTLOAD(c) do { SD_LANE(); const int s2_ = (c) * 64 + lane; const int t2_ = dir ? (SEQ - 1 - s2_) : s2_; dtr = dtbuf[((size_t)b * SEQ + t2_) * 16]; } while (0)
#define SD_SCAN(buf) do { SD_LANE(); const float dt_ = softplusf(dtr + dtb); float ac_ = dt_ * Ah; \
        _Pragma("unroll") for (int o_ = 1; o_ < 64; o_ <<= 1) { const float v_ = __shfl_up(ac_, o_); if (lane >= o_) ac_ += v_; } \
        ((float*)(L + O_DTS))[(buf) * 64 + lane] = dt_; ((float*)(L + O_ACU))[(buf) * 64 + lane] = ac_; } while (0)
    SD_LOAD(0);
    if (w == 7) { SD_DTLOAD(0); SD_SCAN(0); SD_DTLOAD(1); }
    LDS_BAR();
    const int nv = (w & 1) ? 32 : 0;
#pragma unroll 1
    for (int c = 0; c < SEQ / 64; ++c) {
        const float* DTS = (const float*)(L + O_DTS) + (c & 1) * 64; const float* ACU = (const float*)(L + O_ACU) + (c & 1) * 64;
        SDP0(1);
        {   SD_LANE(); const float dt = DTS[tok]; const float ac = ACU[tok], ae = ACU[63];
            const float dend = __expf(ae - ac);
            *(bf16x8*)(L + O_CM + tok * PW + q8 * 32) = rc[0]; *(bf16x8*)(L + O_CM + tok * PW + q8 * 32 + 16) = rc[1];
            *(bf16x8*)(L + O_BM + tok * PW + q8 * 32) = rb[0]; *(bf16x8*)(L + O_BM + tok * PW + q8 * 32 + 16) = rb[1];
            *(bf16x8*)(L + O_XM + tok * PN + q8 * 16) = rx;
            const int tsw = ((((tok >> 3) ^ q8) << 3) + (tok & 7)) * 2;
#pragma unroll
            for (int e = 0; e < 8; ++e) { *(bf16_t*)(L + O_BDT + (q8 * 16 + e) * PN + tsw) = f2bf(bf2f((bf16_t)rb[0][e]) * dend); *(bf16_t*)(L + O_BDT + (q8 * 16 + 8 + e) * PN + tsw) = f2bf(bf2f((bf16_t)rb[1][e]) * dend);
                *(bf16_t*)(L + O_XDT + (q8 * 8 + e) * PN + tsw) = f2bf(bf2f((bf16_t)rx[e]) * dt); } }
        LDS_BAR(); SDP1(1); SDP0(2);
        if (c + 1 < SEQ / 64) SD_LOAD(c + 1);
        f32x16 yoff = {};
        const int ml = ((w - 3) & 2) ? 32 : 0, np = ((w - 3) & 1) ? 32 : 0;
        if (w < 3) { SD_LANE(); const int ms = (w == 2) ? 32 : 0, nl = (w >= 1) ? 32 : 0;
            f32x16 gq = {}; mmx<8, PW, PW>(gq, L + O_BM, ms, L + O_CM, nl, 0, r32, hi);
            const int lq = nl + r32; const float al = ACU[lq];
#pragma unroll
            for (int g4 = 0; g4 < 4; ++g4) { const f32x4 as4 = *(const f32x4*)(ACU + ms + 8 * g4 + 4 * hi);
#pragma unroll
                for (int e = 0; e < 4; ++e) { const int s = ms + 8 * g4 + 4 * hi + e; const float d = __expf(fminf(al - as4[e], 0.f)); gq[4 * g4 + e] = (s <= lq) ? gq[4 * g4 + e] * d : 0.f; } }
            stT<PN>(gq, L + O_MM, nl, ms, r32, hi);
        } else if (w < 7) { SD_LANE(); mmx<8, PW, PW>(yoff, L + O_CM, ml, L + O_HB, np, 0, r32, hi); }
        {   SD_LANE(); const float eend = __expf(ACU[63]);
#pragma unroll
            for (int r = 0; r < 16; ++r) hacc[r] *= eend;
            mmx<4, PN, PN, 4, 3>(hacc, L + O_BDT, (w >> 1) * 32, L + O_XDT, nv, 0, r32, hi); }
        if (w == 7 && c + 1 < SEQ / 64) { SD_SCAN((c + 1) & 1); if (c + 2 < SEQ / 64) SD_DTLOAD(c + 2); }
        LDS_BAR(); SDP1(2); SDP0(3);
        {   SD_LANE(); stT<PW>(hacc, L + O_HB, nv, (w >> 1) * 32, r32, hi); }
        if (w >= 3 && w < 7) { SD_LANE(); f32x16 yd = {};
            if (ml) mmx<4, PN, PN, -1, 3>(yd, L + O_MM, ml, L + O_XDT, np, 0, r32, hi); else mmx<2, PN, PN, -1, 3>(yd, L + O_MM, ml, L + O_XDT, np, 0, r32, hi);
            float ea[16], xv[16];
#pragma unroll
            for (int g4 = 0; g4 < 4; ++g4) { const f32x4 a4 = *(const f32x4*)(ACU + ml + 8 * g4 + 4 * hi);
#pragma unroll
                for (int e = 0; e < 4; ++e) { ea[4 * g4 + e] = __expf(a4[e]); xv[4 * g4 + e] = bf2f(*(const bf16_t*)(L + O_XM + (ml + 8 * g4 + 4 * hi + e) * PN + (np + r32) * 2)); } }
#pragma unroll
            for (int r = 0; r < 16; ++r) { const int lq = ml + crow(r, hi); const int s_ = c * 64 + lq; const int t_ = dir ? (SEQ - 1 - s_) : s_;
                yout[((size_t)b * SEQ + t_) * 512 + np + r32] = f2bf(yd[r] + ea[r] * yoff[r] + Dh * xv[r]); } }
        LDS_BAR(); SDP1(3);
    }
#undef SD_LOAD
#undef SD_DTLOAD
#undef SD_SCAN
#undef SD_LANE
    return pacc;
}
}

__device__ __forceinline__ void combine_tokens(const Params& p, const int l, const int m_first, const int m_end, const int m_step) {
    const int tid = otid(), lane = tid & 63;
    const bf16_t* wkv = (const bf16_t*)(g_scr + SCR_WKV); const bf16_t* bon = (const bf16_t*)(g_scr + SCR_BON); const bf16_t* sy = (const bf16_t*)(g_scr + SCR_SSDY);
    const int h = lane >> 3, c8 = (lane & 7) * 8, ch = h * 64 + c8;
    float eps_gn = 64e-5f, eps_rms = NORM_EPS; asm volatile("" : "+v"(eps_gn), "+v"(eps_rms));
    float lnw[8], lnb[8], snw[8];
#pragma unroll
    for (int e = 0; e < 8; ++e) { lnw[e] = p.in[19][l * 512 + ch + e]; lnb[e] = p.in[20][l * 512 + ch + e]; snw[e] = p.in[10][l * 512 + ch + e]; }
    bf16x8 nwf, nwb, nbf, nbb, ng, nz, nyf, nyb;
#define CMB_LOAD(mm) { const int m_ = (mm); const int bq = m_ >> 13, tq = m_ & (SEQ - 1);       \
        nwf = *(const bf16x8*)(wkv + (((size_t)(bq * 16 + h)) * SEQ + tq) * 64 + c8); nwb = *(const bf16x8*)(wkv + (((size_t)(bq * 16 + 8 + h)) * SEQ + (SEQ - 1 - tq)) * 64 + c8); \
        nbf = *(const bf16x8*)(bon + (size_t)m_ * 512 + ch); nbb = *(const bf16x8*)(bon + (size_t)M_TOK * 512 + (size_t)m_ * 512 + ch); \
        ng = *(const bf16x8*)(pblk(p.ws, PB_RG + (h >> 1)) + (size_t)m_ * 128 + (h & 1) * 64 + c8); nz = *(const bf16x8*)(pblk(p.ws, PB_Z + (h >> 1)) + (size_t)m_ * 128 + (h & 1) * 64 + c8); \
        nyf = *(const bf16x8*)(sy + (size_t)m_ * 512 + ch); nyb = *(const bf16x8*)(sy + (size_t)M_TOK * 512 + (size_t)m_ * 512 + ch); }
    CMB_LOAD(m_first)
    for (int m = m_first; m < m_end; m += m_step) {
        bf16_t* gp = pblk(p.ws, PB_RG + (h >> 1)) + (size_t)m * 128 + (h & 1) * 64 + c8; bf16_t* zp = pblk(p.ws, PB_Z + (h >> 1)) + (size_t)m * 128 + (h & 1) * 64 + c8;
        const bf16x8 vwf = nwf, vwb = nwb, vbf = nbf, vbb = nbb, vg = ng, vz = nz, vyf = nyf, vyb = nyb;
        if (m + m_step < m_end) CMB_LOAD(m + m_step)
        float a[8], bq8[8], x[8], y[8];
        unpack8(vwf, a); unpack8(vwb, bq8); float s = 0.f;
#pragma unroll
        for (int e = 0; e < 8; ++e) { x[e] = a[e] + bq8[e]; s += x[e]; }
        s += __shfl_xor(s, 1); s += __shfl_xor(s, 2); s += __shfl_xor(s, 4);
        const float mean = s * (1.f / 64.f); float v2 = 0.f;
#pragma unroll
        for (int e = 0; e < 8; ++e) { x[e] -= mean; v2 += x[e] * x[e]; }
        v2 += __shfl_xor(v2, 1); v2 += __shfl_xor(v2, 2); v2 += __shfl_xor(v2, 4);
        const float rstd = rsqrtf(v2 * (1.f / 64.f) + eps_gn);
        unpack8(vbf, a); unpack8(vbb, bq8); unpack8(vg, y);
#pragma unroll
        for (int e = 0; e < 8; ++e) x[e] = (x[e] * rstd * lnw[e] + lnb[e] + a[e] + bq8[e]) * siluf(y[e]);
        const u32x4 ob = pack8(x);
        unpack8(vyf, a); unpack8(vyb, bq8); unpack8(vz, y); float ss = 0.f;
#pragma unroll
        for (int e = 0; e < 8; ++e) { x[e] = (a[e] + bq8[e]) * siluf(y[e]); ss += x[e] * x[e]; }
        ss += __shfl_xor(ss, 1); ss += __shfl_xor(ss, 2); ss += __shfl_xor(ss, 4); ss += __shfl_xor(ss, 8); ss += __shfl_xor(ss, 16);
        const float rs = rsqrtf(ss * (1.f / 256.f) + eps_rms);
#pragma unroll
        for (int e = 0; e < 8; ++e) x[e] *= rs * snw[e];
        const u32x4 oa = pack8(x);
        *(u32x4*)gp = ob; *(u32x4*)zp = oa;
    }
#undef CMB_LOAD
}

__device__ __forceinline__ void phase_post(const Params& p, const int l) {
    const int G = gridDim.x, tid = otid(), lane = tid & 63, wave = tid >> 6;
    const float* mix = (const float*)(p.ws + WS_MIX); const float* xin = l == 0 ? p.in[0] : p.out; const float* pw = p.in[2] + l * DMODEL;
    f32x4 wv[4];
#pragma unroll
    for (int j = 0; j < 4; ++j) wv[j] = ((const f32x4*)pw)[lane + 64 * j];
    for (int m0 = (blockIdx.x * 8 + wave) * 2; m0 < M_TOK; m0 += G * 16) {
        f32x4 v[2][4], x[2][4];
#pragma unroll
        for (int q = 0; q < 2; ++q)
#pragma unroll
            for (int j = 0; j < 4; ++j) { v[q][j] = ((const f32x4*)(mix + (size_t)(m0 + q) * DMODEL))[lane + 64 * j]; x[q][j] = ((const f32x4*)(xin + (size_t)(m0 + q) * DMODEL))[lane + 64 * j]; }
#pragma unroll
        for (int q = 0; q < 2; ++q) { float s = 0.f;
#pragma unroll
            for (int j = 0; j < 4; ++j) s += (v[q][j].x * v[q][j].x + v[q][j].y * v[q][j].y) + (v[q][j].z * v[q][j].z + v[q][j].w * v[q][j].w);
            const float rs = rsqrtf(wave_sum(s) * (1.f / DMODEL) + NORM_EPS); float s2 = 0.f;
#pragma unroll
            for (int j = 0; j < 4; ++j) { v[q][j] = x[q][j] + v[q][j] * rs * wv[j]; s2 += (v[q][j].x * v[q][j].x + v[q][j].y * v[q][j].y) + (v[q][j].z * v[q][j].z + v[q][j].w * v[q][j].w); }
            s2 = wave_sum(s2);
            if (lane == 0) ((float*)(g_scr + SCR_RS))[m0 + q] = rsqrtf(s2 * (1.f / DMODEL) + NORM_EPS); }
#pragma unroll
        for (int q = 0; q < 2; ++q) { f32x4* orow = (f32x4*)(p.out + (size_t)(m0 + q) * DMODEL) + lane; u32x2* o8 = (u32x2*)((bf16_t*)(g_scr + SCR_XB) + (size_t)(m0 + q) * DMODEL) + lane;
#pragma unroll
            for (int j = 0; j < 4; ++j) { orow[64 * j] = v[q][j]; u32x2 w; w.x = pk2(v[q][j].x, v[q][j].y); w.y = pk2(v[q][j].z, v[q][j].w); o8[64 * j] = w; } }
    }
}

#define XB_TMO      128
#define XB_XCNT(j)  (256  + 64 * (j))
#define XB_XSUB(j)  (1280 + 64 * (j))
#define XB_XGEN(j)  (2304 + 64 * (j))
#define XB_TOP      3328
#define XB_TOPGEN   3392
#define XCD_BAR_WORDS 3456
#define XB_SPIN_CAP (1u << 18)
#define XLAS __attribute__((address_space(3)))
__device__ __forceinline__ unsigned xb_ld(unsigned* p)              { return __hip_atomic_load(p, __ATOMIC_RELAXED, __HIP_MEMORY_SCOPE_AGENT); }
__device__ __forceinline__ unsigned xb_add(unsigned* p, unsigned v) { return __hip_atomic_fetch_add(p, v, __ATOMIC_RELAXED, __HIP_MEMORY_SCOPE_AGENT); }
__device__ __forceinline__ unsigned xb_xcc_id() { return (unsigned)__builtin_amdgcn_s_getreg((3 << 11) | 20) & 0xFu; }
#define XB_SPIN(cond, bar) do { unsigned _sp = 0; while (cond) { __builtin_amdgcn_s_sleep(1); \
    if ((++_sp & 255u) == 0u) { if (xb_ld(&(bar)[XB_TMO])) break; if (_sp > XB_SPIN_CAP) { atomicAdd(&(bar)[XB_TMO], 1u); break; } } } } while (0)
struct XcdBarrier { unsigned* bar; unsigned x; volatile XLAS unsigned* st; };
__device__ __forceinline__ XcdBarrier xcd_barrier_post(unsigned* bar, volatile XLAS unsigned* st) {
    XcdBarrier b; b.bar = bar; b.x = xb_xcc_id(); b.st = st;
    if (threadIdx.x == 0) (void)xb_add(&bar[XB_XCNT(b.x)], 1u);
    return b;
}
__device__ __forceinline__ void xcd_barrier_complete(unsigned* bar, unsigned x, unsigned& nloc, unsigned& nx) {
    const unsigned G = gridDim.x * gridDim.y * gridDim.z;
    unsigned sum, cnt, mine, sp = 0u;
    for (;;) {
        sum = 0u; cnt = 0u; mine = 0u;
#pragma unroll
        for (unsigned j = 0; j < 16; ++j) { const unsigned c = xb_ld(&bar[XB_XCNT(j)]); sum += c; cnt += (c > 0u) ? 1u : 0u; mine = (j == x) ? c : mine; }
        if (sum == G) break;
        __builtin_amdgcn_s_sleep(1);
        if ((++sp & 255u) == 0u) { if (xb_ld(&bar[XB_TMO])) break; if (sp > XB_SPIN_CAP) { atomicAdd(&bar[XB_TMO], 1u); break; } }
    }
    nloc = mine > 0u ? mine : 1u; nx = cnt > 0u ? cnt : 1u;
}
__device__ __forceinline__ void xcd_barrier(const XcdBarrier& b) {
    asm volatile("s_waitcnt vmcnt(0)" ::: "memory");
    __syncthreads();
    if (threadIdx.x == 0) {
        unsigned* bar = b.bar;
        __builtin_amdgcn_s_waitcnt(0);
        unsigned nloc = b.st[0], nx = b.st[1];
        if (nloc == 0u) { xcd_barrier_complete(bar, b.x, nloc, nx); b.st[0] = nloc; b.st[1] = nx; }
        const unsigned old = xb_add(&bar[XB_XSUB(b.x)], 1u);
        const unsigned gen = old / nloc;
        if (old + 1u == (gen + 1u) * nloc) {
            __builtin_amdgcn_fence(__ATOMIC_RELEASE, "agent");
            asm volatile("s_waitcnt vmcnt(0)" ::: "memory");
            const unsigned og = xb_add(&bar[XB_TOP], 1u);
            const unsigned tg = og / nx;
            if (og + 1u == (tg + 1u) * nx) xb_add(&bar[XB_TOPGEN], 1u);
            else XB_SPIN(xb_ld(&bar[XB_TOPGEN]) == tg, bar);
            __builtin_amdgcn_fence(__ATOMIC_ACQUIRE, "agent");
            xb_add(&bar[XB_XGEN(b.x)], 1u);
            asm volatile("s_waitcnt vmcnt(0)" ::: "memory");
        } else {
            XB_SPIN(xb_ld(&bar[XB_XGEN(b.x)]) == gen, bar);
            __builtin_amdgcn_fence(__ATOMIC_ACQUIRE, "agent");
            asm volatile("s_waitcnt vmcnt(0)" ::: "memory");
        }
    }
    __syncthreads();
}

constexpr int LDS_BYTES = 155648;
static_assert(rk::O_END <= LDS_BYTES, "rwkv LDS map");
__device__ __forceinline__ void phase_gemm_in(const Params& p, const int l, unsigned char* lds) {
    pg8::Gemm g{(const bf16_t*)(g_scr + SCR_XB), (const bf16_t*)(g_scr + SCR_WIN + (size_t)l * 15 * MiB), M_TOK, NPROJ, DMODEL, DMODEL, 128};
    pg8::StaticOrder S; S.init(M_TOK, NPROJ, gridDim.x, blockIdx.x);
    pg8::EpiProj E{(bf16_t*)p.ws, (const float*)(g_scr + SCR_RS), (float*)(g_scr + SCR_DT)};
    pg8::gemm_phase<pg8::EpiProj, pg8::StaticOrder, true, true>((PG8_LAS unsigned char*)lds, g, S, E);
}
__device__ __forceinline__ void phase_gemm_out(const Params& p, const int l, unsigned char* lds) {
    pg8::Gemm g{(const bf16_t*)p.ws, (const bf16_t*)(g_scr + SCR_WOUT + (size_t)l * 4 * MiB), M_TOK, DMODEL, DMIX, 128, PBLK_ELEMS};
    pg8::StaticOrder S; S.init(M_TOK, DMODEL, gridDim.x, blockIdx.x);
    pg8::EpiMix E{(float*)(p.ws + WS_MIX)};
    pg8::gemm_phase<pg8::EpiMix, pg8::StaticOrder, true, true>((PG8_LAS unsigned char*)lds, g, S, E);
}
__device__ __forceinline__ unsigned long long phase_mixers(const Params& p, const int l, unsigned char* lds) {
    unsigned long long pr = 0;
    const int bid = blockIdx.x;
#ifdef PRB_SEQ
    const unsigned long long ts0 = __builtin_amdgcn_s_memrealtime();
#endif
    unsigned* seqdone = (unsigned*)(g_scr + SCR_CTL) + 200 + 8 * l; unsigned* cmbctr = seqdone + 1;
    if (bid < 32) rk::chain(p, bid, lds);
    else if (bid < 64) { const unsigned long long q_ = sd::seq(p, l, bid - 32, lds); (void)q_;
#ifdef PRB_SDIV
        pr = q_;
#endif
    }
    if (bid < 64) {
        asm volatile("s_waitcnt vmcnt(0)" ::: "memory"); __syncthreads();
        if (threadIdx.x == 0) { __builtin_amdgcn_fence(__ATOMIC_RELEASE, "agent"); asm volatile("s_waitcnt vmcnt(0)" ::: "memory"); __hip_atomic_fetch_add(seqdone, 1u, __ATOMIC_RELAXED, __HIP_MEMORY_SCOPE_AGENT); }
    }
#ifdef PRB_SEQ
    pr = __builtin_amdgcn_s_memrealtime() - ts0;
#endif
    unsigned* ctr = (unsigned*)(g_scr + SCR_CTL) + 64 * l;
    unsigned* slot = (unsigned*)(lds + LDS_BYTES - 16);
#ifdef PRB_UNIT
    int nun = 0;
#endif
    const int x0 = (int)(__builtin_amdgcn_s_getreg((3 << 11) | 20) & 7u);
    for (int dx = 0; dx < 8; ++dx) { const int x = (x0 + dx) & 7;
        for (;;) {
            __syncthreads();
            if (threadIdx.x == 0) *slot = atomicAdd(ctr + x, 1u);
            __syncthreads();
            const int j = (int)__builtin_amdgcn_readfirstlane(*slot);
            constexpr int NSPL = 16;
            if (j >= 96 + NSPL) break;
#ifdef PRB_UNIT
            const unsigned long long tu0 = __builtin_amdgcn_s_memrealtime();
#endif
            if (j < 32) gqa_unit(p, l, x * 32 + j, (char*)lds);
            else if (j < 96 - NSPL) diff_unit(p, l, x * 64 + (j - 32), (char*)lds);
            else { const int s = j - (96 - NSPL); diff_unit(p, l, x * 64 + (64 - NSPL) + (s >> 1), (char*)lds, s & 1, x * NSPL + (s >> 1)); }
#ifdef PRB_UNIT
            if (nun == PRB_UNIT) pr = __builtin_amdgcn_s_memrealtime() - tu0;
            if (PRB_UNIT == 99) pr = (unsigned long long)(nun + 1) * 10000ull + (j < 32 ? 1000ull : 0ull);
            ++nun;
#endif
        } }
    {   if (threadIdx.x == 0) { unsigned sp = 0; while (__hip_atomic_load(seqdone, __ATOMIC_RELAXED, __HIP_MEMORY_SCOPE_AGENT) < 64u) { __builtin_amdgcn_s_sleep(8); if (++sp > (1u << 22)) break; } }
        __syncthreads();
        __builtin_amdgcn_fence(__ATOMIC_ACQUIRE, "agent"); asm volatile("s_waitcnt vmcnt(0)" ::: "memory");
        const int wave = otid() >> 6;
        for (;;) {
            __syncthreads();
            if (threadIdx.x == 0) *slot = atomicAdd(cmbctr, 1u);
            __syncthreads();
            const int it = (int)__builtin_amdgcn_readfirstlane(*slot);
            if (it >= M_TOK / 64) break;
            combine_tokens(p, l, it * 64 + wave, it * 64 + 64, 8);
        } }
    return pr;
}
#ifdef PROBE
#define PT0(ph) do { if (l == 0 && (ph) == PRB_PH) pt0 = __builtin_amdgcn_s_memrealtime(); } while (0)
#define PT1(ph, aftersync) do { if (l == 0 && (ph) == PRB_PH && (aftersync) == PRB_SYNC) pd = __builtin_amdgcn_s_memrealtime() - pt0; } while (0)
#else
#define PT0(ph) do {} while (0)
#define PT1(ph, aftersync) do {} while (0)
#endif
__global__ void __launch_bounds__(512) mega(const Params p) {
    extern __shared__ __attribute__((aligned(16))) unsigned char lds[];
    cg::grid_group grid = cg::this_grid();
    unsigned* xbar = (unsigned*)(g_scr + SCR_BAR);
    volatile XLAS unsigned* xst = (volatile XLAS unsigned*)(XLAS unsigned char*)(lds + LDS_BYTES - 32);
    if (blockIdx.x == 0) for (int i = threadIdx.x; i < XCD_BAR_WORDS; i += 512) xbar[i] = 0u;
    if (threadIdx.x < 2) xst[threadIdx.x] = 0u;
#ifdef PROBE
    unsigned long long pt0 = 0, pd = 0;
#endif
#ifdef PROBE
    if (PRB_PH == 7) pt0 = __builtin_amdgcn_s_memrealtime();
#endif
    phase_prologue(p, (float*)lds); grid.sync();
    const XcdBarrier xb = xcd_barrier_post(xbar, xst);
#define GRID_BAR() xcd_barrier(xb)
#ifdef PROBE
    if (PRB_PH == 7) pd = __builtin_amdgcn_s_memrealtime() - pt0;
#endif
#pragma unroll 1
    for (int l = 0; l < 2; ++l) {
        PT0(0); phase_gemm_in(p, l, lds); PT1(0, 0); GRID_BAR(); PT1(0, 1);
        PT0(1); phase_prep(p, l); PT1(1, 0); GRID_BAR(); PT1(1, 1);
        kmax_reduce(l, (float*)lds);
        PT0(6); { const unsigned long long pr_ = rk::pass1(p, l, lds); (void)pr_;
#ifdef PRB_IV
        if (l == 0) pd = pr_;
#endif
        } PT1(6, 0); GRID_BAR(); PT1(6, 1);
        PT0(2); { const unsigned long long pr_ = phase_mixers(p, l, lds); (void)pr_;
#if defined(PRB_SEQ) || defined(PRB_SDIV) || defined(PRB_UNIT)
        if (l == 0) pd = pr_;
#endif
        } PT1(2, 0); GRID_BAR(); PT1(2, 1);
        PT0(4); phase_gemm_out(p, l, lds); PT1(4, 0); GRID_BAR(); PT1(4, 1);
        PT0(5); phase_post(p, l); PT1(5, 0); if (l == 0) { GRID_BAR(); PT1(5, 1); }
    }
#ifdef PROBE
    if (blockIdx.x == PRB_BLK && threadIdx.x == 0) { const unsigned long long d = pd * PRB_K; const unsigned long long t0 = __builtin_amdgcn_s_memrealtime();
        while (__builtin_amdgcn_s_memrealtime() - t0 < d) __builtin_amdgcn_s_sleep(8); }
#endif
}

extern "C" void kernel_launch(void* const* d_in, const int* in_sizes, int n_in, void* d_out, int out_size, void* d_ws, size_t ws_size, hipStream_t stream) {
    static int grid_blocks = 0;
    if (!grid_blocks) {
        int dev = 0, cus = 0, per_cu = 0;
        (void)hipGetDevice(&dev);
        (void)hipDeviceGetAttribute(&cus, hipDeviceAttributeMultiprocessorCount, dev);
        (void)hipFuncSetAttribute((const void*)mega, hipFuncAttributeMaxDynamicSharedMemorySize, LDS_BYTES);
        (void)hipOccupancyMaxActiveBlocksPerMultiprocessor(&per_cu, (const void*)mega, 512, LDS_BYTES);
        if (per_cu < 1) { fprintf(stderr, "kernel_launch: occupancy query says %d blocks/CU\n", per_cu); per_cu = 1; }
        grid_blocks = cus;
    }
    Params p{};
    for (int i = 0; i < 25; ++i) p.in[i] = (const float*)d_in[i];
    p.out = (float*)d_out; p.ws = (unsigned char*)d_ws;
    void* args[] = {&p};
    hipError_t e = hipLaunchCooperativeKernel((const void*)mega, dim3(grid_blocks), dim3(512), args, LDS_BYTES, stream);
    if (e != hipSuccess) fprintf(stderr, "cooperative launch failed: %s (grid %d)\n", hipGetErrorString(e), grid_blocks);
}
```

```cpp
#include <hip/hip_runtime.h>
#include <hip/hip_bf16.h>
#include <hip/hip_cooperative_groups.h>
#include <cstdio>
#include <cstdint>
namespace cg = cooperative_groups;

constexpr int M_TOK = 16384, SEQ = 8192, DMODEL = 1024, NPROJ = 7424, NPB = 58, DIN_ORIG = 7312, DMIX = 2048;
constexpr float NORM_EPS = 1e-6f;
constexpr size_t MiB = 1u << 20;
constexpr int PB_Z = 0, PB_RG = 4, PB_DQ = 8, PB_GQ = 12, PB_XS = 16, PB_BM = 20, PB_CM = 22, PB_R = 24, PB_K = 28, PB_V = 32, PB_WA = 36,
              PB_DK = 37, PB_DV = 41, PB_DG = 45, PB_GK = 49, PB_GV = 51, PB_GG = 53, PB_DT = 57;
constexpr size_t PBLK_ELEMS = (size_t)M_TOK * 128;
constexpr size_t SCR_WIN = 0, SCR_WOUT = 30 * MiB, SCR_ROPE = 38 * MiB, SCR_DT = 40 * MiB, SCR_RS = 41 * MiB, SCR_CTL = 41 * MiB + 512 * 1024,
                 SCR_BAR = 41 * MiB + 768 * 1024, SCR_XB = 42 * MiB, SCR_WKV = 74 * MiB, SCR_BON = 106 * MiB, SCR_SSDY = 138 * MiB, SCR_XACT = 170 * MiB, SCR_NN2 = 202 * MiB, SCR_SPL = 210 * MiB, SCR_BYTES = 228 * MiB;
constexpr size_t SCR_KPART = 41 * MiB + 64 * 1024;
constexpr size_t WS_MM = 16 * PBLK_ELEMS * 2;
constexpr size_t WS_NN = 58 * PBLK_ELEMS * 2;
constexpr size_t WS_MIX = 16 * PBLK_ELEMS * 2;
__device__ __attribute__((aligned(256))) unsigned char g_scr[SCR_BYTES];

typedef unsigned short bf16_t;
typedef short bf16x8 __attribute__((ext_vector_type(8)));
typedef float f32x4 __attribute__((ext_vector_type(4)));
typedef unsigned u32x4 __attribute__((ext_vector_type(4)));
typedef unsigned u32x2 __attribute__((ext_vector_type(2)));

struct Params {
    const float* in[25];
    float* out;
    unsigned char* ws;
};

__device__ __forceinline__ int otid() { int t = threadIdx.x; asm volatile("" : "+v"(t)); return t; }
__device__ __forceinline__ float bf2f(bf16_t v) { return __uint_as_float(((unsigned)v) << 16); }
typedef float f32x2_t __attribute__((ext_vector_type(2))); typedef __bf16 bf16x2_t __attribute__((ext_vector_type(2)));
__device__ __forceinline__ unsigned pk2(float lo, float hi) { f32x2_t v = {lo, hi}; bf16x2_t b = __builtin_convertvector(v, bf16x2_t); return __builtin_bit_cast(unsigned, b); }
__device__ __forceinline__ bf16_t f2bf(float f) { return (bf16_t)(pk2(f, 0.f) & 0xffffu); }
__device__ __forceinline__ float wave_sum(float v) {
#pragma unroll
    for (int o = 1; o < 64; o <<= 1) v += __shfl_xor(v, o);
    return v;
}
__device__ __forceinline__ float siluf(float x) { return x / (1.f + __expf(-x)); }
__device__ __forceinline__ float softplusf(float x) { return fmaxf(x, 0.f) + log1pf(__expf(-fabsf(x))); }
__device__ __forceinline__ bf16_t* pblk(unsigned char* ws, int j) { return (bf16_t*)ws + (size_t)j * PBLK_ELEMS; }

namespace pg8 {
#define PG8_LAS __attribute__((address_space(3)))
constexpr int BM = 256, BK = 64, HALF = 128, HTB = HALF * BK * 2, STAGE_BYTES = 8 * HTB, NXCD = 8, WGM = 8;
__host__ __device__ __forceinline__ int lds_byte(int r, int c) { const int st = (r >> 4) * 2 + (c >> 5), rr = r & 15, cc = c & 31, ob = rr * 64 + cc * 2; return st * 1024 + (ob ^ (((ob >> 9) & 1) << 5)); }
__host__ __device__ __forceinline__ void stage_rc(int b, int& R, int& C) { const int st = b / 1024, sb = b % 1024, swz = sb ^ (((sb >> 9) & 1) << 5); R = (st >> 1) * 16 + swz / 64; C = (st & 1) * 32 + (swz % 64) / 2; }
__host__ __device__ __forceinline__ int perm32(int rho) { const int n = rho >> 4, i = rho & 15; return 8 * (i >> 2) + 4 * n + (i & 3); }
struct Unit { int pm, pn; };
struct Gemm { const bf16_t* A; const bf16_t* Bt; int M, N, K; int lda; size_t abig; };
struct StaticOrder {
    int nM, nN, nwg, G, c;
    __host__ __device__ void init(int M, int N, int G_, int c_) { nM = M / BM; nN = N / BM; nwg = nM * nN; G = G_; c = c_; }
    __host__ __device__ bool next(int i, Unit& u) const {
        const long L = (long)i * G + c; if (L >= nwg) return false;
        int wgid = (int)L; { const int q = nwg / NXCD, r = nwg % NXCD, xcd = wgid % NXCD, off = wgid / NXCD; wgid = (xcd < r ? xcd * (q + 1) : r * (q + 1) + (xcd - r) * q) + off; }
        const int nig = WGM * nN, gid = wgid / nig, fm = gid * WGM, gsz = (nM - fm) < WGM ? (nM - fm) : WGM;
        u.pm = fm + ((wgid % nig) % gsz); u.pn = (wgid % nig) / gsz; return true;
    }
};
template <class Epi, class Sched, bool ALIGN_EPI = false, bool SP2 = false>
__device__ __forceinline__ void gemm_phase(PG8_LAS unsigned char* lds, const Gemm g, const Sched& S, const Epi& E) {
    const int tid = otid(), wid = __builtin_amdgcn_readfirstlane(tid >> 6), lane = tid & 63, wr = wid >> 2, wc = wid & 3, fr = lane & 15, fq = lane >> 4;
    const int K = g.K, nt = K / BK;
    unsigned voffA[2], voffB[2];
#pragma unroll
    for (int i = 0; i < 2; ++i) { int R, C; stage_rc(tid * 16 + i * 8192, R, C); const int Rb = Epi::PERM ? ((R & ~31) + perm32(R & 31)) : R;
        voffA[i] = (unsigned)(R * g.lda + C) * 2u; voffB[i] = (unsigned)(Rb * K + C) * 2u; }
    const size_t kstep = (size_t)(BK * 2);
    const size_t abig = g.abig * 2;
    const size_t hstepA = (size_t)HALF * g.lda * 2, hstepB = (size_t)HALF * K * 2;
    const size_t tstepA = 2 * hstepA, tstepB = 2 * hstepB;
    const unsigned ldsw = (unsigned)wid * 1024u;
    const int aoff = lds_byte(wr * 64 + fr, fq * 8), boff = lds_byte(wc * 32 + fr, fq * 8);
#define PG8_SA(b, h) (((b) * 2 + (h)) * HTB)
#define PG8_SB(b, h) ((4 + (b) * 2 + (h)) * HTB)
#define PG8_STAGE(bufoff, gbase, voff) do { _Pragma("unroll") for (int _i = 0; _i < 2; ++_i) \
        __builtin_amdgcn_global_load_lds((const unsigned*)((const char*)(gbase) + (voff)[_i]), (PG8_LAS unsigned*)(lds + (bufoff) + ldsw + _i * 8192), 16, 0, 0); } while (0)
#define PG8_LDA(dst, b, h) do { _Pragma("unroll") for (int m = 0; m < 4; ++m) _Pragma("unroll") for (int k = 0; k < 2; ++k) dst[m][k] = *(const PG8_LAS bf16x8*)(lds + PG8_SA(b, h) + aoff + m * 2048 + k * 1024); } while (0)
#define PG8_LDB(dst, b, h) do { _Pragma("unroll") for (int n = 0; n < 2; ++n) _Pragma("unroll") for (int k = 0; k < 2; ++k) dst[n][k] = *(const PG8_LAS bf16x8*)(lds + PG8_SB(b, h) + boff + n * 2048 + k * 1024); } while (0)
#define PG8_MMA(ai, bj, At, Bt) do { __builtin_amdgcn_s_setprio(1); _Pragma("unroll") for (int m = 0; m < 4; ++m) _Pragma("unroll") for (int n = 0; n < 2; ++n) _Pragma("unroll") for (int k = 0; k < 2; ++k) \
        acc[ai][bj][m][n] = __builtin_amdgcn_mfma_f32_16x16x32_bf16(Bt[n][k], At[m][k], acc[ai][bj][m][n], 0, 0, 0); __builtin_amdgcn_s_setprio(0); } while (0)
#define PG8_WAIT_V(n) asm volatile("s_waitcnt vmcnt(" #n ")" ::: "memory")
#define PG8_WAIT_L(n) asm volatile("s_waitcnt lgkmcnt(" #n ")" ::: "memory")
#define PG8_BAR __builtin_amdgcn_s_barrier()
#define PG8_SCHED __builtin_amdgcn_sched_barrier(0)
    Unit cur, nxt; int ui = 0;
    if (!S.next(0, cur)) return;
    f32x4 acc[2][2][4][2];
#pragma unroll
    for (int a = 0; a < 2; ++a)
#pragma unroll
        for (int b = 0; b < 2; ++b)
#pragma unroll
            for (int m = 0; m < 4; ++m)
#pragma unroll
                for (int n = 0; n < 2; ++n) acc[a][b][m][n] = (f32x4){0.f, 0.f, 0.f, 0.f};
    bf16x8 At[4][2], B0[2][2], B1[2][2];
    const char* cA = (const char*)g.A + (size_t)cur.pm * tstepA; const char* cB = (const char*)g.Bt + (size_t)cur.pn * tstepB;
    if constexpr (SP2) {
        PG8_STAGE(PG8_SB(0, 0), cB, voffB); PG8_STAGE(PG8_SB(0, 1), cB + hstepB, voffB); PG8_STAGE(PG8_SA(0, 0), cA, voffA); PG8_STAGE(PG8_SA(0, 1), cA + hstepA, voffA);
        if (wr == 1) PG8_BAR;
        PG8_WAIT_V(2); PG8_BAR;
        PG8_STAGE(PG8_SB(1, 0), cB + kstep, voffB); PG8_STAGE(PG8_SA(1, 0), cA + kstep, voffA); PG8_STAGE(PG8_SB(1, 1), cB + hstepB + kstep, voffB);
        PG8_WAIT_V(6); PG8_BAR;
    } else {
        PG8_STAGE(PG8_SB(0, 0), cB, voffB); PG8_STAGE(PG8_SA(0, 0), cA, voffA); PG8_STAGE(PG8_SB(0, 1), cB + hstepB, voffB); PG8_STAGE(PG8_SA(0, 1), cA + hstepA, voffA);
        if (wr == 1) PG8_BAR;
        PG8_WAIT_V(4); PG8_BAR;
        PG8_STAGE(PG8_SB(1, 0), cB + kstep, voffB); PG8_STAGE(PG8_SA(1, 0), cA + kstep, voffA); PG8_STAGE(PG8_SB(1, 1), cB + hstepB + kstep, voffB);
        PG8_WAIT_V(6); PG8_BAR;
    }
    for (;;) {
        const bool has_next = S.next(ui + 1, nxt);
        const char* nA = has_next ? (const char*)g.A + (size_t)nxt.pm * tstepA : cA; const char* nB = has_next ? (const char*)g.Bt + (size_t)nxt.pn * tstepB : cB;
        for (int t = 0; t < nt; t += 2) {
            const bool last = (t == nt - 2);
            const char* a1 = cA + (size_t)(t >> 1) * abig + kstep;
            const char* a2 = last ? nA : cA + (size_t)((t >> 1) + 1) * abig; const char* b2 = last ? nB : cB + (size_t)(t + 2) * kstep;
            const char* a3 = a2 + kstep; const char* b3 = b2 + kstep;
            if constexpr (SP2) {
            PG8_LDB(B0, 0, 0); PG8_LDB(B1, 0, 1); PG8_SCHED; PG8_LDA(At, 0, 0); PG8_STAGE(PG8_SA(1, 1), a1 + hstepA, voffA);
            PG8_WAIT_V(8); PG8_WAIT_L(0); PG8_BAR; PG8_MMA(0, 0, At, B0); PG8_MMA(0, 1, At, B1); PG8_BAR; PG8_SCHED;
            PG8_LDA(At, 0, 1); PG8_STAGE(PG8_SB(0, 0), b2, voffB); PG8_STAGE(PG8_SB(0, 1), b2 + hstepB, voffB); PG8_STAGE(PG8_SA(0, 0), a2, voffA);
            PG8_WAIT_V(8); PG8_WAIT_L(0); PG8_BAR; PG8_MMA(1, 0, At, B0); PG8_MMA(1, 1, At, B1); PG8_BAR; PG8_SCHED;
            PG8_LDB(B0, 1, 0); PG8_LDB(B1, 1, 1); PG8_SCHED; PG8_LDA(At, 1, 0); PG8_STAGE(PG8_SA(0, 1), a2 + hstepA, voffA);
            PG8_WAIT_V(8); PG8_WAIT_L(0); PG8_BAR; PG8_MMA(0, 0, At, B0); PG8_MMA(0, 1, At, B1); PG8_BAR; PG8_SCHED;
            PG8_LDA(At, 1, 1); PG8_STAGE(PG8_SB(1, 0), b3, voffB); PG8_STAGE(PG8_SB(1, 1), b3 + hstepB, voffB); PG8_STAGE(PG8_SA(1, 0), a3, voffA);
            PG8_WAIT_V(8); PG8_WAIT_L(0); PG8_BAR; PG8_MMA(1, 0, At, B0); PG8_MMA(1, 1, At, B1); PG8_BAR; PG8_SCHED;
            } else {
            PG8_LDB(B0, 0, 0); PG8_SCHED; PG8_LDA(At, 0, 0); PG8_STAGE(PG8_SA(1, 1), a1 + hstepA, voffA);
            PG8_WAIT_L(8); PG8_BAR; PG8_WAIT_L(0); PG8_MMA(0, 0, At, B0); PG8_BAR; PG8_SCHED;
            PG8_LDB(B1, 0, 1); PG8_STAGE(PG8_SB(0, 0), b2, voffB);
            PG8_BAR; PG8_WAIT_L(0); PG8_MMA(0, 1, At, B1); PG8_BAR;
            PG8_LDA(At, 0, 1); PG8_STAGE(PG8_SA(0, 0), a2, voffA);
            PG8_BAR; PG8_WAIT_L(0); PG8_MMA(1, 0, At, B0); PG8_BAR; PG8_SCHED;
            PG8_STAGE(PG8_SB(0, 1), b2 + hstepB, voffB);
            PG8_WAIT_V(6); PG8_BAR; PG8_MMA(1, 1, At, B1); PG8_BAR;
            PG8_LDB(B0, 1, 0); PG8_SCHED; PG8_LDA(At, 1, 0); PG8_STAGE(PG8_SA(0, 1), a2 + hstepA, voffA);
            PG8_WAIT_L(8); PG8_BAR; PG8_WAIT_L(0); PG8_MMA(0, 0, At, B0); PG8_BAR; PG8_SCHED;
            PG8_LDB(B1, 1, 1); PG8_STAGE(PG8_SB(1, 0), b3, voffB);
            PG8_BAR; PG8_WAIT_L(0); PG8_MMA(0, 1, At, B1); PG8_BAR;
            PG8_LDA(At, 1, 1); PG8_STAGE(PG8_SA(1, 0), a3, voffA);
            PG8_BAR; PG8_WAIT_L(0); PG8_MMA(1, 0, At, B0); PG8_BAR; PG8_SCHED;
            PG8_STAGE(PG8_SB(1, 1), b3 + hstepB, voffB);
            PG8_WAIT_V(6); PG8_BAR; PG8_MMA(1, 1, At, B1); PG8_BAR;
            }
        }
        if constexpr (ALIGN_EPI) { if (wr == 0) PG8_BAR; }
        E(acc, cur, wr, wc, fr, fq);
        if (!has_next) break;
#pragma unroll
        for (int a = 0; a < 2; ++a)
#pragma unroll
            for (int b = 0; b < 2; ++b)
#pragma unroll
                for (int m = 0; m < 4; ++m)
#pragma unroll
                    for (int n = 0; n < 2; ++n) acc[a][b][m][n] = (f32x4){0.f, 0.f, 0.f, 0.f};
        cur = nxt; cA = nA; cB = nB; ++ui;
        if constexpr (ALIGN_EPI) { if (wr == 1) PG8_BAR; }
    }
    PG8_WAIT_V(0);
    if constexpr (!ALIGN_EPI) { if (wr == 0) PG8_BAR; }
    PG8_BAR;
#undef PG8_SA
#undef PG8_SB
#undef PG8_STAGE
#undef PG8_LDA
#undef PG8_LDB
#undef PG8_MMA
#undef PG8_WAIT_V
#undef PG8_WAIT_L
#undef PG8_BAR
#undef PG8_SCHED
}
struct EpiProj {
    static constexpr bool PERM = true;
    bf16_t* P; const float* rowscale; float* dtbuf;
    __device__ __forceinline__ void operator()(const f32x4 (&acc)[2][2][4][2], const Unit& u, int wr, int wc, int fr, int fq) const {
        const int row0 = u.pm * BM + wr * 64 + fr; const int col = wc * 32 + 8 * fq;
#pragma unroll
        for (int ai = 0; ai < 2; ++ai)
#pragma unroll
            for (int m = 0; m < 4; ++m) { const int row = row0 + ai * HALF + m * 16; const float sc = rowscale[row];
#pragma unroll
                for (int bj = 0; bj < 2; ++bj) { const int blk = u.pn * 2 + bj;
                    const f32x4 v0 = acc[ai][bj][m][0] * sc, v1 = acc[ai][bj][m][1] * sc;
                    u32x4 w; w.x = pk2(v0[0], v0[1]); w.y = pk2(v0[2], v0[3]); w.z = pk2(v1[0], v1[1]); w.w = pk2(v1[2], v1[3]);
                    *(u32x4*)(P + (size_t)blk * PBLK_ELEMS + (size_t)row * 128 + col) = w;
                    if (blk == PB_DT && col < 16) { float* d = dtbuf + (size_t)row * 16 + col; *(f32x4*)d = v0; *(f32x4*)(d + 4) = v1; } } }
    }
};
struct EpiMix {
    static constexpr bool PERM = true;
    float* O;
    __device__ __forceinline__ void operator()(const f32x4 (&acc)[2][2][4][2], const Unit& u, int wr, int wc, int fr, int fq) const {
        const int row0 = u.pm * BM + wr * 64 + fr; const int col0 = u.pn * BM + wc * 32 + 8 * fq;
#pragma unroll
        for (int ai = 0; ai < 2; ++ai)
#pragma unroll
            for (int m = 0; m < 4; ++m) { float* rp = O + (size_t)(row0 + ai * HALF + m * 16) * DMODEL + col0;
#pragma unroll
                for (int bj = 0; bj < 2; ++bj) { *(f32x4*)(rp + bj * HALF) = acc[ai][bj][m][0]; *(f32x4*)(rp + bj * HALF + 4) = acc[ai][bj][m][1]; } }
    }
};
}

__device__ __forceinline__ int orig_col(int n) {
    if (n < 512) return n;
    if (n < 1024) return 3216 + (n - 512);
    if (n < 1536) return 3728 + (n - 1024);
    if (n < 2048) return 5776 + (n - 1536);
    if (n < 3072) return 512 + (n - 2048);
    if (n < 4736) return 1552 + (n - 3072);
    if (n < 5248) return 4240 + (n - 4736);
    if (n < 5760) return 4752 + (n - 5248);
    if (n < 6272) return 5264 + (n - 5760);
    if (n < 6528) return 6288 + (n - 6272);
    if (n < 6784) return 6544 + (n - 6528);
    if (n < 7296) return 6800 + (n - 6784);
    if (n < 7312) return 1536 + (n - 7296);
    return -1;
}
struct TrItem { const float* W; const float* ks; bf16_t* WT; int K, Nsrc, k0, n0; bool mapcol; };
__device__ __forceinline__ TrItem tr_item(const Params& p, int it) {
    constexpr int I_IN = 16 * 29, I_OUT = 32 * 4;
    TrItem t; int r = it; const int l = r / (I_IN + I_OUT); r -= l * (I_IN + I_OUT);
    if (r < I_IN) { t.W = p.in[3] + (size_t)l * DMODEL * DIN_ORIG; t.ks = p.in[1] + l * DMODEL; t.WT = (bf16_t*)(g_scr + SCR_WIN + (size_t)l * 15 * MiB); t.K = DMODEL; t.Nsrc = DIN_ORIG; t.k0 = (r / 29) * 64; t.n0 = (r % 29) * 256; t.mapcol = true; }
    else { r -= I_IN; t.W = p.in[4] + (size_t)l * DMIX * DMODEL; t.ks = nullptr; t.WT = (bf16_t*)(g_scr + SCR_WOUT + (size_t)l * 4 * MiB); t.K = DMIX; t.Nsrc = DMODEL; t.k0 = (r / 4) * 64; t.n0 = (r % 4) * 256; t.mapcol = false; }
    return t;
}
__device__ __forceinline__ void tr_load(const TrItem& t, int tid, float* v) {
    const int nn = tid & 63;
#pragma unroll
    for (int q = 0; q < 4; ++q) { const int n = t.n0 + 64 * q + nn; const int oc = t.mapcol ? orig_col(n) : n;
#pragma unroll
        for (int i = 0; i < 8; ++i) { const int kk = (tid >> 6) + 8 * i; v[q * 8 + i] = (oc >= 0) ? t.W[(size_t)(t.k0 + kk) * t.Nsrc + oc] * (t.ks ? t.ks[t.k0 + kk] : 1.f) : 0.f; } }
}
__device__ __forceinline__ void rope_entry(int idx, float* tab) {
    const int pos = idx >> 5, i = idx & 31;
    const float inv = exp2f(-(float)i * (13.287712379549449f / 32.f));
    const float ang = (float)pos * inv;
    const double rev = (double)ang * 0.15915494309189535; const double fr = rev - floor(rev);
    const float a = (float)(fr * 6.283185307179586);
    tab[idx * 2] = cosf(a); tab[idx * 2 + 1] = sinf(a);
}
__device__ __forceinline__ void xrow_to_bf16(const float* xrow, bf16_t* orow, float* rs, int lane) {
    const f32x4* xr = (const f32x4*)xrow + lane; f32x4 v[4]; float s = 0.f;
#pragma unroll
    for (int j = 0; j < 4; ++j) { v[j] = xr[64 * j]; s += (v[j].x * v[j].x + v[j].y * v[j].y) + (v[j].z * v[j].z + v[j].w * v[j].w); }
    s = wave_sum(s);
    if (lane == 0) *rs = rsqrtf(s * (1.f / DMODEL) + NORM_EPS);
    u32x2* o8 = (u32x2*)orow + lane;
#pragma unroll
    for (int j = 0; j < 4; ++j) { u32x2 w; w.x = pk2(v[j].x, v[j].y); w.y = pk2(v[j].z, v[j].w); o8[64 * j] = w; }
}
__device__ __forceinline__ void phase_prologue(const Params& p, float* lds_f) {
    const int G = gridDim.x, bid = blockIdx.x, tid = otid(), lane = tid & 63, wave = tid >> 6;
    {   constexpr int NIT = 2 * (16 * 29 + 32 * 4);
        float v[32], v2[32]; int it = bid; TrItem cur = tr_item(p, it < NIT ? it : 0);
        if (it < NIT) tr_load(cur, tid, v);
        while (it < NIT) {
            const int nn = tid & 63;
#pragma unroll
            for (int q = 0; q < 4; ++q)
#pragma unroll
                for (int i = 0; i < 8; ++i) lds_f[q * 4160 + ((tid >> 6) + 8 * i) * 65 + nn] = v[q * 8 + i];
            const int nx = it + G; TrItem nxt = tr_item(p, nx < NIT ? nx : 0);
            if (nx < NIT) tr_load(nxt, tid, v2);
            __syncthreads();
#pragma unroll
            for (int q = 0; q < 4; ++q) { const int n = tid >> 3, c = tid & 7; const float* s = lds_f + q * 4160 + (8 * c) * 65 + n;
                u32x4 o; o.x = pk2(s[0], s[65]); o.y = pk2(s[2 * 65], s[3 * 65]); o.z = pk2(s[4 * 65], s[5 * 65]); o.w = pk2(s[6 * 65], s[7 * 65]);
                *(u32x4*)(cur.WT + (size_t)(cur.n0 + 64 * q + n) * cur.K + cur.k0 + 8 * c) = o; }
            __syncthreads();
#pragma unroll
            for (int i = 0; i < 32; ++i) v[i] = v2[i];
            cur = nxt; it = nx;
        }
    }
    if (bid == 0) { ((unsigned*)(g_scr + SCR_CTL))[tid] = 0u; ((unsigned*)(g_scr + SCR_CTL))[512 + tid] = 0u; }
    for (int i = bid * 512 + tid; i < SEQ * 32; i += G * 512) rope_entry(i, (float*)(g_scr + SCR_ROPE));
    for (int m = bid * 8 + wave; m < M_TOK; m += G * 8) xrow_to_bf16(p.in[0] + (size_t)m * DMODEL, (bf16_t*)(g_scr + SCR_XB) + (size_t)m * DMODEL, (float*)(g_scr + SCR_RS) + m, lane);
}

__device__ __forceinline__ void unpack8(const bf16x8 v, float* x) {
#pragma unroll
    for (int e = 0; e < 8; ++e) x[e] = bf2f((bf16_t)v[e]);
}
__device__ __forceinline__ u32x4 pack8(const float* x) { u32x4 o; o.x = pk2(x[0], x[1]); o.y = pk2(x[2], x[3]); o.z = pk2(x[4], x[5]); o.w = pk2(x[6], x[7]); return o; }
__device__ __forceinline__ void rope8(float* x, const float* cs, const bool upper) {
#pragma unroll
    for (int e = 0; e < 8; ++e) { const float o = __shfl_xor(x[e], 4); x[e] = upper ? (x[e] * cs[2 * e] + o * cs[2 * e + 1]) : (x[e] * cs[2 * e] - o * cs[2 * e + 1]); }
}
__device__ __forceinline__ void phase_prep(const Params& p, const int l) {
    const int G = gridDim.x;
    {   const int tid = otid(), lane = tid & 63, wave = tid >> 6;
        bf16x8 cv[5], nv_[5];
#define CONV_LOAD(dst, it_) do { const int m_ = (it_) >> 1, t_ = m_ & (SEQ - 1); const int ch_ = ((it_) & 1) * 512 + lane * 8; const bf16_t* src_ = pblk(p.ws, PB_XS + (ch_ >> 7)) + (ch_ & 127); \
            _Pragma("unroll") for (int jj = 0; jj < 5; ++jj) { const int tt = t_ + jj - 2; const bool ok = tt >= 0 && tt < SEQ; dst[jj] = ok ? *(const bf16x8*)(src_ + ((size_t)(m_ - t_ + tt)) * 128) : (bf16x8){0, 0, 0, 0, 0, 0, 0, 0}; } } while (0)
        int it = blockIdx.x * 8 + wave;
        if (it < M_TOK * 2) CONV_LOAD(cv, it);
        for (; it < M_TOK * 2; it += G * 8) {
            const int m = it >> 1, half = it & 1;
            const int ch = half * 512 + lane * 8;
            const float* cw = p.in[5] + (size_t)l * 5 * 1024 + ch; const float* cb = p.in[6] + (size_t)l * 1024 + ch;
            if (it + G * 8 < M_TOK * 2) CONV_LOAD(nv_, it + G * 8);
            float acc[8]; { const f32x4 b0 = *(const f32x4*)cb, b1 = *(const f32x4*)(cb + 4);
#pragma unroll
              for (int e = 0; e < 4; ++e) { acc[e] = b0[e]; acc[4 + e] = b1[e]; } }
#pragma unroll
            for (int jj = 0; jj < 5; ++jj) { const f32x4 w0 = *(const f32x4*)(cw + jj * 1024), w1 = *(const f32x4*)(cw + jj * 1024 + 4);
#pragma unroll
                for (int e = 0; e < 4; ++e) { acc[e] += w0[e] * bf2f((bf16_t)cv[jj][e]); acc[4 + e] += w1[e] * bf2f((bf16_t)cv[jj][4 + e]); } }
#pragma unroll
            for (int e = 0; e < 8; ++e) acc[e] = siluf(acc[e]);
            *(u32x4*)((bf16_t*)(g_scr + SCR_XACT) + (size_t)m * 1024 + ch) = pack8(acc);
#pragma unroll
            for (int jj = 0; jj < 5; ++jj) cv[jj] = nv_[jj];
        }
#undef CONV_LOAD
    }
    const int tid = otid(), lane = tid & 63, wave = tid >> 6;
    const float* tab = (const float*)(g_scr + SCR_ROPE);
    const int hh = lane >> 4, c16 = lane & 15, j8 = (c16 & 7) * 8, fi = j8 & 31; const bool upper = j8 >= 32, second = c16 >= 8;
    float kw[8];
#pragma unroll
    for (int e = 0; e < 8; ++e) kw[e] = p.in[24][l * 128 + c16 * 8 + e];
    float* kpart = (float*)(g_scr + SCR_KPART); const int gwv = blockIdx.x * 8 + wave;
    float mxd = 0.f, mxg = 0.f; int curb = (blockIdx.x * 8 + wave) >> 13;
    bf16x8 vdk, vgk, ndk, ngk; float cst[16], csa[16], nst[16], nsa[16];
#define QK_LOAD(m_, dk_, gk_, st_, sa_) do { const int t_ = (m_) & (SEQ - 1); const int row_ = t_ >> 6, col_ = t_ & 63; \
        dk_ = *(const bf16x8*)(pblk(p.ws, PB_DK + hh) + (size_t)(m_) * 128 + c16 * 8); gk_ = *(const bf16x8*)(pblk(p.ws, PB_GK + (hh & 1)) + (size_t)(m_) * 128 + c16 * 8); \
        const f32x4* a_ = (const f32x4*)(tab + ((size_t)t_ * 32 + fi) * 2); const f32x4* b_ = (const f32x4*)(tab + ((size_t)(second ? col_ : row_) * 32 + fi) * 2); \
        _Pragma("unroll") for (int i_ = 0; i_ < 4; ++i_) { const f32x4 u_ = a_[i_], v_ = b_[i_]; _Pragma("unroll") for (int e_ = 0; e_ < 4; ++e_) { st_[4 * i_ + e_] = u_[e_]; sa_[4 * i_ + e_] = v_[e_]; } } } while (0)
    {   const int m0 = blockIdx.x * 8 + wave; if (m0 < M_TOK) QK_LOAD(m0, vdk, vgk, cst, csa); }
    for (int m = blockIdx.x * 8 + wave; m < M_TOK; m += G * 8) {
        if ((m >> 13) != curb) {
            if ((lane & 7) == 0) { kpart[((size_t)(l * 2 + curb) * 10 + hh * 2 + (c16 >> 3)) * 2048 + gwv] = mxd; if (lane < 32 && c16 == 0) kpart[((size_t)(l * 2 + curb) * 10 + 8 + hh) * 2048 + gwv] = mxg; }
            mxd = 0.f; mxg = 0.f; curb = m >> 13; }
        bf16_t* pdk = pblk(p.ws, PB_DK + hh) + (size_t)m * 128 + c16 * 8; bf16_t* pgk = pblk(p.ws, PB_GK + (hh & 1)) + (size_t)m * 128 + c16 * 8;
        if (m + G * 8 < M_TOK) QK_LOAD(m + G * 8, ndk, ngk, nst, nsa);
        float x[8];
        unpack8(vdk, x);
        { float s2 = 0.f;
#pragma unroll
          for (int e = 0; e < 8; ++e) s2 += x[e] * x[e];
          s2 += __shfl_xor(s2, 1); s2 += __shfl_xor(s2, 2); s2 += __shfl_xor(s2, 4); mxd = fmaxf(mxd, s2); }
        rope8(x, cst, upper); const u32x4 odk = pack8(x);
        float ss;
        unpack8(vgk, x); ss = 0.f;
#pragma unroll
        for (int e = 0; e < 8; ++e) ss += x[e] * x[e];
        ss += __shfl_xor(ss, 1); ss += __shfl_xor(ss, 2); ss += __shfl_xor(ss, 4); ss += __shfl_xor(ss, 8);
        { const float rs = rsqrtf(ss * (1.f / 128.f) + NORM_EPS);
#pragma unroll
          for (int e = 0; e < 8; ++e) x[e] *= rs * kw[e]; }
        { float s2 = 0.f;
#pragma unroll
          for (int e = 0; e < 8; ++e) s2 += x[e] * x[e];
          s2 += __shfl_xor(s2, 1); s2 += __shfl_xor(s2, 2); s2 += __shfl_xor(s2, 4); s2 += __shfl_xor(s2, 8); mxg = fmaxf(mxg, s2); }
        rope8(x, csa, upper); const u32x4 ogk = pack8(x);
        *(u32x4*)pdk = odk; if (lane < 32) *(u32x4*)pgk = ogk;
        vdk = ndk; vgk = ngk;
#pragma unroll
        for (int e = 0; e < 16; ++e) { cst[e] = nst[e]; csa[e] = nsa[e]; }
    }
#undef QK_LOAD
    if ((lane & 7) == 0) { kpart[((size_t)(l * 2 + curb) * 10 + hh * 2 + (c16 >> 3)) * 2048 + gwv] = mxd; if (lane < 32 && c16 == 0) kpart[((size_t)(l * 2 + curb) * 10 + 8 + hh) * 2048 + gwv] = mxg; }
}

__device__ __forceinline__ void kmax_reduce(const int l, float* lds_f) {
    if (blockIdx.x < 20) {
        const int b = blockIdx.x / 10, slot = blockIdx.x % 10, tid = threadIdx.x;
        const float* src = (const float*)(g_scr + SCR_KPART) + ((size_t)(l * 2 + b) * 10 + slot) * 2048;
        float v = fmaxf(fmaxf(src[tid], src[512 + tid]), fmaxf(src[1024 + tid], src[1536 + tid]));
#pragma unroll
        for (int o = 1; o < 64; o <<= 1) v = fmaxf(v, __shfl_xor(v, o));
        if ((tid & 63) == 0) lds_f[tid >> 6] = v;
        __syncthreads();
        if (tid == 0) { float m = lds_f[0];
#pragma unroll
            for (int i = 1; i < 8; ++i) m = fmaxf(m, lds_f[i]);
            ((float*)(g_scr + SCR_CTL))[256 + 64 * l + (slot < 8 ? b * 8 + slot : 16 + b * 2 + (slot - 8))] = m; }
        __syncthreads();
    }
}

namespace att {
using s16x4 = __attribute__((ext_vector_type(4))) short;
using f32x16 = __attribute__((ext_vector_type(16))) float;
constexpr int D = 128, NW = 8, QBLK = 32, KVBLK = 64, LD = 128;
constexpr float THR = 8.f;
constexpr size_t SHM_V = KVBLK * D * 2, SHM_K = KVBLK * D * 2, SHM_ATTN = 2 * SHM_V + 2 * SHM_K + NW * 64 * 4;
#define KSWZ(row, colB) ((row) * 256 + ((colB) ^ (((row) & 7) << 4)))
#define SBAR() __builtin_amdgcn_sched_barrier(0)
__device__ __forceinline__ int crow(int r, int hi) { return (r & 3) + 8 * (r >> 2) + 4 * hi; }
__device__ __forceinline__ unsigned cvtpk(float lo, float hi) { unsigned r; asm volatile("v_cvt_pk_bf16_f32 %0, %1, %2" : "=v"(r) : "v"(lo), "v"(hi)); return r; }
__device__ __forceinline__ void glds16(const void* gsrc, unsigned lds_dst) { unsigned keep;
  asm volatile("s_mov_b32 %0, m0\n\ts_mov_b32 m0, %2\n\ts_nop 0\n\tglobal_load_lds_dwordx4 %1, off\n\ts_mov_b32 m0, %0" : "=&s"(keep) : "v"(gsrc), "s"(lds_dst) : "memory"); }
template <int DIFF>
__device__ __forceinline__ void partialSM(f32x16& p0, f32x16& p1, const float mnC) {
  constexpr float SCALE = DIFF ? 0.125f : 0.088388347648318440f;
  constexpr float C = SCALE * 1.4426950408889634f;
  _Pragma("unroll") for (int r = 0; r < 16; ++r) p0[r] = fmaf(p0[r], C, mnC); _Pragma("unroll") for (int r = 0; r < 16; ++r) p1[r] = fmaf(p1[r], C, mnC);
  _Pragma("unroll") for (int r = 0; r < 16; ++r) p0[r] = __builtin_amdgcn_exp2f(p0[r]);
}
__device__ __forceinline__ void finishSM(f32x16& p0, f32x16& p1, float& l_reg, bf16x8& pa0, bf16x8& pa1, bf16x8& pa2, bf16x8& pa3) {
  _Pragma("unroll") for (int r = 0; r < 16; ++r) p1[r] = __builtin_amdgcn_exp2f(p1[r]);
  float ps = 0; _Pragma("unroll") for (int r = 0; r < 16; ++r) ps += p0[r]; _Pragma("unroll") for (int r = 0; r < 16; ++r) ps += p1[r];
  { auto rr = __builtin_amdgcn_permlane32_swap(__float_as_uint(ps), __float_as_uint(ps), false, false);
    ps = __uint_as_float(rr[0]) + __uint_as_float(rr[1]); }
  l_reg += ps;
#define PK4(P, BASE, OUT) do { unsigned a0 = cvtpk(P[BASE + 0], P[BASE + 1]), a1 = cvtpk(P[BASE + 2], P[BASE + 3]);   \
    unsigned b0 = cvtpk(P[BASE + 4], P[BASE + 5]), b1 = cvtpk(P[BASE + 6], P[BASE + 7]);                              \
    auto r0 = __builtin_amdgcn_permlane32_swap(a0, b0, false, false); auto r1 = __builtin_amdgcn_permlane32_swap(a1, b1, false, false); \
    u32x4 w = {r0[0], r1[0], r0[1], r1[1]}; OUT = *reinterpret_cast<bf16x8*>(&w); } while (0)
  PK4(p0, 0, pa0); PK4(p0, 8, pa1); PK4(p1, 0, pa2); PK4(p1, 8, pa3);
#undef PK4
}
template <int ND0>
__device__ __forceinline__ void qkt(f32x16& p0, f32x16& p1, const bf16_t* Ks, const bf16x8* qr, int r32, int hi, int db0) {
  p0 = f32x16{}; p1 = f32x16{};
  _Pragma("unroll") for (int d0 = 0; d0 < ND0; ++d0) { int cb = ((db0 + d0) * 16 + hi * 8) * 2;
    bf16x8 b0 = *reinterpret_cast<const bf16x8*>((const char*)Ks + KSWZ(r32, cb));
    bf16x8 b1 = *reinterpret_cast<const bf16x8*>((const char*)Ks + KSWZ(32 + r32, cb));
    p0 = __builtin_amdgcn_mfma_f32_32x32x16_bf16(b0, qr[d0], p0, 0, 0, 0);
    p1 = __builtin_amdgcn_mfma_f32_32x32x16_bf16(b1, qr[d0], p1, 0, 0, 0); }
}
__device__ __forceinline__ int v_st(int k, int c) { const int kk = (k & ~0xC) | ((k & 4) << 1) | ((k & 8) >> 1); return ((kk >> 3) * 4 + (c >> 5)) * 512 + ((kk & 7) * 32 + (c & 31)) * 2; }
__device__ __forceinline__ int v_rd_base(int lane) { return ((lane & 3) << 3) | (((lane >> 2) & 3) << 6) | (((lane >> 4) & 1) << 5) | (((lane >> 5) & 1) << 8); }
constexpr int v_rd_off(int d0, int ks, int half) { return d0 * 512 + ks * 4096 + half * 2048; }
template <int OFF> __device__ __forceinline__ s16x4 tr_read(int vb) {
  s16x4 r; asm volatile("ds_read_b64_tr_b16 %0, %1 offset:%2" : "=&v"(r) : "v"(vb), "i"(OFF) : "memory"); return r;
}
template <int D0> __device__ __forceinline__ void pv_one(f32x16& od, int vb, bf16x8 pa0, bf16x8 pa1, bf16x8 pa2, bf16x8 pa3) {
  const s16x4 l0 = tr_read<v_rd_off(D0, 0, 0)>(vb), h0 = tr_read<v_rd_off(D0, 0, 1)>(vb), l1 = tr_read<v_rd_off(D0, 1, 0)>(vb), h1 = tr_read<v_rd_off(D0, 1, 1)>(vb);
  const s16x4 l2 = tr_read<v_rd_off(D0, 2, 0)>(vb), h2 = tr_read<v_rd_off(D0, 2, 1)>(vb), l3 = tr_read<v_rd_off(D0, 3, 0)>(vb), h3 = tr_read<v_rd_off(D0, 3, 1)>(vb);
  asm volatile("s_waitcnt lgkmcnt(0)" ::: "memory"); SBAR();
#define PK(L, H) (bf16x8){L[0], L[1], L[2], L[3], H[0], H[1], H[2], H[3]}
  od = __builtin_amdgcn_mfma_f32_32x32x16_bf16(pa0, PK(l0, h0), od, 0, 0, 0);
  od = __builtin_amdgcn_mfma_f32_32x32x16_bf16(pa1, PK(l1, h1), od, 0, 0, 0);
  od = __builtin_amdgcn_mfma_f32_32x32x16_bf16(pa2, PK(l2, h2), od, 0, 0, 0);
  od = __builtin_amdgcn_mfma_f32_32x32x16_bf16(pa3, PK(l3, h3), od, 0, 0, 0);
#undef PK
}
__device__ __forceinline__ void pv_d0(f32x16* o, int vb, bf16x8 pa0, bf16x8 pa1, bf16x8 pa2, bf16x8 pa3) {
  pv_one<0>(o[0], vb, pa0, pa1, pa2, pa3); pv_one<1>(o[1], vb, pa0, pa1, pa2, pa3); pv_one<2>(o[2], vb, pa0, pa1, pa2, pa3); pv_one<3>(o[3], vb, pa0, pa1, pa2, pa3);
}
template <int DIFF>
__device__ __forceinline__ void attn_unit(const bf16_t* Qb, const bf16_t* __restrict__ Kh, const bf16_t* __restrict__ Vh, bf16_t* Ob, const bf16_t* gate,
                                          int seq, char* lds, const float* lamp, int layer, const float* nw, const float* kmax2p, const int tpos0, const float* qnw, unsigned* splc = nullptr, float* splp = nullptr) {
  constexpr int ND0 = DIFF ? 4 : 8;
  const int tid = otid(), wid = tid >> 6, lane = tid & 63, r32 = lane & 31, hi = lane >> 5;
  const int wq = DIFF ? (wid & 3) : wid, mapc = DIFF ? (wid >> 2) : 0;
  constexpr int RSTG = 32768, RK = 16384, E_ST = 67584, E_WS = 137216;
  float* li_l = (float*)(lds + E_WS) + wid * 64;
  float l_reg = 0; f32x16 o[4] = {}; bf16x8 qr[ND0];
  const bf16_t* Qw = Qb + (long)(wq * QBLK + r32) * LD + mapc * 64 + hi * 8;
  {
      const float* tab = (const float*)(g_scr + SCR_ROPE);
      const int trow = tpos0 + wq * QBLK + r32;
      float qf[ND0][8];
      _Pragma("unroll") for (int d0 = 0; d0 < ND0; ++d0) { const bf16x8 raw = *reinterpret_cast<const bf16x8*>(Qw + d0 * 16); _Pragma("unroll") for (int e = 0; e < 8; ++e) qf[d0][e] = bf2f((bf16_t)raw[e]); }
      if constexpr (!DIFF) {
        float ss = 0.f;
        _Pragma("unroll") for (int d0 = 0; d0 < ND0; ++d0) _Pragma("unroll") for (int e = 0; e < 8; ++e) ss += qf[d0][e] * qf[d0][e];
        { auto rr = __builtin_amdgcn_permlane32_swap(__float_as_uint(ss), __float_as_uint(ss), false, false); ss = __uint_as_float(rr[0]) + __uint_as_float(rr[1]); }
        const float rs = rsqrtf(ss * (1.f / 128.f) + NORM_EPS);
        _Pragma("unroll") for (int d0 = 0; d0 < ND0; ++d0) { const f32x4 w0 = *(const f32x4*)(qnw + d0 * 16 + hi * 8), w1 = *(const f32x4*)(qnw + d0 * 16 + hi * 8 + 4);
          _Pragma("unroll") for (int e = 0; e < 4; ++e) { qf[d0][e] *= rs * w0[e]; qf[d0][4 + e] *= rs * w1[e]; } }
      }
      _Pragma("unroll") for (int hb = 0; hb < ND0 / 4; ++hb) {
        const int pos = DIFF ? trow : (hb == 0 ? (trow >> 6) : (trow & 63));
        _Pragma("unroll") for (int dl = 0; dl < 2; ++dl) { const int d0 = hb * 4 + dl; const float* cp = tab + ((size_t)pos * 32 + dl * 16 + hi * 8) * 2; float cs[16];
          _Pragma("unroll") for (int i = 0; i < 4; ++i) { const f32x4 u_ = ((const f32x4*)cp)[i]; _Pragma("unroll") for (int e = 0; e < 4; ++e) cs[4 * i + e] = u_[e]; }
          _Pragma("unroll") for (int e = 0; e < 8; ++e) { const float x1 = qf[d0][e], x2 = qf[d0 + 2][e]; qf[d0][e] = x1 * cs[2 * e] - x2 * cs[2 * e + 1]; qf[d0 + 2][e] = x2 * cs[2 * e] + x1 * cs[2 * e + 1]; } } }
      _Pragma("unroll") for (int d0 = 0; d0 < ND0; ++d0) { u32x4 w_; w_.x = pk2(qf[d0][0], qf[d0][1]); w_.y = pk2(qf[d0][2], qf[d0][3]); w_.z = pk2(qf[d0][4], qf[d0][5]); w_.w = pk2(qf[d0][6], qf[d0][7]); qr[d0] = *reinterpret_cast<bf16x8*>(&w_); }
  }
  float mnC;
  { float qn2 = 0.f;
    _Pragma("unroll") for (int d0 = 0; d0 < ND0; ++d0) _Pragma("unroll") for (int e = 0; e < 8; ++e) { const float q = bf2f((bf16_t)qr[d0][e]); qn2 += q * q; }
    { auto rr = __builtin_amdgcn_permlane32_swap(__float_as_uint(qn2), __float_as_uint(qn2), false, false); qn2 = __uint_as_float(rr[0]) + __uint_as_float(rr[1]); }
    const float km2 = kmax2p[DIFF ? mapc : 0];
    mnC = -(sqrtf(qn2 * km2) * 1.02f + 1e-3f) * ((DIFF ? 0.125f : 0.088388347648318440f) * 1.4426950408889634f); }
  unsigned ksrc[2], vsrc[2];
  _Pragma("unroll") for (int i = 0; i < 2; ++i) { const int pc = 2 * wid + i;
    { const int row = 4 * pc + (lane >> 4); ksrc[i] = (unsigned)(row * 256 + (((lane & 15) ^ (row & 7)) << 4)); }
    { const int st = 2 * pc + (lane >> 5), l5 = lane & 31, kk = (st >> 2) * 8 + (l5 >> 2), k = (kk & ~0xC) | ((kk & 4) << 1) | ((kk & 8) >> 1); vsrc[i] = (unsigned)(k * 256 + ((st & 3) * 32 + (l5 & 3) * 8) * 2); } }
  const unsigned ldsb = (unsigned)(uintptr_t)lds + (unsigned)__builtin_amdgcn_readfirstlane(wid) * 2048u;
  const int vb0 = (int)(uintptr_t)lds + v_rd_base(lane);
#define DMA(k0, so) do { const char* kt_ = (const char*)Kh + (size_t)(k0) * 256; const char* vt_ = (const char*)Vh + (size_t)(k0) * 256; const unsigned d_ = ldsb + (unsigned)(so); \
    glds16(vt_ + vsrc[0], (unsigned)__builtin_amdgcn_readfirstlane(d_)); glds16(vt_ + vsrc[1], (unsigned)__builtin_amdgcn_readfirstlane(d_ + 1024u)); \
    glds16(kt_ + ksrc[0], (unsigned)__builtin_amdgcn_readfirstlane(d_ + (unsigned)RK)); glds16(kt_ + ksrc[1], (unsigned)__builtin_amdgcn_readfirstlane(d_ + (unsigned)RK + 1024u)); } while (0)
#define DWAIT() asm volatile("s_waitcnt vmcnt(0)" ::: "memory")
  f32x16 p0, p1; bf16x8 pa0, pa1, pa2, pa3; int NT = seq / KVBLK; asm volatile("" : "+s"(NT));
  const bool odd = __builtin_amdgcn_readfirstlane(wid) >= 4;
  int kad[4];
  _Pragma("unroll") for (int i = 0; i < 4; ++i) kad[i] = (int)(uintptr_t)lds + RK + KSWZ(r32, ((mapc * 4 + i) * 16 + hi * 8) * 2);
#define BAR() do { SBAR(); __builtin_amdgcn_s_barrier(); SBAR(); } while (0)
#define LWAIT4(N, A, B, C, Dd) asm volatile("s_waitcnt lgkmcnt(%4)" : "+v"(A), "+v"(B), "+v"(C), "+v"(Dd) : "n"(N))
#define LWAIT2(N, A, B) asm volatile("s_waitcnt lgkmcnt(%2)" : "+v"(A), "+v"(B) : "n"(N))
#define PK(L, H) (bf16x8){L[0], L[1], L[2], L[3], H[0], H[1], H[2], H[3]}
#define VRD(N, D0, KP, VB) N##a = tr_read<v_rd_off(D0, 2 * KP, 0)>(VB); N##b = tr_read<v_rd_off(D0, 2 * KP, 1)>(VB); N##c = tr_read<v_rd_off(D0, 2 * KP + 1, 0)>(VB); N##d = tr_read<v_rd_off(D0, 2 * KP + 1, 1)>(VB)
#define VDECL(N) s16x4 N##a, N##b, N##c, N##d
#define VMM(N, D0, PA, PB, W) LWAIT4(W, N##a, N##b, N##c, N##d); o[D0] = __builtin_amdgcn_mfma_f32_32x32x16_bf16(PA, PK(N##a, N##b), o[D0], 0, 0, 0); o[D0] = __builtin_amdgcn_mfma_f32_32x32x16_bf16(PB, PK(N##c, N##d), o[D0], 0, 0, 0); SBAR()
#define KRD(N, DS) bf16x8 N##a, N##b; asm volatile("ds_read_b128 %0, %1 offset:%2" : "=&v"(N##a) : "v"(ka[(DS) & 3]), "i"(((DS) >> 2) * 128) : "memory"); asm volatile("ds_read_b128 %0, %1 offset:%2" : "=&v"(N##b) : "v"(ka[(DS) & 3]), "i"(((DS) >> 2) * 128 + 8192) : "memory")
#define KMM0(N, DS, W) LWAIT2(W, N##a, N##b); p0 = __builtin_amdgcn_mfma_f32_32x32x16_bf16(N##a, qr[DS], f32x16{}, 0, 0, 0); p1 = __builtin_amdgcn_mfma_f32_32x32x16_bf16(N##b, qr[DS], f32x16{}, 0, 0, 0); SBAR()
#define KMM(N, DS, W) LWAIT2(W, N##a, N##b); p0 = __builtin_amdgcn_mfma_f32_32x32x16_bf16(N##a, qr[DS], p0, 0, 0, 0); p1 = __builtin_amdgcn_mfma_f32_32x32x16_bf16(N##b, qr[DS], p1, 0, 0, 0); SBAR()
  VDECL(g0); VDECL(g1); VDECL(g2);
#define PREISSUE(SO) do { const int vb_ = vb0 + (SO); VRD(g0, 0, 0, vb_); VRD(g1, 0, 1, vb_); VRD(g2, 1, 0, vb_); } while (0)
  DMA(0, 0); DMA(KVBLK, RSTG); DMA(2 * KVBLK, 2 * RSTG);
  asm volatile("s_waitcnt vmcnt(8)" ::: "memory"); BAR();
  if (odd) BAR();
  qkt<ND0>(p0, p1, (const bf16_t*)(lds + RK), qr, r32, hi, mapc * 4);
  asm volatile("s_waitcnt vmcnt(4)" ::: "memory"); SBAR(); BAR();
  partialSM<DIFF>(p0, p1, mnC); finishSM(p0, p1, l_reg, pa0, pa1, pa2, pa3); SBAR();
  PREISSUE(0); BAR();
  _Pragma("unroll 1") for (int j = 0; j + 1 < NT; ++j) {
    const int sV = (j & 3) * RSTG, sK = ((j + 1) & 3) * RSTG, sD = ((j + 3) & 3) * RSTG;
    const bool dma = j + 3 < NT;
    if (dma) DMA((j + 3) * KVBLK, sD);
    SBAR();
    { const int vb = vb0 + sV; int ka[4];
      _Pragma("unroll") for (int i = 0; i < 4; ++i) ka[i] = kad[i] + sK;
      VDECL(g3); VDECL(g4); VDECL(g5); VDECL(g6); VDECL(g7);
      VRD(g3, 1, 1, vb); VMM(g0, 0, pa0, pa1, 12);
      VRD(g4, 2, 0, vb); VMM(g1, 0, pa2, pa3, 12);
      VRD(g5, 2, 1, vb); VMM(g2, 1, pa0, pa1, 12);
      VRD(g6, 3, 0, vb); VMM(g3, 1, pa2, pa3, 12);
      VRD(g7, 3, 1, vb); VMM(g4, 2, pa0, pa1, 12);
      KRD(k0, 0); VMM(g5, 2, pa2, pa3, 10);
      KRD(k1, 1); VMM(g6, 3, pa0, pa1, 8);
      KRD(k2, 2); VMM(g7, 3, pa2, pa3, 6);
      KRD(k3, 3); KMM0(k0, 0, 6);
      if constexpr (ND0 == 8) {
        KRD(k4, 4); KMM(k1, 1, 6);
        KRD(k5, 5); KMM(k2, 2, 6);
        KRD(k6, 6); KMM(k3, 3, 6);
        KRD(k7, 7); KMM(k4, 4, 6);
        KMM(k5, 5, 4); KMM(k6, 6, 2); KMM(k7, 7, 0);
      } else {
        KMM(k1, 1, 4); KMM(k2, 2, 2); KMM(k3, 3, 0);
      } }
    if (dma) asm volatile("s_waitcnt vmcnt(4)" ::: "memory"); else asm volatile("s_waitcnt vmcnt(0)" ::: "memory");
    SBAR(); BAR();
    partialSM<DIFF>(p0, p1, mnC); finishSM(p0, p1, l_reg, pa0, pa1, pa2, pa3); SBAR(); PREISSUE(sK);
    BAR();
  }
  {
    const int vb = vb0 + ((NT - 1) & 3) * RSTG;
    VDECL(g3); VDECL(g4); VDECL(g5); VDECL(g6); VDECL(g7);
    VRD(g3, 1, 1, vb); VMM(g0, 0, pa0, pa1, 12);
    VRD(g4, 2, 0, vb); VMM(g1, 0, pa2, pa3, 12);
    VRD(g5, 2, 1, vb); VMM(g2, 1, pa0, pa1, 12);
    VRD(g6, 3, 0, vb); VMM(g3, 1, pa2, pa3, 12);
    VRD(g7, 3, 1, vb); VMM(g4, 2, pa0, pa1, 12);
    VMM(g5, 2, pa2, pa3, 8); VMM(g6, 3, pa0, pa1, 4); VMM(g7, 3, pa2, pa3, 0);
  }
  if (!odd) BAR();
#undef PREISSUE
#undef KMM
#undef KMM0
#undef KRD
#undef VMM
#undef VDECL
#undef VRD
#undef PK
#undef LWAIT2
#undef LWAIT4
#undef BAR
#undef DMA
#undef DWAIT
  __syncthreads();
  if (splc) {
    unsigned* xs_ = (unsigned*)(lds + 140000);
    if (threadIdx.x == 0) *xs_ = __hip_atomic_fetch_add(splc, 1u, __ATOMIC_RELAXED, __HIP_MEMORY_SCOPE_AGENT);
    __syncthreads();
    const unsigned ord = *xs_;
    float* mine = splp + (size_t)(wid * 65) * 64 + lane;
    if (ord == 0u) {
      _Pragma("unroll") for (int d0 = 0; d0 < 4; ++d0) _Pragma("unroll") for (int r = 0; r < 16; ++r) mine[(d0 * 16 + r) * 64] = o[d0][r];
      mine[64 * 64] = l_reg;
      asm volatile("s_waitcnt vmcnt(0)" ::: "memory"); __syncthreads();
      if (threadIdx.x == 0) { __builtin_amdgcn_fence(__ATOMIC_RELEASE, "agent"); asm volatile("s_waitcnt vmcnt(0)" ::: "memory"); __hip_atomic_store(splc + 1, 1u, __ATOMIC_RELAXED, __HIP_MEMORY_SCOPE_AGENT); }
      __syncthreads();
      return;
    }
    if (threadIdx.x == 0) { unsigned sp = 0; while (__hip_atomic_load(splc + 1, __ATOMIC_RELAXED, __HIP_MEMORY_SCOPE_AGENT) == 0u) { __builtin_amdgcn_s_sleep(4); if (++sp > (1u << 22)) break; } }
    __syncthreads();
    __builtin_amdgcn_fence(__ATOMIC_ACQUIRE, "agent"); asm volatile("s_waitcnt vmcnt(0)" ::: "memory");
    _Pragma("unroll") for (int d0 = 0; d0 < 4; ++d0) _Pragma("unroll") for (int r = 0; r < 16; ++r) o[d0][r] += mine[(d0 * 16 + r) * 64];
    l_reg += mine[64 * 64];
  }
  if (hi == 0) li_l[r32] = l_reg; asm volatile("s_waitcnt lgkmcnt(0)" ::: "memory");
  float rli[16];
  _Pragma("unroll") for (int r = 0; r < 16; ++r) rli[r] = __builtin_amdgcn_rcpf(li_l[crow(r, hi)]);
  int r32e = r32; asm volatile("" : "+v"(r32e));
  char* ST = lds + E_ST + wid * 8704;
  if constexpr (!DIFF) {
    _Pragma("unroll") for (int r = 0; r < 16; ++r) { const int orow = crow(r, hi);
      _Pragma("unroll") for (int d0 = 0; d0 < 4; ++d0) *(bf16_t*)(ST + orow * 272 + (d0 * 32 + r32e) * 2) = f2bf(o[d0][r] * rli[r]); }
  } else {
    const float s1 = wave_sum(lamp[lane] * lamp[64 + lane]), s2 = wave_sum(lamp[128 + lane] * lamp[192 + lane]);
    int ly = layer; asm volatile("" : "+s"(ly));
    const float lambda_init = 0.8f - 0.6f * expf(-0.3f * (float)ly);
    const float lam = expf(s1) - expf(s2) + lambda_init, osc = 1.f - lambda_init;
    float* X = (float*)lds;
    if (mapc == 1) {
      _Pragma("unroll") for (int r = 0; r < 16; ++r) { const int orow = wq * QBLK + crow(r, hi);
        _Pragma("unroll") for (int d0 = 0; d0 < 4; ++d0) X[orow * 128 + d0 * 32 + r32e] = o[d0][r] * rli[r] * lam; }
    }
    __syncthreads();
    if (mapc == 0) {
      float nwv[4];
      _Pragma("unroll") for (int d0 = 0; d0 < 4; ++d0) nwv[d0] = nw[d0 * 32 + r32e] * osc;
      _Pragma("unroll") for (int r = 0; r < 16; ++r) { const int orow = crow(r, hi); float v[4]; float ss = 0.f;
        _Pragma("unroll") for (int d0 = 0; d0 < 4; ++d0) { v[d0] = o[d0][r] * rli[r] - X[(wq * QBLK + orow) * 128 + d0 * 32 + r32e]; ss += v[d0] * v[d0]; }
        ss += __shfl_xor(ss, 1); ss += __shfl_xor(ss, 2); ss += __shfl_xor(ss, 4); ss += __shfl_xor(ss, 8); ss += __shfl_xor(ss, 16);
        const float rs = rsqrtf(ss * (1.f / 128.f) + NORM_EPS);
        _Pragma("unroll") for (int d0 = 0; d0 < 4; ++d0) *(bf16_t*)(ST + orow * 272 + (d0 * 32 + r32e) * 2) = f2bf(v[d0] * rs * nwv[d0]); }
    }
  }
  if (!DIFF || mapc == 0) {
    asm volatile("s_waitcnt lgkmcnt(0)" ::: "memory");
    bf16_t* Ow = Ob + (long)(wq * QBLK) * LD; const bf16_t* Gw = gate + (long)(wq * QBLK) * LD;
    const int er = lane >> 4, ec = (lane & 15) * 8; bf16x8 gv[8];
    _Pragma("unroll") for (int it = 0; it < 8; ++it) gv[it] = *reinterpret_cast<const bf16x8*>(Gw + (long)(it * 4 + er) * LD + ec);
    _Pragma("unroll") for (int it = 0; it < 8; ++it) { const bf16x8 sv = *reinterpret_cast<const bf16x8*>(ST + (it * 4 + er) * 272 + ec * 2); u32x4 ov;
      float f[8]; _Pragma("unroll") for (int e = 0; e < 8; ++e) f[e] = bf2f((bf16_t)sv[e]) * siluf(bf2f((bf16_t)gv[it][e]));
      ov.x = pk2(f[0], f[1]); ov.y = pk2(f[2], f[3]); ov.z = pk2(f[4], f[5]); ov.w = pk2(f[6], f[7]);
      *reinterpret_cast<u32x4*>(Ow + (long)(it * 4 + er) * LD + ec) = ov; }
  }
  __syncthreads();
}
#undef KSWZ
#undef SBAR
}

__device__ __forceinline__ void gqa_unit(const Params& p, const int l, int u, char* lds, int half = -1, int rec = 0) {
    const int qb = u & 31, hq = (u >> 5) & 3, b = u >> 7; const size_t row0 = (size_t)b * SEQ + (size_t)qb * 256, k0 = (size_t)b * SEQ + (half > 0 ? SEQ / 2 : 0);
    bf16_t* Q = pblk(p.ws, PB_GQ + hq) + row0 * 128;
    att::attn_unit<0>(Q, pblk(p.ws, PB_GK + (hq >> 1)) + k0 * 128, pblk(p.ws, PB_GV + (hq >> 1)) + k0 * 128, Q, pblk(p.ws, PB_GG + hq) + row0 * 128, half >= 0 ? SEQ / 2 : SEQ, lds, nullptr, 0, nullptr,
                      (const float*)(g_scr + SCR_CTL) + 256 + 64 * l + 16 + b * 2 + (hq >> 1),
                      qb * 256, p.in[23] + l * 128,
                      half >= 0 ? (unsigned*)(g_scr + SCR_CTL) + 384 + l * 256 + rec * 2 : nullptr, half >= 0 ? (float*)(g_scr + SCR_SPL + (size_t)rec * 133120) : nullptr);
}
__device__ __forceinline__ void diff_unit(const Params& p, const int l, int u, char* lds, int half = -1, int rec = 0) {
    const int qb = u & 63, h = (u >> 6) & 3, b = u >> 8; const size_t row0 = (size_t)b * SEQ + (size_t)qb * 128, k0 = (size_t)b * SEQ + (half > 0 ? SEQ / 2 : 0);
    bf16_t* Q = pblk(p.ws, PB_DQ + h) + row0 * 128;
    att::attn_unit<1>(Q, pblk(p.ws, PB_DK + h) + k0 * 128, pblk(p.ws, PB_DV + h) + k0 * 128, Q, pblk(p.ws, PB_DG + h) + row0 * 128, half >= 0 ? SEQ / 2 : SEQ, lds, p.in[21] + l * 256, l, p.in[22] + l * 128,
                      (const float*)(g_scr + SCR_CTL) + 256 + 64 * l + b * 8 + h * 2,
                      qb * 128, nullptr,
                      half >= 0 ? (unsigned*)(g_scr + SCR_CTL) + 384 + l * 256 + rec * 2 : nullptr, half >= 0 ? (float*)(g_scr + SCR_SPL + (size_t)rec * 133120) : nullptr);
}

#define LDS_BAR() asm volatile("s_waitcnt lgkmcnt(0)\n\ts_barrier" ::: "memory")
namespace rk {
using f32x16 = __attribute__((ext_vector_type(16))) float;
constexpr int PB = 144, MAT = 64 * PB;
constexpr int O_W2T = 0, O_A2T = MAT, O_SB = 2 * MAT, O_GAM = 3 * MAT, O_CONST = O_GAM + 256,
              O_T = O_CONST + 2560, O_TW = O_T, O_G1T = O_T + MAT, O_AD = O_G1T,
              O_R2 = O_G1T + MAT, O_CL = O_R2, O_AA = O_R2 + 16384, O_ABD = O_R2, O_AAB = O_R2 + 4096, O_AAK = O_AAB + MAT, O_ARB = O_AAK + MAT, O_ARK = O_ARB + MAT,
              O_R3 = O_ARK + MAT, O_AT = O_R3, O_RT = O_AT + MAT, O_BT = O_RT + MAT, O_DT = O_BT, O_UT = O_BT, O_KT = O_BT + MAT, O_PT = O_KT,
              O_BHT = O_KT + MAT, O_KHT = O_BHT + MAT, O_VT = O_KHT + MAT, O_END = O_VT + MAT;
__device__ __forceinline__ int crow(int r, int hi) { return (r & 3) + 8 * (r >> 2) + 4 * hi; }
#define RK_FENCE() do { asm volatile("s_waitcnt lgkmcnt(0)" ::: "memory"); __builtin_amdgcn_wave_barrier(); } while (0)
template <int NKS> __device__ __forceinline__ void mm32(f32x16& acc, const char* A, int m0, const char* B, int n0, int k0, int r32, int hi) {
#pragma unroll
    for (int ks = 0; ks < NKS; ++ks) {
        const bf16x8 a = *(const bf16x8*)(A + (m0 + r32) * PB + (k0 + ks * 16 + hi * 8) * 2);
        const bf16x8 b = *(const bf16x8*)(B + (n0 + r32) * PB + (k0 + ks * 16 + hi * 8) * 2);
        acc = __builtin_amdgcn_mfma_f32_32x32x16_bf16(a, b, acc, 0, 0, 0); }
}
template <int NKS, bool SA, bool SB> __device__ __forceinline__ void mm32s(f32x16& acc, const char* A, int m0, const char* B, int n0, int r32, int hi) {
    const int ra = m0 + r32, rb = n0 + r32; const int fa = SA ? ((ra >> 3) & 7) : 0, fb = SB ? ((rb >> 3) & 7) : 0;
#pragma unroll
    for (int ks = 0; ks < NKS; ++ks) { const int q = ks * 2 + hi;
        const bf16x8 a = *(const bf16x8*)(A + ra * PB + ((q ^ fa) << 4));
        const bf16x8 b = *(const bf16x8*)(B + rb * PB + ((q ^ fb) << 4));
        acc = __builtin_amdgcn_mfma_f32_32x32x16_bf16(a, b, acc, 0, 0, 0); }
}
__device__ __forceinline__ void st_T(const f32x16& acc, char* Z, int n0, int m0, int r32, int hi) {
#pragma unroll
    for (int g = 0; g < 4; ++g) { u32x2 w; w.x = pk2(acc[4 * g], acc[4 * g + 1]); w.y = pk2(acc[4 * g + 2], acc[4 * g + 3]);
        *(u32x2*)(Z + (n0 + r32) * PB + (m0 + 8 * g + 4 * hi) * 2) = w; }
}
__device__ __forceinline__ unsigned long long pass1(const Params& p, const int l, unsigned char* lds) {
    const int sid = blockIdx.x >> 3, c_first = blockIdx.x & 7;
    const int tid = otid(), w = __builtin_amdgcn_readfirstlane(tid >> 6);
    const int h = sid & 7, dir = (sid >> 3) & 1, b = sid >> 4;
    unsigned long long pacc = 0, ptt = 0; (void)ptt;
#ifdef PRB_IV
#define RKP0(i) do { if ((PRB_IV >> (i)) & 1) ptt = __builtin_amdgcn_s_memrealtime(); } while (0)
#define RKP1(i) do { if ((PRB_IV >> (i)) & 1) pacc += __builtin_amdgcn_s_memrealtime() - ptt; } while (0)
#else
#define RKP0(i) do {} while (0)
#define RKP1(i) do {} while (0)
#endif
#define RK_LANE() int tq_ = tid; asm volatile("" : "+v"(tq_)); const int lane = tq_ & 63, r32 = lane & 31, hi = lane >> 5, tok = tq_ >> 3, c8 = (tq_ & 7) * 8; (void)lane; (void)r32; (void)hi; (void)tok; (void)c8
    char* L = (char*)lds; float* CF = (float*)(L + O_CONST);
    {   RK_LANE();
        const float* w2 = p.in[13] + ((size_t)(l * 2 + dir) * 64) * 512 + h * 64; const float* a2 = p.in[15] + ((size_t)l * 64) * 512 + h * 64;
        float t[8], u[8];
#pragma unroll
        for (int e = 0; e < 8; ++e) { t[e] = w2[(size_t)(c8 + e) * 512 + tok]; u[e] = a2[(size_t)(c8 + e) * 512 + tok]; }
        u32x4 ww, aa; ww.x = pk2(t[0], t[1]); ww.y = pk2(t[2], t[3]); ww.z = pk2(t[4], t[5]); ww.w = pk2(t[6], t[7]);
        aa.x = pk2(u[0], u[1]); aa.y = pk2(u[2], u[3]); aa.z = pk2(u[4], u[5]); aa.w = pk2(u[6], u[7]);
        *(u32x4*)(L + O_W2T + tok * PB + c8 * 2) = ww; *(u32x4*)(L + O_A2T + tok * PB + c8 * 2) = aa;
        { unsigned zz = 0u; asm volatile("" : "+v"(zz)); *(u32x4*)(L + O_SB + tok * PB + c8 * 2) = (u32x4){zz, zz, zz, zz}; }
        const float* mu = p.in[11] + (size_t)(l * 2 + dir) * 1664;
        for (int i = tid; i < 640; i += 512) { const int row = i >> 6, j = i & 63; float v;
            if (row == 0) v = p.in[12][(l * 2 + dir) * 512 + h * 64 + j]; else if (row == 1) v = p.in[14][l * 512 + h * 64 + j];
            else if (row == 2) v = p.in[16][l * 512 + h * 64 + j]; else if (row == 3) v = p.in[17][l * 512 + h * 64 + j]; else if (row == 4) v = p.in[18][l * 512 + h * 64 + j];
            else if (row == 5) v = mu[h * 64 + j]; else if (row == 6) v = mu[512 + h * 64 + j]; else if (row == 7) v = mu[1024 + h * 64 + j]; else if (row == 8) v = mu[1536 + j]; else v = mu[1600 + j];
            CF[i] = v; }
    }
    const bf16_t* Pr = pblk(p.ws, PB_R + (h >> 1)) + (h & 1) * 64; const bf16_t* Pk = pblk(p.ws, PB_K + (h >> 1)) + (h & 1) * 64;
    const bf16_t* Pv = pblk(p.ws, PB_V + (h >> 1)) + (h & 1) * 64; const bf16_t* Pw = pblk(p.ws, PB_WA); const bf16_t* Pa = pblk(p.ws, PB_WA) + 64;
    bf16_t* wkv = (bf16_t*)(g_scr + SCR_WKV) + (size_t)sid * SEQ * 64; bf16_t* bon = (bf16_t*)(g_scr + SCR_BON) + (size_t)dir * M_TOK * 512 + h * 64;
    bf16x8 cu[5], pv[5];
#define RK_LOAD(c) do { RK_LANE(); const int s_ = (c) * 64 + tok; const int t_ = dir ? (SEQ - 1 - s_) : s_; const size_t m_ = ((size_t)b * SEQ + t_) * 128 + c8; \
        cu[0] = *(const bf16x8*)(Pr + m_); cu[1] = *(const bf16x8*)(Pk + m_); cu[2] = *(const bf16x8*)(Pv + m_); cu[3] = *(const bf16x8*)(Pw + m_); cu[4] = *(const bf16x8*)(Pa + m_); \
        if (s_ > 0) { const size_t q_ = dir ? m_ + 128 : m_ - 128; pv[0] = *(const bf16x8*)(Pr + q_); pv[1] = *(const bf16x8*)(Pk + q_); pv[2] = *(const bf16x8*)(Pv + q_); pv[3] = *(const bf16x8*)(Pw + q_); pv[4] = *(const bf16x8*)(Pa + q_); } \
        else { _Pragma("unroll") for (int i_ = 0; i_ < 5; ++i_) pv[i_] = (bf16x8){0, 0, 0, 0, 0, 0, 0, 0}; } } while (0)
    RK_LOAD(c_first);
    LDS_BAR();
#pragma unroll 1
    for (int c = c_first; c < SEQ / 64; c += 8) {
        RKP0(1);
        float rr[8], kx[8], vv[8];
        {   RK_LANE(); float tw[8], ad[8];
#pragma unroll
            for (int e = 0; e < 8; ++e) {
                const float x0 = bf2f((bf16_t)cu[0][e]), x1 = bf2f((bf16_t)cu[1][e]), x2 = bf2f((bf16_t)cu[2][e]), x3 = bf2f((bf16_t)cu[3][e]), x4 = bf2f((bf16_t)cu[4][e]);
                const float p0 = bf2f((bf16_t)pv[0][e]), p1 = bf2f((bf16_t)pv[1][e]), p2 = bf2f((bf16_t)pv[2][e]), p3 = bf2f((bf16_t)pv[3][e]), p4 = bf2f((bf16_t)pv[4][e]);
                rr[e] = x0 + (p0 - x0) * CF[5 * 64 + (h * 0) + c8 + e]; kx[e] = x1 + (p1 - x1) * CF[6 * 64 + c8 + e]; vv[e] = x2 + (p2 - x2) * CF[7 * 64 + c8 + e];
                const float wd = x3 + (p3 - x3) * CF[8 * 64 + c8 + e]; ad[e] = x4 + (p4 - x4) * CF[9 * 64 + c8 + e];
                tw[e] = 1.f - 2.f / (1.f + __expf(2.f * wd)); }
            u32x4 a, d; a.x = pk2(tw[0], tw[1]); a.y = pk2(tw[2], tw[3]); a.z = pk2(tw[4], tw[5]); a.w = pk2(tw[6], tw[7]);
            d.x = pk2(ad[0], ad[1]); d.y = pk2(ad[2], ad[3]); d.z = pk2(ad[4], ad[5]); d.w = pk2(ad[6], ad[7]);
            *(u32x4*)(L + O_TW + tok * PB + c8 * 2) = a; *(u32x4*)(L + O_AD + tok * PB + c8 * 2) = d; }
        LDS_BAR(); RKP1(1); RKP0(2);
        {   RK_LANE(); const bool isA = w >= 4; const int mt2 = (w & 2) ? 32 : 0, n0 = (w & 1) * 32;
            const char* Aop = L + (isA ? O_AD : O_TW); const char* Bop = L + (isA ? O_A2T : O_W2T);
            f32x16 x0 = {};
            mm32<4>(x0, Aop, mt2, Bop, n0, 0, r32, hi);
            const int ch = n0 + r32; const float c0 = CF[(isA ? 64 : 0) + ch];
            float* TOT = (float*)(L + O_GAM);
            if (!isA) {
#pragma unroll
                for (int r = 0; r < 16; ++r) x0[r] = -0.6065306597126334f / (1.f + __expf(-(c0 + x0[r])));
                float run = 0.f;
#pragma unroll
                for (int g = 0; g < 4; ++g) { const float gs = (x0[4 * g] + x0[4 * g + 1]) + (x0[4 * g + 2] + x0[4 * g + 3]); const float ps = __shfl_xor(gs, 32);
                    float st = run + (hi ? ps : 0.f); x0[4 * g] += st; x0[4 * g + 1] += x0[4 * g]; x0[4 * g + 2] += x0[4 * g + 1]; x0[4 * g + 3] += x0[4 * g + 2]; run += gs + ps; }
                if (mt2 == 0 && hi == 0) TOT[ch] = run;
            } else {
#pragma unroll
                for (int r = 0; r < 16; ++r) x0[r] = 1.f / (1.f + __expf(-(c0 + x0[r])));
            }
            LDS_BAR();
            if (!isA && mt2) { const float t0 = TOT[ch];
#pragma unroll
                for (int r = 0; r < 16; ++r) x0[r] += t0; }
            float* O = (float*)(L + (isA ? O_AA : O_CL));
#pragma unroll
            for (int r = 0; r < 16; ++r) O[(mt2 + crow(r, hi)) * 64 + ch] = x0[r];
        }
        LDS_BAR(); RKP1(2); RKP0(3);
        {   RK_LANE(); const float* clp = (const float*)(L + O_CL + tok * 256 + c8 * 4); const float* cle = (const float*)(L + O_CL + (tok > 0 ? tok - 1 : 0) * 256 + c8 * 4);
            const float* cln = (const float*)(L + O_CL + 63 * 256 + c8 * 4); const float* aap = (const float*)(L + O_AA + tok * 256 + c8 * 4);
            float kk[8], kp[8]; float ss = 0.f, bs = 0.f;
#pragma unroll
            for (int e = 0; e < 8; ++e) { kk[e] = kx[e] * CF[2 * 64 + c8 + e]; ss += kk[e] * kk[e]; kp[e] = kx[e] * (1.f + (aap[e] - 1.f) * CF[3 * 64 + c8 + e]); bs += rr[e] * kp[e] * CF[4 * 64 + c8 + e]; }
            ss += __shfl_xor(ss, 1); ss += __shfl_xor(ss, 2); ss += __shfl_xor(ss, 4);
            bs += __shfl_xor(bs, 1); bs += __shfl_xor(bs, 2); bs += __shfl_xor(bs, 4);
            const float rn = 1.f / fmaxf(sqrtf(ss), 1e-12f);
            const int tsw = ((((tok >> 3) ^ (c8 >> 3)) << 3) + (tok & 7)) * 2;
#pragma unroll
            for (int e2 = 0; e2 < 4; ++e2) { float At[2], Rt[2], Bt[2], Kt[2];
#pragma unroll
                for (int q = 0; q < 2; ++q) { const int e = 2 * e2 + q; const float cl = clp[e], ce = (tok > 0) ? cle[e] : 0.f, cn = cln[e];
                    const float kn = kk[e] * rn; const float bb = kn * aap[e];
                    const float ein = __expf(cl), eex = __expf(ce), eng = __expf(-cl), een = __expf(cn - cl);
                    At[q] = -kn * eex; Rt[q] = rr[e] * ein; Bt[q] = bb * eng; Kt[q] = kp[e] * eng;
                    *(bf16_t*)(L + O_BHT + (c8 + e) * PB + tsw) = f2bf(bb * een); *(bf16_t*)(L + O_KHT + (c8 + e) * PB + tsw) = f2bf(kp[e] * een); *(bf16_t*)(L + O_VT + (c8 + e) * PB + tsw) = f2bf(vv[e]); *(bf16_t*)(L + O_SB + (c8 + e) * PB + tsw) = f2bf(At[q]);
                    if (tok == 63) ((float*)(L + O_GAM))[c8 + e] = __expf(cn); }
                const int ob = tok * PB + (c8 + 2 * e2) * 2;
                *(unsigned*)(L + O_AT + ob) = pk2(At[0], At[1]); *(unsigned*)(L + O_RT + ob) = pk2(Rt[0], Rt[1]); *(unsigned*)(L + O_BT + ob) = pk2(Bt[0], Bt[1]); *(unsigned*)(L + O_KT + ob) = pk2(Kt[0], Kt[1]); }
            {   const int s_ = c * 64 + tok; const int t_ = dir ? (SEQ - 1 - s_) : s_;
                u32x4 w_; w_.x = pk2(bs * vv[0], bs * vv[1]); w_.y = pk2(bs * vv[2], bs * vv[3]); w_.z = pk2(bs * vv[4], bs * vv[5]); w_.w = pk2(bs * vv[6], bs * vv[7]);
                *(u32x4*)(bon + ((size_t)b * SEQ + t_) * 512 + c8) = w_; }
        }
        LDS_BAR(); RKP1(3); RKP0(4);
        if (c + 8 < SEQ / 64) RK_LOAD(c + 8);
        for (int idx = w; idx < 12; idx += 8) {
            RK_LANE(); const int pr = idx / 3, tl = idx - pr * 3; const int mi = (tl == 2) ? 32 : 0, nt = (tl >= 1) ? 32 : 0;
            const char* X = L + ((pr & 1) ? O_KT : O_BT); const char* Y = L + ((pr >= 2) ? O_RT : O_AT);
            f32x16 acc = {}; mm32<4>(acc, X, mi, Y, nt, 0, r32, hi);
            const int t = nt + r32;
            if (tl != 1) {
#pragma unroll
                for (int r = 0; r < 16; ++r) { const int i = mi + crow(r, hi); const bool keep = (pr < 2) ? (i < t) : (i <= t); if (!keep) acc[r] = 0.f; } }
            char* Z = L + (pr == 0 ? O_AAB : pr == 1 ? O_AAK : pr == 2 ? O_ARB : O_ARK);
            st_T(acc, Z, nt, mi, r32, hi);
            if (pr == 0 && tl != 1) { float* ABD = (float*)(L + O_ABD);
#pragma unroll
                for (int g = 0; g < 4; ++g) if ((g >> 1) == (r32 >> 4)) *(f32x4*)(ABD + (t >> 4) * 256 + (t & 15) * 16 + 8 * (g & 1) + 4 * hi) = (f32x4){acc[4 * g], acc[4 * g + 1], acc[4 * g + 2], acc[4 * g + 3]}; }
        }
        LDS_BAR(); RKP1(4); RKP0(5);
        f32x16 yacc = {}, nacc = {};
        const int mt = (w & 2) ? 32 : 0, nv = (w & 1) ? 32 : 0;
        if (w < 4) {
            RK_LANE(); f32x16 xq = {};
            if (mt) mm32s<4, false, true>(xq, L + O_AAK, mt, L + O_VT, nv, r32, hi); else mm32s<2, false, true>(xq, L + O_AAK, mt, L + O_VT, nv, r32, hi);
            st_T(xq, L + O_G1T, nv, mt, r32, hi);
            mm32s<4, true, true>(nacc, L + O_KHT, mt, L + O_VT, nv, r32, hi);
        } else if (w < 7) {
            RK_LANE(); if (mt) mm32s<4, false, true>(yacc, L + O_ARK, mt, L + O_VT, nv, r32, hi); else mm32s<2, false, true>(yacc, L + O_ARK, mt, L + O_VT, nv, r32, hi);
        } else {
            RK_LANE(); const int blk = lane >> 4, j = lane & 15; const float* A = (const float*)(L + O_ABD) + blk * 256;
            float x[16];
#pragma unroll
            for (int t = 0; t < 16; ++t) { float s = (t == j) ? 1.f : 0.f;
#pragma unroll
                for (int i = 0; i < t; ++i) s += A[t * 16 + i] * x[i];
                x[t] = s; asm volatile("" ::: "memory"); }
            char* Tm = L + O_T; char* Dm = L + O_DT;
#pragma unroll
            for (int t = 0; t < 16; ++t) *(bf16_t*)(Tm + (16 * blk + t) * PB + (16 * blk + j) * 2) = f2bf(x[t]);
            { u32x4 a, d; a.x = pk2(x[0], x[1]); a.y = pk2(x[2], x[3]); a.z = pk2(x[4], x[5]); a.w = pk2(x[6], x[7]); d.x = pk2(x[8], x[9]); d.y = pk2(x[10], x[11]); d.z = pk2(x[12], x[13]); d.w = pk2(x[14], x[15]);
              *(u32x4*)(Dm + (16 * blk + j) * PB + (16 * blk) * 2) = a; *(u32x4*)(Dm + (16 * blk + j) * PB + (16 * blk + 8) * 2) = d; }
            if ((blk & 1) == 0) {
#pragma unroll
                for (int t = 0; t < 16; ++t) *(bf16_t*)(Tm + (16 * blk + t) * PB + (16 * (blk + 1) + j) * 2) = 0;
            } else { *(u32x4*)(Dm + (16 * blk + j) * PB + (16 * (blk - 1)) * 2) = (u32x4){0u, 0u, 0u, 0u}; *(u32x4*)(Dm + (16 * blk + j) * PB + (16 * (blk - 1) + 8) * 2) = (u32x4){0u, 0u, 0u, 0u}; }
            RK_FENCE();
            const int m16 = lane & 15, kg = lane >> 4; const bf16x8 z8 = {0, 0, 0, 0, 0, 0, 0, 0};
#pragma unroll
            for (int pp = 0; pp < 2; ++pp) { const int o = 32 * pp;
                bf16x8 a = z8, bb = z8;
                if (kg < 2) { a = *(const bf16x8*)(L + O_AAB + (o + 16 + m16) * PB + (o + 8 * kg) * 2); bb = *(const bf16x8*)(Dm + (o + m16) * PB + (o + 8 * kg) * 2); }
                f32x4 pq = __builtin_amdgcn_mfma_f32_16x16x32_bf16(a, bb, (f32x4){0.f, 0.f, 0.f, 0.f}, 0, 0, 0);
                { u32x2 wv; wv.x = pk2(pq[0], pq[1]); wv.y = pk2(pq[2], pq[3]); *(u32x2*)(L + O_PT + (o + m16) * PB + (o + 16 + 4 * kg) * 2) = wv; } }
            RK_FENCE();
#pragma unroll
            for (int pp = 0; pp < 2; ++pp) { const int o = 32 * pp;
                bf16x8 a = z8, bb = z8;
                if (kg < 2) { a = *(const bf16x8*)(Tm + (o + 16 + m16) * PB + (o + 16 + 8 * kg) * 2); bb = *(const bf16x8*)(L + O_PT + (o + m16) * PB + (o + 16 + 8 * kg) * 2); }
                f32x4 tq = __builtin_amdgcn_mfma_f32_16x16x32_bf16(a, bb, (f32x4){0.f, 0.f, 0.f, 0.f}, 0, 0, 0);
#pragma unroll
                for (int e = 0; e < 4; ++e) *(bf16_t*)(Tm + (o + 16 + 4 * kg + e) * PB + (o + m16) * 2) = f2bf(tq[e]);
                { u32x2 wv; wv.x = pk2(tq[0], tq[1]); wv.y = pk2(tq[2], tq[3]); *(u32x2*)(Dm + (o + m16) * PB + (o + 16 + 4 * kg) * 2) = wv; } }
            RK_FENCE();
            { f32x16 q = {}; mm32<2>(q, L + O_AAB, 32, Dm, 0, 0, r32, hi); st_T(q, L + O_PT, 0, 32, r32, hi); }
            RK_FENCE();
            { f32x16 tc = {}; mm32<2>(tc, Tm, 32, L + O_PT, 0, 32, r32, hi);
#pragma unroll
              for (int r = 0; r < 16; ++r) *(bf16_t*)(Tm + (32 + crow(r, hi)) * PB + r32 * 2) = f2bf(tc[r]); }
        }
        LDS_BAR(); RKP1(5); RKP0(6);
        if (w < 4) {
            RK_LANE(); f32x16 q = {};
            if (mt) mm32s<4, false, true>(q, L + O_T, mt, L + O_SB, nv, r32, hi); else mm32s<2, false, true>(q, L + O_T, mt, L + O_SB, nv, r32, hi);
            st_T(q, L + O_PT, nv, mt, r32, hi);
        } else {
            RK_LANE(); if (w == 7) mm32s<4, false, true>(yacc, L + O_ARK, mt, L + O_VT, nv, r32, hi);
            f32x16 q = {};
            if (mt) mm32<4>(q, L + O_T, mt, L + O_G1T, nv, 0, r32, hi); else mm32<2>(q, L + O_T, mt, L + O_G1T, nv, 0, r32, hi);
            st_T(q, L + O_UT, nv, mt, r32, hi);
        }
        LDS_BAR(); RKP1(6); RKP0(7);
        {   const size_t ci = (size_t)sid * (SEQ / 64) + c;
            if (w < 4) {
                RK_LANE(); mm32s<4, true, false>(nacc, L + O_BHT, mt, L + O_UT, nv, r32, hi);
                {   bf16_t* NN = (sid < 24 ? (bf16_t*)(p.ws + WS_NN) : (bf16_t*)(g_scr + SCR_NN2) - (size_t)24 * 128 * 4096) + ci * 4096 + ((size_t)(w * 64 + lane)) * 16;
                    u32x4 a, d; a.x = pk2(nacc[0], nacc[1]); a.y = pk2(nacc[2], nacc[3]); a.z = pk2(nacc[4], nacc[5]); a.w = pk2(nacc[6], nacc[7]);
                    d.x = pk2(nacc[8], nacc[9]); d.y = pk2(nacc[10], nacc[11]); d.z = pk2(nacc[12], nacc[13]); d.w = pk2(nacc[14], nacc[15]);
                    *(u32x4*)NN = a; *(u32x4*)(NN + 8) = d; }
                f32x16 mq = {}; mm32s<4, false, true>(mq, L + O_PT, mt, L + O_BHT, nv, r32, hi);
                const int kq = nv + r32; const float gk = ((const float*)(L + O_GAM))[kq];
#pragma unroll
                for (int r = 0; r < 16; ++r) if (mt + crow(r, hi) == kq) mq[r] += gk;
                bf16_t* MM = (bf16_t*)(p.ws + WS_MM) + ci * 4096 + (size_t)kq * 64 + mt + 4 * hi;
#pragma unroll
                for (int g = 0; g < 4; ++g) { u32x2 wv; wv.x = pk2(mq[4 * g], mq[4 * g + 1]); wv.y = pk2(mq[4 * g + 2], mq[4 * g + 3]); *(u32x2*)(MM + 8 * g) = wv; }
            } else {
                RK_LANE(); if (mt) mm32<4>(yacc, L + O_ARB, mt, L + O_UT, nv, 0, r32, hi); else mm32<2>(yacc, L + O_ARB, mt, L + O_UT, nv, 0, r32, hi);
                {
                    bf16_t* yp = wkv + (size_t)c * 4096 + (size_t)((w - 4) * 64 + lane) * 16;
                    u32x4 a_, d_; a_.x = pk2(yacc[0], yacc[1]); a_.y = pk2(yacc[2], yacc[3]); a_.z = pk2(yacc[4], yacc[5]); a_.w = pk2(yacc[6], yacc[7]);
                    d_.x = pk2(yacc[8], yacc[9]); d_.y = pk2(yacc[10], yacc[11]); d_.z = pk2(yacc[12], yacc[13]); d_.w = pk2(yacc[14], yacc[15]);
                    *(u32x4*)yp = a_; *(u32x4*)(yp + 8) = d_; }
                f32x16 qq = {};
                if (nv) mm32<4>(qq, L + O_PT, mt, L + O_ARB, nv, 0, r32, hi); else mm32<2>(qq, L + O_PT, mt, L + O_ARB, nv, 0, r32, hi);
                const int tq = nv + r32;
                bf16_t* QQ = (bf16_t*)(g_scr + SCR_XB) + ci * 4096 + (size_t)tq * 64 + mt + 4 * hi;
#pragma unroll
                for (int g = 0; g < 4; ++g) { const u32x2 rw = *(const u32x2*)(L + O_RT + tq * PB + (mt + 8 * g + 4 * hi) * 2);
                    const float r0 = __uint_as_float(rw.x << 16), r1 = __uint_as_float(rw.x & 0xffff0000u), r2 = __uint_as_float(rw.y << 16), r3 = __uint_as_float(rw.y & 0xffff0000u);
                    u32x2 wv; wv.x = pk2(qq[4 * g] + r0, qq[4 * g + 1] + r1); wv.y = pk2(qq[4 * g + 2] + r2, qq[4 * g + 3] + r3); *(u32x2*)(QQ + 8 * g) = wv; }
            }
        }
        LDS_BAR(); RKP1(7);
    }
#undef RK_LOAD
#undef RK_LANE
    return pacc;
}

__device__ __forceinline__ void chain(const Params& p, const int sid, unsigned char* lds) {
    const int tid = otid(), w = __builtin_amdgcn_readfirstlane(tid >> 6);
    constexpr int C_MT = 0, C_QT = MAT, C_SB = 2 * MAT;
#define RK_LANE() int tq_ = tid; asm volatile("" : "+v"(tq_)); const int lane = tq_ & 63, r32 = lane & 31, hi = lane >> 5, row = tq_ >> 3, c8 = (tq_ & 7) * 8; (void)lane; (void)r32; (void)hi; (void)row; (void)c8
    char* L = (char*)lds;
    const bf16_t* MMg = (const bf16_t*)(p.ws + WS_MM) + (size_t)sid * 128 * 4096; const bf16_t* QQg = (const bf16_t*)(g_scr + SCR_XB) + (size_t)sid * 128 * 4096;
    const bf16_t* NNg = (sid < 24 ? (const bf16_t*)(p.ws + WS_NN) : (const bf16_t*)(g_scr + SCR_NN2) - (size_t)24 * 128 * 4096) + (size_t)sid * 128 * 4096;
    bf16_t* wkv = (bf16_t*)(g_scr + SCR_WKV) + (size_t)sid * SEQ * 64;
    const int mt = (w & 2) ? 32 : 0, nv = (w & 1) ? 32 : 0;
    {   RK_LANE(); unsigned zz = 0u; asm volatile("" : "+v"(zz)); *(u32x4*)(L + C_SB + row * PB + c8 * 2) = (u32x4){zz, zz, zz, zz}; }
    f32x16 sacc = {};
    bf16x8 rm, rq, rn0, rn1;
#define CH_LOAD(c) do { RK_LANE(); rm = *(const bf16x8*)(MMg + (size_t)(c) * 4096 + row * 64 + c8); rq = *(const bf16x8*)(QQg + (size_t)(c) * 4096 + row * 64 + c8); \
        if (w < 4) { const bf16_t* n_ = NNg + (size_t)(c) * 4096 + (size_t)(w * 64 + lane) * 16; rn0 = *(const bf16x8*)n_; rn1 = *(const bf16x8*)(n_ + 8); } \
        else { const bf16_t* y_ = wkv + (size_t)(c) * 4096 + (size_t)((w - 4) * 64 + lane) * 16; rn0 = *(const bf16x8*)y_; rn1 = *(const bf16x8*)(y_ + 8); } } while (0)
    CH_LOAD(0);
#pragma unroll 1
    for (int c = 0; c < SEQ / 64; ++c) {
        {   RK_LANE(); *(bf16x8*)(L + C_MT + row * PB + c8 * 2) = rm; *(bf16x8*)(L + C_QT + row * PB + c8 * 2) = rq; }
        f32x16 acc;
#pragma unroll
        for (int r = 0; r < 8; ++r) { acc[r] = bf2f((bf16_t)rn0[r]); acc[8 + r] = bf2f((bf16_t)rn1[r]); }
        LDS_BAR();
        if (c + 1 < SEQ / 64) CH_LOAD(c + 1);
        {   RK_LANE();
            if (w < 4) { mm32<4>(acc, L + C_MT, mt, L + C_SB, nv, 0, r32, hi); sacc = acc; }
            else { mm32<4>(acc, L + C_QT, mt, L + C_SB, nv, 0, r32, hi);
#pragma unroll
                for (int r = 0; r < 16; ++r) wkv[((size_t)c * 64 + mt + crow(r, hi)) * 64 + nv + r32] = f2bf(acc[r]); } }
        LDS_BAR();
        if (w < 4) { RK_LANE(); st_T(sacc, L + C_SB, nv, mt, r32, hi); }
    }
#undef CH_LOAD
#undef RK_LANE
}

}

namespace sd {
using rk::f32x16; using rk::crow;
constexpr int PW = 272, PN = 144;
constexpr int O_CM = 0, O_BM = 64 * PW, O_HB = 2 * 64 * PW, O_BDT = 3 * 64 * PW, O_XDT = O_BDT + 128 * PN, O_XM = O_XDT + 64 * PN, O_MM = O_XM + 64 * PN, O_DTS = O_MM + 64 * PN, O_ACU = O_DTS + 512, O_END = O_ACU + 512;
template <int NKS, int PA, int PBB, int SA = -1, int SBW = -1> __device__ __forceinline__ void mmx(f32x16& acc, const char* A, int m0, const char* B, int n0, int k0, int r32, int hi) {
    const int ra = m0 + r32, rb = n0 + r32; const int fa = SA >= 0 ? ((ra >> (SA >= 0 ? SA : 0)) & 7) : 0, fb = SBW >= 0 ? ((rb >> (SBW >= 0 ? SBW : 0)) & 7) : 0;
#pragma unroll
    for (int ks = 0; ks < NKS; ++ks) { const int q = (k0 >> 3) + ks * 2 + hi;
        const bf16x8 a = *(const bf16x8*)(A + ra * PA + ((q ^ fa) << 4));
        const bf16x8 b = *(const bf16x8*)(B + rb * PBB + ((q ^ fb) << 4));
        acc = __builtin_amdgcn_mfma_f32_32x32x16_bf16(a, b, acc, 0, 0, 0); }
}
template <int PZ> __device__ __forceinline__ void stT(const f32x16& acc, char* Z, int n0, int m0, int r32, int hi) {
#pragma unroll
    for (int g = 0; g < 4; ++g) { u32x2 w; w.x = pk2(acc[4 * g], acc[4 * g + 1]); w.y = pk2(acc[4 * g + 2], acc[4 * g + 3]);
        *(u32x2*)(Z + (n0 + r32) * PZ + (m0 + 8 * g + 4 * hi) * 2) = w; }
}
__device__ __forceinline__ unsigned long long seq(const Params& p, const int l, const int sid, unsigned char* lds) {
    const int tid = otid(), w = __builtin_amdgcn_readfirstlane(tid >> 6);
    const int h = sid & 7, dir = (sid >> 3) & 1, b = sid >> 4, g = h >> 2;
    unsigned long long pacc = 0, ptt = 0; (void)ptt;
#ifdef PRB_SDIV
#define SDP0(i) do { if ((PRB_SDIV >> (i)) & 1) ptt = __builtin_amdgcn_s_memrealtime(); } while (0)
#define SDP1(i) do { if ((PRB_SDIV >> (i)) & 1) pacc += __builtin_amdgcn_s_memrealtime() - ptt; } while (0)
#else
#define SDP0(i) do {} while (0)
#define SDP1(i) do {} while (0)
#endif
#define SD_LANE() int tq_ = tid; asm volatile("" : "+v"(tq_)); const int lane = tq_ & 63, r32 = lane & 31, hi = lane >> 5, tok = tq_ >> 3, q8 = tq_ & 7; (void)lane; (void)r32; (void)hi; (void)tok; (void)q8
    char* L = (char*)lds;
    const float Ah = -expf(p.in[7][(l * 2 + dir) * 8 + h]), dtb = p.in[8][(l * 2 + dir) * 8 + h], Dh = (dir == 0) ? p.in[9][l * 8 + h] : 0.f;
    const float* dtbuf = (const float*)(g_scr + SCR_DT) + dir * 8 + h;
    const bf16_t* xact = (const bf16_t*)(g_scr + SCR_XACT);
    bf16_t* yout = (bf16_t*)(g_scr + SCR_SSDY) + (size_t)dir * M_TOK * 512 + h * 64;
    {   SD_LANE(); unsigned zz = 0u; asm volatile("" : "+v"(zz));
        for (int i = tid; i < 64 * PW / 16; i += 512) *(u32x4*)(L + O_HB + i * 16) = (u32x4){zz, zz, zz, zz}; }
    f32x16 hacc = {};
    bf16x8 rc[2], rb[2], rx; float dtr = 0.f;
#define SD_LOAD(c) do { SD_LANE(); const int s_ = (c) * 64 + tok; const int t_ = dir ? (SEQ - 1 - s_) : s_; const bf16_t* row_ = xact + ((size_t)b * SEQ + t_) * 1024; \
        rc[0] = *(const bf16x8*)(row_ + 768 + g * 128 + q8 * 16); rc[1] = *(const bf16x8*)(row_ + 768 + g * 128 + q8 * 16 + 8); \
        rb[0] = *(const bf16x8*)(row_ + 512 + g * 128 + q8 * 16); rb[1] = *(const bf16x8*)(row_ + 512 + g * 128 + q8 * 16 + 8); \
        rx = *(const bf16x8*)(row_ + h * 64 + q8 * 8); } while (0)
#define SD_DTLOAD(c) do { SD_LANE(); const int s2_ = (c) * 64 + lane; const int t2_ = dir ? (SEQ - 1 - s2_) : s2_; dtr = dtbuf[((size_t)b * SEQ + t2_) * 16]; } while (0)
#define SD_SCAN(buf) do { SD_LANE(); const float dt_ = softplusf(dtr + dtb); float ac_ = dt_ * Ah; \
        _Pragma("unroll") for (int o_ = 1; o_ < 64; o_ <<= 1) { const float v_ = __shfl_up(ac_, o_); if (lane >= o_) ac_ += v_; } \
        ((float*)(L + O_DTS))[(buf) * 64 + lane] = dt_; ((float*)(L + O_ACU))[(buf) * 64 + lane] = ac_; } while (0)
    SD_LOAD(0);
    if (w == 7) { SD_DTLOAD(0); SD_SCAN(0); SD_DTLOAD(1); }
    LDS_BAR();
    const int nv = (w & 1) ? 32 : 0;
#pragma unroll 1
    for (int c = 0; c < SEQ / 64; ++c) {
        const float* DTS = (const float*)(L + O_DTS) + (c & 1) * 64; const float* ACU = (const float*)(L + O_ACU) + (c & 1) * 64;
        SDP0(1);
        {   SD_LANE(); const float dt = DTS[tok]; const float ac = ACU[tok], ae = ACU[63];
            const float dend = __expf(ae - ac);
            *(bf16x8*)(L + O_CM + tok * PW + q8 * 32) = rc[0]; *(bf16x8*)(L + O_CM + tok * PW + q8 * 32 + 16) = rc[1];
            *(bf16x8*)(L + O_BM + tok * PW + q8 * 32) = rb[0]; *(bf16x8*)(L + O_BM + tok * PW + q8 * 32 + 16) = rb[1];
            *(bf16x8*)(L + O_XM + tok * PN + q8 * 16) = rx;
            const int tsw = ((((tok >> 3) ^ q8) << 3) + (tok & 7)) * 2;
#pragma unroll
            for (int e = 0; e < 8; ++e) { *(bf16_t*)(L + O_BDT + (q8 * 16 + e) * PN + tsw) = f2bf(bf2f((bf16_t)rb[0][e]) * dend); *(bf16_t*)(L + O_BDT + (q8 * 16 + 8 + e) * PN + tsw) = f2bf(bf2f((bf16_t)rb[1][e]) * dend);
                *(bf16_t*)(L + O_XDT + (q8 * 8 + e) * PN + tsw) = f2bf(bf2f((bf16_t)rx[e]) * dt); } }
        LDS_BAR(); SDP1(1); SDP0(2);
        if (c + 1 < SEQ / 64) SD_LOAD(c + 1);
        f32x16 yoff = {};
        const int ml = ((w - 3) & 2) ? 32 : 0, np = ((w - 3) & 1) ? 32 : 0;
        if (w < 3) { SD_LANE(); const int ms = (w == 2) ? 32 : 0, nl = (w >= 1) ? 32 : 0;
            f32x16 gq = {}; mmx<8, PW, PW>(gq, L + O_BM, ms, L + O_CM, nl, 0, r32, hi);
            const int lq = nl + r32; const float al = ACU[lq];
#pragma unroll
            for (int g4 = 0; g4 < 4; ++g4) { const f32x4 as4 = *(const f32x4*)(ACU + ms + 8 * g4 + 4 * hi);
#pragma unroll
                for (int e = 0; e < 4; ++e) { const int s = ms + 8 * g4 + 4 * hi + e; const float d = __expf(fminf(al - as4[e], 0.f)); gq[4 * g4 + e] = (s <= lq) ? gq[4 * g4 + e] * d : 0.f; } }
            stT<PN>(gq, L + O_MM, nl, ms, r32, hi);
        } else if (w < 7) { SD_LANE(); mmx<8, PW, PW>(yoff, L + O_CM, ml, L + O_HB, np, 0, r32, hi); }
        {   SD_LANE(); const float eend = __expf(ACU[63]);
#pragma unroll
            for (int r = 0; r < 16; ++r) hacc[r] *= eend;
            mmx<4, PN, PN, 4, 3>(hacc, L + O_BDT, (w >> 1) * 32, L + O_XDT, nv, 0, r32, hi); }
        if (w == 7 && c + 1 < SEQ / 64) { SD_SCAN((c + 1) & 1); if (c + 2 < SEQ / 64) SD_DTLOAD(c + 2); }
        LDS_BAR(); SDP1(2); SDP0(3);
        {   SD_LANE(); stT<PW>(hacc, L + O_HB, nv, (w >> 1) * 32, r32, hi); }
        if (w >= 3 && w < 7) { SD_LANE(); f32x16 yd = {};
            if (ml) mmx<4, PN, PN, -1, 3>(yd, L + O_MM, ml, L + O_XDT, np, 0, r32, hi); else mmx<2, PN, PN, -1, 3>(yd, L + O_MM, ml, L + O_XDT, np, 0, r32, hi);
            float ea[16], xv[16];
#pragma unroll
            for (int g4 = 0; g4 < 4; ++g4) { const f32x4 a4 = *(const f32x4*)(ACU + ml + 8 * g4 + 4 * hi);
#pragma unroll
                for (int e = 0; e < 4; ++e) { ea[4 * g4 + e] = __expf(a4[e]); xv[4 * g4 + e] = bf2f(*(const bf16_t*)(L + O_XM + (ml + 8 * g4 + 4 * hi + e) * PN + (np + r32) * 2)); } }
#pragma unroll
            for (int r = 0; r < 16; ++r) { const int lq = ml + crow(r, hi); const int s_ = c * 64 + lq; const int t_ = dir ? (SEQ - 1 - s_) : s_;
                yout[((size_t)b * SEQ + t_) * 512 + np + r32] = f2bf(yd[r] + ea[r] * yoff[r] + Dh * xv[r]); } }
        LDS_BAR(); SDP1(3);
    }
#undef SD_LOAD
#undef SD_DTLOAD
#undef SD_SCAN
#undef SD_LANE
    return pacc;
}
}

__device__ __forceinline__ void combine_tokens(const Params& p, const int l, const int m_first, const int m_end, const int m_step) {
    const int tid = otid(), lane = tid & 63;
    const bf16_t* wkv = (const bf16_t*)(g_scr + SCR_WKV); const bf16_t* bon = (const bf16_t*)(g_scr + SCR_BON); const bf16_t* sy = (const bf16_t*)(g_scr + SCR_SSDY);
    const int h = lane >> 3, c8 = (lane & 7) * 8, ch = h * 64 + c8;
    float eps_gn = 64e-5f, eps_rms = NORM_EPS; asm volatile("" : "+v"(eps_gn), "+v"(eps_rms));
    float lnw[8], lnb[8], snw[8];
#pragma unroll
    for (int e = 0; e < 8; ++e) { lnw[e] = p.in[19][l * 512 + ch + e]; lnb[e] = p.in[20][l * 512 + ch + e]; snw[e] = p.in[10][l * 512 + ch + e]; }
    for (int m = m_first; m < m_end; m += m_step) {
        const int bq = m >> 13, tq = m & (SEQ - 1);
        bf16_t* gp = pblk(p.ws, PB_RG + (h >> 1)) + (size_t)m * 128 + (h & 1) * 64 + c8; bf16_t* zp = pblk(p.ws, PB_Z + (h >> 1)) + (size_t)m * 128 + (h & 1) * 64 + c8;
        const bf16x8 vwf = *(const bf16x8*)(wkv + (((size_t)(bq * 16 + h)) * SEQ + tq) * 64 + c8), vwb = *(const bf16x8*)(wkv + (((size_t)(bq * 16 + 8 + h)) * SEQ + (SEQ - 1 - tq)) * 64 + c8);
        const bf16x8 vbf = *(const bf16x8*)(bon + (size_t)m * 512 + ch), vbb = *(const bf16x8*)(bon + (size_t)M_TOK * 512 + (size_t)m * 512 + ch);
        const bf16x8 vg = *(const bf16x8*)gp, vz = *(const bf16x8*)zp;
        const bf16x8 vyf = *(const bf16x8*)(sy + (size_t)m * 512 + ch), vyb = *(const bf16x8*)(sy + (size_t)M_TOK * 512 + (size_t)m * 512 + ch);
        float a[8], bq8[8], x[8], y[8];
        unpack8(vwf, a); unpack8(vwb, bq8); float s = 0.f;
#pragma unroll
        for (int e = 0; e < 8; ++e) { x[e] = a[e] + bq8[e]; s += x[e]; }
        s += __shfl_xor(s, 1); s += __shfl_xor(s, 2); s += __shfl_xor(s, 4);
        const float mean = s * (1.f / 64.f); float v2 = 0.f;
#pragma unroll
        for (int e = 0; e < 8; ++e) { x[e] -= mean; v2 += x[e] * x[e]; }
        v2 += __shfl_xor(v2, 1); v2 += __shfl_xor(v2, 2); v2 += __shfl_xor(v2, 4);
        const float rstd = rsqrtf(v2 * (1.f / 64.f) + eps_gn);
        unpack8(vbf, a); unpack8(vbb, bq8); unpack8(vg, y);
#pragma unroll
        for (int e = 0; e < 8; ++e) x[e] = (x[e] * rstd * lnw[e] + lnb[e] + a[e] + bq8[e]) * siluf(y[e]);
        const u32x4 ob = pack8(x);
        unpack8(vyf, a); unpack8(vyb, bq8); unpack8(vz, y); float ss = 0.f;
#pragma unroll
        for (int e = 0; e < 8; ++e) { x[e] = (a[e] + bq8[e]) * siluf(y[e]); ss += x[e] * x[e]; }
        ss += __shfl_xor(ss, 1); ss += __shfl_xor(ss, 2); ss += __shfl_xor(ss, 4); ss += __shfl_xor(ss, 8); ss += __shfl_xor(ss, 16);
        const float rs = rsqrtf(ss * (1.f / 256.f) + eps_rms);
#pragma unroll
        for (int e = 0; e < 8; ++e) x[e] *= rs * snw[e];
        const u32x4 oa = pack8(x);
        *(u32x4*)gp = ob; *(u32x4*)zp = oa;
    }
}

__device__ __forceinline__ void phase_post(const Params& p, const int l) {
    const int G = gridDim.x, tid = otid(), lane = tid & 63, wave = tid >> 6;
    const float* mix = (const float*)(p.ws + WS_MIX); const float* xin = l == 0 ? p.in[0] : p.out; const float* pw = p.in[2] + l * DMODEL;
    f32x4 wv[4];
#pragma unroll
    for (int j = 0; j < 4; ++j) wv[j] = ((const f32x4*)pw)[lane + 64 * j];
    for (int m0 = (blockIdx.x * 8 + wave) * 2; m0 < M_TOK; m0 += G * 16) {
        f32x4 v[2][4], x[2][4];
#pragma unroll
        for (int q = 0; q < 2; ++q)
#pragma unroll
            for (int j = 0; j < 4; ++j) { v[q][j] = ((const f32x4*)(mix + (size_t)(m0 + q) * DMODEL))[lane + 64 * j]; x[q][j] = ((const f32x4*)(xin + (size_t)(m0 + q) * DMODEL))[lane + 64 * j]; }
#pragma unroll
        for (int q = 0; q < 2; ++q) { float s = 0.f;
#pragma unroll
            for (int j = 0; j < 4; ++j) s += (v[q][j].x * v[q][j].x + v[q][j].y * v[q][j].y) + (v[q][j].z * v[q][j].z + v[q][j].w * v[q][j].w);
            const float rs = rsqrtf(wave_sum(s) * (1.f / DMODEL) + NORM_EPS); float s2 = 0.f;
#pragma unroll
            for (int j = 0; j < 4; ++j) { v[q][j] = x[q][j] + v[q][j] * rs * wv[j]; s2 += (v[q][j].x * v[q][j].x + v[q][j].y * v[q][j].y) + (v[q][j].z * v[q][j].z + v[q][j].w * v[q][j].w); }
            s2 = wave_sum(s2);
            if (lane == 0) ((float*)(g_scr + SCR_RS))[m0 + q] = rsqrtf(s2 * (1.f / DMODEL) + NORM_EPS); }
#pragma unroll
        for (int q = 0; q < 2; ++q) { f32x4* orow = (f32x4*)(p.out + (size_t)(m0 + q) * DMODEL) + lane; u32x2* o8 = (u32x2*)((bf16_t*)(g_scr + SCR_XB) + (size_t)(m0 + q) * DMODEL) + lane;
#pragma unroll
            for (int j = 0; j < 4; ++j) { orow[64 * j] = v[q][j]; u32x2 w; w.x = pk2(v[q][j].x, v[q][j].y); w.y = pk2(v[q][j].z, v[q][j].w); o8[64 * j] = w; } }
    }
}

#define XB_TMO      128
#define XB_XCNT(j)  (256  + 64 * (j))
#define XB_XSUB(j)  (1280 + 64 * (j))
#define XB_XGEN(j)  (2304 + 64 * (j))
#define XB_TOP      3328
#define XB_TOPGEN   3392
#define XCD_BAR_WORDS 3456
#define XB_SPIN_CAP (1u << 18)
#define XLAS __attribute__((address_space(3)))
__device__ __forceinline__ unsigned xb_ld(unsigned* p)              { return __hip_atomic_load(p, __ATOMIC_RELAXED, __HIP_MEMORY_SCOPE_AGENT); }
__device__ __forceinline__ unsigned xb_add(unsigned* p, unsigned v) { return __hip_atomic_fetch_add(p, v, __ATOMIC_RELAXED, __HIP_MEMORY_SCOPE_AGENT); }
__device__ __forceinline__ unsigned xb_xcc_id() { return (unsigned)__builtin_amdgcn_s_getreg((3 << 11) | 20) & 0xFu; }
#define XB_SPIN(cond, bar) do { unsigned _sp = 0; while (cond) { __builtin_amdgcn_s_sleep(1); \
    if ((++_sp & 255u) == 0u) { if (xb_ld(&(bar)[XB_TMO])) break; if (_sp > XB_SPIN_CAP) { atomicAdd(&(bar)[XB_TMO], 1u); break; } } } } while (0)
struct XcdBarrier { unsigned* bar; unsigned x; volatile XLAS unsigned* st; };
__device__ __forceinline__ XcdBarrier xcd_barrier_post(unsigned* bar, volatile XLAS unsigned* st) {
    XcdBarrier b; b.bar = bar; b.x = xb_xcc_id(); b.st = st;
    if (threadIdx.x == 0) (void)xb_add(&bar[XB_XCNT(b.x)], 1u);
    return b;
}
__device__ __forceinline__ void xcd_barrier_complete(unsigned* bar, unsigned x, unsigned& nloc, unsigned& nx) {
    const unsigned G = gridDim.x * gridDim.y * gridDim.z;
    unsigned sum, cnt, mine, sp = 0u;
    for (;;) {
        sum = 0u; cnt = 0u; mine = 0u;
#pragma unroll
        for (unsigned j = 0; j < 16; ++j) { const unsigned c = xb_ld(&bar[XB_XCNT(j)]); sum += c; cnt += (c > 0u) ? 1u : 0u; mine = (j == x) ? c : mine; }
        if (sum == G) break;
        __builtin_amdgcn_s_sleep(1);
        if ((++sp & 255u) == 0u) { if (xb_ld(&bar[XB_TMO])) break; if (sp > XB_SPIN_CAP) { atomicAdd(&bar[XB_TMO], 1u); break; } }
    }
    nloc = mine > 0u ? mine : 1u; nx = cnt > 0u ? cnt : 1u;
}
__device__ __forceinline__ void xcd_barrier(const XcdBarrier& b) {
    asm volatile("s_waitcnt vmcnt(0)" ::: "memory");
    __syncthreads();
    if (threadIdx.x == 0) {
        unsigned* bar = b.bar;
        __builtin_amdgcn_s_waitcnt(0);
        unsigned nloc = b.st[0], nx = b.st[1];
        if (nloc == 0u) { xcd_barrier_complete(bar, b.x, nloc, nx); b.st[0] = nloc; b.st[1] = nx; }
        const unsigned old = xb_add(&bar[XB_XSUB(b.x)], 1u);
        const unsigned gen = old / nloc;
        if (old + 1u == (gen + 1u) * nloc) {
            __builtin_amdgcn_fence(__ATOMIC_RELEASE, "agent");
            asm volatile("s_waitcnt vmcnt(0)" ::: "memory");
            const unsigned og = xb_add(&bar[XB_TOP], 1u);
            const unsigned tg = og / nx;
            if (og + 1u == (tg + 1u) * nx) xb_add(&bar[XB_TOPGEN], 1u);
            else XB_SPIN(xb_ld(&bar[XB_TOPGEN]) == tg, bar);
            __builtin_amdgcn_fence(__ATOMIC_ACQUIRE, "agent");
            xb_add(&bar[XB_XGEN(b.x)], 1u);
            asm volatile("s_waitcnt vmcnt(0)" ::: "memory");
        } else {
            XB_SPIN(xb_ld(&bar[XB_XGEN(b.x)]) == gen, bar);
            __builtin_amdgcn_fence(__ATOMIC_ACQUIRE, "agent");
            asm volatile("s_waitcnt vmcnt(0)" ::: "memory");
        }
    }
    __syncthreads();
}

constexpr int LDS_BYTES = 155648;
static_assert(rk::O_END <= LDS_BYTES, "rwkv LDS map");
__device__ __forceinline__ void phase_gemm_in(const Params& p, const int l, unsigned char* lds) {
    pg8::Gemm g{(const bf16_t*)(g_scr + SCR_XB), (const bf16_t*)(g_scr + SCR_WIN + (size_t)l * 15 * MiB), M_TOK, NPROJ, DMODEL, DMODEL, 128};
    pg8::StaticOrder S; S.init(M_TOK, NPROJ, gridDim.x, blockIdx.x);
    pg8::EpiProj E{(bf16_t*)p.ws, (const float*)(g_scr + SCR_RS), (float*)(g_scr + SCR_DT)};
    pg8::gemm_phase<pg8::EpiProj, pg8::StaticOrder, true, true>((PG8_LAS unsigned char*)lds, g, S, E);
}
__device__ __forceinline__ void phase_gemm_out(const Params& p, const int l, unsigned char* lds) {
    pg8::Gemm g{(const bf16_t*)p.ws, (const bf16_t*)(g_scr + SCR_WOUT + (size_t)l * 4 * MiB), M_TOK, DMODEL, DMIX, 128, PBLK_ELEMS};
    pg8::StaticOrder S; S.init(M_TOK, DMODEL, gridDim.x, blockIdx.x);
    pg8::EpiMix E{(float*)(p.ws + WS_MIX)};
    pg8::gemm_phase<pg8::EpiMix, pg8::StaticOrder, true, true>((PG8_LAS unsigned char*)lds, g, S, E);
}
__device__ __forceinline__ unsigned long long phase_mixers(const Params& p, const int l, unsigned char* lds) {
    unsigned long long pr = 0;
    const int bid = blockIdx.x;
#ifdef PRB_SEQ
    const unsigned long long ts0 = __builtin_amdgcn_s_memrealtime();
#endif
    unsigned* seqdone = (unsigned*)(g_scr + SCR_CTL) + 200 + 8 * l; unsigned* cmbctr = seqdone + 1;
    if (bid < 32) rk::chain(p, bid, lds);
    else if (bid < 64) { const unsigned long long q_ = sd::seq(p, l, bid - 32, lds); (void)q_;
#ifdef PRB_SDIV
        pr = q_;
#endif
    }
    if (bid < 64) {
        asm volatile("s_waitcnt vmcnt(0)" ::: "memory"); __syncthreads();
        if (threadIdx.x == 0) { __builtin_amdgcn_fence(__ATOMIC_RELEASE, "agent"); asm volatile("s_waitcnt vmcnt(0)" ::: "memory"); __hip_atomic_fetch_add(seqdone, 1u, __ATOMIC_RELAXED, __HIP_MEMORY_SCOPE_AGENT); }
    }
#ifdef PRB_SEQ
    pr = __builtin_amdgcn_s_memrealtime() - ts0;
#endif
    unsigned* ctr = (unsigned*)(g_scr + SCR_CTL) + 64 * l;
    unsigned* slot = (unsigned*)(lds + LDS_BYTES - 16);
#ifdef PRB_UNIT
    int nun = 0;
#endif
    const int x0 = (int)(__builtin_amdgcn_s_getreg((3 << 11) | 20) & 7u);
    for (int dx = 0; dx < 8; ++dx) { const int x = (x0 + dx) & 7;
        for (;;) {
            __syncthreads();
            if (threadIdx.x == 0) *slot = atomicAdd(ctr + x, 1u);
            __syncthreads();
            const int j = (int)__builtin_amdgcn_readfirstlane(*slot);
            constexpr int NSPL = 16;
            if (j >= 96 + NSPL) break;
#ifdef PRB_UNIT
            const unsigned long long tu0 = __builtin_amdgcn_s_memrealtime();
#endif
            if (j < 32) gqa_unit(p, l, x * 32 + j, (char*)lds);
            else if (j < 96 - NSPL) diff_unit(p, l, x * 64 + (j - 32), (char*)lds);
            else { const int s = j - (96 - NSPL); diff_unit(p, l, x * 64 + (64 - NSPL) + (s >> 1), (char*)lds, s & 1, x * NSPL + (s >> 1)); }
#ifdef PRB_UNIT
            if (nun == PRB_UNIT) pr = __builtin_amdgcn_s_memrealtime() - tu0;
            if (PRB_UNIT == 99) pr = (unsigned long long)(nun + 1) * 10000ull + (j < 32 ? 1000ull : 0ull);
            ++nun;
#endif
        } }
    {   if (threadIdx.x == 0) { unsigned sp = 0; while (__hip_atomic_load(seqdone, __ATOMIC_RELAXED, __HIP_MEMORY_SCOPE_AGENT) < 64u) { __builtin_amdgcn_s_sleep(8); if (++sp > (1u << 22)) break; } }
        __syncthreads();
        __builtin_amdgcn_fence(__ATOMIC_ACQUIRE, "agent"); asm volatile("s_waitcnt vmcnt(0)" ::: "memory");
        const int wave = otid() >> 6;
        for (;;) {
            __syncthreads();
            if (threadIdx.x == 0) *slot = atomicAdd(cmbctr, 1u);
            __syncthreads();
            const int it = (int)__builtin_amdgcn_readfirstlane(*slot);
            if (it >= M_TOK / 64) break;
            combine_tokens(p, l, it * 64 + wave, it * 64 + 64, 8);
        } }
    return pr;
}
#ifdef PROBE
#define PT0(ph) do { if (l == 0 && (ph) == PRB_PH) pt0 = __builtin_amdgcn_s_memrealtime(); } while (0)
#define PT1(ph, aftersync) do { if (l == 0 && (ph) == PRB_PH && (aftersync) == PRB_SYNC) pd = __builtin_amdgcn_s_memrealtime() - pt0; } while (0)
#else
#define PT0(ph) do {} while (0)
#define PT1(ph, aftersync) do {} while (0)
#endif
__global__ void __launch_bounds__(512) mega(const Params p) {
    extern __shared__ __attribute__((aligned(16))) unsigned char lds[];
    cg::grid_group grid = cg::this_grid();
    unsigned* xbar = (unsigned*)(g_scr + SCR_BAR);
    volatile XLAS unsigned* xst = (volatile XLAS unsigned*)(XLAS unsigned char*)(lds + LDS_BYTES - 32);
    if (blockIdx.x == 0) for (int i = threadIdx.x; i < XCD_BAR_WORDS; i += 512) xbar[i] = 0u;
    if (threadIdx.x < 2) xst[threadIdx.x] = 0u;
#ifdef PROBE
    unsigned long long pt0 = 0, pd = 0;
#endif
#ifdef PROBE
    if (PRB_PH == 7) pt0 = __builtin_amdgcn_s_memrealtime();
#endif
    phase_prologue(p, (float*)lds); grid.sync();
    const XcdBarrier xb = xcd_barrier_post(xbar, xst);
#define GRID_BAR() xcd_barrier(xb)
#ifdef PROBE
    if (PRB_PH == 7) pd = __builtin_amdgcn_s_memrealtime() - pt0;
#endif
#pragma unroll 1
    for (int l = 0; l < 2; ++l) {
        PT0(0); phase_gemm_in(p, l, lds); PT1(0, 0); GRID_BAR(); PT1(0, 1);
        PT0(1); phase_prep(p, l); PT1(1, 0); GRID_BAR(); PT1(1, 1);
        kmax_reduce(l, (float*)lds);
        PT0(6); { const unsigned long long pr_ = rk::pass1(p, l, lds); (void)pr_;
#ifdef PRB_IV
        if (l == 0) pd = pr_;
#endif
        } PT1(6, 0); GRID_BAR(); PT1(6, 1);
        PT0(2); { const unsigned long long pr_ = phase_mixers(p, l, lds); (void)pr_;
#if defined(PRB_SEQ) || defined(PRB_SDIV) || defined(PRB_UNIT)
        if (l == 0) pd = pr_;
#endif
        } PT1(2, 0); GRID_BAR(); PT1(2, 1);
        PT0(4); phase_gemm_out(p, l, lds); PT1(4, 0); GRID_BAR(); PT1(4, 1);
        PT0(5); phase_post(p, l); PT1(5, 0); if (l == 0) { GRID_BAR(); PT1(5, 1); }
    }
#ifdef PROBE
    if (blockIdx.x == PRB_BLK && threadIdx.x == 0) { const unsigned long long d = pd * PRB_K; const unsigned long long t0 = __builtin_amdgcn_s_memrealtime();
        while (__builtin_amdgcn_s_memrealtime() - t0 < d) __builtin_amdgcn_s_sleep(8); }
#endif
}

extern "C" void kernel_launch(void* const* d_in, const int* in_sizes, int n_in, void* d_out, int out_size, void* d_ws, size_t ws_size, hipStream_t stream) {
    static int grid_blocks = 0;
    if (!grid_blocks) {
        int dev = 0, cus = 0, per_cu = 0;
        (void)hipGetDevice(&dev);
        (void)hipDeviceGetAttribute(&cus, hipDeviceAttributeMultiprocessorCount, dev);
        (void)hipFuncSetAttribute((const void*)mega, hipFuncAttributeMaxDynamicSharedMemorySize, LDS_BYTES);
        (void)hipOccupancyMaxActiveBlocksPerMultiprocessor(&per_cu, (const void*)mega, 512, LDS_BYTES);
        if (per_cu < 1) { fprintf(stderr, "kernel_launch: occupancy query says %d blocks/CU\n", per_cu); per_cu = 1; }
        grid_blocks = cus;
    }
    Params p{};
    for (int i = 0; i < 25; ++i) p.in[i] = (const float*)d_in[i];
    p.out = (float*)d_out; p.ws = (unsigned char*)d_ws;
    void* args[] = {&p};
    hipError_t e = hipLaunchCooperativeKernel((const void*)mega, dim3(grid_blocks), dim3(512), args, LDS_BYTES, stream);
    if (e != hipSuccess) fprintf(stderr, "cooperative launch failed: %s (grid %d)\n", hipGetErrorString(e), grid_blocks);
}
```

```cpp
#include <hip/hip_runtime.h>
#include <hip/hip_bf16.h>
#include <hip/hip_cooperative_groups.h>
#include <cstdio>
#include <cstdint>
namespace cg = cooperative_groups;

constexpr int M_TOK = 16384, SEQ = 8192, DMODEL = 1024, NPROJ = 7424, NPB = 58, DIN_ORIG = 7312, DMIX = 2048;
constexpr float NORM_EPS = 1e-6f;
constexpr size_t MiB = 1u << 20;
constexpr int PB_Z = 0, PB_RG = 4, PB_DQ = 8, PB_GQ = 12, PB_XS = 16, PB_BM = 20, PB_CM = 22, PB_R = 24, PB_K = 28, PB_V = 32, PB_WA = 36,
              PB_DK = 37, PB_DV = 41, PB_DG = 45, PB_GK = 49, PB_GV = 51, PB_GG = 53, PB_DT = 57;
constexpr size_t PBLK_ELEMS = (size_t)M_TOK * 128;
constexpr size_t SCR_WIN = 0, SCR_WOUT = 30 * MiB, SCR_ROPE = 38 * MiB, SCR_DT = 40 * MiB, SCR_RS = 41 * MiB, SCR_CTL = 41 * MiB + 512 * 1024,
                 SCR_BAR = 41 * MiB + 768 * 1024, SCR_XB = 42 * MiB, SCR_WKV = 74 * MiB, SCR_BON = 106 * MiB, SCR_SSDY = 138 * MiB, SCR_XACT = 170 * MiB, SCR_NN2 = 202 * MiB, SCR_SPL = 210 * MiB, SCR_BYTES = 228 * MiB;
constexpr size_t SCR_KPART = 41 * MiB + 64 * 1024;
constexpr size_t WS_MM = 16 * PBLK_ELEMS * 2;
constexpr size_t WS_NN = 58 * PBLK_ELEMS * 2;
constexpr size_t WS_MIX = 16 * PBLK_ELEMS * 2;
__device__ __attribute__((aligned(256))) unsigned char g_scr[SCR_BYTES];

typedef unsigned short bf16_t;
typedef short bf16x8 __attribute__((ext_vector_type(8)));
typedef float f32x4 __attribute__((ext_vector_type(4)));
typedef unsigned u32x4 __attribute__((ext_vector_type(4)));
typedef unsigned u32x2 __attribute__((ext_vector_type(2)));

struct Params {
    const float* in[25];
    float* out;
    unsigned char* ws;
};

__device__ __forceinline__ int otid() { int t = threadIdx.x; asm volatile("" : "+v"(t)); return t; }
__device__ __forceinline__ float bf2f(bf16_t v) { return __uint_as_float(((unsigned)v) << 16); }
typedef float f32x2_t __attribute__((ext_vector_type(2))); typedef __bf16 bf16x2_t __attribute__((ext_vector_type(2)));
__device__ __forceinline__ unsigned pk2(float lo, float hi) { f32x2_t v = {lo, hi}; bf16x2_t b = __builtin_convertvector(v, bf16x2_t); return __builtin_bit_cast(unsigned, b); }
__device__ __forceinline__ bf16_t f2bf(float f) { return (bf16_t)(pk2(f, 0.f) & 0xffffu); }
__device__ __forceinline__ float wave_sum(float v) {
#pragma unroll
    for (int o = 1; o < 64; o <<= 1) v += __shfl_xor(v, o);
    return v;
}
__device__ __forceinline__ float siluf(float x) { return x / (1.f + __expf(-x)); }
__device__ __forceinline__ float softplusf(float x) { return fmaxf(x, 0.f) + log1pf(__expf(-fabsf(x))); }
__device__ __forceinline__ bf16_t* pblk(unsigned char* ws, int j) { return (bf16_t*)ws + (size_t)j * PBLK_ELEMS; }

namespace pg8 {
#define PG8_LAS __attribute__((address_space(3)))
constexpr int BM = 256, BK = 64, HALF = 128, HTB = HALF * BK * 2, STAGE_BYTES = 8 * HTB, NXCD = 8, WGM = 8;
__host__ __device__ __forceinline__ int lds_byte(int r, int c) { const int st = (r >> 4) * 2 + (c >> 5), rr = r & 15, cc = c & 31, ob = rr * 64 + cc * 2; return st * 1024 + (ob ^ (((ob >> 9) & 1) << 5)); }
__host__ __device__ __forceinline__ void stage_rc(int b, int& R, int& C) { const int st = b / 1024, sb = b % 1024, swz = sb ^ (((sb >> 9) & 1) << 5); R = (st >> 1) * 16 + swz / 64; C = (st & 1) * 32 + (swz % 64) / 2; }
__host__ __device__ __forceinline__ int perm32(int rho) { const int n = rho >> 4, i = rho & 15; return 8 * (i >> 2) + 4 * n + (i & 3); }
struct Unit { int pm, pn; };
struct Gemm { const bf16_t* A; const bf16_t* Bt; int M, N, K; int lda; size_t abig; };
struct StaticOrder {
    int nM, nN, nwg, G, c;
    __host__ __device__ void init(int M, int N, int G_, int c_) { nM = M / BM; nN = N / BM; nwg = nM * nN; G = G_; c = c_; }
    __host__ __device__ bool next(int i, Unit& u) const {
        const long L = (long)i * G + c; if (L >= nwg) return false;
        int wgid = (int)L; { const int q = nwg / NXCD, r = nwg % NXCD, xcd = wgid % NXCD, off = wgid / NXCD; wgid = (xcd < r ? xcd * (q + 1) : r * (q + 1) + (xcd - r) * q) + off; }
        const int nig = WGM * nN, gid = wgid / nig, fm = gid * WGM, gsz = (nM - fm) < WGM ? (nM - fm) : WGM;
        u.pm = fm + ((wgid % nig) % gsz); u.pn = (wgid % nig) / gsz; return true;
    }
};
template <class Epi, class Sched, bool ALIGN_EPI = false, bool SP2 = false>
__device__ __forceinline__ void gemm_phase(PG8_LAS unsigned char* lds, const Gemm g, const Sched& S, const Epi& E) {
    const int tid = otid(), wid = __builtin_amdgcn_readfirstlane(tid >> 6), lane = tid & 63, wr = wid >> 2, wc = wid & 3, fr = lane & 15, fq = lane >> 4;
    const int K = g.K, nt = K / BK;
    unsigned voffA[2], voffB[2];
#pragma unroll
    for (int i = 0; i < 2; ++i) { int R, C; stage_rc(tid * 16 + i * 8192, R, C); const int Rb = Epi::PERM ? ((R & ~31) + perm32(R & 31)) : R;
        voffA[i] = (unsigned)(R * g.lda + C) * 2u; voffB[i] = (unsigned)(Rb * K + C) * 2u; }
    const size_t kstep = (size_t)(BK * 2);
    const size_t abig = g.abig * 2;
    const size_t hstepA = (size_t)HALF * g.lda * 2, hstepB = (size_t)HALF * K * 2;
    const size_t tstepA = 2 * hstepA, tstepB = 2 * hstepB;
    const unsigned ldsw = (unsigned)wid * 1024u;
    const int aoff = lds_byte(wr * 64 + fr, fq * 8), boff = lds_byte(wc * 32 + fr, fq * 8);
#define PG8_SA(b, h) (((b) * 2 + (h)) * HTB)
#define PG8_SB(b, h) ((4 + (b) * 2 + (h)) * HTB)
#define PG8_STAGE(bufoff, gbase, voff) do { _Pragma("unroll") for (int _i = 0; _i < 2; ++_i) \
        __builtin_amdgcn_global_load_lds((const unsigned*)((const char*)(gbase) + (voff)[_i]), (PG8_LAS unsigned*)(lds + (bufoff) + ldsw + _i * 8192), 16, 0, 0); } while (0)
#define PG8_LDA(dst, b, h) do { _Pragma("unroll") for (int m = 0; m < 4; ++m) _Pragma("unroll") for (int k = 0; k < 2; ++k) dst[m][k] = *(const PG8_LAS bf16x8*)(lds + PG8_SA(b, h) + aoff + m * 2048 + k * 1024); } while (0)
#define PG8_LDB(dst, b, h) do { _Pragma("unroll") for (int n = 0; n < 2; ++n) _Pragma("unroll") for (int k = 0; k < 2; ++k) dst[n][k] = *(const PG8_LAS bf16x8*)(lds + PG8_SB(b, h) + boff + n * 2048 + k * 1024); } while (0)
#define PG8_MMA(ai, bj, At, Bt) do { __builtin_amdgcn_s_setprio(1); _Pragma("unroll") for (int m = 0; m < 4; ++m) _Pragma("unroll") for (int n = 0; n < 2; ++n) _Pragma("unroll") for (int k = 0; k < 2; ++k) \
        acc[ai][bj][m][n] = __builtin_amdgcn_mfma_f32_16x16x32_bf16(Bt[n][k], At[m][k], acc[ai][bj][m][n], 0, 0, 0); __builtin_amdgcn_s_setprio(0); } while (0)
#define PG8_WAIT_V(n) asm volatile("s_waitcnt vmcnt(" #n ")" ::: "memory")
#define PG8_WAIT_L(n) asm volatile("s_waitcnt lgkmcnt(" #n ")" ::: "memory")
#define PG8_BAR __builtin_amdgcn_s_barrier()
#define PG8_SCHED __builtin_amdgcn_sched_barrier(0)
    Unit cur, nxt; int ui = 0;
    if (!S.next(0, cur)) return;
    f32x4 acc[2][2][4][2];
#pragma unroll
    for (int a = 0; a < 2; ++a)
#pragma unroll
        for (int b = 0; b < 2; ++b)
#pragma unroll
            for (int m = 0; m < 4; ++m)
#pragma unroll
                for (int n = 0; n < 2; ++n) acc[a][b][m][n] = (f32x4){0.f, 0.f, 0.f, 0.f};
    bf16x8 At[4][2], B0[2][2], B1[2][2];
    const char* cA = (const char*)g.A + (size_t)cur.pm * tstepA; const char* cB = (const char*)g.Bt + (size_t)cur.pn * tstepB;
    if constexpr (SP2) {
        PG8_STAGE(PG8_SB(0, 0), cB, voffB); PG8_STAGE(PG8_SB(0, 1), cB + hstepB, voffB); PG8_STAGE(PG8_SA(0, 0), cA, voffA); PG8_STAGE(PG8_SA(0, 1), cA + hstepA, voffA);
        if (wr == 1) PG8_BAR;
        PG8_WAIT_V(2); PG8_BAR;
        PG8_STAGE(PG8_SB(1, 0), cB + kstep, voffB); PG8_STAGE(PG8_SA(1, 0), cA + kstep, voffA); PG8_STAGE(PG8_SB(1, 1), cB + hstepB + kstep, voffB);
        PG8_WAIT_V(6); PG8_BAR;
    } else {
        PG8_STAGE(PG8_SB(0, 0), cB, voffB); PG8_STAGE(PG8_SA(0, 0), cA, voffA); PG8_STAGE(PG8_SB(0, 1), cB + hstepB, voffB); PG8_STAGE(PG8_SA(0, 1), cA + hstepA, voffA);
        if (wr == 1) PG8_BAR;
        PG8_WAIT_V(4); PG8_BAR;
        PG8_STAGE(PG8_SB(1, 0), cB + kstep, voffB); PG8_STAGE(PG8_SA(1, 0), cA + kstep, voffA); PG8_STAGE(PG8_SB(1, 1), cB + hstepB + kstep, voffB);
        PG8_WAIT_V(6); PG8_BAR;
    }
    for (;;) {
        const bool has_next = S.next(ui + 1, nxt);
        const char* nA = has_next ? (const char*)g.A + (size_t)nxt.pm * tstepA : cA; const char* nB = has_next ? (const char*)g.Bt + (size_t)nxt.pn * tstepB : cB;
        for (int t = 0; t < nt; t += 2) {
            const bool last = (t == nt - 2);
            const char* a1 = cA + (size_t)(t >> 1) * abig + kstep;
            const char* a2 = last ? nA : cA + (size_t)((t >> 1) + 1) * abig; const char* b2 = last ? nB : cB + (size_t)(t + 2) * kstep;
            const char* a3 = a2 + kstep; const char* b3 = b2 + kstep;
            if constexpr (SP2) {
            PG8_LDB(B0, 0, 0); PG8_LDB(B1, 0, 1); PG8_SCHED; PG8_LDA(At, 0, 0); PG8_STAGE(PG8_SA(1, 1), a1 + hstepA, voffA);
            PG8_WAIT_V(8); PG8_WAIT_L(0); PG8_BAR; PG8_MMA(0, 0, At, B0); PG8_MMA(0, 1, At, B1); PG8_BAR; PG8_SCHED;
            PG8_LDA(At, 0, 1); PG8_STAGE(PG8_SB(0, 0), b2, voffB); PG8_STAGE(PG8_SB(0, 1), b2 + hstepB, voffB); PG8_STAGE(PG8_SA(0, 0), a2, voffA);
            PG8_WAIT_V(8); PG8_WAIT_L(0); PG8_BAR; PG8_MMA(1, 0, At, B0); PG8_MMA(1, 1, At, B1); PG8_BAR; PG8_SCHED;
            PG8_LDB(B0, 1, 0); PG8_LDB(B1, 1, 1); PG8_SCHED; PG8_LDA(At, 1, 0); PG8_STAGE(PG8_SA(0, 1), a2 + hstepA, voffA);
            PG8_WAIT_V(8); PG8_WAIT_L(0); PG8_BAR; PG8_MMA(0, 0, At, B0); PG8_MMA(0, 1, At, B1); PG8_BAR; PG8_SCHED;
            PG8_LDA(At, 1, 1); PG8_STAGE(PG8_SB(1, 0), b3, voffB); PG8_STAGE(PG8_SB(1, 1), b3 + hstepB, voffB); PG8_STAGE(PG8_SA(1, 0), a3, voffA);
            PG8_WAIT_V(8); PG8_WAIT_L(0); PG8_BAR; PG8_MMA(1, 0, At, B0); PG8_MMA(1, 1, At, B1); PG8_BAR; PG8_SCHED;
            } else {
            PG8_LDB(B0, 0, 0); PG8_SCHED; PG8_LDA(At, 0, 0); PG8_STAGE(PG8_SA(1, 1), a1 + hstepA, voffA);
            PG8_WAIT_L(8); PG8_BAR; PG8_WAIT_L(0); PG8_MMA(0, 0, At, B0); PG8_BAR; PG8_SCHED;
            PG8_LDB(B1, 0, 1); PG8_STAGE(PG8_SB(0, 0), b2, voffB);
            PG8_BAR; PG8_WAIT_L(0); PG8_MMA(0, 1, At, B1); PG8_BAR;
            PG8_LDA(At, 0, 1); PG8_STAGE(PG8_SA(0, 0), a2, voffA);
            PG8_BAR; PG8_WAIT_L(0); PG8_MMA(1, 0, At, B0); PG8_BAR; PG8_SCHED;
            PG8_STAGE(PG8_SB(0, 1), b2 + hstepB, voffB);
            PG8_WAIT_V(6); PG8_BAR; PG8_MMA(1, 1, At, B1); PG8_BAR;
            PG8_LDB(B0, 1, 0); PG8_SCHED; PG8_LDA(At, 1, 0); PG8_STAGE(PG8_SA(0, 1), a2 + hstepA, voffA);
            PG8_WAIT_L(8); PG8_BAR; PG8_WAIT_L(0); PG8_MMA(0, 0, At, B0); PG8_BAR; PG8_SCHED;
            PG8_LDB(B1, 1, 1); PG8_STAGE(PG8_SB(1, 0), b3, voffB);
            PG8_BAR; PG8_WAIT_L(0); PG8_MMA(0, 1, At, B1); PG8_BAR;
            PG8_LDA(At, 1, 1); PG8_STAGE(PG8_SA(1, 0), a3, voffA);
            PG8_BAR; PG8_WAIT_L(0); PG8_MMA(1, 0, At, B0); PG8_BAR; PG8_SCHED;
            PG8_STAGE(PG8_SB(1, 1), b3 + hstepB, voffB);
            PG8_WAIT_V(6); PG8_BAR; PG8_MMA(1, 1, At, B1); PG8_BAR;
            }
        }
        if constexpr (ALIGN_EPI) { if (wr == 0) PG8_BAR; }
        E(acc, cur, wr, wc, fr, fq);
        if (!has_next) break;
#pragma unroll
        for (int a = 0; a < 2; ++a)
#pragma unroll
            for (int b = 0; b < 2; ++b)
#pragma unroll
                for (int m = 0; m < 4; ++m)
#pragma unroll
                    for (int n = 0; n < 2; ++n) acc[a][b][m][n] = (f32x4){0.f, 0.f, 0.f, 0.f};
        cur = nxt; cA = nA; cB = nB; ++ui;
        if constexpr (ALIGN_EPI) { if (wr == 1) PG8_BAR; }
    }
    PG8_WAIT_V(0);
    if constexpr (!ALIGN_EPI) { if (wr == 0) PG8_BAR; }
    PG8_BAR;
#undef PG8_SA
#undef PG8_SB
#undef PG8_STAGE
#undef PG8_LDA
#undef PG8_LDB
#undef PG8_MMA
#undef PG8_WAIT_V
#undef PG8_WAIT_L
#undef PG8_BAR
#undef PG8_SCHED
}
struct EpiProj {
    static constexpr bool PERM = true;
    bf16_t* P; const float* rowscale; float* dtbuf;
    __device__ __forceinline__ void operator()(const f32x4 (&acc)[2][2][4][2], const Unit& u, int wr, int wc, int fr, int fq) const {
        const int row0 = u.pm * BM + wr * 64 + fr; const int col = wc * 32 + 8 * fq;
#pragma unroll
        for (int ai = 0; ai < 2; ++ai)
#pragma unroll
            for (int m = 0; m < 4; ++m) { const int row = row0 + ai * HALF + m * 16; const float sc = rowscale[row];
#pragma unroll
                for (int bj = 0; bj < 2; ++bj) { const int blk = u.pn * 2 + bj;
                    const f32x4 v0 = acc[ai][bj][m][0] * sc, v1 = acc[ai][bj][m][1] * sc;
                    u32x4 w; w.x = pk2(v0[0], v0[1]); w.y = pk2(v0[2], v0[3]); w.z = pk2(v1[0], v1[1]); w.w = pk2(v1[2], v1[3]);
                    *(u32x4*)(P + (size_t)blk * PBLK_ELEMS + (size_t)row * 128 + col) = w;
                    if (blk == PB_DT && col < 16) { float* d = dtbuf + (size_t)row * 16 + col; *(f32x4*)d = v0; *(f32x4*)(d + 4) = v1; } } }
    }
};
struct EpiMix {
    static constexpr bool PERM = true;
    float* O;
    __device__ __forceinline__ void operator()(const f32x4 (&acc)[2][2][4][2], const Unit& u, int wr, int wc, int fr, int fq) const {
        const int row0 = u.pm * BM + wr * 64 + fr; const int col0 = u.pn * BM + wc * 32 + 8 * fq;
#pragma unroll
        for (int ai = 0; ai < 2; ++ai)
#pragma unroll
            for (int m = 0; m < 4; ++m) { float* rp = O + (size_t)(row0 + ai * HALF + m * 16) * DMODEL + col0;
#pragma unroll
                for (int bj = 0; bj < 2; ++bj) { *(f32x4*)(rp + bj * HALF) = acc[ai][bj][m][0]; *(f32x4*)(rp + bj * HALF + 4) = acc[ai][bj][m][1]; } }
    }
};
}

__device__ __forceinline__ int orig_col(int n) {
    if (n < 512) return n;
    if (n < 1024) return 3216 + (n - 512);
    if (n < 1536) return 3728 + (n - 1024);
    if (n < 2048) return 5776 + (n - 1536);
    if (n < 3072) return 512 + (n - 2048);
    if (n < 4736) return 1552 + (n - 3072);
    if (n < 5248) return 4240 + (n - 4736);
    if (n < 5760) return 4752 + (n - 5248);
    if (n < 6272) return 5264 + (n - 5760);
    if (n < 6528) return 6288 + (n - 6272);
    if (n < 6784) return 6544 + (n - 6528);
    if (n < 7296) return 6800 + (n - 6784);
    if (n < 7312) return 1536 + (n - 7296);
    return -1;
}
struct TrItem { const float* W; const float* ks; bf16_t* WT; int K, Nsrc, k0, n0; bool mapcol; };
__device__ __forceinline__ TrItem tr_item(const Params& p, int it) {
    constexpr int I_IN = 16 * 29, I_OUT = 32 * 4;
    TrItem t; int r = it; const int l = r / (I_IN + I_OUT); r -= l * (I_IN + I_OUT);
    if (r < I_IN) { t.W = p.in[3] + (size_t)l * DMODEL * DIN_ORIG; t.ks = p.in[1] + l * DMODEL; t.WT = (bf16_t*)(g_scr + SCR_WIN + (size_t)l * 15 * MiB); t.K = DMODEL; t.Nsrc = DIN_ORIG; t.k0 = (r / 29) * 64; t.n0 = (r % 29) * 256; t.mapcol = true; }
    else { r -= I_IN; t.W = p.in[4] + (size_t)l * DMIX * DMODEL; t.ks = nullptr; t.WT = (bf16_t*)(g_scr + SCR_WOUT + (size_t)l * 4 * MiB); t.K = DMIX; t.Nsrc = DMODEL; t.k0 = (r / 4) * 64; t.n0 = (r % 4) * 256; t.mapcol = false; }
    return t;
}
__device__ __forceinline__ void tr_load(const TrItem& t, int tid, float* v) {
    const int nn = tid & 63;
#pragma unroll
    for (int q = 0; q < 4; ++q) { const int n = t.n0 + 64 * q + nn; const int oc = t.mapcol ? orig_col(n) : n;
#pragma unroll
        for (int i = 0; i < 8; ++i) { const int kk = (tid >> 6) + 8 * i; v[q * 8 + i] = (oc >= 0) ? t.W[(size_t)(t.k0 + kk) * t.Nsrc + oc] * (t.ks ? t.ks[t.k0 + kk] : 1.f) : 0.f; } }
}
__device__ __forceinline__ void rope_entry(int idx, float* tab) {
    const int pos = idx >> 5, i = idx & 31;
    const float inv = exp2f(-(float)i * (13.287712379549449f / 32.f));
    const float ang = (float)pos * inv;
    const double rev = (double)ang * 0.15915494309189535; const double fr = rev - floor(rev);
    const float a = (float)(fr * 6.283185307179586);
    tab[idx * 2] = cosf(a); tab[idx * 2 + 1] = sinf(a);
}
__device__ __forceinline__ void xrow_to_bf16(const float* xrow, bf16_t* orow, float* rs, int lane) {
    const f32x4* xr = (const f32x4*)xrow + lane; f32x4 v[4]; float s = 0.f;
#pragma unroll
    for (int j = 0; j < 4; ++j) { v[j] = xr[64 * j]; s += (v[j].x * v[j].x + v[j].y * v[j].y) + (v[j].z * v[j].z + v[j].w * v[j].w); }
    s = wave_sum(s);
    if (lane == 0) *rs = rsqrtf(s * (1.f / DMODEL) + NORM_EPS);
    u32x2* o8 = (u32x2*)orow + lane;
#pragma unroll
    for (int j = 0; j < 4; ++j) { u32x2 w; w.x = pk2(v[j].x, v[j].y); w.y = pk2(v[j].z, v[j].w); o8[64 * j] = w; }
}
__device__ __forceinline__ void phase_prologue(const Params& p, float* lds_f) {
    const int G = gridDim.x, bid = blockIdx.x, tid = otid(), lane = tid & 63, wave = tid >> 6;
    {   constexpr int NIT = 2 * (16 * 29 + 32 * 4);
        float v[32], v2[32]; int it = bid; TrItem cur = tr_item(p, it < NIT ? it : 0);
        if (it < NIT) tr_load(cur, tid, v);
        while (it < NIT) {
            const int nn = tid & 63;
#pragma unroll
            for (int q = 0; q < 4; ++q)
#pragma unroll
                for (int i = 0; i < 8; ++i) lds_f[q * 4160 + ((tid >> 6) + 8 * i) * 65 + nn] = v[q * 8 + i];
            const int nx = it + G; TrItem nxt = tr_item(p, nx < NIT ? nx : 0);
            if (nx < NIT) tr_load(nxt, tid, v2);
            __syncthreads();
#pragma unroll
            for (int q = 0; q < 4; ++q) { const int n = tid >> 3, c = tid & 7; const float* s = lds_f + q * 4160 + (8 * c) * 65 + n;
                u32x4 o; o.x = pk2(s[0], s[65]); o.y = pk2(s[2 * 65], s[3 * 65]); o.z = pk2(s[4 * 65], s[5 * 65]); o.w = pk2(s[6 * 65], s[7 * 65]);
                *(u32x4*)(cur.WT + (size_t)(cur.n0 + 64 * q + n) * cur.K + cur.k0 + 8 * c) = o; }
            __syncthreads();
#pragma unroll
            for (int i = 0; i < 32; ++i) v[i] = v2[i];
            cur = nxt; it = nx;
        }
    }
    if (bid == 0) { ((unsigned*)(g_scr + SCR_CTL))[tid] = 0u; ((unsigned*)(g_scr + SCR_CTL))[512 + tid] = 0u; }
    for (int i = bid * 512 + tid; i < SEQ * 32; i += G * 512) rope_entry(i, (float*)(g_scr + SCR_ROPE));
    for (int m = bid * 8 + wave; m < M_TOK; m += G * 8) xrow_to_bf16(p.in[0] + (size_t)m * DMODEL, (bf16_t*)(g_scr + SCR_XB) + (size_t)m * DMODEL, (float*)(g_scr + SCR_RS) + m, lane);
}

__device__ __forceinline__ void unpack8(const bf16x8 v, float* x) {
#pragma unroll
    for (int e = 0; e < 8; ++e) x[e] = bf2f((bf16_t)v[e]);
}
__device__ __forceinline__ u32x4 pack8(const float* x) { u32x4 o; o.x = pk2(x[0], x[1]); o.y = pk2(x[2], x[3]); o.z = pk2(x[4], x[5]); o.w = pk2(x[6], x[7]); return o; }
__device__ __forceinline__ void rope8(float* x, const float* cs, const bool upper) {
#pragma unroll
    for (int e = 0; e < 8; ++e) { const float o = __shfl_xor(x[e], 4); x[e] = upper ? (x[e] * cs[2 * e] + o * cs[2 * e + 1]) : (x[e] * cs[2 * e] - o * cs[2 * e + 1]); }
}
__device__ __forceinline__ void phase_prep(const Params& p, const int l) {
    const int G = gridDim.x;
    {   const int tid = otid(), lane = tid & 63, wave = tid >> 6;
        bf16x8 cv[5], nv_[5];
#define CONV_LOAD(dst, it_) do { const int m_ = (it_) >> 1, t_ = m_ & (SEQ - 1); const int ch_ = ((it_) & 1) * 512 + lane * 8; const bf16_t* src_ = pblk(p.ws, PB_XS + (ch_ >> 7)) + (ch_ & 127); \
            _Pragma("unroll") for (int jj = 0; jj < 5; ++jj) { const int tt = t_ + jj - 2; const bool ok = tt >= 0 && tt < SEQ; dst[jj] = ok ? *(const bf16x8*)(src_ + ((size_t)(m_ - t_ + tt)) * 128) : (bf16x8){0, 0, 0, 0, 0, 0, 0, 0}; } } while (0)
        int it = blockIdx.x * 8 + wave;
        if (it < M_TOK * 2) CONV_LOAD(cv, it);
        for (; it < M_TOK * 2; it += G * 8) {
            const int m = it >> 1, half = it & 1;
            const int ch = half * 512 + lane * 8;
            const float* cw = p.in[5] + (size_t)l * 5 * 1024 + ch; const float* cb = p.in[6] + (size_t)l * 1024 + ch;
            if (it + G * 8 < M_TOK * 2) CONV_LOAD(nv_, it + G * 8);
            float acc[8]; { const f32x4 b0 = *(const f32x4*)cb, b1 = *(const f32x4*)(cb + 4);
#pragma unroll
              for (int e = 0; e < 4; ++e) { acc[e] = b0[e]; acc[4 + e] = b1[e]; } }
#pragma unroll
            for (int jj = 0; jj < 5; ++jj) { const f32x4 w0 = *(const f32x4*)(cw + jj * 1024), w1 = *(const f32x4*)(cw + jj * 1024 + 4);
#pragma unroll
                for (int e = 0; e < 4; ++e) { acc[e] += w0[e] * bf2f((bf16_t)cv[jj][e]); acc[4 + e] += w1[e] * bf2f((bf16_t)cv[jj][4 + e]); } }
#pragma unroll
            for (int e = 0; e < 8; ++e) acc[e] = siluf(acc[e]);
            *(u32x4*)((bf16_t*)(g_scr + SCR_XACT) + (size_t)m * 1024 + ch) = pack8(acc);
#pragma unroll
            for (int jj = 0; jj < 5; ++jj) cv[jj] = nv_[jj];
        }
#undef CONV_LOAD
    }
    const int tid = otid(), lane = tid & 63, wave = tid >> 6;
    const float* tab = (const float*)(g_scr + SCR_ROPE);
    const int hh = lane >> 4, c16 = lane & 15, j8 = (c16 & 7) * 8, fi = j8 & 31; const bool upper = j8 >= 32, second = c16 >= 8;
    float kw[8];
#pragma unroll
    for (int e = 0; e < 8; ++e) kw[e] = p.in[24][l * 128 + c16 * 8 + e];
    float* kpart = (float*)(g_scr + SCR_KPART); const int gwv = blockIdx.x * 8 + wave;
    float mxd = 0.f, mxg = 0.f; int curb = (blockIdx.x * 8 + wave) >> 13;
    bf16x8 vdk, vgk, ndk, ngk; float cst[16], csa[16], nst[16], nsa[16];
#define QK_LOAD(m_, dk_, gk_, st_, sa_) do { const int t_ = (m_) & (SEQ - 1); const int row_ = t_ >> 6, col_ = t_ & 63; \
        dk_ = *(const bf16x8*)(pblk(p.ws, PB_DK + hh) + (size_t)(m_) * 128 + c16 * 8); gk_ = *(const bf16x8*)(pblk(p.ws, PB_GK + (hh & 1)) + (size_t)(m_) * 128 + c16 * 8); \
        const f32x4* a_ = (const f32x4*)(tab + ((size_t)t_ * 32 + fi) * 2); const f32x4* b_ = (const f32x4*)(tab + ((size_t)(second ? col_ : row_) * 32 + fi) * 2); \
        _Pragma("unroll") for (int i_ = 0; i_ < 4; ++i_) { const f32x4 u_ = a_[i_], v_ = b_[i_]; _Pragma("unroll") for (int e_ = 0; e_ < 4; ++e_) { st_[4 * i_ + e_] = u_[e_]; sa_[4 * i_ + e_] = v_[e_]; } } } while (0)
    {   const int m0 = blockIdx.x * 8 + wave; if (m0 < M_TOK) QK_LOAD(m0, vdk, vgk, cst, csa); }
    for (int m = blockIdx.x * 8 + wave; m < M_TOK; m += G * 8) {
        if ((m >> 13) != curb) {
            if ((lane & 7) == 0) { kpart[((size_t)(l * 2 + curb) * 10 + hh * 2 + (c16 >> 3)) * 2048 + gwv] = mxd; if (lane < 32 && c16 == 0) kpart[((size_t)(l * 2 + curb) * 10 + 8 + hh) * 2048 + gwv] = mxg; }
            mxd = 0.f; mxg = 0.f; curb = m >> 13; }
        bf16_t* pdk = pblk(p.ws, PB_DK + hh) + (size_t)m * 128 + c16 * 8; bf16_t* pgk = pblk(p.ws, PB_GK + (hh & 1)) + (size_t)m * 128 + c16 * 8;
        if (m + G * 8 < M_TOK) QK_LOAD(m + G * 8, ndk, ngk, nst, nsa);
        float x[8];
        unpack8(vdk, x);
        { float s2 = 0.f;
#pragma unroll
          for (int e = 0; e < 8; ++e) s2 += x[e] * x[e];
          s2 += __shfl_xor(s2, 1); s2 += __shfl_xor(s2, 2); s2 += __shfl_xor(s2, 4); mxd = fmaxf(mxd, s2); }
        rope8(x, cst, upper); const u32x4 odk = pack8(x);
        float ss;
        unpack8(vgk, x); ss = 0.f;
#pragma unroll
        for (int e = 0; e < 8; ++e) ss += x[e] * x[e];
        ss += __shfl_xor(ss, 1); ss += __shfl_xor(ss, 2); ss += __shfl_xor(ss, 4); ss += __shfl_xor(ss, 8);
        { const float rs = rsqrtf(ss * (1.f / 128.f) + NORM_EPS);
#pragma unroll
          for (int e = 0; e < 8; ++e) x[e] *= rs * kw[e]; }
        { float s2 = 0.f;
#pragma unroll
          for (int e = 0; e < 8; ++e) s2 += x[e] * x[e];
          s2 += __shfl_xor(s2, 1); s2 += __shfl_xor(s2, 2); s2 += __shfl_xor(s2, 4); s2 += __shfl_xor(s2, 8); mxg = fmaxf(mxg, s2); }
        rope8(x, csa, upper); const u32x4 ogk = pack8(x);
        *(u32x4*)pdk = odk; if (lane < 32) *(u32x4*)pgk = ogk;
        vdk = ndk; vgk = ngk;
#pragma unroll
        for (int e = 0; e < 16; ++e) { cst[e] = nst[e]; csa[e] = nsa[e]; }
    }
#undef QK_LOAD
    if ((lane & 7) == 0) { kpart[((size_t)(l * 2 + curb) * 10 + hh * 2 + (c16 >> 3)) * 2048 + gwv] = mxd; if (lane < 32 && c16 == 0) kpart[((size_t)(l * 2 + curb) * 10 + 8 + hh) * 2048 + gwv] = mxg; }
}

__device__ __forceinline__ void kmax_reduce(const int l, float* lds_f) {
    if (blockIdx.x < 20) {
        const int b = blockIdx.x / 10, slot = blockIdx.x % 10, tid = threadIdx.x;
        const float* src = (const float*)(g_scr + SCR_KPART) + ((size_t)(l * 2 + b) * 10 + slot) * 2048;
        float v = fmaxf(fmaxf(src[tid], src[512 + tid]), fmaxf(src[1024 + tid], src[1536 + tid]));
#pragma unroll
        for (int o = 1; o < 64; o <<= 1) v = fmaxf(v, __shfl_xor(v, o));
        if ((tid & 63) == 0) lds_f[tid >> 6] = v;
        __syncthreads();
        if (tid == 0) { float m = lds_f[0];
#pragma unroll
            for (int i = 1; i < 8; ++i) m = fmaxf(m, lds_f[i]);
            ((float*)(g_scr + SCR_CTL))[256 + 64 * l + (slot < 8 ? b * 8 + slot : 16 + b * 2 + (slot - 8))] = m; }
        __syncthreads();
    }
}

namespace att {
using s16x4 = __attribute__((ext_vector_type(4))) short;
using f32x16 = __attribute__((ext_vector_type(16))) float;
constexpr int D = 128, NW = 8, QBLK = 32, KVBLK = 64, LD = 128;
constexpr float THR = 8.f;
constexpr size_t SHM_V = KVBLK * D * 2, SHM_K = KVBLK * D * 2, SHM_ATTN = 2 * SHM_V + 2 * SHM_K + NW * 64 * 4;
#define KSWZ(row, colB) ((row) * 256 + ((colB) ^ (((row) & 7) << 4)))
#define SBAR() __builtin_amdgcn_sched_barrier(0)
__device__ __forceinline__ int crow(int r, int hi) { return (r & 3) + 8 * (r >> 2) + 4 * hi; }
__device__ __forceinline__ unsigned cvtpk(float lo, float hi) { unsigned r; asm volatile("v_cvt_pk_bf16_f32 %0, %1, %2" : "=v"(r) : "v"(lo), "v"(hi)); return r; }
__device__ __forceinline__ void glds16(const void* gsrc, unsigned lds_dst) { unsigned keep;
  asm volatile("s_mov_b32 %0, m0\n\ts_mov_b32 m0, %2\n\ts_nop 0\n\tglobal_load_lds_dwordx4 %1, off\n\ts_mov_b32 m0, %0" : "=&s"(keep) : "v"(gsrc), "s"(lds_dst) : "memory"); }
template <int DIFF>
__device__ __forceinline__ void partialSM(f32x16& p0, f32x16& p1, const float mnC) {
  constexpr float SCALE = DIFF ? 0.125f : 0.088388347648318440f;
  constexpr float C = SCALE * 1.4426950408889634f;
  _Pragma("unroll") for (int r = 0; r < 16; ++r) p0[r] = fmaf(p0[r], C, mnC); _Pragma("unroll") for (int r = 0; r < 16; ++r) p1[r] = fmaf(p1[r], C, mnC);
  _Pragma("unroll") for (int r = 0; r < 16; ++r) p0[r] = __builtin_amdgcn_exp2f(p0[r]);
}
__device__ __forceinline__ void finishSM(f32x16& p0, f32x16& p1, float& l_reg, bf16x8& pa0, bf16x8& pa1, bf16x8& pa2, bf16x8& pa3) {
  _Pragma("unroll") for (int r = 0; r < 16; ++r) p1[r] = __builtin_amdgcn_exp2f(p1[r]);
  float ps = 0; _Pragma("unroll") for (int r = 0; r < 16; ++r) ps += p0[r]; _Pragma("unroll") for (int r = 0; r < 16; ++r) ps += p1[r];
  { auto rr = __builtin_amdgcn_permlane32_swap(__float_as_uint(ps), __float_as_uint(ps), false, false);
    ps = __uint_as_float(rr[0]) + __uint_as_float(rr[1]); }
  l_reg += ps;
#define PK4(P, BASE, OUT) do { unsigned a0 = cvtpk(P[BASE + 0], P[BASE + 1]), a1 = cvtpk(P[BASE + 2], P[BASE + 3]);   \
    unsigned b0 = cvtpk(P[BASE + 4], P[BASE + 5]), b1 = cvtpk(P[BASE + 6], P[BASE + 7]);                              \
    auto r0 = __builtin_amdgcn_permlane32_swap(a0, b0, false, false); auto r1 = __builtin_amdgcn_permlane32_swap(a1, b1, false, false); \
    u32x4 w = {r0[0], r1[0], r0[1], r1[1]}; OUT = *reinterpret_cast<bf16x8*>(&w); } while (0)
  PK4(p0, 0, pa0); PK4(p0, 8, pa1); PK4(p1, 0, pa2); PK4(p1, 8, pa3);
#undef PK4
}
template <int ND0>
__device__ __forceinline__ void qkt(f32x16& p0, f32x16& p1, const bf16_t* Ks, const bf16x8* qr, int r32, int hi, int db0) {
  p0 = f32x16{}; p1 = f32x16{};
  _Pragma("unroll") for (int d0 = 0; d0 < ND0; ++d0) { int cb = ((db0 + d0) * 16 + hi * 8) * 2;
    bf16x8 b0 = *reinterpret_cast<const bf16x8*>((const char*)Ks + KSWZ(r32, cb));
    bf16x8 b1 = *reinterpret_cast<const bf16x8*>((const char*)Ks + KSWZ(32 + r32, cb));
    p0 = __builtin_amdgcn_mfma_f32_32x32x16_bf16(b0, qr[d0], p0, 0, 0, 0);
    p1 = __builtin_amdgcn_mfma_f32_32x32x16_bf16(b1, qr[d0], p1, 0, 0, 0); }
}
__device__ __forceinline__ int v_st(int k, int c) { const int kk = (k & ~0xC) | ((k & 4) << 1) | ((k & 8) >> 1); return ((kk >> 3) * 4 + (c >> 5)) * 512 + ((kk & 7) * 32 + (c & 31)) * 2; }
__device__ __forceinline__ int v_rd_base(int lane) { return ((lane & 3) << 3) | (((lane >> 2) & 3) << 6) | (((lane >> 4) & 1) << 5) | (((lane >> 5) & 1) << 8); }
constexpr int v_rd_off(int d0, int ks, int half) { return d0 * 512 + ks * 4096 + half * 2048; }
template <int OFF> __device__ __forceinline__ s16x4 tr_read(int vb) {
  s16x4 r; asm volatile("ds_read_b64_tr_b16 %0, %1 offset:%2" : "=&v"(r) : "v"(vb), "i"(OFF) : "memory"); return r;
}
template <int D0> __device__ __forceinline__ void pv_one(f32x16& od, int vb, bf16x8 pa0, bf16x8 pa1, bf16x8 pa2, bf16x8 pa3) {
  const s16x4 l0 = tr_read<v_rd_off(D0, 0, 0)>(vb), h0 = tr_read<v_rd_off(D0, 0, 1)>(vb), l1 = tr_read<v_rd_off(D0, 1, 0)>(vb), h1 = tr_read<v_rd_off(D0, 1, 1)>(vb);
  const s16x4 l2 = tr_read<v_rd_off(D0, 2, 0)>(vb), h2 = tr_read<v_rd_off(D0, 2, 1)>(vb), l3 = tr_read<v_rd_off(D0, 3, 0)>(vb), h3 = tr_read<v_rd_off(D0, 3, 1)>(vb);
  asm volatile("s_waitcnt lgkmcnt(0)" ::: "memory"); SBAR();
#define PK(L, H) (bf16x8){L[0], L[1], L[2], L[3], H[0], H[1], H[2], H[3]}
  od = __builtin_amdgcn_mfma_f32_32x32x16_bf16(pa0, PK(l0, h0), od, 0, 0, 0);
  od = __builtin_amdgcn_mfma_f32_32x32x16_bf16(pa1, PK(l1, h1), od, 0, 0, 0);
  od = __builtin_amdgcn_mfma_f32_32x32x16_bf16(pa2, PK(l2, h2), od, 0, 0, 0);
  od = __builtin_amdgcn_mfma_f32_32x32x16_bf16(pa3, PK(l3, h3), od, 0, 0, 0);
#undef PK
}
__device__ __forceinline__ void pv_d0(f32x16* o, int vb, bf16x8 pa0, bf16x8 pa1, bf16x8 pa2, bf16x8 pa3) {
  pv_one<0>(o[0], vb, pa0, pa1, pa2, pa3); pv_one<1>(o[1], vb, pa0, pa1, pa2, pa3); pv_one<2>(o[2], vb, pa0, pa1, pa2, pa3); pv_one<3>(o[3], vb, pa0, pa1, pa2, pa3);
}
template <int DIFF>
__device__ __forceinline__ void attn_unit(const bf16_t* Qb, const bf16_t* __restrict__ Kh, const bf16_t* __restrict__ Vh, bf16_t* Ob, const bf16_t* gate,
                                          int seq, char* lds, const float* lamp, int layer, const float* nw, const float* kmax2p, const int tpos0, const float* qnw, unsigned* splc = nullptr, float* splp = nullptr) {
  constexpr int ND0 = DIFF ? 4 : 8;
  const int tid = otid(), wid = tid >> 6, lane = tid & 63, r32 = lane & 31, hi = lane >> 5;
  const int wq = DIFF ? (wid & 3) : wid, mapc = DIFF ? (wid >> 2) : 0;
  constexpr int RSTG = 32768, RK = 16384, E_ST = 67584, E_WS = 137216;
  float* li_l = (float*)(lds + E_WS) + wid * 64;
  float l_reg = 0; f32x16 o[4] = {}; bf16x8 qr[ND0];
  const bf16_t* Qw = Qb + (long)(wq * QBLK + r32) * LD + mapc * 64 + hi * 8;
  {
      const float* tab = (const float*)(g_scr + SCR_ROPE);
      const int trow = tpos0 + wq * QBLK + r32;
      float qf[ND0][8];
      _Pragma("unroll") for (int d0 = 0; d0 < ND0; ++d0) { const bf16x8 raw = *reinterpret_cast<const bf16x8*>(Qw + d0 * 16); _Pragma("unroll") for (int e = 0; e < 8; ++e) qf[d0][e] = bf2f((bf16_t)raw[e]); }
      if constexpr (!DIFF) {
        float ss = 0.f;
        _Pragma("unroll") for (int d0 = 0; d0 < ND0; ++d0) _Pragma("unroll") for (int e = 0; e < 8; ++e) ss += qf[d0][e] * qf[d0][e];
        { auto rr = __builtin_amdgcn_permlane32_swap(__float_as_uint(ss), __float_as_uint(ss), false, false); ss = __uint_as_float(rr[0]) + __uint_as_float(rr[1]); }
        const float rs = rsqrtf(ss * (1.f / 128.f) + NORM_EPS);
        _Pragma("unroll") for (int d0 = 0; d0 < ND0; ++d0) { const f32x4 w0 = *(const f32x4*)(qnw + d0 * 16 + hi * 8), w1 = *(const f32x4*)(qnw + d0 * 16 + hi * 8 + 4);
          _Pragma("unroll") for (int e = 0; e < 4; ++e) { qf[d0][e] *= rs * w0[e]; qf[d0][4 + e] *= rs * w1[e]; } }
      }
      _Pragma("unroll") for (int hb = 0; hb < ND0 / 4; ++hb) {
        const int pos = DIFF ? trow : (hb == 0 ? (trow >> 6) : (trow & 63));
        _Pragma("unroll") for (int dl = 0; dl < 2; ++dl) { const int d0 = hb * 4 + dl; const float* cp = tab + ((size_t)pos * 32 + dl * 16 + hi * 8) * 2; float cs[16];
          _Pragma("unroll") for (int i = 0; i < 4; ++i) { const f32x4 u_ = ((const f32x4*)cp)[i]; _Pragma("unroll") for (int e = 0; e < 4; ++e) cs[4 * i + e] = u_[e]; }
          _Pragma("unroll") for (int e = 0; e < 8; ++e) { const float x1 = qf[d0][e], x2 = qf[d0 + 2][e]; qf[d0][e] = x1 * cs[2 * e] - x2 * cs[2 * e + 1]; qf[d0 + 2][e] = x2 * cs[2 * e] + x1 * cs[2 * e + 1]; } } }
      _Pragma("unroll") for (int d0 = 0; d0 < ND0; ++d0) { u32x4 w_; w_.x = pk2(qf[d0][0], qf[d0][1]); w_.y = pk2(qf[d0][2], qf[d0][3]); w_.z = pk2(qf[d0][4], qf[d0][5]); w_.w = pk2(qf[d0][6], qf[d0][7]); qr[d0] = *reinterpret_cast<bf16x8*>(&w_); }
  }
  float mnC;
  { float qn2 = 0.f;
    _Pragma("unroll") for (int d0 = 0; d0 < ND0; ++d0) _Pragma("unroll") for (int e = 0; e < 8; ++e) { const float q = bf2f((bf16_t)qr[d0][e]); qn2 += q * q; }
    { auto rr = __builtin_amdgcn_permlane32_swap(__float_as_uint(qn2), __float_as_uint(qn2), false, false); qn2 = __uint_as_float(rr[0]) + __uint_as_float(rr[1]); }
    const float km2 = kmax2p[DIFF ? mapc : 0];
    mnC = -(sqrtf(qn2 * km2) * 1.02f + 1e-3f) * ((DIFF ? 0.125f : 0.088388347648318440f) * 1.4426950408889634f); }
  unsigned ksrc[2], vsrc[2];
  _Pragma("unroll") for (int i = 0; i < 2; ++i) { const int pc = 2 * wid + i;
    { const int row = 4 * pc + (lane >> 4); ksrc[i] = (unsigned)(row * 256 + (((lane & 15) ^ (row & 7)) << 4)); }
    { const int st = 2 * pc + (lane >> 5), l5 = lane & 31, kk = (st >> 2) * 8 + (l5 >> 2), k = (kk & ~0xC) | ((kk & 4) << 1) | ((kk & 8) >> 1); vsrc[i] = (unsigned)(k * 256 + ((st & 3) * 32 + (l5 & 3) * 8) * 2); } }
  const unsigned ldsb = (unsigned)(uintptr_t)lds + (unsigned)__builtin_amdgcn_readfirstlane(wid) * 2048u;
  const int vb0 = (int)(uintptr_t)lds + v_rd_base(lane);
#define DMA(k0, so) do { const char* kt_ = (const char*)Kh + (size_t)(k0) * 256; const char* vt_ = (const char*)Vh + (size_t)(k0) * 256; const unsigned d_ = ldsb + (unsigned)(so); \
    glds16(vt_ + vsrc[0], (unsigned)__builtin_amdgcn_readfirstlane(d_)); glds16(vt_ + vsrc[1], (unsigned)__builtin_amdgcn_readfirstlane(d_ + 1024u)); \
    glds16(kt_ + ksrc[0], (unsigned)__builtin_amdgcn_readfirstlane(d_ + (unsigned)RK)); glds16(kt_ + ksrc[1], (unsigned)__builtin_amdgcn_readfirstlane(d_ + (unsigned)RK + 1024u)); } while (0)
#define DWAIT() asm volatile("s_waitcnt vmcnt(0)" ::: "memory")
  f32x16 p0, p1; bf16x8 pa0, pa1, pa2, pa3; int NT = seq / KVBLK; asm volatile("" : "+s"(NT));
  const bool odd = __builtin_amdgcn_readfirstlane(wid) >= 4;
  int kad[4];
  _Pragma("unroll") for (int i = 0; i < 4; ++i) kad[i] = (int)(uintptr_t)lds + RK + KSWZ(r32, ((mapc * 4 + i) * 16 + hi * 8) * 2);
#define BAR() do { SBAR(); __builtin_amdgcn_s_barrier(); SBAR(); } while (0)
#define LWAIT4(N, A, B, C, Dd) asm volatile("s_waitcnt lgkmcnt(%4)" : "+v"(A), "+v"(B), "+v"(C), "+v"(Dd) : "n"(N))
#define LWAIT2(N, A, B) asm volatile("s_waitcnt lgkmcnt(%2)" : "+v"(A), "+v"(B) : "n"(N))
#define PK(L, H) (bf16x8){L[0], L[1], L[2], L[3], H[0], H[1], H[2], H[3]}
#define VRD(N, D0, KP, VB) N##a = tr_read<v_rd_off(D0, 2 * KP, 0)>(VB); N##b = tr_read<v_rd_off(D0, 2 * KP, 1)>(VB); N##c = tr_read<v_rd_off(D0, 2 * KP + 1, 0)>(VB); N##d = tr_read<v_rd_off(D0, 2 * KP + 1, 1)>(VB)
#define VDECL(N) s16x4 N##a, N##b, N##c, N##d
#define VMM(N, D0, PA, PB, W) LWAIT4(W, N##a, N##b, N##c, N##d); o[D0] = __builtin_amdgcn_mfma_f32_32x32x16_bf16(PA, PK(N##a, N##b), o[D0], 0, 0, 0); o[D0] = __builtin_amdgcn_mfma_f32_32x32x16_bf16(PB, PK(N##c, N##d), o[D0], 0, 0, 0); SBAR()
#define KRD(N, DS) bf16x8 N##a, N##b; asm volatile("ds_read_b128 %0, %1 offset:%2" : "=&v"(N##a) : "v"(ka[(DS) & 3]), "i"(((DS) >> 2) * 128) : "memory"); asm volatile("ds_read_b128 %0, %1 offset:%2" : "=&v"(N##b) : "v"(ka[(DS) & 3]), "i"(((DS) >> 2) * 128 + 8192) : "memory")
#define KMM0(N, DS, W) LWAIT2(W, N##a, N##b); p0 = __builtin_amdgcn_mfma_f32_32x32x16_bf16(N##a, qr[DS], f32x16{}, 0, 0, 0); p1 = __builtin_amdgcn_mfma_f32_32x32x16_bf16(N##b, qr[DS], f32x16{}, 0, 0, 0); SBAR()
#define KMM(N, DS, W) LWAIT2(W, N##a, N##b); p0 = __builtin_amdgcn_mfma_f32_32x32x16_bf16(N##a, qr[DS], p0, 0, 0, 0); p1 = __builtin_amdgcn_mfma_f32_32x32x16_bf16(N##b, qr[DS], p1, 0, 0, 0); SBAR()
  VDECL(g0); VDECL(g1); VDECL(g2);
#define PREISSUE(SO) do { const int vb_ = vb0 + (SO); VRD(g0, 0, 0, vb_); VRD(g1, 0, 1, vb_); VRD(g2, 1, 0, vb_); } while (0)
  DMA(0, 0); DMA(KVBLK, RSTG); DMA(2 * KVBLK, 2 * RSTG);
  asm volatile("s_waitcnt vmcnt(8)" ::: "memory"); BAR();
  if (odd) BAR();
  qkt<ND0>(p0, p1, (const bf16_t*)(lds + RK), qr, r32, hi, mapc * 4);
  asm volatile("s_waitcnt vmcnt(4)" ::: "memory"); SBAR(); BAR();
  partialSM<DIFF>(p0, p1, mnC); finishSM(p0, p1, l_reg, pa0, pa1, pa2, pa3); SBAR();
  PREISSUE(0); BAR();
  _Pragma("unroll 1") for (int j = 0; j + 1 < NT; ++j) {
    const int sV = (j & 3) * RSTG, sK = ((j + 1) & 3) * RSTG, sD = ((j + 3) & 3) * RSTG;
    const bool dma = j + 3 < NT;
    if (dma) DMA((j + 3) * KVBLK, sD);
    SBAR(); __builtin_amdgcn_s_setprio(1); SBAR();
    { const int vb = vb0 + sV; int ka[4];
      _Pragma("unroll") for (int i = 0; i < 4; ++i) ka[i] = kad[i] + sK;
      VDECL(g3); VDECL(g4); VDECL(g5); VDECL(g6); VDECL(g7);
      VRD(g3, 1, 1, vb); VMM(g0, 0, pa0, pa1, 12);
      VRD(g4, 2, 0, vb); VMM(g1, 0, pa2, pa3, 12);
      VRD(g5, 2, 1, vb); VMM(g2, 1, pa0, pa1, 12);
      VRD(g6, 3, 0, vb); VMM(g3, 1, pa2, pa3, 12);
      VRD(g7, 3, 1, vb); VMM(g4, 2, pa0, pa1, 12);
      KRD(k0, 0); VMM(g5, 2, pa2, pa3, 10);
      KRD(k1, 1); VMM(g6, 3, pa0, pa1, 8);
      KRD(k2, 2); VMM(g7, 3, pa2, pa3, 6);
      KRD(k3, 3); KMM0(k0, 0, 6);
      if constexpr (ND0 == 8) {
        KRD(k4, 4); KMM(k1, 1, 6);
        KRD(k5, 5); KMM(k2, 2, 6);
        KRD(k6, 6); KMM(k3, 3, 6);
        KRD(k7, 7); KMM(k4, 4, 6);
        KMM(k5, 5, 4); KMM(k6, 6, 2); KMM(k7, 7, 0);
      } else {
        KMM(k1, 1, 4); KMM(k2, 2, 2); KMM(k3, 3, 0);
      } }
    __builtin_amdgcn_s_setprio(0);
    if (dma) asm volatile("s_waitcnt vmcnt(4)" ::: "memory"); else asm volatile("s_waitcnt vmcnt(0)" ::: "memory");
    SBAR(); BAR();
    partialSM<DIFF>(p0, p1, mnC); finishSM(p0, p1, l_reg, pa0, pa1, pa2, pa3); SBAR(); PREISSUE(sK);
    BAR();
  }
  {
    const int vb = vb0 + ((NT - 1) & 3) * RSTG;
    VDECL(g3); VDECL(g4); VDECL(g5); VDECL(g6); VDECL(g7);
    VRD(g3, 1, 1, vb); VMM(g0, 0, pa0, pa1, 12);
    VRD(g4, 2, 0, vb); VMM(g1, 0, pa2, pa3, 12);
    VRD(g5, 2, 1, vb); VMM(g2, 1, pa0, pa1, 12);
    VRD(g6, 3, 0, vb); VMM(g3, 1, pa2, pa3, 12);
    VRD(g7, 3, 1, vb); VMM(g4, 2, pa0, pa1, 12);
    VMM(g5, 2, pa2, pa3, 8); VMM(g6, 3, pa0, pa1, 4); VMM(g7, 3, pa2, pa3, 0);
  }
  if (!odd) BAR();
#undef PREISSUE
#undef KMM
#undef KMM0
#undef KRD
#undef VMM
#undef VDECL
#undef VRD
#undef PK
#undef LWAIT2
#undef LWAIT4
#undef BAR
#undef DMA
#undef DWAIT
  __syncthreads();
  if (splc) {
    unsigned* xs_ = (unsigned*)(lds + 140000);
    if (threadIdx.x == 0) *xs_ = __hip_atomic_fetch_add(splc, 1u, __ATOMIC_RELAXED, __HIP_MEMORY_SCOPE_AGENT);
    __syncthreads();
    const unsigned ord = *xs_;
    float* mine = splp + (size_t)(wid * 65) * 64 + lane;
    if (ord == 0u) {
      _Pragma("unroll") for (int d0 = 0; d0 < 4; ++d0) _Pragma("unroll") for (int r = 0; r < 16; ++r) mine[(d0 * 16 + r) * 64] = o[d0][r];
      mine[64 * 64] = l_reg;
      asm volatile("s_waitcnt vmcnt(0)" ::: "memory"); __syncthreads();
      if (threadIdx.x == 0) { __builtin_amdgcn_fence(__ATOMIC_RELEASE, "agent"); asm volatile("s_waitcnt vmcnt(0)" ::: "memory"); __hip_atomic_store(splc + 1, 1u, __ATOMIC_RELAXED, __HIP_MEMORY_SCOPE_AGENT); }
      __syncthreads();
      return;
    }
    if (threadIdx.x == 0) { unsigned sp = 0; while (__hip_atomic_load(splc + 1, __ATOMIC_RELAXED, __HIP_MEMORY_SCOPE_AGENT) == 0u) { __builtin_amdgcn_s_sleep(4); if (++sp > (1u << 22)) break; } }
    __syncthreads();
    __builtin_amdgcn_fence(__ATOMIC_ACQUIRE, "agent"); asm volatile("s_waitcnt vmcnt(0)" ::: "memory");
    _Pragma("unroll") for (int d0 = 0; d0 < 4; ++d0) _Pragma("unroll") for (int r = 0; r < 16; ++r) o[d0][r] += mine[(d0 * 16 + r) * 64];
    l_reg += mine[64 * 64];
  }
  if (hi == 0) li_l[r32] = l_reg; asm volatile("s_waitcnt lgkmcnt(0)" ::: "memory");
  float rli[16];
  _Pragma("unroll") for (int r = 0; r < 16; ++r) rli[r] = __builtin_amdgcn_rcpf(li_l[crow(r, hi)]);
  int r32e = r32; asm volatile("" : "+v"(r32e));
  char* ST = lds + E_ST + wid * 8704;
  if constexpr (!DIFF) {
    _Pragma("unroll") for (int r = 0; r < 16; ++r) { const int orow = crow(r, hi);
      _Pragma("unroll") for (int d0 = 0; d0 < 4; ++d0) *(bf16_t*)(ST + orow * 272 + (d0 * 32 + r32e) * 2) = f2bf(o[d0][r] * rli[r]); }
  } else {
    const float s1 = wave_sum(lamp[lane] * lamp[64 + lane]), s2 = wave_sum(lamp[128 + lane] * lamp[192 + lane]);
    int ly = layer; asm volatile("" : "+s"(ly));
    const float lambda_init = 0.8f - 0.6f * expf(-0.3f * (float)ly);
    const float lam = expf(s1) - expf(s2) + lambda_init, osc = 1.f - lambda_init;
    float* X = (float*)lds;
    if (mapc == 1) {
      _Pragma("unroll") for (int r = 0; r < 16; ++r) { const int orow = wq * QBLK + crow(r, hi);
        _Pragma("unroll") for (int d0 = 0; d0 < 4; ++d0) X[orow * 128 + d0 * 32 + r32e] = o[d0][r] * rli[r] * lam; }
    }
    __syncthreads();
    if (mapc == 0) {
      float nwv[4];
      _Pragma("unroll") for (int d0 = 0; d0 < 4; ++d0) nwv[d0] = nw[d0 * 32 + r32e] * osc;
      _Pragma("unroll") for (int r = 0; r < 16; ++r) { const int orow = crow(r, hi); float v[4]; float ss = 0.f;
        _Pragma("unroll") for (int d0 = 0; d0 < 4; ++d0) { v[d0] = o[d0][r] * rli[r] - X[(wq * QBLK + orow) * 128 + d0 * 32 + r32e]; ss += v[d0] * v[d0]; }
        ss += __shfl_xor(ss, 1); ss += __shfl_xor(ss, 2); ss += __shfl_xor(ss, 4); ss += __shfl_xor(ss, 8); ss += __shfl_xor(ss, 16);
        const float rs = rsqrtf(ss * (1.f / 128.f) + NORM_EPS);
        _Pragma("unroll") for (int d0 = 0; d0 < 4; ++d0) *(bf16_t*)(ST + orow * 272 + (d0 * 32 + r32e) * 2) = f2bf(v[d0] * rs * nwv[d0]); }
    }
  }
  if (!DIFF || mapc == 0) {
    asm volatile("s_waitcnt lgkmcnt(0)" ::: "memory");
    bf16_t* Ow = Ob + (long)(wq * QBLK) * LD; const bf16_t* Gw = gate + (long)(wq * QBLK) * LD;
    const int er = lane >> 4, ec = (lane & 15) * 8; bf16x8 gv[8];
    _Pragma("unroll") for (int it = 0; it < 8; ++it) gv[it] = *reinterpret_cast<const bf16x8*>(Gw + (long)(it * 4 + er) * LD + ec);
    _Pragma("unroll") for (int it = 0; it < 8; ++it) { const bf16x8 sv = *reinterpret_cast<const bf16x8*>(ST + (it * 4 + er) * 272 + ec * 2); u32x4 ov;
      float f[8]; _Pragma("unroll") for (int e = 0; e < 8; ++e) f[e] = bf2f((bf16_t)sv[e]) * siluf(bf2f((bf16_t)gv[it][e]));
      ov.x = pk2(f[0], f[1]); ov.y = pk2(f[2], f[3]); ov.z = pk2(f[4], f[5]); ov.w = pk2(f[6], f[7]);
      *reinterpret_cast<u32x4*>(Ow + (long)(it * 4 + er) * LD + ec) = ov; }
  }
  __syncthreads();
}
#undef KSWZ
#undef SBAR
}

__device__ __forceinline__ void gqa_unit(const Params& p, const int l, int u, char* lds, int half = -1, int rec = 0) {
    const int qb = u & 31, hq = (u >> 5) & 3, b = u >> 7; const size_t row0 = (size_t)b * SEQ + (size_t)qb * 256, k0 = (size_t)b * SEQ + (half > 0 ? SEQ / 2 : 0);
    bf16_t* Q = pblk(p.ws, PB_GQ + hq) + row0 * 128;
    att::attn_unit<0>(Q, pblk(p.ws, PB_GK + (hq >> 1)) + k0 * 128, pblk(p.ws, PB_GV + (hq >> 1)) + k0 * 128, Q, pblk(p.ws, PB_GG + hq) + row0 * 128, half >= 0 ? SEQ / 2 : SEQ, lds, nullptr, 0, nullptr,
                      (const float*)(g_scr + SCR_CTL) + 256 + 64 * l + 16 + b * 2 + (hq >> 1),
                      qb * 256, p.in[23] + l * 128,
                      half >= 0 ? (unsigned*)(g_scr + SCR_CTL) + 384 + l * 256 + rec * 2 : nullptr, half >= 0 ? (float*)(g_scr + SCR_SPL + (size_t)rec * 133120) : nullptr);
}
__device__ __forceinline__ void diff_unit(const Params& p, const int l, int u, char* lds, int half = -1, int rec = 0) {
    const int qb = u & 63, h = (u >> 6) & 3, b = u >> 8; const size_t row0 = (size_t)b * SEQ + (size_t)qb * 128, k0 = (size_t)b * SEQ + (half > 0 ? SEQ / 2 : 0);
    bf16_t* Q = pblk(p.ws, PB_DQ + h) + row0 * 128;
    att::attn_unit<1>(Q, pblk(p.ws, PB_DK + h) + k0 * 128, pblk(p.ws, PB_DV + h) + k0 * 128, Q, pblk(p.ws, PB_DG + h) + row0 * 128, half >= 0 ? SEQ / 2 : SEQ, lds, p.in[21] + l * 256, l, p.in[22] + l * 128,
                      (const float*)(g_scr + SCR_CTL) + 256 + 64 * l + b * 8 + h * 2,
                      qb * 128, nullptr,
                      half >= 0 ? (unsigned*)(g_scr + SCR_CTL) + 384 + l * 256 + rec * 2 : nullptr, half >= 0 ? (float*)(g_scr + SCR_SPL + (size_t)rec * 133120) : nullptr);
}

#define LDS_BAR() asm volatile("s_waitcnt lgkmcnt(0)\n\ts_barrier" ::: "memory")
namespace rk {
using f32x16 = __attribute__((ext_vector_type(16))) float;
constexpr int PB = 144, MAT = 64 * PB;
constexpr int O_W2T = 0, O_A2T = MAT, O_SB = 2 * MAT, O_GAM = 3 * MAT, O_CONST = O_GAM + 256,
              O_T = O_CONST + 2560, O_TW = O_T, O_G1T = O_T + MAT, O_AD = O_G1T,
              O_R2 = O_G1T + MAT, O_CL = O_R2, O_AA = O_R2 + 16384, O_ABD = O_R2, O_AAB = O_R2 + 4096, O_AAK = O_AAB + MAT, O_ARB = O_AAK + MAT, O_ARK = O_ARB + MAT,
              O_R3 = O_ARK + MAT, O_AT = O_R3, O_RT = O_AT + MAT, O_BT = O_RT + MAT, O_DT = O_BT, O_UT = O_BT, O_KT = O_BT + MAT, O_PT = O_KT,
              O_BHT = O_KT + MAT, O_KHT = O_BHT + MAT, O_VT = O_KHT + MAT, O_END = O_VT + MAT;
__device__ __forceinline__ int crow(int r, int hi) { return (r & 3) + 8 * (r >> 2) + 4 * hi; }
#define RK_FENCE() do { asm volatile("s_waitcnt lgkmcnt(0)" ::: "memory"); __builtin_amdgcn_wave_barrier(); } while (0)
template <int NKS> __device__ __forceinline__ void mm32(f32x16& acc, const char* A, int m0, const char* B, int n0, int k0, int r32, int hi) {
#pragma unroll
    for (int ks = 0; ks < NKS; ++ks) {
        const bf16x8 a = *(const bf16x8*)(A + (m0 + r32) * PB + (k0 + ks * 16 + hi * 8) * 2);
        const bf16x8 b = *(const bf16x8*)(B + (n0 + r32) * PB + (k0 + ks * 16 + hi * 8) * 2);
        acc = __builtin_amdgcn_mfma_f32_32x32x16_bf16(a, b, acc, 0, 0, 0); }
}
template <int NKS, bool SA, bool SB> __device__ __forceinline__ void mm32s(f32x16& acc, const char* A, int m0, const char* B, int n0, int r32, int hi) {
    const int ra = m0 + r32, rb = n0 + r32; const int fa = SA ? ((ra >> 3) & 7) : 0, fb = SB ? ((rb >> 3) & 7) : 0;
#pragma unroll
    for (int ks = 0; ks < NKS; ++ks) { const int q = ks * 2 + hi;
        const bf16x8 a = *(const bf16x8*)(A + ra * PB + ((q ^ fa) << 4));
        const bf16x8 b = *(const bf16x8*)(B + rb * PB + ((q ^ fb) << 4));
        acc = __builtin_amdgcn_mfma_f32_32x32x16_bf16(a, b, acc, 0, 0, 0); }
}
__device__ __forceinline__ void st_T(const f32x16& acc, char* Z, int n0, int m0, int r32, int hi) {
#pragma unroll
    for (int g = 0; g < 4; ++g) { u32x2 w; w.x = pk2(acc[4 * g], acc[4 * g + 1]); w.y = pk2(acc[4 * g + 2], acc[4 * g + 3]);
        *(u32x2*)(Z + (n0 + r32) * PB + (m0 + 8 * g + 4 * hi) * 2) = w; }
}
__device__ __forceinline__ unsigned long long pass1(const Params& p, const int l, unsigned char* lds) {
    const int sid = blockIdx.x >> 3, c_first = blockIdx.x & 7;
    const int tid = otid(), w = __builtin_amdgcn_readfirstlane(tid >> 6);
    const int h = sid & 7, dir = (sid >> 3) & 1, b = sid >> 4;
    unsigned long long pacc = 0, ptt = 0; (void)ptt;
#ifdef PRB_IV
#define RKP0(i) do { if ((PRB_IV >> (i)) & 1) ptt = __builtin_amdgcn_s_memrealtime(); } while (0)
#define RKP1(i) do { if ((PRB_IV >> (i)) & 1) pacc += __builtin_amdgcn_s_memrealtime() - ptt; } while (0)
#else
#define RKP0(i) do {} while (0)
#define RKP1(i) do {} while (0)
#endif
#define RK_LANE() int tq_ = tid; asm volatile("" : "+v"(tq_)); const int lane = tq_ & 63, r32 = lane & 31, hi = lane >> 5, tok = tq_ >> 3, c8 = (tq_ & 7) * 8; (void)lane; (void)r32; (void)hi; (void)tok; (void)c8
    char* L = (char*)lds; float* CF = (float*)(L + O_CONST);
    {   RK_LANE();
        const float* w2 = p.in[13] + ((size_t)(l * 2 + dir) * 64) * 512 + h * 64; const float* a2 = p.in[15] + ((size_t)l * 64) * 512 + h * 64;
        float t[8], u[8];
#pragma unroll
        for (int e = 0; e < 8; ++e) { t[e] = w2[(size_t)(c8 + e) * 512 + tok]; u[e] = a2[(size_t)(c8 + e) * 512 + tok]; }
        u32x4 ww, aa; ww.x = pk2(t[0], t[1]); ww.y = pk2(t[2], t[3]); ww.z = pk2(t[4], t[5]); ww.w = pk2(t[6], t[7]);
        aa.x = pk2(u[0], u[1]); aa.y = pk2(u[2], u[3]); aa.z = pk2(u[4], u[5]); aa.w = pk2(u[6], u[7]);
        *(u32x4*)(L + O_W2T + tok * PB + c8 * 2) = ww; *(u32x4*)(L + O_A2T + tok * PB + c8 * 2) = aa;
        { unsigned zz = 0u; asm volatile("" : "+v"(zz)); *(u32x4*)(L + O_SB + tok * PB + c8 * 2) = (u32x4){zz, zz, zz, zz}; }
        const float* mu = p.in[11] + (size_t)(l * 2 + dir) * 1664;
        for (int i = tid; i < 640; i += 512) { const int row = i >> 6, j = i & 63; float v;
            if (row == 0) v = p.in[12][(l * 2 + dir) * 512 + h * 64 + j]; else if (row == 1) v = p.in[14][l * 512 + h * 64 + j];
            else if (row == 2) v = p.in[16][l * 512 + h * 64 + j]; else if (row == 3) v = p.in[17][l * 512 + h * 64 + j]; else if (row == 4) v = p.in[18][l * 512 + h * 64 + j];
            else if (row == 5) v = mu[h * 64 + j]; else if (row == 6) v = mu[512 + h * 64 + j]; else if (row == 7) v = mu[1024 + h * 64 + j]; else if (row == 8) v = mu[1536 + j]; else v = mu[1600 + j];
            CF[i] = v; }
    }
    const bf16_t* Pr = pblk(p.ws, PB_R + (h >> 1)) + (h & 1) * 64; const bf16_t* Pk = pblk(p.ws, PB_K + (h >> 1)) + (h & 1) * 64;
    const bf16_t* Pv = pblk(p.ws, PB_V + (h >> 1)) + (h & 1) * 64; const bf16_t* Pw = pblk(p.ws, PB_WA); const bf16_t* Pa = pblk(p.ws, PB_WA) + 64;
    bf16_t* wkv = (bf16_t*)(g_scr + SCR_WKV) + (size_t)sid * SEQ * 64; bf16_t* bon = (bf16_t*)(g_scr + SCR_BON) + (size_t)dir * M_TOK * 512 + h * 64;
    bf16x8 cu[5], pv[5];
#define RK_LOAD(c) do { RK_LANE(); const int s_ = (c) * 64 + tok; const int t_ = dir ? (SEQ - 1 - s_) : s_; const size_t m_ = ((size_t)b * SEQ + t_) * 128 + c8; \
        cu[0] = *(const bf16x8*)(Pr + m_); cu[1] = *(const bf16x8*)(Pk + m_); cu[2] = *(const bf16x8*)(Pv + m_); cu[3] = *(const bf16x8*)(Pw + m_); cu[4] = *(const bf16x8*)(Pa + m_); \
        if (s_ > 0) { const size_t q_ = dir ? m_ + 128 : m_ - 128; pv[0] = *(const bf16x8*)(Pr + q_); pv[1] = *(const bf16x8*)(Pk + q_); pv[2] = *(const bf16x8*)(Pv + q_); pv[3] = *(const bf16x8*)(Pw + q_); pv[4] = *(const bf16x8*)(Pa + q_); } \
        else { _Pragma("unroll") for (int i_ = 0; i_ < 5; ++i_) pv[i_] = (bf16x8){0, 0, 0, 0, 0, 0, 0, 0}; } } while (0)
    RK_LOAD(c_first);
    LDS_BAR();
#pragma unroll 1
    for (int c = c_first; c < SEQ / 64; c += 8) {
        RKP0(1);
        float rr[8], kx[8], vv[8];
        {   RK_LANE(); float tw[8], ad[8];
#pragma unroll
            for (int e = 0; e < 8; ++e) {
                const float x0 = bf2f((bf16_t)cu[0][e]), x1 = bf2f((bf16_t)cu[1][e]), x2 = bf2f((bf16_t)cu[2][e]), x3 = bf2f((bf16_t)cu[3][e]), x4 = bf2f((bf16_t)cu[4][e]);
                const float p0 = bf2f((bf16_t)pv[0][e]), p1 = bf2f((bf16_t)pv[1][e]), p2 = bf2f((bf16_t)pv[2][e]), p3 = bf2f((bf16_t)pv[3][e]), p4 = bf2f((bf16_t)pv[4][e]);
                rr[e] = x0 + (p0 - x0) * CF[5 * 64 + (h * 0) + c8 + e]; kx[e] = x1 + (p1 - x1) * CF[6 * 64 + c8 + e]; vv[e] = x2 + (p2 - x2) * CF[7 * 64 + c8 + e];
                const float wd = x3 + (p3 - x3) * CF[8 * 64 + c8 + e]; ad[e] = x4 + (p4 - x4) * CF[9 * 64 + c8 + e];
                tw[e] = 1.f - 2.f / (1.f + __expf(2.f * wd)); }
            u32x4 a, d; a.x = pk2(tw[0], tw[1]); a.y = pk2(tw[2], tw[3]); a.z = pk2(tw[4], tw[5]); a.w = pk2(tw[6], tw[7]);
            d.x = pk2(ad[0], ad[1]); d.y = pk2(ad[2], ad[3]); d.z = pk2(ad[4], ad[5]); d.w = pk2(ad[6], ad[7]);
            *(u32x4*)(L + O_TW + tok * PB + c8 * 2) = a; *(u32x4*)(L + O_AD + tok * PB + c8 * 2) = d; }
        LDS_BAR(); RKP1(1); RKP0(2);
        {   RK_LANE(); const bool isA = w >= 4; const int mt2 = (w & 2) ? 32 : 0, n0 = (w & 1) * 32;
            const char* Aop = L + (isA ? O_AD : O_TW); const char* Bop = L + (isA ? O_A2T : O_W2T);
            f32x16 x0 = {};
            mm32<4>(x0, Aop, mt2, Bop, n0, 0, r32, hi);
            const int ch = n0 + r32; const float c0 = CF[(isA ? 64 : 0) + ch];
            float* TOT = (float*)(L + O_GAM);
            if (!isA) {
#pragma unroll
                for (int r = 0; r < 16; ++r) x0[r] = -0.6065306597126334f / (1.f + __expf(-(c0 + x0[r])));
                float run = 0.f;
#pragma unroll
                for (int g = 0; g < 4; ++g) { const float gs = (x0[4 * g] + x0[4 * g + 1]) + (x0[4 * g + 2] + x0[4 * g + 3]); const float ps = __shfl_xor(gs, 32);
                    float st = run + (hi ? ps : 0.f); x0[4 * g] += st; x0[4 * g + 1] += x0[4 * g]; x0[4 * g + 2] += x0[4 * g + 1]; x0[4 * g + 3] += x0[4 * g + 2]; run += gs + ps; }
                if (mt2 == 0 && hi == 0) TOT[ch] = run;
            } else {
#pragma unroll
                for (int r = 0; r < 16; ++r) x0[r] = 1.f / (1.f + __expf(-(c0 + x0[r])));
            }
            LDS_BAR();
            if (!isA && mt2) { const float t0 = TOT[ch];
#pragma unroll
                for (int r = 0; r < 16; ++r) x0[r] += t0; }
            float* O = (float*)(L + (isA ? O_AA : O_CL));
#pragma unroll
            for (int r = 0; r < 16; ++r) O[(mt2 + crow(r, hi)) * 64 + ch] = x0[r];
        }
        LDS_BAR(); RKP1(2); RKP0(3);
        {   RK_LANE(); const float* clp = (const float*)(L + O_CL + tok * 256 + c8 * 4); const float* cle = (const float*)(L + O_CL + (tok > 0 ? tok - 1 : 0) * 256 + c8 * 4);
            const float* cln = (const float*)(L + O_CL + 63 * 256 + c8 * 4); const float* aap = (const float*)(L + O_AA + tok * 256 + c8 * 4);
            float kk[8], kp[8]; float ss = 0.f, bs = 0.f;
#pragma unroll
            for (int e = 0; e < 8; ++e) { kk[e] = kx[e] * CF[2 * 64 + c8 + e]; ss += kk[e] * kk[e]; kp[e] = kx[e] * (1.f + (aap[e] - 1.f) * CF[3 * 64 + c8 + e]); bs += rr[e] * kp[e] * CF[4 * 64 + c8 + e]; }
            ss += __shfl_xor(ss, 1); ss += __shfl_xor(ss, 2); ss += __shfl_xor(ss, 4);
            bs += __shfl_xor(bs, 1); bs += __shfl_xor(bs, 2); bs += __shfl_xor(bs, 4);
            const float rn = 1.f / fmaxf(sqrtf(ss), 1e-12f);
            const int tsw = ((((tok >> 3) ^ (c8 >> 3)) << 3) + (tok & 7)) * 2;
#pragma unroll
            for (int e2 = 0; e2 < 4; ++e2) { float At[2], Rt[2], Bt[2], Kt[2];
#pragma unroll
                for (int q = 0; q < 2; ++q) { const int e = 2 * e2 + q; const float cl = clp[e], ce = (tok > 0) ? cle[e] : 0.f, cn = cln[e];
                    const float kn = kk[e] * rn; const float bb = kn * aap[e];
                    const float ein = __expf(cl), eex = __expf(ce), eng = __expf(-cl), een = __expf(cn - cl);
                    At[q] = -kn * eex; Rt[q] = rr[e] * ein; Bt[q] = bb * eng; Kt[q] = kp[e] * eng;
                    *(bf16_t*)(L + O_BHT + (c8 + e) * PB + tsw) = f2bf(bb * een); *(bf16_t*)(L + O_KHT + (c8 + e) * PB + tsw) = f2bf(kp[e] * een); *(bf16_t*)(L + O_VT + (c8 + e) * PB + tsw) = f2bf(vv[e]); *(bf16_t*)(L + O_SB + (c8 + e) * PB + tsw) = f2bf(At[q]);
                    if (tok == 63) ((float*)(L + O_GAM))[c8 + e] = __expf(cn); }
                const int ob = tok * PB + (c8 + 2 * e2) * 2;
                *(unsigned*)(L + O_AT + ob) = pk2(At[0], At[1]); *(unsigned*)(L + O_RT + ob) = pk2(Rt[0], Rt[1]); *(unsigned*)(L + O_BT + ob) = pk2(Bt[0], Bt[1]); *(unsigned*)(L + O_KT + ob) = pk2(Kt[0], Kt[1]); }
            {   const int s_ = c * 64 + tok; const int t_ = dir ? (SEQ - 1 - s_) : s_;
                u32x4 w_; w_.x = pk2(bs * vv[0], bs * vv[1]); w_.y = pk2(bs * vv[2], bs * vv[3]); w_.z = pk2(bs * vv[4], bs * vv[5]); w_.w = pk2(bs * vv[6], bs * vv[7]);
                *(u32x4*)(bon + ((size_t)b * SEQ + t_) * 512 + c8) = w_; }
        }
        LDS_BAR(); RKP1(3); RKP0(4);
        if (c + 8 < SEQ / 64) RK_LOAD(c + 8);
        for (int idx = w; idx < 12; idx += 8) {
            RK_LANE(); const int pr = idx / 3, tl = idx - pr * 3; const int mi = (tl == 2) ? 32 : 0, nt = (tl >= 1) ? 32 : 0;
            const char* X = L + ((pr & 1) ? O_KT : O_BT); const char* Y = L + ((pr >= 2) ? O_RT : O_AT);
            f32x16 acc = {}; mm32<4>(acc, X, mi, Y, nt, 0, r32, hi);
            const int t = nt + r32;
            if (tl != 1) {
#pragma unroll
                for (int r = 0; r < 16; ++r) { const int i = mi + crow(r, hi); const bool keep = (pr < 2) ? (i < t) : (i <= t); if (!keep) acc[r] = 0.f; } }
            char* Z = L + (pr == 0 ? O_AAB : pr == 1 ? O_AAK : pr == 2 ? O_ARB : O_ARK);
            st_T(acc, Z, nt, mi, r32, hi);
            if (pr == 0 && tl != 1) { float* ABD = (float*)(L + O_ABD);
#pragma unroll
                for (int g = 0; g < 4; ++g) if ((g >> 1) == (r32 >> 4)) *(f32x4*)(ABD + (t >> 4) * 256 + (t & 15) * 16 + 8 * (g & 1) + 4 * hi) = (f32x4){acc[4 * g], acc[4 * g + 1], acc[4 * g + 2], acc[4 * g + 3]}; }
        }
        LDS_BAR(); RKP1(4); RKP0(5);
        f32x16 yacc = {}, nacc = {};
        const int mt = (w & 2) ? 32 : 0, nv = (w & 1) ? 32 : 0;
        if (w < 4) {
            RK_LANE(); f32x16 xq = {};
            if (mt) mm32s<4, false, true>(xq, L + O_AAK, mt, L + O_VT, nv, r32, hi); else mm32s<2, false, true>(xq, L + O_AAK, mt, L + O_VT, nv, r32, hi);
            st_T(xq, L + O_G1T, nv, mt, r32, hi);
            mm32s<4, true, true>(nacc, L + O_KHT, mt, L + O_VT, nv, r32, hi);
        } else if (w < 7) {
            RK_LANE(); if (mt) mm32s<4, false, true>(yacc, L + O_ARK, mt, L + O_VT, nv, r32, hi); else mm32s<2, false, true>(yacc, L + O_ARK, mt, L + O_VT, nv, r32, hi);
        } else {
            RK_LANE(); const int blk = lane >> 4, j = lane & 15; const float* A = (const float*)(L + O_ABD) + blk * 256;
            float x[16];
#pragma unroll
            for (int t = 0; t < 16; ++t) { float s = (t == j) ? 1.f : 0.f;
#pragma unroll
                for (int i = 0; i < t; ++i) s += A[t * 16 + i] * x[i];
                x[t] = s; asm volatile("" ::: "memory"); }
            char* Tm = L + O_T; char* Dm = L + O_DT;
#pragma unroll
            for (int t = 0; t < 16; ++t) *(bf16_t*)(Tm + (16 * blk + t) * PB + (16 * blk + j) * 2) = f2bf(x[t]);
            { u32x4 a, d; a.x = pk2(x[0], x[1]); a.y = pk2(x[2], x[3]); a.z = pk2(x[4], x[5]); a.w = pk2(x[6], x[7]); d.x = pk2(x[8], x[9]); d.y = pk2(x[10], x[11]); d.z = pk2(x[12], x[13]); d.w = pk2(x[14], x[15]);
              *(u32x4*)(Dm + (16 * blk + j) * PB + (16 * blk) * 2) = a; *(u32x4*)(Dm + (16 * blk + j) * PB + (16 * blk + 8) * 2) = d; }
            if ((blk & 1) == 0) {
#pragma unroll
                for (int t = 0; t < 16; ++t) *(bf16_t*)(Tm + (16 * blk + t) * PB + (16 * (blk + 1) + j) * 2) = 0;
            } else { *(u32x4*)(Dm + (16 * blk + j) * PB + (16 * (blk - 1)) * 2) = (u32x4){0u, 0u, 0u, 0u}; *(u32x4*)(Dm + (16 * blk + j) * PB + (16 * (blk - 1) + 8) * 2) = (u32x4){0u, 0u, 0u, 0u}; }
            RK_FENCE();
            const int m16 = lane & 15, kg = lane >> 4; const bf16x8 z8 = {0, 0, 0, 0, 0, 0, 0, 0};
#pragma unroll
            for (int pp = 0; pp < 2; ++pp) { const int o = 32 * pp;
                bf16x8 a = z8, bb = z8;
                if (kg < 2) { a = *(const bf16x8*)(L + O_AAB + (o + 16 + m16) * PB + (o + 8 * kg) * 2); bb = *(const bf16x8*)(Dm + (o + m16) * PB + (o + 8 * kg) * 2); }
                f32x4 pq = __builtin_amdgcn_mfma_f32_16x16x32_bf16(a, bb, (f32x4){0.f, 0.f, 0.f, 0.f}, 0, 0, 0);
                { u32x2 wv; wv.x = pk2(pq[0], pq[1]); wv.y = pk2(pq[2], pq[3]); *(u32x2*)(L + O_PT + (o + m16) * PB + (o + 16 + 4 * kg) * 2) = wv; } }
            RK_FENCE();
#pragma unroll
            for (int pp = 0; pp < 2; ++pp) { const int o = 32 * pp;
                bf16x8 a = z8, bb = z8;
                if (kg < 2) { a = *(const bf16x8*)(Tm + (o + 16 + m16) * PB + (o + 16 + 8 * kg) * 2); bb = *(const bf16x8*)(L + O_PT + (o + m16) * PB + (o + 16 + 8 * kg) * 2); }
                f32x4 tq = __builtin_amdgcn_mfma_f32_16x16x32_bf16(a, bb, (f32x4){0.f, 0.f, 0.f, 0.f}, 0, 0, 0);
#pragma unroll
                for (int e = 0; e < 4; ++e) *(bf16_t*)(Tm + (o + 16 + 4 * kg + e) * PB + (o + m16) * 2) = f2bf(tq[e]);
                { u32x2 wv; wv.x = pk2(tq[0], tq[1]); wv.y = pk2(tq[2], tq[3]); *(u32x2*)(Dm + (o + m16) * PB + (o + 16 + 4 * kg) * 2) = wv; } }
            RK_FENCE();
            { f32x16 q = {}; mm32<2>(q, L + O_AAB, 32, Dm, 0, 0, r32, hi); st_T(q, L + O_PT, 0, 32, r32, hi); }
            RK_FENCE();
            { f32x16 tc = {}; mm32<2>(tc, Tm, 32, L + O_PT, 0, 32, r32, hi);
#pragma unroll
              for (int r = 0; r < 16; ++r) *(bf16_t*)(Tm + (32 + crow(r, hi)) * PB + r32 * 2) = f2bf(tc[r]); }
        }
        LDS_BAR(); RKP1(5); RKP0(6);
        if (w < 4) {
            RK_LANE(); f32x16 q = {};
            if (mt) mm32s<4, false, true>(q, L + O_T, mt, L + O_SB, nv, r32, hi); else mm32s<2, false, true>(q, L + O_T, mt, L + O_SB, nv, r32, hi);
            st_T(q, L + O_PT, nv, mt, r32, hi);
        } else {
            RK_LANE(); if (w == 7) mm32s<4, false, true>(yacc, L + O_ARK, mt, L + O_VT, nv, r32, hi);
            f32x16 q = {};
            if (mt) mm32<4>(q, L + O_T, mt, L + O_G1T, nv, 0, r32, hi); else mm32<2>(q, L + O_T, mt, L + O_G1T, nv, 0, r32, hi);
            st_T(q, L + O_UT, nv, mt, r32, hi);
        }
        LDS_BAR(); RKP1(6); RKP0(7);
        {   const size_t ci = (size_t)sid * (SEQ / 64) + c;
            if (w < 4) {
                RK_LANE(); mm32s<4, true, false>(nacc, L + O_BHT, mt, L + O_UT, nv, r32, hi);
                {   bf16_t* NN = (sid < 24 ? (bf16_t*)(p.ws + WS_NN) : (bf16_t*)(g_scr + SCR_NN2) - (size_t)24 * 128 * 4096) + ci * 4096 + ((size_t)(w * 64 + lane)) * 16;
                    u32x4 a, d; a.x = pk2(nacc[0], nacc[1]); a.y = pk2(nacc[2], nacc[3]); a.z = pk2(nacc[4], nacc[5]); a.w = pk2(nacc[6], nacc[7]);
                    d.x = pk2(nacc[8], nacc[9]); d.y = pk2(nacc[10], nacc[11]); d.z = pk2(nacc[12], nacc[13]); d.w = pk2(nacc[14], nacc[15]);
                    *(u32x4*)NN = a; *(u32x4*)(NN + 8) = d; }
                f32x16 mq = {}; mm32s<4, false, true>(mq, L + O_PT, mt, L + O_BHT, nv, r32, hi);
                const int kq = nv + r32; const float gk = ((const float*)(L + O_GAM))[kq];
#pragma unroll
                for (int r = 0; r < 16; ++r) if (mt + crow(r, hi) == kq) mq[r] += gk;
                bf16_t* MM = (bf16_t*)(p.ws + WS_MM) + ci * 4096 + (size_t)kq * 64 + mt + 4 * hi;
#pragma unroll
                for (int g = 0; g < 4; ++g) { u32x2 wv; wv.x = pk2(mq[4 * g], mq[4 * g + 1]); wv.y = pk2(mq[4 * g + 2], mq[4 * g + 3]); *(u32x2*)(MM + 8 * g) = wv; }
            } else {
                RK_LANE(); if (mt) mm32<4>(yacc, L + O_ARB, mt, L + O_UT, nv, 0, r32, hi); else mm32<2>(yacc, L + O_ARB, mt, L + O_UT, nv, 0, r32, hi);
                {
                    bf16_t* yp = wkv + (size_t)c * 4096 + (size_t)((w - 4) * 64 + lane) * 16;
                    u32x4 a_, d_; a_.x = pk2(yacc[0], yacc[1]); a_.y = pk2(yacc[2], yacc[3]); a_.z = pk2(yacc[4], yacc[5]); a_.w = pk2(yacc[6], yacc[7]);
                    d_.x = pk2(yacc[8], yacc[9]); d_.y = pk2(yacc[10], yacc[11]); d_.z = pk2(yacc[12], yacc[13]); d_.w = pk2(yacc[14], yacc[15]);
                    *(u32x4*)yp = a_; *(u32x4*)(yp + 8) = d_; }
                f32x16 qq = {};
                if (nv) mm32<4>(qq, L + O_PT, mt, L + O_ARB, nv, 0, r32, hi); else mm32<2>(qq, L + O_PT, mt, L + O_ARB, nv, 0, r32, hi);
                const int tq = nv + r32;
                bf16_t* QQ = (bf16_t*)(g_scr + SCR_XB) + ci * 4096 + (size_t)tq * 64 + mt + 4 * hi;
#pragma unroll
                for (int g = 0; g < 4; ++g) { const u32x2 rw = *(const u32x2*)(L + O_RT + tq * PB + (mt + 8 * g + 4 * hi) * 2);
                    const float r0 = __uint_as_float(rw.x << 16), r1 = __uint_as_float(rw.x & 0xffff0000u), r2 = __uint_as_float(rw.y << 16), r3 = __uint_as_float(rw.y & 0xffff0000u);
                    u32x2 wv; wv.x = pk2(qq[4 * g] + r0, qq[4 * g + 1] + r1); wv.y = pk2(qq[4 * g + 2] + r2, qq[4 * g + 3] + r3); *(u32x2*)(QQ + 8 * g) = wv; }
            }
        }
        LDS_BAR(); RKP1(7);
    }
#undef RK_LOAD
#undef RK_LANE
    return pacc;
}

__device__ __forceinline__ void chain(const Params& p, const int sid, unsigned char* lds) {
    const int tid = otid(), w = __builtin_amdgcn_readfirstlane(tid >> 6);
    constexpr int C_MT = 0, C_QT = MAT, C_SB = 2 * MAT;
#define RK_LANE() int tq_ = tid; asm volatile("" : "+v"(tq_)); const int lane = tq_ & 63, r32 = lane & 31, hi = lane >> 5, row = tq_ >> 3, c8 = (tq_ & 7) * 8; (void)lane; (void)r32; (void)hi; (void)row; (void)c8
    char* L = (char*)lds;
    const bf16_t* MMg = (const bf16_t*)(p.ws + WS_MM) + (size_t)sid * 128 * 4096; const bf16_t* QQg = (const bf16_t*)(g_scr + SCR_XB) + (size_t)sid * 128 * 4096;
    const bf16_t* NNg = (sid < 24 ? (const bf16_t*)(p.ws + WS_NN) : (const bf16_t*)(g_scr + SCR_NN2) - (size_t)24 * 128 * 4096) + (size_t)sid * 128 * 4096;
    bf16_t* wkv = (bf16_t*)(g_scr + SCR_WKV) + (size_t)sid * SEQ * 64;
    const int mt = (w & 2) ? 32 : 0, nv = (w & 1) ? 32 : 0;
    {   RK_LANE(); unsigned zz = 0u; asm volatile("" : "+v"(zz)); *(u32x4*)(L + C_SB + row * PB + c8 * 2) = (u32x4){zz, zz, zz, zz}; }
    f32x16 sacc = {};
    bf16x8 rm, rq, rn0, rn1;
#define CH_LOAD(c) do { RK_LANE(); rm = *(const bf16x8*)(MMg + (size_t)(c) * 4096 + row * 64 + c8); rq = *(const bf16x8*)(QQg + (size_t)(c) * 4096 + row * 64 + c8); \
        if (w < 4) { const bf16_t* n_ = NNg + (size_t)(c) * 4096 + (size_t)(w * 64 + lane) * 16; rn0 = *(const bf16x8*)n_; rn1 = *(const bf16x8*)(n_ + 8); } \
        else { const bf16_t* y_ = wkv + (size_t)(c) * 4096 + (size_t)((w - 4) * 64 + lane) * 16; rn0 = *(const bf16x8*)y_; rn1 = *(const bf16x8*)(y_ + 8); } } while (0)
    CH_LOAD(0);
#pragma unroll 1
    for (int c = 0; c < SEQ / 64; ++c) {
        {   RK_LANE(); *(bf16x8*)(L + C_MT + row * PB + c8 * 2) = rm; *(bf16x8*)(L + C_QT + row * PB + c8 * 2) = rq; }
        f32x16 acc;
#pragma unroll
        for (int r = 0; r < 8; ++r) { acc[r] = bf2f((bf16_t)rn0[r]); acc[8 + r] = bf2f((bf16_t)rn1[r]); }
        LDS_BAR();
        if (c + 1 < SEQ / 64) CH_LOAD(c + 1);
        {   RK_LANE();
            if (w < 4) { mm32<4>(acc, L + C_MT, mt, L + C_SB, nv, 0, r32, hi); sacc = acc; }
            else { mm32<4>(acc, L + C_QT, mt, L + C_SB, nv, 0, r32, hi);
#pragma unroll
                for (int r = 0; r < 16; ++r) wkv[((size_t)c * 64 + mt + crow(r, hi)) * 64 + nv + r32] = f2bf(acc[r]); } }
        LDS_BAR();
        if (w < 4) { RK_LANE(); st_T(sacc, L + C_SB, nv, mt, r32, hi); }
    }
#undef CH_LOAD
#undef RK_LANE
}

}

namespace sd {
using rk::f32x16; using rk::crow;
constexpr int PW = 272, PN = 144;
constexpr int O_CM = 0, O_BM = 64 * PW, O_HB = 2 * 64 * PW, O_BDT = 3 * 64 * PW, O_XDT = O_BDT + 128 * PN, O_XM = O_XDT + 64 * PN, O_MM = O_XM + 64 * PN, O_DTS = O_MM + 64 * PN, O_ACU = O_DTS + 512, O_END = O_ACU + 512;
template <int NKS, int PA, int PBB, int SA = -1, int SBW = -1> __device__ __forceinline__ void mmx(f32x16& acc, const char* A, int m0, const char* B, int n0, int k0, int r32, int hi) {
    const int ra = m0 + r32, rb = n0 + r32; const int fa = SA >= 0 ? ((ra >> (SA >= 0 ? SA : 0)) & 7) : 0, fb = SBW >= 0 ? ((rb >> (SBW >= 0 ? SBW : 0)) & 7) : 0;
#pragma unroll
    for (int ks = 0; ks < NKS; ++ks) { const int q = (k0 >> 3) + ks * 2 + hi;
        const bf16x8 a = *(const bf16x8*)(A + ra * PA + ((q ^ fa) << 4));
        const bf16x8 b = *(const bf16x8*)(B + rb * PBB + ((q ^ fb) << 4));
        acc = __builtin_amdgcn_mfma_f32_32x32x16_bf16(a, b, acc, 0, 0, 0); }
}
template <int PZ> __device__ __forceinline__ void stT(const f32x16& acc, char* Z, int n0, int m0, int r32, int hi) {
#pragma unroll
    for (int g = 0; g < 4; ++g) { u32x2 w; w.x = pk2(acc[4 * g], acc[4 * g + 1]); w.y = pk2(acc[4 * g + 2], acc[4 * g + 3]);
        *(u32x2*)(Z + (n0 + r32) * PZ + (m0 + 8 * g + 4 * hi) * 2) = w; }
}
__device__ __forceinline__ unsigned long long seq(const Params& p, const int l, const int sid, unsigned char* lds) {
    const int tid = otid(), w = __builtin_amdgcn_readfirstlane(tid >> 6);
    const int h = sid & 7, dir = (sid >> 3) & 1, b = sid >> 4, g = h >> 2;
    unsigned long long pacc = 0, ptt = 0; (void)ptt;
#ifdef PRB_SDIV
#define SDP0(i) do { if ((PRB_SDIV >> (i)) & 1) ptt = __builtin_amdgcn_s_memrealtime(); } while (0)
#define SDP1(i) do { if ((PRB_SDIV >> (i)) & 1) pacc += __builtin_amdgcn_s_memrealtime() - ptt; } while (0)
#else
#define SDP0(i) do {} while (0)
#define SDP1(i) do {} while (0)
#endif
#define SD_LANE() int tq_ = tid; asm volatile("" : "+v"(tq_)); const int lane = tq_ & 63, r32 = lane & 31, hi = lane >> 5, tok = tq_ >> 3, q8 = tq_ & 7; (void)lane; (void)r32; (void)hi; (void)tok; (void)q8
    char* L = (char*)lds;
    const float Ah = -expf(p.in[7][(l * 2 + dir) * 8 + h]), dtb = p.in[8][(l * 2 + dir) * 8 + h], Dh = (dir == 0) ? p.in[9][l * 8 + h] : 0.f;
    const float* dtbuf = (const float*)(g_scr + SCR_DT) + dir * 8 + h;
    const bf16_t* xact = (const bf16_t*)(g_scr + SCR_XACT);
    bf16_t* yout = (bf16_t*)(g_scr + SCR_SSDY) + (size_t)dir * M_TOK * 512 + h * 64;
    {   SD_LANE(); unsigned zz = 0u; asm volatile("" : "+v"(zz));
        for (int i = tid; i < 64 * PW / 16; i += 512) *(u32x4*)(L + O_HB + i * 16) = (u32x4){zz, zz, zz, zz}; }
    f32x16 hacc = {};
    bf16x8 rc[2], rb[2], rx; float dtr = 0.f;
#define SD_LOAD(c) do { SD_LANE(); const int s_ = (c) * 64 + tok; const int t_ = dir ? (SEQ - 1 - s_) : s_; const bf16_t* row_ = xact + ((size_t)b * SEQ + t_) * 1024; \
        rc[0] = *(const bf16x8*)(row_ + 768 + g * 128 + q8 * 16); rc[1] = *(const bf16x8*)(row_ + 768 + g * 128 + q8 * 16 + 8); \
        rb[0] = *(const bf16x8*)(row_ + 512 + g * 128 + q8 * 16); rb[1] = *(const bf16x8*)(row_ + 512 + g * 128 + q8 * 16 + 8); \
        rx = *(const bf16x8*)(row_ + h * 64 + q8 * 8); } while (0)
#define SD_DTLOAD(c) do { SD_LANE(); const int s2_ = (c) * 64 + lane; const int t2_ = dir ? (SEQ - 1 - s2_) : s2_; dtr = dtbuf[((size_t)b * SEQ + t2_) * 16]; } while (0)
#define SD_SCAN(buf) do { SD_LANE(); const float dt_ = softplusf(dtr + dtb); float ac_ = dt_ * Ah; \
        _Pragma("unroll") for (int o_ = 1; o_ < 64; o_ <<= 1) { const float v_ = __shfl_up(ac_, o_); if (lane >= o_) ac_ += v_; } \
        ((float*)(L + O_DTS))[(buf) * 64 + lane] = dt_; ((float*)(L + O_ACU))[(buf) * 64 + lane] = ac_; } while (0)
    SD_LOAD(0);
    if (w == 7) { SD_DTLOAD(0); SD_SCAN(0); SD_DTLOAD(1); }
    LDS_BAR();
    const int nv = (w & 1) ? 32 : 0;
#pragma unroll 1
    for (int c = 0; c < SEQ / 64; ++c) {
        const float* DTS = (const float*)(L + O_DTS) + (c & 1) * 64; const float* ACU = (const float*)(L + O_ACU) + (c & 1) * 64;
        SDP0(1);
        {   SD_LANE(); const float dt = DTS[tok]; const float ac = ACU[tok], ae = ACU[63];
            const float dend = __expf(ae - ac);
            *(bf16x8*)(L + O_CM + tok * PW + q8 * 32) = rc[0]; *(bf16x8*)(L + O_CM + tok * PW + q8 * 32 + 16) = rc[1];
            *(bf16x8*)(L + O_BM + tok * PW + q8 * 32) = rb[0]; *(bf16x8*)(L + O_BM + tok * PW + q8 * 32 + 16) = rb[1];
            *(bf16x8*)(L + O_XM + tok * PN + q8 * 16) = rx;
            const int tsw = ((((tok >> 3) ^ q8) << 3) + (tok & 7)) * 2;
#pragma unroll
            for (int e = 0; e < 8; ++e) { *(bf16_t*)(L + O_BDT + (q8 * 16 + e) * PN + tsw) = f2bf(bf2f((bf16_t)rb[0][e]) * dend); *(bf16_t*)(L + O_BDT + (q8 * 16 + 8 + e) * PN + tsw) = f2bf(bf2f((bf16_t)rb[1][e]) * dend);
                *(bf16_t*)(L + O_XDT + (q8 * 8 + e) * PN + tsw) = f2bf(bf2f((bf16_t)rx[e]) * dt); } }
        LDS_BAR(); SDP1(1); SDP0(2);
        if (c + 1 < SEQ / 64) SD_LOAD(c + 1);
        f32x16 yoff = {};
        const int ml = ((w - 3) & 2) ? 32 : 0, np = ((w - 3) & 1) ? 32 : 0;
        if (w < 3) { SD_LANE(); const int ms = (w == 2) ? 32 : 0, nl = (w >= 1) ? 32 : 0;
            f32x16 gq = {}; mmx<8, PW, PW>(gq, L + O_BM, ms, L + O_CM, nl, 0, r32, hi);
            const int lq = nl + r32; const float al = ACU[lq];
#pragma unroll
            for (int g4 = 0; g4 < 4; ++g4) { const f32x4 as4 = *(const f32x4*)(ACU + ms + 8 * g4 + 4 * hi);
#pragma unroll
                for (int e = 0; e < 4; ++e) { const int s = ms + 8 * g4 + 4 * hi + e; const float d = __expf(fminf(al - as4[e], 0.f)); gq[4 * g4 + e] = (s <= lq) ? gq[4 * g4 + e] * d : 0.f; } }
            stT<PN>(gq, L + O_MM, nl, ms, r32, hi);
        } else if (w < 7) { SD_LANE(); mmx<8, PW, PW>(yoff, L + O_CM, ml, L + O_HB, np, 0, r32, hi); }
        {   SD_LANE(); const float eend = __expf(ACU[63]);
#pragma unroll
            for (int r = 0; r < 16; ++r) hacc[r] *= eend;
            mmx<4, PN, PN, 4, 3>(hacc, L + O_BDT, (w >> 1) * 32, L + O_XDT, nv, 0, r32, hi); }
        if (w == 7 && c + 1 < SEQ / 64) { SD_SCAN((c + 1) & 1); if (c + 2 < SEQ / 64) SD_DTLOAD(c + 2); }
        LDS_BAR(); SDP1(2); SDP0(3);
        {   SD_LANE(); stT<PW>(hacc, L + O_HB, nv, (w >> 1) * 32, r32, hi); }
        if (w >= 3 && w < 7) { SD_LANE(); f32x16 yd = {};
            if (ml) mmx<4, PN, PN, -1, 3>(yd, L + O_MM, ml, L + O_XDT, np, 0, r32, hi); else mmx<2, PN, PN, -1, 3>(yd, L + O_MM, ml, L + O_XDT, np, 0, r32, hi);
            float ea[16], xv[16];
#pragma unroll
            for (int g4 = 0; g4 < 4; ++g4) { const f32x4 a4 = *(const f32x4*)(ACU + ml + 8 * g4 + 4 * hi);
#pragma unroll
                for (int e = 0; e < 4; ++e) { ea[4 * g4 + e] = __expf(a4[e]); xv[4 * g4 + e] = bf2f(*(const bf16_t*)(L + O_XM + (ml + 8 * g4 + 4 * hi + e) * PN + (np + r32) * 2)); } }
#pragma unroll
            for (int r = 0; r < 16; ++r) { const int lq = ml + crow(r, hi); const int s_ = c * 64 + lq; const int t_ = dir ? (SEQ - 1 - s_) : s_;
                yout[((size_t)b * SEQ + t_) * 512 + np + r32] = f2bf(yd[r] + ea[r] * yoff[r] + Dh * xv[r]); } }
        LDS_BAR(); SDP1(3);
    }
#undef SD_LOAD
#undef SD_DTLOAD
#undef SD_SCAN
#undef SD_LANE
    return pacc;
}
}

__device__ __forceinline__ void combine_tokens(const Params& p, const int l, const int m_first, const int m_end, const int m_step) {
    const int tid = otid(), lane = tid & 63;
    const bf16_t* wkv = (const bf16_t*)(g_scr + SCR_WKV); const bf16_t* bon = (const bf16_t*)(g_scr + SCR_BON); const bf16_t* sy = (const bf16_t*)(g_scr + SCR_SSDY);
    const int h = lane >> 3, c8 = (lane & 7) * 8, ch = h * 64 + c8;
    float eps_gn = 64e-5f, eps_rms = NORM_EPS; asm volatile("" : "+v"(eps_gn), "+v"(eps_rms));
    float lnw[8], lnb[8], snw[8];
#pragma unroll
    for (int e = 0; e < 8; ++e) { lnw[e] = p.in[19][l * 512 + ch + e]; lnb[e] = p.in[20][l * 512 + ch + e]; snw[e] = p.in[10][l * 512 + ch + e]; }
    for (int m = m_first; m < m_end; m += m_step) {
        const int bq = m >> 13, tq = m & (SEQ - 1);
        bf16_t* gp = pblk(p.ws, PB_RG + (h >> 1)) + (size_t)m * 128 + (h & 1) * 64 + c8; bf16_t* zp = pblk(p.ws, PB_Z + (h >> 1)) + (size_t)m * 128 + (h & 1) * 64 + c8;
        const bf16x8 vwf = *(const bf16x8*)(wkv + (((size_t)(bq * 16 + h)) * SEQ + tq) * 64 + c8), vwb = *(const bf16x8*)(wkv + (((size_t)(bq * 16 + 8 + h)) * SEQ + (SEQ - 1 - tq)) * 64 + c8);
        const bf16x8 vbf = *(const bf16x8*)(bon + (size_t)m * 512 + ch), vbb = *(const bf16x8*)(bon + (size_t)M_TOK * 512 + (size_t)m * 512 + ch);
        const bf16x8 vg = *(const bf16x8*)gp, vz = *(const bf16x8*)zp;
        const bf16x8 vyf = *(const bf16x8*)(sy + (size_t)m * 512 + ch), vyb = *(const bf16x8*)(sy + (size_t)M_TOK * 512 + (size_t)m * 512 + ch);
        float a[8], bq8[8], x[8], y[8];
        unpack8(vwf, a); unpack8(vwb, bq8); float s = 0.f;
#pragma unroll
        for (int e = 0; e < 8; ++e) { x[e] = a[e] + bq8[e]; s += x[e]; }
        s += __shfl_xor(s, 1); s += __shfl_xor(s, 2); s += __shfl_xor(s, 4);
        const float mean = s * (1.f / 64.f); float v2 = 0.f;
#pragma unroll
        for (int e = 0; e < 8; ++e) { x[e] -= mean; v2 += x[e] * x[e]; }
        v2 += __shfl_xor(v2, 1); v2 += __shfl_xor(v2, 2); v2 += __shfl_xor(v2, 4);
        const float rstd = rsqrtf(v2 * (1.f / 64.f) + eps_gn);
        unpack8(vbf, a); unpack8(vbb, bq8); unpack8(vg, y);
#pragma unroll
        for (int e = 0; e < 8; ++e) x[e] = (x[e] * rstd * lnw[e] + lnb[e] + a[e] + bq8[e]) * siluf(y[e]);
        const u32x4 ob = pack8(x);
        unpack8(vyf, a); unpack8(vyb, bq8); unpack8(vz, y); float ss = 0.f;
#pragma unroll
        for (int e = 0; e < 8; ++e) { x[e] = (a[e] + bq8[e]) * siluf(y[e]); ss += x[e] * x[e]; }
        ss += __shfl_xor(ss, 1); ss += __shfl_xor(ss, 2); ss += __shfl_xor(ss, 4); ss += __shfl_xor(ss, 8); ss += __shfl_xor(ss, 16);
        const float rs = rsqrtf(ss * (1.f / 256.f) + eps_rms);
#pragma unroll
        for (int e = 0; e < 8; ++e) x[e] *= rs * snw[e];
        const u32x4 oa = pack8(x);
        *(u32x4*)gp = ob; *(u32x4*)zp = oa;
    }
}

__device__ __forceinline__ void phase_post(const Params& p, const int l) {
    const int G = gridDim.x, tid = otid(), lane = tid & 63, wave = tid >> 6;
    const float* mix = (const float*)(p.ws + WS_MIX); const float* xin = l == 0 ? p.in[0] : p.out; const float* pw = p.in[2] + l * DMODEL;
    f32x4 wv[4];
#pragma unroll
    for (int j = 0; j < 4; ++j) wv[j] = ((const f32x4*)pw)[lane + 64 * j];
    for (int m0 = (blockIdx.x * 8 + wave) * 2; m0 < M_TOK; m0 += G * 16) {
        f32x4 v[2][4], x[2][4];
#pragma unroll
        for (int q = 0; q < 2; ++q)
#pragma unroll
            for (int j = 0; j < 4; ++j) { v[q][j] = ((const f32x4*)(mix + (size_t)(m0 + q) * DMODEL))[lane + 64 * j]; x[q][j] = ((const f32x4*)(xin + (size_t)(m0 + q) * DMODEL))[lane + 64 * j]; }
#pragma unroll
        for (int q = 0; q < 2; ++q) { float s = 0.f;
#pragma unroll
            for (int j = 0; j < 4; ++j) s += (v[q][j].x * v[q][j].x + v[q][j].y * v[q][j].y) + (v[q][j].z * v[q][j].z + v[q][j].w * v[q][j].w);
            const float rs = rsqrtf(wave_sum(s) * (1.f / DMODEL) + NORM_EPS); float s2 = 0.f;
#pragma unroll
            for (int j = 0; j < 4; ++j) { v[q][j] = x[q][j] + v[q][j] * rs * wv[j]; s2 += (v[q][j].x * v[q][j].x + v[q][j].y * v[q][j].y) + (v[q][j].z * v[q][j].z + v[q][j].w * v[q][j].w); }
            s2 = wave_sum(s2);
            if (lane == 0) ((float*)(g_scr + SCR_RS))[m0 + q] = rsqrtf(s2 * (1.f / DMODEL) + NORM_EPS); }
#pragma unroll
        for (int q = 0; q < 2; ++q) { f32x4* orow = (f32x4*)(p.out + (size_t)(m0 + q) * DMODEL) + lane; u32x2* o8 = (u32x2*)((bf16_t*)(g_scr + SCR_XB) + (size_t)(m0 + q) * DMODEL) + lane;
#pragma unroll
            for (int j = 0; j < 4; ++j) { orow[64 * j] = v[q][j]; u32x2 w; w.x = pk2(v[q][j].x, v[q][j].y); w.y = pk2(v[q][j].z, v[q][j].w); o8[64 * j] = w; } }
    }
}

#define XB_TMO      128
#define XB_XCNT(j)  (256  + 64 * (j))
#define XB_XSUB(j)  (1280 + 64 * (j))
#define XB_XGEN(j)  (2304 + 64 * (j))
#define XB_TOP      3328
#define XB_TOPGEN   3392
#define XCD_BAR_WORDS 3456
#define XB_SPIN_CAP (1u << 18)
#define XLAS __attribute__((address_space(3)))
__device__ __forceinline__ unsigned xb_ld(unsigned* p)              { return __hip_atomic_load(p, __ATOMIC_RELAXED, __HIP_MEMORY_SCOPE_AGENT); }
__device__ __forceinline__ unsigned xb_add(unsigned* p, unsigned v) { return __hip_atomic_fetch_add(p, v, __ATOMIC_RELAXED, __HIP_MEMORY_SCOPE_AGENT); }
__device__ __forceinline__ unsigned xb_xcc_id() { return (unsigned)__builtin_amdgcn_s_getreg((3 << 11) | 20) & 0xFu; }
#define XB_SPIN(cond, bar) do { unsigned _sp = 0; while (cond) { __builtin_amdgcn_s_sleep(1); \
    if ((++_sp & 255u) == 0u) { if (xb_ld(&(bar)[XB_TMO])) break; if (_sp > XB_SPIN_CAP) { atomicAdd(&(bar)[XB_TMO], 1u); break; } } } } while (0)
struct XcdBarrier { unsigned* bar; unsigned x; volatile XLAS unsigned* st; };
__device__ __forceinline__ XcdBarrier xcd_barrier_post(unsigned* bar, volatile XLAS unsigned* st) {
    XcdBarrier b; b.bar = bar; b.x = xb_xcc_id(); b.st = st;
    if (threadIdx.x == 0) (void)xb_add(&bar[XB_XCNT(b.x)], 1u);
    return b;
}
__device__ __forceinline__ void xcd_barrier_complete(unsigned* bar, unsigned x, unsigned& nloc, unsigned& nx) {
    const unsigned G = gridDim.x * gridDim.y * gridDim.z;
    unsigned sum, cnt, mine, sp = 0u;
    for (;;) {
        sum = 0u; cnt = 0u; mine = 0u;
#pragma unroll
        for (unsigned j = 0; j < 16; ++j) { const unsigned c = xb_ld(&bar[XB_XCNT(j)]); sum += c; cnt += (c > 0u) ? 1u : 0u; mine = (j == x) ? c : mine; }
        if (sum == G) break;
        __builtin_amdgcn_s_sleep(1);
        if ((++sp & 255u) == 0u) { if (xb_ld(&bar[XB_TMO])) break; if (sp > XB_SPIN_CAP) { atomicAdd(&bar[XB_TMO], 1u); break; } }
    }
    nloc = mine > 0u ? mine : 1u; nx = cnt > 0u ? cnt : 1u;
}
__device__ __forceinline__ void xcd_barrier(const XcdBarrier& b) {
    asm volatile("s_waitcnt vmcnt(0)" ::: "memory");
    __syncthreads();
    if (threadIdx.x == 0) {
        unsigned* bar = b.bar;
        __builtin_amdgcn_s_waitcnt(0);
        unsigned nloc = b.st[0], nx = b.st[1];
        if (nloc == 0u) { xcd_barrier_complete(bar, b.x, nloc, nx); b.st[0] = nloc; b.st[1] = nx; }
        const unsigned old = xb_add(&bar[XB_XSUB(b.x)], 1u);
        const unsigned gen = old / nloc;
        if (old + 1u == (gen + 1u) * nloc) {
            __builtin_amdgcn_fence(__ATOMIC_RELEASE, "agent");
            asm volatile("s_waitcnt vmcnt(0)" ::: "memory");
            const unsigned og = xb_add(&bar[XB_TOP], 1u);
            const unsigned tg = og / nx;
            if (og + 1u == (tg + 1u) * nx) xb_add(&bar[XB_TOPGEN], 1u);
            else XB_SPIN(xb_ld(&bar[XB_TOPGEN]) == tg, bar);
            __builtin_amdgcn_fence(__ATOMIC_ACQUIRE, "agent");
            xb_add(&bar[XB_XGEN(b.x)], 1u);
            asm volatile("s_waitcnt vmcnt(0)" ::: "memory");
        } else {
            XB_SPIN(xb_ld(&bar[XB_XGEN(b.x)]) == gen, bar);
            __builtin_amdgcn_fence(__ATOMIC_ACQUIRE, "agent");
            asm volatile("s_waitcnt vmcnt(0)" ::: "memory");
        }
    }
    __syncthreads();
}

constexpr int LDS_BYTES = 155648;
static_assert(rk::O_END <= LDS_BYTES, "rwkv LDS map");
__device__ __forceinline__ void phase_gemm_in(const Params& p, const int l, unsigned char* lds) {
    pg8::Gemm g{(const bf16_t*)(g_scr + SCR_XB), (const bf16_t*)(g_scr + SCR_WIN + (size_t)l * 15 * MiB), M_TOK, NPROJ, DMODEL, DMODEL, 128};
    pg8::StaticOrder S; S.init(M_TOK, NPROJ, gridDim.x, blockIdx.x);
    pg8::EpiProj E{(bf16_t*)p.ws, (const float*)(g_scr + SCR_RS), (float*)(g_scr + SCR_DT)};
    pg8::gemm_phase<pg8::EpiProj, pg8::StaticOrder, true, true>((PG8_LAS unsigned char*)lds, g, S, E);
}
__device__ __forceinline__ void phase_gemm_out(const Params& p, const int l, unsigned char* lds) {
    pg8::Gemm g{(const bf16_t*)p.ws, (const bf16_t*)(g_scr + SCR_WOUT + (size_t)l * 4 * MiB), M_TOK, DMODEL, DMIX, 128, PBLK_ELEMS};
    pg8::StaticOrder S; S.init(M_TOK, DMODEL, gridDim.x, blockIdx.x);
    pg8::EpiMix E{(float*)(p.ws + WS_MIX)};
    pg8::gemm_phase<pg8::EpiMix, pg8::StaticOrder, true, true>((PG8_LAS unsigned char*)lds, g, S, E);
}
__device__ __forceinline__ unsigned long long phase_mixers(const Params& p, const int l, unsigned char* lds) {
    unsigned long long pr = 0;
    const int bid = blockIdx.x;
#ifdef PRB_SEQ
    const unsigned long long ts0 = __builtin_amdgcn_s_memrealtime();
#endif
    unsigned* seqdone = (unsigned*)(g_scr + SCR_CTL) + 200 + 8 * l; unsigned* cmbctr = seqdone + 1;
    if (bid < 32) rk::chain(p, bid, lds);
    else if (bid < 64) { const unsigned long long q_ = sd::seq(p, l, bid - 32, lds); (void)q_;
#ifdef PRB_SDIV
        pr = q_;
#endif
    }
    if (bid < 64) {
        asm volatile("s_waitcnt vmcnt(0)" ::: "memory"); __syncthreads();
        if (threadIdx.x == 0) { __builtin_amdgcn_fence(__ATOMIC_RELEASE, "agent"); asm volatile("s_waitcnt vmcnt(0)" ::: "memory"); __hip_atomic_fetch_add(seqdone, 1u, __ATOMIC_RELAXED, __HIP_MEMORY_SCOPE_AGENT); }
    }
#ifdef PRB_SEQ
    pr = __builtin_amdgcn_s_memrealtime() - ts0;
#endif
    unsigned* ctr = (unsigned*)(g_scr + SCR_CTL) + 64 * l;
    unsigned* slot = (unsigned*)(lds + LDS_BYTES - 16);
#ifdef PRB_UNIT
    int nun = 0;
#endif
    const int x0 = (int)(__builtin_amdgcn_s_getreg((3 << 11) | 20) & 7u);
    for (int dx = 0; dx < 8; ++dx) { const int x = (x0 + dx) & 7;
        for (;;) {
            __syncthreads();
            if (threadIdx.x == 0) *slot = atomicAdd(ctr + x, 1u);
            __syncthreads();
            const int j = (int)__builtin_amdgcn_readfirstlane(*slot);
            constexpr int NSPL = 16;
            if (j >= 96 + NSPL) break;
#ifdef PRB_UNIT
            const unsigned long long tu0 = __builtin_amdgcn_s_memrealtime();
#endif
            if (j < 32) gqa_unit(p, l, x * 32 + j, (char*)lds);
            else if (j < 96 - NSPL) diff_unit(p, l, x * 64 + (j - 32), (char*)lds);
            else { const int s = j - (96 - NSPL); diff_unit(p, l, x * 64 + (64 - NSPL) + (s >> 1), (char*)lds, s & 1, x * NSPL + (s >> 1)); }
#ifdef PRB_UNIT
            if (nun == PRB_UNIT) pr = __builtin_amdgcn_s_memrealtime() - tu0;
            if (PRB_UNIT == 99) pr = (unsigned long long)(nun + 1) * 10000ull + (j < 32 ? 1000ull : 0ull);
            ++nun;
#endif
        } }
    {   if (threadIdx.x == 0) { unsigned sp = 0; while (__hip_atomic_load(seqdone, __ATOMIC_RELAXED, __HIP_MEMORY_SCOPE_AGENT) < 64u) { __builtin_amdgcn_s_sleep(8); if (++sp > (1u << 22)) break; } }
        __syncthreads();
        __builtin_amdgcn_fence(__ATOMIC_ACQUIRE, "agent"); asm volatile("s_waitcnt vmcnt(0)" ::: "memory");
        const int wave = otid() >> 6;
        for (;;) {
            __syncthreads();
            if (threadIdx.x == 0) *slot = atomicAdd(cmbctr, 1u);
            __syncthreads();
            const int it = (int)__builtin_amdgcn_readfirstlane(*slot);
            if (it >= M_TOK / 64) break;
            combine_tokens(p, l, it * 64 + wave, it * 64 + 64, 8);
        } }
    return pr;
}
#ifdef PROBE
#define PT0(ph) do { if (l == 0 && (ph) == PRB_PH) pt0 = __builtin_amdgcn_s_memrealtime(); } while (0)
#define PT1(ph, aftersync) do { if (l == 0 && (ph) == PRB_PH && (aftersync) == PRB_SYNC) pd = __builtin_amdgcn_s_memrealtime() - pt0; } while (0)
#else
#define PT0(ph) do {} while (0)
#define PT1(ph, aftersync) do {} while (0)
#endif
__global__ void __launch_bounds__(512) mega(const Params p) {
    extern __shared__ __attribute__((aligned(16))) unsigned char lds[];
    cg::grid_group grid = cg::this_grid();
    unsigned* xbar = (unsigned*)(g_scr + SCR_BAR);
    volatile XLAS unsigned* xst = (volatile XLAS unsigned*)(XLAS unsigned char*)(lds + LDS_BYTES - 32);
    if (blockIdx.x == 0) for (int i = threadIdx.x; i < XCD_BAR_WORDS; i += 512) xbar[i] = 0u;
    if (threadIdx.x < 2) xst[threadIdx.x] = 0u;
#ifdef PROBE
    unsigned long long pt0 = 0, pd = 0;
#endif
#ifdef PROBE
    if (PRB_PH == 7) pt0 = __builtin_amdgcn_s_memrealtime();
#endif
    phase_prologue(p, (float*)lds); grid.sync();
    const XcdBarrier xb = xcd_barrier_post(xbar, xst);
#define GRID_BAR() xcd_barrier(xb)
#ifdef PROBE
    if (PRB_PH == 7) pd = __builtin_amdgcn_s_memrealtime() - pt0;
#endif
#pragma unroll 1
    for (int l = 0; l < 2; ++l) {
        PT0(0); phase_gemm_in(p, l, lds); PT1(0, 0); GRID_BAR(); PT1(0, 1);
        PT0(1); phase_prep(p, l); PT1(1, 0); GRID_BAR(); PT1(1, 1);
        kmax_reduce(l, (float*)lds);
        PT0(6); { const unsigned long long pr_ = rk::pass1(p, l, lds); (void)pr_;
#ifdef PRB_IV
        if (l == 0) pd = pr_;
#endif
        } PT1(6, 0); GRID_BAR(); PT1(6, 1);
        PT0(2); { const unsigned long long pr_ = phase_mixers(p, l, lds); (void)pr_;
#if defined(PRB_SEQ) || defined(PRB_SDIV) || defined(PRB_UNIT)
        if (l == 0) pd = pr_;
#endif
        } PT1(2, 0); GRID_BAR(); PT1(2, 1);
        PT0(4); phase_gemm_out(p, l, lds); PT1(4, 0); GRID_BAR(); PT1(4, 1);
        PT0(5); phase_post(p, l); PT1(5, 0); if (l == 0) { GRID_BAR(); PT1(5, 1); }
    }
#ifdef PROBE
    if (blockIdx.x == PRB_BLK && threadIdx.x == 0) { const unsigned long long d = pd * PRB_K; const unsigned long long t0 = __builtin_amdgcn_s_memrealtime();
        while (__builtin_amdgcn_s_memrealtime() - t0 < d) __builtin_amdgcn_s_sleep(8); }
#endif
}

extern "C" void kernel_launch(void* const* d_in, const int* in_sizes, int n_in, void* d_out, int out_size, void* d_ws, size_t ws_size, hipStream_t stream) {
    static int grid_blocks = 0;
    if (!grid_blocks) {
        int dev = 0, cus = 0, per_cu = 0;
        (void)hipGetDevice(&dev);
        (void)hipDeviceGetAttribute(&cus, hipDeviceAttributeMultiprocessorCount, dev);
        (void)hipFuncSetAttribute((const void*)mega, hipFuncAttributeMaxDynamicSharedMemorySize, LDS_BYTES);
        (void)hipOccupancyMaxActiveBlocksPerMultiprocessor(&per_cu, (const void*)mega, 512, LDS_BYTES);
        if (per_cu < 1) { fprintf(stderr, "kernel_launch: occupancy query says %d blocks/CU\n", per_cu); per_cu = 1; }
        grid_blocks = cus;
    }
    Params p{};
    for (int i = 0; i < 25; ++i) p.in[i] = (const float*)d_in[i];
    p.out = (float*)d_out; p.ws = (unsigned char*)d_ws;
    void* args[] = {&p};
    hipError_t e = hipLaunchCooperativeKernel((const void*)mega, dim3(grid_blocks), dim3(512), args, LDS_BYTES, stream);
    if (e != hipSuccess) fprintf(stderr, "cooperative launch failed: %s (grid %d)\n", hipGetErrorString(e), grid_blocks);
}
```

```cpp
#include <hip/hip_runtime.h>
#include <hip/hip_bf16.h>
#include <hip/hip_cooperative_groups.h>
#include <cstdio>
#include <cstdint>
namespace cg = cooperative_groups;

constexpr int M_TOK = 16384, SEQ = 8192, DMODEL = 1024, NPROJ = 7424, NPB = 58, DIN_ORIG = 7312, DMIX = 2048;
constexpr float NORM_EPS = 1e-6f;
constexpr size_t MiB = 1u << 20;
constexpr int PB_Z = 0, PB_RG = 4, PB_DQ = 8, PB_GQ = 12, PB_XS = 16, PB_BM = 20, PB_CM = 22, PB_R = 24, PB_K = 28, PB_V = 32, PB_WA = 36,
              PB_DK = 37, PB_DV = 41, PB_DG = 45, PB_GK = 49, PB_GV = 51, PB_GG = 53, PB_DT = 57;
constexpr size_t PBLK_ELEMS = (size_t)M_TOK * 128;
constexpr size_t SCR_WIN = 0, SCR_WOUT = 30 * MiB, SCR_ROPE = 38 * MiB, SCR_DT = 40 * MiB, SCR_RS = 41 * MiB, SCR_CTL = 41 * MiB + 512 * 1024,
                 SCR_BAR = 41 * MiB + 768 * 1024, SCR_XB = 42 * MiB, SCR_WKV = 74 * MiB, SCR_BON = 106 * MiB, SCR_SSDY = 138 * MiB, SCR_XACT = 170 * MiB, SCR_NN2 = 202 * MiB, SCR_SPL = 210 * MiB, SCR_BYTES = 228 * MiB;
constexpr size_t SCR_KPART = 41 * MiB + 64 * 1024;
constexpr size_t WS_MM = 16 * PBLK_ELEMS * 2;
constexpr size_t WS_NN = 58 * PBLK_ELEMS * 2;
constexpr size_t WS_MIX = 16 * PBLK_ELEMS * 2;
__device__ __attribute__((aligned(256))) unsigned char g_scr[SCR_BYTES];

typedef unsigned short bf16_t;
typedef short bf16x8 __attribute__((ext_vector_type(8)));
typedef float f32x4 __attribute__((ext_vector_type(4)));
typedef unsigned u32x4 __attribute__((ext_vector_type(4)));
typedef unsigned u32x2 __attribute__((ext_vector_type(2)));

struct Params {
    const float* in[25];
    float* out;
    unsigned char* ws;
};

__device__ __forceinline__ int otid() { int t = threadIdx.x; asm volatile("" : "+v"(t)); return t; }
__device__ __forceinline__ float bf2f(bf16_t v) { return __uint_as_float(((unsigned)v) << 16); }
typedef float f32x2_t __attribute__((ext_vector_type(2))); typedef __bf16 bf16x2_t __attribute__((ext_vector_type(2)));
__device__ __forceinline__ unsigned pk2(float lo, float hi) { f32x2_t v = {lo, hi}; bf16x2_t b = __builtin_convertvector(v, bf16x2_t); return __builtin_bit_cast(unsigned, b); }
__device__ __forceinline__ bf16_t f2bf(float f) { return (bf16_t)(pk2(f, 0.f) & 0xffffu); }
__device__ __forceinline__ float wave_sum(float v) {
#pragma unroll
    for (int o = 1; o < 64; o <<= 1) v += __shfl_xor(v, o);
    return v;
}
__device__ __forceinline__ float siluf(float x) { return x / (1.f + __expf(-x)); }
__device__ __forceinline__ float softplusf(float x) { return fmaxf(x, 0.f) + log1pf(__expf(-fabsf(x))); }
__device__ __forceinline__ bf16_t* pblk(unsigned char* ws, int j) { return (bf16_t*)ws + (size_t)j * PBLK_ELEMS; }

namespace pg8 {
#define PG8_LAS __attribute__((address_space(3)))
constexpr int BM = 256, BK = 64, HALF = 128, HTB = HALF * BK * 2, STAGE_BYTES = 8 * HTB, NXCD = 8, WGM = 8;
__host__ __device__ __forceinline__ int lds_byte(int r, int c) { const int st = (r >> 4) * 2 + (c >> 5), rr = r & 15, cc = c & 31, ob = rr * 64 + cc * 2; return st * 1024 + (ob ^ (((ob >> 9) & 1) << 5)); }
__host__ __device__ __forceinline__ void stage_rc(int b, int& R, int& C) { const int st = b / 1024, sb = b % 1024, swz = sb ^ (((sb >> 9) & 1) << 5); R = (st >> 1) * 16 + swz / 64; C = (st & 1) * 32 + (swz % 64) / 2; }
__host__ __device__ __forceinline__ int perm32(int rho) { const int n = rho >> 4, i = rho & 15; return 8 * (i >> 2) + 4 * n + (i & 3); }
struct Unit { int pm, pn; };
struct Gemm { const bf16_t* A; const bf16_t* Bt; int M, N, K; int lda; size_t abig; };
struct StaticOrder {
    int nM, nN, nwg, G, c;
    __host__ __device__ void init(int M, int N, int G_, int c_) { nM = M / BM; nN = N / BM; nwg = nM * nN; G = G_; c = c_; }
    __host__ __device__ bool next(int i, Unit& u) const {
        const long L = (long)i * G + c; if (L >= nwg) return false;
        int wgid = (int)L; { const int q = nwg / NXCD, r = nwg % NXCD, xcd = wgid % NXCD, off = wgid / NXCD; wgid = (xcd < r ? xcd * (q + 1) : r * (q + 1) + (xcd - r) * q) + off; }
        const int nig = WGM * nN, gid = wgid / nig, fm = gid * WGM, gsz = (nM - fm) < WGM ? (nM - fm) : WGM;
        u.pm = fm + ((wgid % nig) % gsz); u.pn = (wgid % nig) / gsz; return true;
    }
};
template <class Epi, class Sched, bool ALIGN_EPI = false, bool SP2 = false>
__device__ __forceinline__ void gemm_phase(PG8_LAS unsigned char* lds, const Gemm g, const Sched& S, const Epi& E) {
    const int tid = otid(), wid = __builtin_amdgcn_readfirstlane(tid >> 6), lane = tid & 63, wr = wid >> 2, wc = wid & 3, fr = lane & 15, fq = lane >> 4;
    const int K = g.K, nt = K / BK;
    unsigned voffA[2], voffB[2];
#pragma unroll
    for (int i = 0; i < 2; ++i) { int R, C; stage_rc(tid * 16 + i * 8192, R, C); const int Rb = Epi::PERM ? ((R & ~31) + perm32(R & 31)) : R;
        voffA[i] = (unsigned)(R * g.lda + C) * 2u; voffB[i] = (unsigned)(Rb * K + C) * 2u; }
    const size_t kstep = (size_t)(BK * 2);
    const size_t abig = g.abig * 2;
    const size_t hstepA = (size_t)HALF * g.lda * 2, hstepB = (size_t)HALF * K * 2;
    const size_t tstepA = 2 * hstepA, tstepB = 2 * hstepB;
    const unsigned ldsw = (unsigned)wid * 1024u;
    const int aoff = lds_byte(wr * 64 + fr, fq * 8), boff = lds_byte(wc * 32 + fr, fq * 8);
#define PG8_SA(b, h) (((b) * 2 + (h)) * HTB)
#define PG8_SB(b, h) ((4 + (b) * 2 + (h)) * HTB)
#define PG8_STAGE(bufoff, gbase, voff) do { _Pragma("unroll") for (int _i = 0; _i < 2; ++_i) \
        __builtin_amdgcn_global_load_lds((const unsigned*)((const char*)(gbase) + (voff)[_i]), (PG8_LAS unsigned*)(lds + (bufoff) + ldsw + _i * 8192), 16, 0, 0); } while (0)
#define PG8_LDA(dst, b, h) do { _Pragma("unroll") for (int m = 0; m < 4; ++m) _Pragma("unroll") for (int k = 0; k < 2; ++k) dst[m][k] = *(const PG8_LAS bf16x8*)(lds + PG8_SA(b, h) + aoff + m * 2048 + k * 1024); } while (0)
#define PG8_LDB(dst, b, h) do { _Pragma("unroll") for (int n = 0; n < 2; ++n) _Pragma("unroll") for (int k = 0; k < 2; ++k) dst[n][k] = *(const PG8_LAS bf16x8*)(lds + PG8_SB(b, h) + boff + n * 2048 + k * 1024); } while (0)
#define PG8_MMA(ai, bj, At, Bt) do { __builtin_amdgcn_s_setprio(1); _Pragma("unroll") for (int m = 0; m < 4; ++m) _Pragma("unroll") for (int n = 0; n < 2; ++n) _Pragma("unroll") for (int k = 0; k < 2; ++k) \
        acc[ai][bj][m][n] = __builtin_amdgcn_mfma_f32_16x16x32_bf16(Bt[n][k], At[m][k], acc[ai][bj][m][n], 0, 0, 0); __builtin_amdgcn_s_setprio(0); } while (0)
#define PG8_WAIT_V(n) asm volatile("s_waitcnt vmcnt(" #n ")" ::: "memory")
#define PG8_WAIT_L(n) asm volatile("s_waitcnt lgkmcnt(" #n ")" ::: "memory")
#define PG8_BAR __builtin_amdgcn_s_barrier()
#define PG8_SCHED __builtin_amdgcn_sched_barrier(0)
    Unit cur, nxt; int ui = 0;
    if (!S.next(0, cur)) return;
    f32x4 acc[2][2][4][2];
#pragma unroll
    for (int a = 0; a < 2; ++a)
#pragma unroll
        for (int b = 0; b < 2; ++b)
#pragma unroll
            for (int m = 0; m < 4; ++m)
#pragma unroll
                for (int n = 0; n < 2; ++n) acc[a][b][m][n] = (f32x4){0.f, 0.f, 0.f, 0.f};
    bf16x8 At[4][2], B0[2][2], B1[2][2];
    const char* cA = (const char*)g.A + (size_t)cur.pm * tstepA; const char* cB = (const char*)g.Bt + (size_t)cur.pn * tstepB;
    if constexpr (SP2) {
        PG8_STAGE(PG8_SB(0, 0), cB, voffB); PG8_STAGE(PG8_SB(0, 1), cB + hstepB, voffB); PG8_STAGE(PG8_SA(0, 0), cA, voffA); PG8_STAGE(PG8_SA(0, 1), cA + hstepA, voffA);
        if (wr == 1) PG8_BAR;
        PG8_WAIT_V(2); PG8_BAR;
        PG8_STAGE(PG8_SB(1, 0), cB + kstep, voffB); PG8_STAGE(PG8_SA(1, 0), cA + kstep, voffA); PG8_STAGE(PG8_SB(1, 1), cB + hstepB + kstep, voffB);
        PG8_WAIT_V(6); PG8_BAR;
    } else {
        PG8_STAGE(PG8_SB(0, 0), cB, voffB); PG8_STAGE(PG8_SA(0, 0), cA, voffA); PG8_STAGE(PG8_SB(0, 1), cB + hstepB, voffB); PG8_STAGE(PG8_SA(0, 1), cA + hstepA, voffA);
        if (wr == 1) PG8_BAR;
        PG8_WAIT_V(4); PG8_BAR;
        PG8_STAGE(PG8_SB(1, 0), cB + kstep, voffB); PG8_STAGE(PG8_SA(1, 0), cA + kstep, voffA); PG8_STAGE(PG8_SB(1, 1), cB + hstepB + kstep, voffB);
        PG8_WAIT_V(6); PG8_BAR;
    }
    for (;;) {
        const bool has_next = S.next(ui + 1, nxt);
        const char* nA = has_next ? (const char*)g.A + (size_t)nxt.pm * tstepA : cA; const char* nB = has_next ? (const char*)g.Bt + (size_t)nxt.pn * tstepB : cB;
        for (int t = 0; t < nt; t += 2) {
            const bool last = (t == nt - 2);
            const char* a1 = cA + (size_t)(t >> 1) * abig + kstep;
            const char* a2 = last ? nA : cA + (size_t)((t >> 1) + 1) * abig; const char* b2 = last ? nB : cB + (size_t)(t + 2) * kstep;
            const char* a3 = a2 + kstep; const char* b3 = b2 + kstep;
            if constexpr (SP2) {
            PG8_LDB(B0, 0, 0); PG8_LDB(B1, 0, 1); PG8_SCHED; PG8_LDA(At, 0, 0); PG8_STAGE(PG8_SA(1, 1), a1 + hstepA, voffA);
            PG8_WAIT_V(8); PG8_WAIT_L(0); PG8_BAR; PG8_MMA(0, 0, At, B0); PG8_MMA(0, 1, At, B1); PG8_BAR; PG8_SCHED;
            PG8_LDA(At, 0, 1); PG8_STAGE(PG8_SB(0, 0), b2, voffB); PG8_STAGE(PG8_SB(0, 1), b2 + hstepB, voffB); PG8_STAGE(PG8_SA(0, 0), a2, voffA);
            PG8_WAIT_V(8); PG8_WAIT_L(0); PG8_BAR; PG8_MMA(1, 0, At, B0); PG8_MMA(1, 1, At, B1); PG8_BAR; PG8_SCHED;
            PG8_LDB(B0, 1, 0); PG8_LDB(B1, 1, 1); PG8_SCHED; PG8_LDA(At, 1, 0); PG8_STAGE(PG8_SA(0, 1), a2 + hstepA, voffA);
            PG8_WAIT_V(8); PG8_WAIT_L(0); PG8_BAR; PG8_MMA(0, 0, At, B0); PG8_MMA(0, 1, At, B1); PG8_BAR; PG8_SCHED;
            PG8_LDA(At, 1, 1); PG8_STAGE(PG8_SB(1, 0), b3, voffB); PG8_STAGE(PG8_SB(1, 1), b3 + hstepB, voffB); PG8_STAGE(PG8_SA(1, 0), a3, voffA);
            PG8_WAIT_V(8); PG8_WAIT_L(0); PG8_BAR; PG8_MMA(1, 0, At, B0); PG8_MMA(1, 1, At, B1); PG8_BAR; PG8_SCHED;
            } else {
            PG8_LDB(B0, 0, 0); PG8_SCHED; PG8_LDA(At, 0, 0); PG8_STAGE(PG8_SA(1, 1), a1 + hstepA, voffA);
            PG8_WAIT_L(8); PG8_BAR; PG8_WAIT_L(0); PG8_MMA(0, 0, At, B0); PG8_BAR; PG8_SCHED;
            PG8_LDB(B1, 0, 1); PG8_STAGE(PG8_SB(0, 0), b2, voffB);
            PG8_BAR; PG8_WAIT_L(0); PG8_MMA(0, 1, At, B1); PG8_BAR;
            PG8_LDA(At, 0, 1); PG8_STAGE(PG8_SA(0, 0), a2, voffA);
            PG8_BAR; PG8_WAIT_L(0); PG8_MMA(1, 0, At, B0); PG8_BAR; PG8_SCHED;
            PG8_STAGE(PG8_SB(0, 1), b2 + hstepB, voffB);
            PG8_WAIT_V(6); PG8_BAR; PG8_MMA(1, 1, At, B1); PG8_BAR;
            PG8_LDB(B0, 1, 0); PG8_SCHED; PG8_LDA(At, 1, 0); PG8_STAGE(PG8_SA(0, 1), a2 + hstepA, voffA);
            PG8_WAIT_L(8); PG8_BAR; PG8_WAIT_L(0); PG8_MMA(0, 0, At, B0); PG8_BAR; PG8_SCHED;
            PG8_LDB(B1, 1, 1); PG8_STAGE(PG8_SB(1, 0), b3, voffB);
            PG8_BAR; PG8_WAIT_L(0); PG8_MMA(0, 1, At, B1); PG8_BAR;
            PG8_LDA(At, 1, 1); PG8_STAGE(PG8_SA(1, 0), a3, voffA);
            PG8_BAR; PG8_WAIT_L(0); PG8_MMA(1, 0, At, B0); PG8_BAR; PG8_SCHED;
            PG8_STAGE(PG8_SB(1, 1), b3 + hstepB, voffB);
            PG8_WAIT_V(6); PG8_BAR; PG8_MMA(1, 1, At, B1); PG8_BAR;
            }
        }
        if constexpr (ALIGN_EPI) { if (wr == 0) PG8_BAR; }
        E(acc, cur, wr, wc, fr, fq);
        if (!has_next) break;
#pragma unroll
        for (int a = 0; a < 2; ++a)
#pragma unroll
            for (int b = 0; b < 2; ++b)
#pragma unroll
                for (int m = 0; m < 4; ++m)
#pragma unroll
                    for (int n = 0; n < 2; ++n) acc[a][b][m][n] = (f32x4){0.f, 0.f, 0.f, 0.f};
        cur = nxt; cA = nA; cB = nB; ++ui;
        if constexpr (ALIGN_EPI) { if (wr == 1) PG8_BAR; }
    }
    PG8_WAIT_V(0);
    if constexpr (!ALIGN_EPI) { if (wr == 0) PG8_BAR; }
    PG8_BAR;
#undef PG8_SA
#undef PG8_SB
#undef PG8_STAGE
#undef PG8_LDA
#undef PG8_LDB
#undef PG8_MMA
#undef PG8_WAIT_V
#undef PG8_WAIT_L
#undef PG8_BAR
#undef PG8_SCHED
}
struct EpiProj {
    static constexpr bool PERM = true;
    bf16_t* P; const float* rowscale; float* dtbuf;
    __device__ __forceinline__ void operator()(const f32x4 (&acc)[2][2][4][2], const Unit& u, int wr, int wc, int fr, int fq) const {
        const int row0 = u.pm * BM + wr * 64 + fr; const int col = wc * 32 + 8 * fq;
#pragma unroll
        for (int ai = 0; ai < 2; ++ai)
#pragma unroll
            for (int m = 0; m < 4; ++m) { const int row = row0 + ai * HALF + m * 16; const float sc = rowscale[row];
#pragma unroll
                for (int bj = 0; bj < 2; ++bj) { const int blk = u.pn * 2 + bj;
                    const f32x4 v0 = acc[ai][bj][m][0] * sc, v1 = acc[ai][bj][m][1] * sc;
                    u32x4 w; w.x = pk2(v0[0], v0[1]); w.y = pk2(v0[2], v0[3]); w.z = pk2(v1[0], v1[1]); w.w = pk2(v1[2], v1[3]);
                    *(u32x4*)(P + (size_t)blk * PBLK_ELEMS + (size_t)row * 128 + col) = w;
                    if (blk == PB_DT && col < 16) { float* d = dtbuf + (size_t)row * 16 + col; *(f32x4*)d = v0; *(f32x4*)(d + 4) = v1; } } }
    }
};
struct EpiMix {
    static constexpr bool PERM = true;
    float* O;
    __device__ __forceinline__ void operator()(const f32x4 (&acc)[2][2][4][2], const Unit& u, int wr, int wc, int fr, int fq) const {
        const int row0 = u.pm * BM + wr * 64 + fr; const int col0 = u.pn * BM + wc * 32 + 8 * fq;
#pragma unroll
        for (int ai = 0; ai < 2; ++ai)
#pragma unroll
            for (int m = 0; m < 4; ++m) { float* rp = O + (size_t)(row0 + ai * HALF + m * 16) * DMODEL + col0;
#pragma unroll
                for (int bj = 0; bj < 2; ++bj) { *(f32x4*)(rp + bj * HALF) = acc[ai][bj][m][0]; *(f32x4*)(rp + bj * HALF + 4) = acc[ai][bj][m][1]; } }
    }
};
}

__device__ __forceinline__ int orig_col(int n) {
    if (n < 512) return n;
    if (n < 1024) return 3216 + (n - 512);
    if (n < 1536) return 3728 + (n - 1024);
    if (n < 2048) return 5776 + (n - 1536);
    if (n < 3072) return 512 + (n - 2048);
    if (n < 4736) return 1552 + (n - 3072);
    if (n < 5248) return 4240 + (n - 4736);
    if (n < 5760) return 4752 + (n - 5248);
    if (n < 6272) return 5264 + (n - 5760);
    if (n < 6528) return 6288 + (n - 6272);
    if (n < 6784) return 6544 + (n - 6528);
    if (n < 7296) return 6800 + (n - 6784);
    if (n < 7312) return 1536 + (n - 7296);
    return -1;
}
struct TrItem { const float* W; const float* ks; bf16_t* WT; int K, Nsrc, k0, n0; bool mapcol; };
__device__ __forceinline__ TrItem tr_item(const Params& p, int it) {
    constexpr int I_IN = 16 * 29, I_OUT = 32 * 4;
    TrItem t; int r = it; const int l = r / (I_IN + I_OUT); r -= l * (I_IN + I_OUT);
    if (r < I_IN) { t.W = p.in[3] + (size_t)l * DMODEL * DIN_ORIG; t.ks = p.in[1] + l * DMODEL; t.WT = (bf16_t*)(g_scr + SCR_WIN + (size_t)l * 15 * MiB); t.K = DMODEL; t.Nsrc = DIN_ORIG; t.k0 = (r / 29) * 64; t.n0 = (r % 29) * 256; t.mapcol = true; }
    else { r -= I_IN; t.W = p.in[4] + (size_t)l * DMIX * DMODEL; t.ks = nullptr; t.WT = (bf16_t*)(g_scr + SCR_WOUT + (size_t)l * 4 * MiB); t.K = DMIX; t.Nsrc = DMODEL; t.k0 = (r / 4) * 64; t.n0 = (r % 4) * 256; t.mapcol = false; }
    return t;
}
__device__ __forceinline__ void tr_load(const TrItem& t, int tid, float* v) {
    const int nn = tid & 63;
#pragma unroll
    for (int q = 0; q < 4; ++q) { const int n = t.n0 + 64 * q + nn; const int oc = t.mapcol ? orig_col(n) : n;
#pragma unroll
        for (int i = 0; i < 8; ++i) { const int kk = (tid >> 6) + 8 * i; v[q * 8 + i] = (oc >= 0) ? t.W[(size_t)(t.k0 + kk) * t.Nsrc + oc] * (t.ks ? t.ks[t.k0 + kk] : 1.f) : 0.f; } }
}
__device__ __forceinline__ void rope_entry(int idx, float* tab) {
    const int pos = idx >> 5, i = idx & 31;
    const float inv = exp2f(-(float)i * (13.287712379549449f / 32.f));
    const float ang = (float)pos * inv;
    const double rev = (double)ang * 0.15915494309189535; const double fr = rev - floor(rev);
    const float a = (float)(fr * 6.283185307179586);
    tab[idx * 2] = cosf(a); tab[idx * 2 + 1] = sinf(a);
}
__device__ __forceinline__ void xrow_to_bf16(const float* xrow, bf16_t* orow, float* rs, int lane) {
    const f32x4* xr = (const f32x4*)xrow + lane; f32x4 v[4]; float s = 0.f;
#pragma unroll
    for (int j = 0; j < 4; ++j) { v[j] = xr[64 * j]; s += (v[j].x * v[j].x + v[j].y * v[j].y) + (v[j].z * v[j].z + v[j].w * v[j].w); }
    s = wave_sum(s);
    if (lane == 0) *rs = rsqrtf(s * (1.f / DMODEL) + NORM_EPS);
    u32x2* o8 = (u32x2*)orow + lane;
#pragma unroll
    for (int j = 0; j < 4; ++j) { u32x2 w; w.x = pk2(v[j].x, v[j].y); w.y = pk2(v[j].z, v[j].w); o8[64 * j] = w; }
}
__device__ __forceinline__ void phase_prologue(const Params& p, float* lds_f) {
    const int G = gridDim.x, bid = blockIdx.x, tid = otid(), lane = tid & 63, wave = tid >> 6;
    {   constexpr int NIT = 2 * (16 * 29 + 32 * 4);
        float v[32], v2[32]; int it = bid; TrItem cur = tr_item(p, it < NIT ? it : 0);
        if (it < NIT) tr_load(cur, tid, v);
        while (it < NIT) {
            const int nn = tid & 63;
#pragma unroll
            for (int q = 0; q < 4; ++q)
#pragma unroll
                for (int i = 0; i < 8; ++i) lds_f[q * 4160 + ((tid >> 6) + 8 * i) * 65 + nn] = v[q * 8 + i];
            const int nx = it + G; TrItem nxt = tr_item(p, nx < NIT ? nx : 0);
            if (nx < NIT) tr_load(nxt, tid, v2);
            __syncthreads();
#pragma unroll
            for (int q = 0; q < 4; ++q) { const int n = tid >> 3, c = tid & 7; const float* s = lds_f + q * 4160 + (8 * c) * 65 + n;
                u32x4 o; o.x = pk2(s[0], s[65]); o.y = pk2(s[2 * 65], s[3 * 65]); o.z = pk2(s[4 * 65], s[5 * 65]); o.w = pk2(s[6 * 65], s[7 * 65]);
                *(u32x4*)(cur.WT + (size_t)(cur.n0 + 64 * q + n) * cur.K + cur.k0 + 8 * c) = o; }
            __syncthreads();
#pragma unroll
            for (int i = 0; i < 32; ++i) v[i] = v2[i];
            cur = nxt; it = nx;
        }
    }
    if (bid == 0) { ((unsigned*)(g_scr + SCR_CTL))[tid] = 0u; ((unsigned*)(g_scr + SCR_CTL))[512 + tid] = 0u; }
    for (int i = bid * 512 + tid; i < SEQ * 32; i += G * 512) rope_entry(i, (float*)(g_scr + SCR_ROPE));
    for (int m = bid * 8 + wave; m < M_TOK; m += G * 8) xrow_to_bf16(p.in[0] + (size_t)m * DMODEL, (bf16_t*)(g_scr + SCR_XB) + (size_t)m * DMODEL, (float*)(g_scr + SCR_RS) + m, lane);
}

__device__ __forceinline__ void unpack8(const bf16x8 v, float* x) {
#pragma unroll
    for (int e = 0; e < 8; ++e) x[e] = bf2f((bf16_t)v[e]);
}
__device__ __forceinline__ u32x4 pack8(const float* x) { u32x4 o; o.x = pk2(x[0], x[1]); o.y = pk2(x[2], x[3]); o.z = pk2(x[4], x[5]); o.w = pk2(x[6], x[7]); return o; }
__device__ __forceinline__ void rope8(float* x, const float* cs, const bool upper) {
#pragma unroll
    for (int e = 0; e < 8; ++e) { const float o = __shfl_xor(x[e], 4); x[e] = upper ? (x[e] * cs[2 * e] + o * cs[2 * e + 1]) : (x[e] * cs[2 * e] - o * cs[2 * e + 1]); }
}
__device__ __forceinline__ void phase_prep(const Params& p, const int l) {
    const int G = gridDim.x;
    {   const int tid = otid(), lane = tid & 63, wave = tid >> 6;
        bf16x8 cv[5], nv_[5];
#define CONV_LOAD(dst, it_) do { const int m_ = (it_) >> 1, t_ = m_ & (SEQ - 1); const int ch_ = ((it_) & 1) * 512 + lane * 8; const bf16_t* src_ = pblk(p.ws, PB_XS + (ch_ >> 7)) + (ch_ & 127); \
            _Pragma("unroll") for (int jj = 0; jj < 5; ++jj) { const int tt = t_ + jj - 2; const bool ok = tt >= 0 && tt < SEQ; dst[jj] = ok ? *(const bf16x8*)(src_ + ((size_t)(m_ - t_ + tt)) * 128) : (bf16x8){0, 0, 0, 0, 0, 0, 0, 0}; } } while (0)
        int it = blockIdx.x * 8 + wave;
        if (it < M_TOK * 2) CONV_LOAD(cv, it);
        for (; it < M_TOK * 2; it += G * 8) {
            const int m = it >> 1, half = it & 1;
            const int ch = half * 512 + lane * 8;
            const float* cw = p.in[5] + (size_t)l * 5 * 1024 + ch; const float* cb = p.in[6] + (size_t)l * 1024 + ch;
            if (it + G * 8 < M_TOK * 2) CONV_LOAD(nv_, it + G * 8);
            float acc[8]; { const f32x4 b0 = *(const f32x4*)cb, b1 = *(const f32x4*)(cb + 4);
#pragma unroll
              for (int e = 0; e < 4; ++e) { acc[e] = b0[e]; acc[4 + e] = b1[e]; } }
#pragma unroll
            for (int jj = 0; jj < 5; ++jj) { const f32x4 w0 = *(const f32x4*)(cw + jj * 1024), w1 = *(const f32x4*)(cw + jj * 1024 + 4);
#pragma unroll
                for (int e = 0; e < 4; ++e) { acc[e] += w0[e] * bf2f((bf16_t)cv[jj][e]); acc[4 + e] += w1[e] * bf2f((bf16_t)cv[jj][4 + e]); } }
#pragma unroll
            for (int e = 0; e < 8; ++e) acc[e] = siluf(acc[e]);
            *(u32x4*)((bf16_t*)(g_scr + SCR_XACT) + (size_t)m * 1024 + ch) = pack8(acc);
#pragma unroll
            for (int jj = 0; jj < 5; ++jj) cv[jj] = nv_[jj];
        }
#undef CONV_LOAD
    }
    const int tid = otid(), lane = tid & 63, wave = tid >> 6;
    const float* tab = (const float*)(g_scr + SCR_ROPE);
    const int hh = lane >> 4, c16 = lane & 15, j8 = (c16 & 7) * 8, fi = j8 & 31; const bool upper = j8 >= 32, second = c16 >= 8;
    float kw[8];
#pragma unroll
    for (int e = 0; e < 8; ++e) kw[e] = p.in[24][l * 128 + c16 * 8 + e];
    float* kpart = (float*)(g_scr + SCR_KPART); const int gwv = blockIdx.x * 8 + wave;
    float mxd = 0.f, mxg = 0.f; int curb = (blockIdx.x * 8 + wave) >> 13;
    bf16x8 vdk, vgk, ndk, ngk; float cst[16], csa[16], nst[16], nsa[16];
#define QK_LOAD(m_, dk_, gk_, st_, sa_) do { const int t_ = (m_) & (SEQ - 1); const int row_ = t_ >> 6, col_ = t_ & 63; \
        dk_ = *(const bf16x8*)(pblk(p.ws, PB_DK + hh) + (size_t)(m_) * 128 + c16 * 8); gk_ = *(const bf16x8*)(pblk(p.ws, PB_GK + (hh & 1)) + (size_t)(m_) * 128 + c16 * 8); \
        const f32x4* a_ = (const f32x4*)(tab + ((size_t)t_ * 32 + fi) * 2); const f32x4* b_ = (const f32x4*)(tab + ((size_t)(second ? col_ : row_) * 32 + fi) * 2); \
        _Pragma("unroll") for (int i_ = 0; i_ < 4; ++i_) { const f32x4 u_ = a_[i_], v_ = b_[i_]; _Pragma("unroll") for (int e_ = 0; e_ < 4; ++e_) { st_[4 * i_ + e_] = u_[e_]; sa_[4 * i_ + e_] = v_[e_]; } } } while (0)
    {   const int m0 = blockIdx.x * 8 + wave; if (m0 < M_TOK) QK_LOAD(m0, vdk, vgk, cst, csa); }
    for (int m = blockIdx.x * 8 + wave; m < M_TOK; m += G * 8) {
        if ((m >> 13) != curb) {
            if ((lane & 7) == 0) { kpart[((size_t)(l * 2 + curb) * 10 + hh * 2 + (c16 >> 3)) * 2048 + gwv] = mxd; if (lane < 32 && c16 == 0) kpart[((size_t)(l * 2 + curb) * 10 + 8 + hh) * 2048 + gwv] = mxg; }
            mxd = 0.f; mxg = 0.f; curb = m >> 13; }
        bf16_t* pdk = pblk(p.ws, PB_DK + hh) + (size_t)m * 128 + c16 * 8; bf16_t* pgk = pblk(p.ws, PB_GK + (hh & 1)) + (size_t)m * 128 + c16 * 8;
        if (m + G * 8 < M_TOK) QK_LOAD(m + G * 8, ndk, ngk, nst, nsa);
        float x[8];
        unpack8(vdk, x);
        { float s2 = 0.f;
#pragma unroll
          for (int e = 0; e < 8; ++e) s2 += x[e] * x[e];
          s2 += __shfl_xor(s2, 1); s2 += __shfl_xor(s2, 2); s2 += __shfl_xor(s2, 4); mxd = fmaxf(mxd, s2); }
        rope8(x, cst, upper); const u32x4 odk = pack8(x);
        float ss;
        unpack8(vgk, x); ss = 0.f;
#pragma unroll
        for (int e = 0; e < 8; ++e) ss += x[e] * x[e];
        ss += __shfl_xor(ss, 1); ss += __shfl_xor(ss, 2); ss += __shfl_xor(ss, 4); ss += __shfl_xor(ss, 8);
        { const float rs = rsqrtf(ss * (1.f / 128.f) + NORM_EPS);
#pragma unroll
          for (int e = 0; e < 8; ++e) x[e] *= rs * kw[e]; }
        { float s2 = 0.f;
#pragma unroll
          for (int e = 0; e < 8; ++e) s2 += x[e] * x[e];
          s2 += __shfl_xor(s2, 1); s2 += __shfl_xor(s2, 2); s2 += __shfl_xor(s2, 4); s2 += __shfl_xor(s2, 8); mxg = fmaxf(mxg, s2); }
        rope8(x, csa, upper); const u32x4 ogk = pack8(x);
        *(u32x4*)pdk = odk; if (lane < 32) *(u32x4*)pgk = ogk;
        vdk = ndk; vgk = ngk;
#pragma unroll
        for (int e = 0; e < 16; ++e) { cst[e] = nst[e]; csa[e] = nsa[e]; }
    }
#undef QK_LOAD
    if ((lane & 7) == 0) { kpart[((size_t)(l * 2 + curb) * 10 + hh * 2 + (c16 >> 3)) * 2048 + gwv] = mxd; if (lane < 32 && c16 == 0) kpart[((size_t)(l * 2 + curb) * 10 + 8 + hh) * 2048 + gwv] = mxg; }
}

__device__ __forceinline__ void kmax_reduce(const int l, float* lds_f) {
    if (blockIdx.x < 20) {
        const int b = blockIdx.x / 10, slot = blockIdx.x % 10, tid = threadIdx.x;
        const float* src = (const float*)(g_scr + SCR_KPART) + ((size_t)(l * 2 + b) * 10 + slot) * 2048;
        float v = fmaxf(fmaxf(src[tid], src[512 + tid]), fmaxf(src[1024 + tid], src[1536 + tid]));
#pragma unroll
        for (int o = 1; o < 64; o <<= 1) v = fmaxf(v, __shfl_xor(v, o));
        if ((tid & 63) == 0) lds_f[tid >> 6] = v;
        __syncthreads();
        if (tid == 0) { float m = lds_f[0];
#pragma unroll
            for (int i = 1; i < 8; ++i) m = fmaxf(m, lds_f[i]);
            ((float*)(g_scr + SCR_CTL))[256 + 64 * l + (slot < 8 ? b * 8 + slot : 16 + b * 2 + (slot - 8))] = m; }
        __syncthreads();
    }
}

namespace att {
using s16x4 = __attribute__((ext_vector_type(4))) short;
using f32x16 = __attribute__((ext_vector_type(16))) float;
constexpr int D = 128, NW = 8, QBLK = 32, KVBLK = 64, LD = 128;
constexpr float THR = 8.f;
constexpr size_t SHM_V = KVBLK * D * 2, SHM_K = KVBLK * D * 2, SHM_ATTN = 2 * SHM_V + 2 * SHM_K + NW * 64 * 4;
#define KSWZ(row, colB) ((row) * 256 + ((colB) ^ (((row) & 7) << 4)))
#define SBAR() __builtin_amdgcn_sched_barrier(0)
__device__ __forceinline__ int crow(int r, int hi) { return (r & 3) + 8 * (r >> 2) + 4 * hi; }
__device__ __forceinline__ unsigned cvtpk(float lo, float hi) { unsigned r; asm volatile("v_cvt_pk_bf16_f32 %0, %1, %2" : "=v"(r) : "v"(lo), "v"(hi)); return r; }
__device__ __forceinline__ void glds16(const void* gsrc, unsigned lds_dst) { unsigned keep;
  asm volatile("s_mov_b32 %0, m0\n\ts_mov_b32 m0, %2\n\ts_nop 0\n\tglobal_load_lds_dwordx4 %1, off\n\ts_mov_b32 m0, %0" : "=&s"(keep) : "v"(gsrc), "s"(lds_dst) : "memory"); }
template <int DIFF>
__device__ __forceinline__ void partialSM(f32x16& p0, f32x16& p1, const float mnC) {
  _Pragma("unroll") for (int r = 0; r < 16; ++r) p0[r] = __builtin_amdgcn_exp2f(p0[r]);
}
__device__ __forceinline__ void finishSM(f32x16& p0, f32x16& p1, float& l_reg, bf16x8& pa0, bf16x8& pa1, bf16x8& pa2, bf16x8& pa3) {
  _Pragma("unroll") for (int r = 0; r < 16; ++r) p1[r] = __builtin_amdgcn_exp2f(p1[r]);
  float ps = 0; _Pragma("unroll") for (int r = 0; r < 16; ++r) ps += p0[r]; _Pragma("unroll") for (int r = 0; r < 16; ++r) ps += p1[r];
  { auto rr = __builtin_amdgcn_permlane32_swap(__float_as_uint(ps), __float_as_uint(ps), false, false);
    ps = __uint_as_float(rr[0]) + __uint_as_float(rr[1]); }
  l_reg += ps;
#define PK4(P, BASE, OUT) do { unsigned a0 = cvtpk(P[BASE + 0], P[BASE + 1]), a1 = cvtpk(P[BASE + 2], P[BASE + 3]);   \
    unsigned b0 = cvtpk(P[BASE + 4], P[BASE + 5]), b1 = cvtpk(P[BASE + 6], P[BASE + 7]);                              \
    auto r0 = __builtin_amdgcn_permlane32_swap(a0, b0, false, false); auto r1 = __builtin_amdgcn_permlane32_swap(a1, b1, false, false); \
    u32x4 w = {r0[0], r1[0], r0[1], r1[1]}; OUT = *reinterpret_cast<bf16x8*>(&w); } while (0)
  PK4(p0, 0, pa0); PK4(p0, 8, pa1); PK4(p1, 0, pa2); PK4(p1, 8, pa3);
#undef PK4
}
template <int ND0>
__device__ __forceinline__ void qkt(f32x16& p0, f32x16& p1, const bf16_t* Ks, const bf16x8* qr, int r32, int hi, int db0, const f32x16& init) {
  p0 = init; p1 = init;
  _Pragma("unroll") for (int d0 = 0; d0 < ND0; ++d0) { int cb = ((db0 + d0) * 16 + hi * 8) * 2;
    bf16x8 b0 = *reinterpret_cast<const bf16x8*>((const char*)Ks + KSWZ(r32, cb));
    bf16x8 b1 = *reinterpret_cast<const bf16x8*>((const char*)Ks + KSWZ(32 + r32, cb));
    p0 = __builtin_amdgcn_mfma_f32_32x32x16_bf16(b0, qr[d0], p0, 0, 0, 0);
    p1 = __builtin_amdgcn_mfma_f32_32x32x16_bf16(b1, qr[d0], p1, 0, 0, 0); }
}
__device__ __forceinline__ int v_st(int k, int c) { const int kk = (k & ~0xC) | ((k & 4) << 1) | ((k & 8) >> 1); return ((kk >> 3) * 4 + (c >> 5)) * 512 + ((kk & 7) * 32 + (c & 31)) * 2; }
__device__ __forceinline__ int v_rd_base(int lane) { return ((lane & 3) << 3) | (((lane >> 2) & 3) << 6) | (((lane >> 4) & 1) << 5) | (((lane >> 5) & 1) << 8); }
constexpr int v_rd_off(int d0, int ks, int half) { return d0 * 512 + ks * 4096 + half * 2048; }
template <int OFF> __device__ __forceinline__ s16x4 tr_read(int vb) {
  s16x4 r; asm volatile("ds_read_b64_tr_b16 %0, %1 offset:%2" : "=&v"(r) : "v"(vb), "i"(OFF) : "memory"); return r;
}
template <int D0> __device__ __forceinline__ void pv_one(f32x16& od, int vb, bf16x8 pa0, bf16x8 pa1, bf16x8 pa2, bf16x8 pa3) {
  const s16x4 l0 = tr_read<v_rd_off(D0, 0, 0)>(vb), h0 = tr_read<v_rd_off(D0, 0, 1)>(vb), l1 = tr_read<v_rd_off(D0, 1, 0)>(vb), h1 = tr_read<v_rd_off(D0, 1, 1)>(vb);
  const s16x4 l2 = tr_read<v_rd_off(D0, 2, 0)>(vb), h2 = tr_read<v_rd_off(D0, 2, 1)>(vb), l3 = tr_read<v_rd_off(D0, 3, 0)>(vb), h3 = tr_read<v_rd_off(D0, 3, 1)>(vb);
  asm volatile("s_waitcnt lgkmcnt(0)" ::: "memory"); SBAR();
#define PK(L, H) (bf16x8){L[0], L[1], L[2], L[3], H[0], H[1], H[2], H[3]}
  od = __builtin_amdgcn_mfma_f32_32x32x16_bf16(pa0, PK(l0, h0), od, 0, 0, 0);
  od = __builtin_amdgcn_mfma_f32_32x32x16_bf16(pa1, PK(l1, h1), od, 0, 0, 0);
  od = __builtin_amdgcn_mfma_f32_32x32x16_bf16(pa2, PK(l2, h2), od, 0, 0, 0);
  od = __builtin_amdgcn_mfma_f32_32x32x16_bf16(pa3, PK(l3, h3), od, 0, 0, 0);
#undef PK
}
__device__ __forceinline__ void pv_d0(f32x16* o, int vb, bf16x8 pa0, bf16x8 pa1, bf16x8 pa2, bf16x8 pa3) {
  pv_one<0>(o[0], vb, pa0, pa1, pa2, pa3); pv_one<1>(o[1], vb, pa0, pa1, pa2, pa3); pv_one<2>(o[2], vb, pa0, pa1, pa2, pa3); pv_one<3>(o[3], vb, pa0, pa1, pa2, pa3);
}
template <int DIFF>
__device__ __forceinline__ void attn_unit(const bf16_t* Qb, const bf16_t* __restrict__ Kh, const bf16_t* __restrict__ Vh, bf16_t* Ob, const bf16_t* gate,
                                          int seq, char* lds, const float* lamp, int layer, const float* nw, const float* kmax2p, const int tpos0, const float* qnw, unsigned* splc = nullptr, float* splp = nullptr) {
  constexpr int ND0 = DIFF ? 4 : 8;
  constexpr float CQ = (DIFF ? 0.125f : 0.088388347648318440f) * 1.4426950408889634f;
  const int tid = otid(), wid = tid >> 6, lane = tid & 63, r32 = lane & 31, hi = lane >> 5;
  const int wq = DIFF ? (wid & 3) : wid, mapc = DIFF ? (wid >> 2) : 0;
  constexpr int RSTG = 32768, RK = 16384, E_ST = 67584, E_WS = 137216;
  float* li_l = (float*)(lds + E_WS) + wid * 64;
  float l_reg = 0; f32x16 o[4] = {}; bf16x8 qr[ND0];
  const bf16_t* Qw = Qb + (long)(wq * QBLK + r32) * LD + mapc * 64 + hi * 8;
  {
      const float* tab = (const float*)(g_scr + SCR_ROPE);
      const int trow = tpos0 + wq * QBLK + r32;
      float qf[ND0][8];
      _Pragma("unroll") for (int d0 = 0; d0 < ND0; ++d0) { const bf16x8 raw = *reinterpret_cast<const bf16x8*>(Qw + d0 * 16); _Pragma("unroll") for (int e = 0; e < 8; ++e) qf[d0][e] = bf2f((bf16_t)raw[e]) * (DIFF ? CQ : 1.f); }
      if constexpr (!DIFF) {
        float ss = 0.f;
        _Pragma("unroll") for (int d0 = 0; d0 < ND0; ++d0) _Pragma("unroll") for (int e = 0; e < 8; ++e) ss += qf[d0][e] * qf[d0][e];
        { auto rr = __builtin_amdgcn_permlane32_swap(__float_as_uint(ss), __float_as_uint(ss), false, false); ss = __uint_as_float(rr[0]) + __uint_as_float(rr[1]); }
        const float rs = rsqrtf(ss * (1.f / 128.f) + NORM_EPS) * CQ;
        _Pragma("unroll") for (int d0 = 0; d0 < ND0; ++d0) { const f32x4 w0 = *(const f32x4*)(qnw + d0 * 16 + hi * 8), w1 = *(const f32x4*)(qnw + d0 * 16 + hi * 8 + 4);
          _Pragma("unroll") for (int e = 0; e < 4; ++e) { qf[d0][e] *= rs * w0[e]; qf[d0][4 + e] *= rs * w1[e]; } }
      }
      _Pragma("unroll") for (int hb = 0; hb < ND0 / 4; ++hb) {
        const int pos = DIFF ? trow : (hb == 0 ? (trow >> 6) : (trow & 63));
        _Pragma("unroll") for (int dl = 0; dl < 2; ++dl) { const int d0 = hb * 4 + dl; const float* cp = tab + ((size_t)pos * 32 + dl * 16 + hi * 8) * 2; float cs[16];
          _Pragma("unroll") for (int i = 0; i < 4; ++i) { const f32x4 u_ = ((const f32x4*)cp)[i]; _Pragma("unroll") for (int e = 0; e < 4; ++e) cs[4 * i + e] = u_[e]; }
          _Pragma("unroll") for (int e = 0; e < 8; ++e) { const float x1 = qf[d0][e], x2 = qf[d0 + 2][e]; qf[d0][e] = x1 * cs[2 * e] - x2 * cs[2 * e + 1]; qf[d0 + 2][e] = x2 * cs[2 * e] + x1 * cs[2 * e + 1]; } } }
      _Pragma("unroll") for (int d0 = 0; d0 < ND0; ++d0) { u32x4 w_; w_.x = pk2(qf[d0][0], qf[d0][1]); w_.y = pk2(qf[d0][2], qf[d0][3]); w_.z = pk2(qf[d0][4], qf[d0][5]); w_.w = pk2(qf[d0][6], qf[d0][7]); qr[d0] = *reinterpret_cast<bf16x8*>(&w_); }
  }
  float mnC;
  { float qn2 = 0.f;
    _Pragma("unroll") for (int d0 = 0; d0 < ND0; ++d0) _Pragma("unroll") for (int e = 0; e < 8; ++e) { const float q = bf2f((bf16_t)qr[d0][e]); qn2 += q * q; }
    { auto rr = __builtin_amdgcn_permlane32_swap(__float_as_uint(qn2), __float_as_uint(qn2), false, false); qn2 = __uint_as_float(rr[0]) + __uint_as_float(rr[1]); }
    const float km2 = kmax2p[DIFF ? mapc : 0];
    mnC = -(sqrtf(qn2 * km2) * 1.02f + 1e-3f * CQ); }
  f32x16 mnv; _Pragma("unroll") for (int r = 0; r < 16; ++r) mnv[r] = mnC;
  unsigned ksrc[2], vsrc[2];
  _Pragma("unroll") for (int i = 0; i < 2; ++i) { const int pc = 2 * wid + i;
    { const int row = 4 * pc + (lane >> 4); ksrc[i] = (unsigned)(row * 256 + (((lane & 15) ^ (row & 7)) << 4)); }
    { const int st = 2 * pc + (lane >> 5), l5 = lane & 31, kk = (st >> 2) * 8 + (l5 >> 2), k = (kk & ~0xC) | ((kk & 4) << 1) | ((kk & 8) >> 1); vsrc[i] = (unsigned)(k * 256 + ((st & 3) * 32 + (l5 & 3) * 8) * 2); } }
  const unsigned ldsb = (unsigned)(uintptr_t)lds + (unsigned)__builtin_amdgcn_readfirstlane(wid) * 2048u;
  const int vb0 = (int)(uintptr_t)lds + v_rd_base(lane);
#define DMA(k0, so) do { const char* kt_ = (const char*)Kh + (size_t)(k0) * 256; const char* vt_ = (const char*)Vh + (size_t)(k0) * 256; const unsigned d_ = ldsb + (unsigned)(so); \
    glds16(vt_ + vsrc[0], (unsigned)__builtin_amdgcn_readfirstlane(d_)); glds16(vt_ + vsrc[1], (unsigned)__builtin_amdgcn_readfirstlane(d_ + 1024u)); \
    glds16(kt_ + ksrc[0], (unsigned)__builtin_amdgcn_readfirstlane(d_ + (unsigned)RK)); glds16(kt_ + ksrc[1], (unsigned)__builtin_amdgcn_readfirstlane(d_ + (unsigned)RK + 1024u)); } while (0)
#define DWAIT() asm volatile("s_waitcnt vmcnt(0)" ::: "memory")
  f32x16 p0, p1; bf16x8 pa0, pa1, pa2, pa3; int NT = seq / KVBLK; asm volatile("" : "+s"(NT));
  const bool odd = __builtin_amdgcn_readfirstlane(wid) >= 4;
  int kad[4];
  _Pragma("unroll") for (int i = 0; i < 4; ++i) kad[i] = (int)(uintptr_t)lds + RK + KSWZ(r32, ((mapc * 4 + i) * 16 + hi * 8) * 2);
#define BAR() do { SBAR(); __builtin_amdgcn_s_barrier(); SBAR(); } while (0)
#define LWAIT4(N, A, B, C, Dd) asm volatile("s_waitcnt lgkmcnt(%4)" : "+v"(A), "+v"(B), "+v"(C), "+v"(Dd) : "n"(N))
#define LWAIT2(N, A, B) asm volatile("s_waitcnt lgkmcnt(%2)" : "+v"(A), "+v"(B) : "n"(N))
#define PK(L, H) (bf16x8){L[0], L[1], L[2], L[3], H[0], H[1], H[2], H[3]}
#define VRD(N, D0, KP, VB) N##a = tr_read<v_rd_off(D0, 2 * KP, 0)>(VB); N##b = tr_read<v_rd_off(D0, 2 * KP, 1)>(VB); N##c = tr_read<v_rd_off(D0, 2 * KP + 1, 0)>(VB); N##d = tr_read<v_rd_off(D0, 2 * KP + 1, 1)>(VB)
#define VDECL(N) s16x4 N##a, N##b, N##c, N##d
#define VMM(N, D0, PA, PB, W) LWAIT4(W, N##a, N##b, N##c, N##d); o[D0] = __builtin_amdgcn_mfma_f32_32x32x16_bf16(PA, PK(N##a, N##b), o[D0], 0, 0, 0); o[D0] = __builtin_amdgcn_mfma_f32_32x32x16_bf16(PB, PK(N##c, N##d), o[D0], 0, 0, 0); SBAR()
#define KRD(N, DS) bf16x8 N##a, N##b; asm volatile("ds_read_b128 %0, %1 offset:%2" : "=&v"(N##a) : "v"(ka[(DS) & 3]), "i"(((DS) >> 2) * 128) : "memory"); asm volatile("ds_read_b128 %0, %1 offset:%2" : "=&v"(N##b) : "v"(ka[(DS) & 3]), "i"(((DS) >> 2) * 128 + 8192) : "memory")
#define KMM0(N, DS, W) LWAIT2(W, N##a, N##b); p0 = __builtin_amdgcn_mfma_f32_32x32x16_bf16(N##a, qr[DS], mnv, 0, 0, 0); p1 = __builtin_amdgcn_mfma_f32_32x32x16_bf16(N##b, qr[DS], mnv, 0, 0, 0); SBAR()
#define KMM(N, DS, W) LWAIT2(W, N##a, N##b); p0 = __builtin_amdgcn_mfma_f32_32x32x16_bf16(N##a, qr[DS], p0, 0, 0, 0); p1 = __builtin_amdgcn_mfma_f32_32x32x16_bf16(N##b, qr[DS], p1, 0, 0, 0); SBAR()
  VDECL(g0); VDECL(g1); VDECL(g2);
#define PREISSUE(SO) do { const int vb_ = vb0 + (SO); VRD(g0, 0, 0, vb_); VRD(g1, 0, 1, vb_); VRD(g2, 1, 0, vb_); } while (0)
  DMA(0, 0); DMA(KVBLK, RSTG); DMA(2 * KVBLK, 2 * RSTG);
  asm volatile("s_waitcnt vmcnt(8)" ::: "memory"); BAR();
  if (odd) BAR();
  qkt<ND0>(p0, p1, (const bf16_t*)(lds + RK), qr, r32, hi, mapc * 4, mnv);
  asm volatile("s_waitcnt vmcnt(4)" ::: "memory"); SBAR(); BAR();
  partialSM<DIFF>(p0, p1, mnC); finishSM(p0, p1, l_reg, pa0, pa1, pa2, pa3); SBAR();
  PREISSUE(0); BAR();
  _Pragma("unroll 1") for (int j = 0; j + 1 < NT; ++j) {
    const int sV = (j & 3) * RSTG, sK = ((j + 1) & 3) * RSTG, sD = ((j + 3) & 3) * RSTG;
    const bool dma = j + 3 < NT;
    if (dma) DMA((j + 3) * KVBLK, sD);
    SBAR(); __builtin_amdgcn_s_setprio(1); SBAR();
    { const int vb = vb0 + sV; int ka[4];
      _Pragma("unroll") for (int i = 0; i < 4; ++i) ka[i] = kad[i] + sK;
      VDECL(g3); VDECL(g4); VDECL(g5); VDECL(g6); VDECL(g7);
      VRD(g3, 1, 1, vb); VMM(g0, 0, pa0, pa1, 12);
      VRD(g4, 2, 0, vb); VMM(g1, 0, pa2, pa3, 12);
      VRD(g5, 2, 1, vb); VMM(g2, 1, pa0, pa1, 12);
      VRD(g6, 3, 0, vb); VMM(g3, 1, pa2, pa3, 12);
      VRD(g7, 3, 1, vb); VMM(g4, 2, pa0, pa1, 12);
      KRD(k0, 0); VMM(g5, 2, pa2, pa3, 10);
      KRD(k1, 1); VMM(g6, 3, pa0, pa1, 8);
      KRD(k2, 2); VMM(g7, 3, pa2, pa3, 6);
      KRD(k3, 3); KMM0(k0, 0, 6);
      if constexpr (ND0 == 8) {
        KRD(k4, 4); KMM(k1, 1, 6);
        KRD(k5, 5); KMM(k2, 2, 6);
        KRD(k6, 6); KMM(k3, 3, 6);
        KRD(k7, 7); KMM(k4, 4, 6);
        KMM(k5, 5, 4); KMM(k6, 6, 2); KMM(k7, 7, 0);
      } else {
        KMM(k1, 1, 4); KMM(k2, 2, 2); KMM(k3, 3, 0);
      } }
    __builtin_amdgcn_s_setprio(0);
    if (dma) asm volatile("s_waitcnt vmcnt(4)" ::: "memory"); else asm volatile("s_waitcnt vmcnt(0)" ::: "memory");
    SBAR(); BAR();
    partialSM<DIFF>(p0, p1, mnC); finishSM(p0, p1, l_reg, pa0, pa1, pa2, pa3); SBAR(); PREISSUE(sK);
    BAR();
  }
  {
    const int vb = vb0 + ((NT - 1) & 3) * RSTG;
    VDECL(g3); VDECL(g4); VDECL(g5); VDECL(g6); VDECL(g7);
    VRD(g3, 1, 1, vb); VMM(g0, 0, pa0, pa1, 12);
    VRD(g4, 2, 0, vb); VMM(g1, 0, pa2, pa3, 12);
    VRD(g5, 2, 1, vb); VMM(g2, 1, pa0, pa1, 12);
    VRD(g6, 3, 0, vb); VMM(g3, 1, pa2, pa3, 12);
    VRD(g7, 3, 1, vb); VMM(g4, 2, pa0, pa1, 12);
    VMM(g5, 2, pa2, pa3, 8); VMM(g6, 3, pa0, pa1, 4); VMM(g7, 3, pa2, pa3, 0);
  }
  if (!odd) BAR();
#undef PREISSUE
#undef KMM
#undef KMM0
#undef KRD
#undef VMM
#undef VDECL
#undef VRD
#undef PK
#undef LWAIT2
#undef LWAIT4
#undef BAR
#undef DMA
#undef DWAIT
  __syncthreads();
  if (splc) {
    unsigned* xs_ = (unsigned*)(lds + 140000);
    if (threadIdx.x == 0) *xs_ = __hip_atomic_fetch_add(splc, 1u, __ATOMIC_RELAXED, __HIP_MEMORY_SCOPE_AGENT);
    __syncthreads();
    const unsigned ord = *xs_;
    float* mine = splp + (size_t)(wid * 65) * 64 + lane;
    if (ord == 0u) {
      _Pragma("unroll") for (int d0 = 0; d0 < 4; ++d0) _Pragma("unroll") for (int r = 0; r < 16; ++r) mine[(d0 * 16 + r) * 64] = o[d0][r];
      mine[64 * 64] = l_reg;
      asm volatile("s_waitcnt vmcnt(0)" ::: "memory"); __syncthreads();
      if (threadIdx.x == 0) { __builtin_amdgcn_fence(__ATOMIC_RELEASE, "agent"); asm volatile("s_waitcnt vmcnt(0)" ::: "memory"); __hip_atomic_store(splc + 1, 1u, __ATOMIC_RELAXED, __HIP_MEMORY_SCOPE_AGENT); }
      __syncthreads();
      return;
    }
    if (threadIdx.x == 0) { unsigned sp = 0; while (__hip_atomic_load(splc + 1, __ATOMIC_RELAXED, __HIP_MEMORY_SCOPE_AGENT) == 0u) { __builtin_amdgcn_s_sleep(4); if (++sp > (1u << 22)) break; } }
    __syncthreads();
    __builtin_amdgcn_fence(__ATOMIC_ACQUIRE, "agent"); asm volatile("s_waitcnt vmcnt(0)" ::: "memory");
    _Pragma("unroll") for (int d0 = 0; d0 < 4; ++d0) _Pragma("unroll") for (int r = 0; r < 16; ++r) o[d0][r] += mine[(d0 * 16 + r) * 64];
    l_reg += mine[64 * 64];
  }
  if (hi == 0) li_l[r32] = l_reg; asm volatile("s_waitcnt lgkmcnt(0)" ::: "memory");
  float rli[16];
  _Pragma("unroll") for (int r = 0; r < 16; ++r) rli[r] = __builtin_amdgcn_rcpf(li_l[crow(r, hi)]);
  int r32e = r32; asm volatile("" : "+v"(r32e));
  char* ST = lds + E_ST + wid * 8704;
  if constexpr (!DIFF) {
    _Pragma("unroll") for (int r = 0; r < 16; ++r) { const int orow = crow(r, hi);
      _Pragma("unroll") for (int d0 = 0; d0 < 4; ++d0) *(bf16_t*)(ST + orow * 272 + (d0 * 32 + r32e) * 2) = f2bf(o[d0][r] * rli[r]); }
  } else {
    const float s1 = wave_sum(lamp[lane] * lamp[64 + lane]), s2 = wave_sum(lamp[128 + lane] * lamp[192 + lane]);
    int ly = layer; asm volatile("" : "+s"(ly));
    const float lambda_init = 0.8f - 0.6f * expf(-0.3f * (float)ly);
    const float lam = expf(s1) - expf(s2) + lambda_init, osc = 1.f - lambda_init;
    float* X = (float*)lds;
    if (mapc == 1) {
      _Pragma("unroll") for (int r = 0; r < 16; ++r) { const int orow = wq * QBLK + crow(r, hi);
        _Pragma("unroll") for (int d0 = 0; d0 < 4; ++d0) X[orow * 128 + d0 * 32 + r32e] = o[d0][r] * rli[r] * lam; }
    }
    __syncthreads();
    if (mapc == 0) {
      float nwv[4];
      _Pragma("unroll") for (int d0 = 0; d0 < 4; ++d0) nwv[d0] = nw[d0 * 32 + r32e] * osc;
      _Pragma("unroll") for (int r = 0; r < 16; ++r) { const int orow = crow(r, hi); float v[4]; float ss = 0.f;
        _Pragma("unroll") for (int d0 = 0; d0 < 4; ++d0) { v[d0] = o[d0][r] * rli[r] - X[(wq * QBLK + orow) * 128 + d0 * 32 + r32e]; ss += v[d0] * v[d0]; }
        ss += __shfl_xor(ss, 1); ss += __shfl_xor(ss, 2); ss += __shfl_xor(ss, 4); ss += __shfl_xor(ss, 8); ss += __shfl_xor(ss, 16);
        const float rs = rsqrtf(ss * (1.f / 128.f) + NORM_EPS);
        _Pragma("unroll") for (int d0 = 0; d0 < 4; ++d0) *(bf16_t*)(ST + orow * 272 + (d0 * 32 + r32e) * 2) = f2bf(v[d0] * rs * nwv[d0]); }
    }
  }
  if (!DIFF || mapc == 0) {
    asm volatile("s_waitcnt lgkmcnt(0)" ::: "memory");
    bf16_t* Ow = Ob + (long)(wq * QBLK) * LD; const bf16_t* Gw = gate + (long)(wq * QBLK) * LD;
    const int er = lane >> 4, ec = (lane & 15) * 8; bf16x8 gv[8];
    _Pragma("unroll") for (int it = 0; it < 8; ++it) gv[it] = *reinterpret_cast<const bf16x8*>(Gw + (long)(it * 4 + er) * LD + ec);
    _Pragma("unroll") for (int it = 0; it < 8; ++it) { const bf16x8 sv = *reinterpret_cast<const bf16x8*>(ST + (it * 4 + er) * 272 + ec * 2); u32x4 ov;
      float f[8]; _Pragma("unroll") for (int e = 0; e < 8; ++e) f[e] = bf2f((bf16_t)sv[e]) * siluf(bf2f((bf16_t)gv[it][e]));
      ov.x = pk2(f[0], f[1]); ov.y = pk2(f[2], f[3]); ov.z = pk2(f[4], f[5]); ov.w = pk2(f[6], f[7]);
      *reinterpret_cast<u32x4*>(Ow + (long)(it * 4 + er) * LD + ec) = ov; }
  }
  __syncthreads();
}
#undef KSWZ
#undef SBAR
}

__device__ __forceinline__ void gqa_unit(const Params& p, const int l, int u, char* lds, int half = -1, int rec = 0) {
    const int qb = u & 31, hq = (u >> 5) & 3, b = u >> 7; const size_t row0 = (size_t)b * SEQ + (size_t)qb * 256, k0 = (size_t)b * SEQ + (half > 0 ? SEQ / 2 : 0);
    bf16_t* Q = pblk(p.ws, PB_GQ + hq) + row0 * 128;
    att::attn_unit<0>(Q, pblk(p.ws, PB_GK + (hq >> 1)) + k0 * 128, pblk(p.ws, PB_GV + (hq >> 1)) + k0 * 128, Q, pblk(p.ws, PB_GG + hq) + row0 * 128, half >= 0 ? SEQ / 2 : SEQ, lds, nullptr, 0, nullptr,
                      (const float*)(g_scr + SCR_CTL) + 256 + 64 * l + 16 + b * 2 + (hq >> 1),
                      qb * 256, p.in[23] + l * 128,
                      half >= 0 ? (unsigned*)(g_scr + SCR_CTL) + 384 + l * 256 + rec * 2 : nullptr, half >= 0 ? (float*)(g_scr + SCR_SPL + (size_t)rec * 133120) : nullptr);
}
__device__ __forceinline__ void diff_unit(const Params& p, const int l, int u, char* lds, int half = -1, int rec = 0) {
    const int qb = u & 63, h = (u >> 6) & 3, b = u >> 8; const size_t row0 = (size_t)b * SEQ + (size_t)qb * 128, k0 = (size_t)b * SEQ + (half > 0 ? SEQ / 2 : 0);
    bf16_t* Q = pblk(p.ws, PB_DQ + h) + row0 * 128;
    att::attn_unit<1>(Q, pblk(p.ws, PB_DK + h) + k0 * 128, pblk(p.ws, PB_DV + h) + k0 * 128, Q, pblk(p.ws, PB_DG + h) + row0 * 128, half >= 0 ? SEQ / 2 : SEQ, lds, p.in[21] + l * 256, l, p.in[22] + l * 128,
                      (const float*)(g_scr + SCR_CTL) + 256 + 64 * l + b * 8 + h * 2,
                      qb * 128, nullptr,
                      half >= 0 ? (unsigned*)(g_scr + SCR_CTL) + 384 + l * 256 + rec * 2 : nullptr, half >= 0 ? (float*)(g_scr + SCR_SPL + (size_t)rec * 133120) : nullptr);
}

#define LDS_BAR() asm volatile("s_waitcnt lgkmcnt(0)\n\ts_barrier" ::: "memory")
namespace rk {
using f32x16 = __attribute__((ext_vector_type(16))) float;
constexpr int PB = 144, MAT = 64 * PB;
constexpr int O_W2T = 0, O_A2T = MAT, O_SB = 2 * MAT, O_GAM = 3 * MAT, O_CONST = O_GAM + 256,
              O_T = O_CONST + 2560, O_TW = O_T, O_G1T = O_T + MAT, O_AD = O_G1T,
              O_R2 = O_G1T + MAT, O_CL = O_R2, O_AA = O_R2 + 16384, O_ABD = O_R2, O_AAB = O_R2 + 4096, O_AAK = O_AAB + MAT, O_ARB = O_AAK + MAT, O_ARK = O_ARB + MAT,
              O_R3 = O_ARK + MAT, O_AT = O_R3, O_RT = O_AT + MAT, O_BT = O_RT + MAT, O_DT = O_BT, O_UT = O_BT, O_KT = O_BT + MAT, O_PT = O_KT,
              O_BHT = O_KT + MAT, O_KHT = O_BHT + MAT, O_VT = O_KHT + MAT, O_END = O_VT + MAT;
__device__ __forceinline__ int crow(int r, int hi) { return (r & 3) + 8 * (r >> 2) + 4 * hi; }
#define RK_FENCE() do { asm volatile("s_waitcnt lgkmcnt(0)" ::: "memory"); __builtin_amdgcn_wave_barrier(); } while (0)
template <int NKS> __device__ __forceinline__ void mm32(f32x16& acc, const char* A, int m0, const char* B, int n0, int k0, int r32, int hi) {
#pragma unroll
    for (int ks = 0; ks < NKS; ++ks) {
        const bf16x8 a = *(const bf16x8*)(A + (m0 + r32) * PB + (k0 + ks * 16 + hi * 8) * 2);
        const bf16x8 b = *(const bf16x8*)(B + (n0 + r32) * PB + (k0 + ks * 16 + hi * 8) * 2);
        acc = __builtin_amdgcn_mfma_f32_32x32x16_bf16(a, b, acc, 0, 0, 0); }
}
template <int NKS, bool SA, bool SB> __device__ __forceinline__ void mm32s(f32x16& acc, const char* A, int m0, const char* B, int n0, int r32, int hi) {
    const int ra = m0 + r32, rb = n0 + r32; const int fa = SA ? ((ra >> 3) & 7) : 0, fb = SB ? ((rb >> 3) & 7) : 0;
#pragma unroll
    for (int ks = 0; ks < NKS; ++ks) { const int q = ks * 2 + hi;
        const bf16x8 a = *(const bf16x8*)(A + ra * PB + ((q ^ fa) << 4));
        const bf16x8 b = *(const bf16x8*)(B + rb * PB + ((q ^ fb) << 4));
        acc = __builtin_amdgcn_mfma_f32_32x32x16_bf16(a, b, acc, 0, 0, 0); }
}
__device__ __forceinline__ void st_T(const f32x16& acc, char* Z, int n0, int m0, int r32, int hi) {
#pragma unroll
    for (int g = 0; g < 4; ++g) { u32x2 w; w.x = pk2(acc[4 * g], acc[4 * g + 1]); w.y = pk2(acc[4 * g + 2], acc[4 * g + 3]);
        *(u32x2*)(Z + (n0 + r32) * PB + (m0 + 8 * g + 4 * hi) * 2) = w; }
}
__device__ __forceinline__ unsigned long long pass1(const Params& p, const int l, unsigned char* lds) {
    const int sid = blockIdx.x >> 3, c_first = blockIdx.x & 7;
    const int tid = otid(), w = __builtin_amdgcn_readfirstlane(tid >> 6);
    const int h = sid & 7, dir = (sid >> 3) & 1, b = sid >> 4;
    unsigned long long pacc = 0, ptt = 0; (void)ptt;
#ifdef PRB_IV
#define RKP0(i) do { if ((PRB_IV >> (i)) & 1) ptt = __builtin_amdgcn_s_memrealtime(); } while (0)
#define RKP1(i) do { if ((PRB_IV >> (i)) & 1) pacc += __builtin_amdgcn_s_memrealtime() - ptt; } while (0)
#else
#define RKP0(i) do {} while (0)
#define RKP1(i) do {} while (0)
#endif
#define RK_LANE() int tq_ = tid; asm volatile("" : "+v"(tq_)); const int lane = tq_ & 63, r32 = lane & 31, hi = lane >> 5, tok = tq_ >> 3, c8 = (tq_ & 7) * 8; (void)lane; (void)r32; (void)hi; (void)tok; (void)c8
    char* L = (char*)lds; float* CF = (float*)(L + O_CONST);
    {   RK_LANE();
        const float* w2 = p.in[13] + ((size_t)(l * 2 + dir) * 64) * 512 + h * 64; const float* a2 = p.in[15] + ((size_t)l * 64) * 512 + h * 64;
        float t[8], u[8];
#pragma unroll
        for (int e = 0; e < 8; ++e) { t[e] = w2[(size_t)(c8 + e) * 512 + tok]; u[e] = a2[(size_t)(c8 + e) * 512 + tok]; }
        u32x4 ww, aa; ww.x = pk2(t[0], t[1]); ww.y = pk2(t[2], t[3]); ww.z = pk2(t[4], t[5]); ww.w = pk2(t[6], t[7]);
        aa.x = pk2(u[0], u[1]); aa.y = pk2(u[2], u[3]); aa.z = pk2(u[4], u[5]); aa.w = pk2(u[6], u[7]);
        *(u32x4*)(L + O_W2T + tok * PB + c8 * 2) = ww; *(u32x4*)(L + O_A2T + tok * PB + c8 * 2) = aa;
        { unsigned zz = 0u; asm volatile("" : "+v"(zz)); *(u32x4*)(L + O_SB + tok * PB + c8 * 2) = (u32x4){zz, zz, zz, zz}; }
        const float* mu = p.in[11] + (size_t)(l * 2 + dir) * 1664;
        for (int i = tid; i < 640; i += 512) { const int row = i >> 6, j = i & 63; float v;
            if (row == 0) v = p.in[12][(l * 2 + dir) * 512 + h * 64 + j]; else if (row == 1) v = p.in[14][l * 512 + h * 64 + j];
            else if (row == 2) v = p.in[16][l * 512 + h * 64 + j]; else if (row == 3) v = p.in[17][l * 512 + h * 64 + j]; else if (row == 4) v = p.in[18][l * 512 + h * 64 + j];
            else if (row == 5) v = mu[h * 64 + j]; else if (row == 6) v = mu[512 + h * 64 + j]; else if (row == 7) v = mu[1024 + h * 64 + j]; else if (row == 8) v = mu[1536 + j]; else v = mu[1600 + j];
            CF[i] = v; }
    }
    const bf16_t* Pr = pblk(p.ws, PB_R + (h >> 1)) + (h & 1) * 64; const bf16_t* Pk = pblk(p.ws, PB_K + (h >> 1)) + (h & 1) * 64;
    const bf16_t* Pv = pblk(p.ws, PB_V + (h >> 1)) + (h & 1) * 64; const bf16_t* Pw = pblk(p.ws, PB_WA); const bf16_t* Pa = pblk(p.ws, PB_WA) + 64;
    bf16_t* wkv = (bf16_t*)(g_scr + SCR_WKV) + (size_t)sid * SEQ * 64; bf16_t* bon = (bf16_t*)(g_scr + SCR_BON) + (size_t)dir * M_TOK * 512 + h * 64;
    bf16x8 cu[5], pv[5];
#define RK_LOAD(c) do { RK_LANE(); const int s_ = (c) * 64 + tok; const int t_ = dir ? (SEQ - 1 - s_) : s_; const size_t m_ = ((size_t)b * SEQ + t_) * 128 + c8; \
        cu[0] = *(const bf16x8*)(Pr + m_); cu[1] = *(const bf16x8*)(Pk + m_); cu[2] = *(const bf16x8*)(Pv + m_); cu[3] = *(const bf16x8*)(Pw + m_); cu[4] = *(const bf16x8*)(Pa + m_); \
        if (s_ > 0) { const size_t q_ = dir ? m_ + 128 : m_ - 128; pv[0] = *(const bf16x8*)(Pr + q_); pv[1] = *(const bf16x8*)(Pk + q_); pv[2] = *(const bf16x8*)(Pv + q_); pv[3] = *(const bf16x8*)(Pw + q_); pv[4] = *(const bf16x8*)(Pa + q_); } \
        else { _Pragma("unroll") for (int i_ = 0; i_ < 5; ++i_) pv[i_] = (bf16x8){0, 0, 0, 0, 0, 0, 0, 0}; } } while (0)
    RK_LOAD(c_first);
    LDS_BAR();
#pragma unroll 1
    for (int c = c_first; c < SEQ / 64; c += 8) {
        RKP0(1);
        float rr[8], kx[8], vv[8];
        {   RK_LANE(); float tw[8], ad[8];
#pragma unroll
            for (int e = 0; e < 8; ++e) {
                const float x0 = bf2f((bf16_t)cu[0][e]), x1 = bf2f((bf16_t)cu[1][e]), x2 = bf2f((bf16_t)cu[2][e]), x3 = bf2f((bf16_t)cu[3][e]), x4 = bf2f((bf16_t)cu[4][e]);
                const float p0 = bf2f((bf16_t)pv[0][e]), p1 = bf2f((bf16_t)pv[1][e]), p2 = bf2f((bf16_t)pv[2][e]), p3 = bf2f((bf16_t)pv[3][e]), p4 = bf2f((bf16_t)pv[4][e]);
                rr[e] = x0 + (p0 - x0) * CF[5 * 64 + (h * 0) + c8 + e]; kx[e] = x1 + (p1 - x1) * CF[6 * 64 + c8 + e]; vv[e] = x2 + (p2 - x2) * CF[7 * 64 + c8 + e];
                const float wd = x3 + (p3 - x3) * CF[8 * 64 + c8 + e]; ad[e] = x4 + (p4 - x4) * CF[9 * 64 + c8 + e];
                tw[e] = 1.f - 2.f / (1.f + __expf(2.f * wd)); }
            u32x4 a, d; a.x = pk2(tw[0], tw[1]); a.y = pk2(tw[2], tw[3]); a.z = pk2(tw[4], tw[5]); a.w = pk2(tw[6], tw[7]);
            d.x = pk2(ad[0], ad[1]); d.y = pk2(ad[2], ad[3]); d.z = pk2(ad[4], ad[5]); d.w = pk2(ad[6], ad[7]);
            *(u32x4*)(L + O_TW + tok * PB + c8 * 2) = a; *(u32x4*)(L + O_AD + tok * PB + c8 * 2) = d; }
        LDS_BAR(); RKP1(1); RKP0(2);
        {   RK_LANE(); const bool isA = w >= 4; const int mt2 = (w & 2) ? 32 : 0, n0 = (w & 1) * 32;
            const char* Aop = L + (isA ? O_AD : O_TW); const char* Bop = L + (isA ? O_A2T : O_W2T);
            f32x16 x0 = {};
            mm32<4>(x0, Aop, mt2, Bop, n0, 0, r32, hi);
            const int ch = n0 + r32; const float c0 = CF[(isA ? 64 : 0) + ch];
            float* TOT = (float*)(L + O_GAM);
            if (!isA) {
#pragma unroll
                for (int r = 0; r < 16; ++r) x0[r] = -0.6065306597126334f / (1.f + __expf(-(c0 + x0[r])));
                float run = 0.f;
#pragma unroll
                for (int g = 0; g < 4; ++g) { const float gs = (x0[4 * g] + x0[4 * g + 1]) + (x0[4 * g + 2] + x0[4 * g + 3]); const float ps = __shfl_xor(gs, 32);
                    float st = run + (hi ? ps : 0.f); x0[4 * g] += st; x0[4 * g + 1] += x0[4 * g]; x0[4 * g + 2] += x0[4 * g + 1]; x0[4 * g + 3] += x0[4 * g + 2]; run += gs + ps; }
                if (mt2 == 0 && hi == 0) TOT[ch] = run;
            } else {
#pragma unroll
                for (int r = 0; r < 16; ++r) x0[r] = 1.f / (1.f + __expf(-(c0 + x0[r])));
            }
            LDS_BAR();
            if (!isA && mt2) { const float t0 = TOT[ch];
#pragma unroll
                for (int r = 0; r < 16; ++r) x0[r] += t0; }
            float* O = (float*)(L + (isA ? O_AA : O_CL));
#pragma unroll
            for (int r = 0; r < 16; ++r) O[(mt2 + crow(r, hi)) * 64 + ch] = x0[r];
        }
        LDS_BAR(); RKP1(2); RKP0(3);
        {   RK_LANE(); const float* clp = (const float*)(L + O_CL + tok * 256 + c8 * 4); const float* cle = (const float*)(L + O_CL + (tok > 0 ? tok - 1 : 0) * 256 + c8 * 4);
            const float* cln = (const float*)(L + O_CL + 63 * 256 + c8 * 4); const float* aap = (const float*)(L + O_AA + tok * 256 + c8 * 4);
            float kk[8], kp[8]; float ss = 0.f, bs = 0.f;
#pragma unroll
            for (int e = 0; e < 8; ++e) { kk[e] = kx[e] * CF[2 * 64 + c8 + e]; ss += kk[e] * kk[e]; kp[e] = kx[e] * (1.f + (aap[e] - 1.f) * CF[3 * 64 + c8 + e]); bs += rr[e] * kp[e] * CF[4 * 64 + c8 + e]; }
            ss += __shfl_xor(ss, 1); ss += __shfl_xor(ss, 2); ss += __shfl_xor(ss, 4);
            bs += __shfl_xor(bs, 1); bs += __shfl_xor(bs, 2); bs += __shfl_xor(bs, 4);
            const float rn = 1.f / fmaxf(sqrtf(ss), 1e-12f);
            const int tsw = ((((tok >> 3) ^ (c8 >> 3)) << 3) + (tok & 7)) * 2;
#pragma unroll
            for (int e2 = 0; e2 < 4; ++e2) { float At[2], Rt[2], Bt[2], Kt[2];
#pragma unroll
                for (int q = 0; q < 2; ++q) { const int e = 2 * e2 + q; const float cl = clp[e], ce = (tok > 0) ? cle[e] : 0.f, cn = cln[e];
                    const float kn = kk[e] * rn; const float bb = kn * aap[e];
                    const float ein = __expf(cl), eex = __expf(ce), eng = __expf(-cl), een = __expf(cn - cl);
                    At[q] = -kn * eex; Rt[q] = rr[e] * ein; Bt[q] = bb * eng; Kt[q] = kp[e] * eng;
                    *(bf16_t*)(L + O_BHT + (c8 + e) * PB + tsw) = f2bf(bb * een); *(bf16_t*)(L + O_KHT + (c8 + e) * PB + tsw) = f2bf(kp[e] * een); *(bf16_t*)(L + O_VT + (c8 + e) * PB + tsw) = f2bf(vv[e]); *(bf16_t*)(L + O_SB + (c8 + e) * PB + tsw) = f2bf(At[q]);
                    if (tok == 63) ((float*)(L + O_GAM))[c8 + e] = __expf(cn); }
                const int ob = tok * PB + (c8 + 2 * e2) * 2;
                *(unsigned*)(L + O_AT + ob) = pk2(At[0], At[1]); *(unsigned*)(L + O_RT + ob) = pk2(Rt[0], Rt[1]); *(unsigned*)(L + O_BT + ob) = pk2(Bt[0], Bt[1]); *(unsigned*)(L + O_KT + ob) = pk2(Kt[0], Kt[1]); }
            {   const int s_ = c * 64 + tok; const int t_ = dir ? (SEQ - 1 - s_) : s_;
                u32x4 w_; w_.x = pk2(bs * vv[0], bs * vv[1]); w_.y = pk2(bs * vv[2], bs * vv[3]); w_.z = pk2(bs * vv[4], bs * vv[5]); w_.w = pk2(bs * vv[6], bs * vv[7]);
                *(u32x4*)(bon + ((size_t)b * SEQ + t_) * 512 + c8) = w_; }
        }
        LDS_BAR(); RKP1(3); RKP0(4);
        if (c + 8 < SEQ / 64) RK_LOAD(c + 8);
        for (int idx = w; idx < 12; idx += 8) {
            RK_LANE(); const int pr = idx / 3, tl = idx - pr * 3; const int mi = (tl == 2) ? 32 : 0, nt = (tl >= 1) ? 32 : 0;
            const char* X = L + ((pr & 1) ? O_KT : O_BT); const char* Y = L + ((pr >= 2) ? O_RT : O_AT);
            f32x16 acc = {}; mm32<4>(acc, X, mi, Y, nt, 0, r32, hi);
            const int t = nt + r32;
            if (tl != 1) {
#pragma unroll
                for (int r = 0; r < 16; ++r) { const int i = mi + crow(r, hi); const bool keep = (pr < 2) ? (i < t) : (i <= t); if (!keep) acc[r] = 0.f; } }
            char* Z = L + (pr == 0 ? O_AAB : pr == 1 ? O_AAK : pr == 2 ? O_ARB : O_ARK);
            st_T(acc, Z, nt, mi, r32, hi);
            if (pr == 0 && tl != 1) { float* ABD = (float*)(L + O_ABD);
#pragma unroll
                for (int g = 0; g < 4; ++g) if ((g >> 1) == (r32 >> 4)) *(f32x4*)(ABD + (t >> 4) * 256 + (t & 15) * 16 + 8 * (g & 1) + 4 * hi) = (f32x4){acc[4 * g], acc[4 * g + 1], acc[4 * g + 2], acc[4 * g + 3]}; }
        }
        LDS_BAR(); RKP1(4); RKP0(5);
        f32x16 yacc = {}, nacc = {};
        const int mt = (w & 2) ? 32 : 0, nv = (w & 1) ? 32 : 0;
        if (w < 4) {
            RK_LANE(); f32x16 xq = {};
            if (mt) mm32s<4, false, true>(xq, L + O_AAK, mt, L + O_VT, nv, r32, hi); else mm32s<2, false, true>(xq, L + O_AAK, mt, L + O_VT, nv, r32, hi);
            st_T(xq, L + O_G1T, nv, mt, r32, hi);
            mm32s<4, true, true>(nacc, L + O_KHT, mt, L + O_VT, nv, r32, hi);
        } else if (w < 7) {
            RK_LANE(); if (mt) mm32s<4, false, true>(yacc, L + O_ARK, mt, L + O_VT, nv, r32, hi); else mm32s<2, false, true>(yacc, L + O_ARK, mt, L + O_VT, nv, r32, hi);
        } else {
            RK_LANE(); const int blk = lane >> 4, j = lane & 15; const float* A = (const float*)(L + O_ABD) + blk * 256;
            float x[16];
#pragma unroll
            for (int t = 0; t < 16; ++t) { float s = (t == j) ? 1.f : 0.f;
#pragma unroll
                for (int i = 0; i < t; ++i) s += A[t * 16 + i] * x[i];
                x[t] = s; asm volatile("" ::: "memory"); }
            char* Tm = L + O_T; char* Dm = L + O_DT;
#pragma unroll
            for (int t = 0; t < 16; ++t) *(bf16_t*)(Tm + (16 * blk + t) * PB + (16 * blk + j) * 2) = f2bf(x[t]);
            { u32x4 a, d; a.x = pk2(x[0], x[1]); a.y = pk2(x[2], x[3]); a.z = pk2(x[4], x[5]); a.w = pk2(x[6], x[7]); d.x = pk2(x[8], x[9]); d.y = pk2(x[10], x[11]); d.z = pk2(x[12], x[13]); d.w = pk2(x[14], x[15]);
              *(u32x4*)(Dm + (16 * blk + j) * PB + (16 * blk) * 2) = a; *(u32x4*)(Dm + (16 * blk + j) * PB + (16 * blk + 8) * 2) = d; }
            if ((blk & 1) == 0) {
#pragma unroll
                for (int t = 0; t < 16; ++t) *(bf16_t*)(Tm + (16 * blk + t) * PB + (16 * (blk + 1) + j) * 2) = 0;
            } else { *(u32x4*)(Dm + (16 * blk + j) * PB + (16 * (blk - 1)) * 2) = (u32x4){0u, 0u, 0u, 0u}; *(u32x4*)(Dm + (16 * blk + j) * PB + (16 * (blk - 1) + 8) * 2) = (u32x4){0u, 0u, 0u, 0u}; }
            RK_FENCE();
            const int m16 = lane & 15, kg = lane >> 4; const bf16x8 z8 = {0, 0, 0, 0, 0, 0, 0, 0};
#pragma unroll
            for (int pp = 0; pp < 2; ++pp) { const int o = 32 * pp;
                bf16x8 a = z8, bb = z8;
                if (kg < 2) { a = *(const bf16x8*)(L + O_AAB + (o + 16 + m16) * PB + (o + 8 * kg) * 2); bb = *(const bf16x8*)(Dm + (o + m16) * PB + (o + 8 * kg) * 2); }
                f32x4 pq = __builtin_amdgcn_mfma_f32_16x16x32_bf16(a, bb, (f32x4){0.f, 0.f, 0.f, 0.f}, 0, 0, 0);
                { u32x2 wv; wv.x = pk2(pq[0], pq[1]); wv.y = pk2(pq[2], pq[3]); *(u32x2*)(L + O_PT + (o + m16) * PB + (o + 16 + 4 * kg) * 2) = wv; } }
            RK_FENCE();
#pragma unroll
            for (int pp = 0; pp < 2; ++pp) { const int o = 32 * pp;
                bf16x8 a = z8, bb = z8;
                if (kg < 2) { a = *(const bf16x8*)(Tm + (o + 16 + m16) * PB + (o + 16 + 8 * kg) * 2); bb = *(const bf16x8*)(L + O_PT + (o + m16) * PB + (o + 16 + 8 * kg) * 2); }
                f32x4 tq = __builtin_amdgcn_mfma_f32_16x16x32_bf16(a, bb, (f32x4){0.f, 0.f, 0.f, 0.f}, 0, 0, 0);
#pragma unroll
                for (int e = 0; e < 4; ++e) *(bf16_t*)(Tm + (o + 16 + 4 * kg + e) * PB + (o + m16) * 2) = f2bf(tq[e]);
                { u32x2 wv; wv.x = pk2(tq[0], tq[1]); wv.y = pk2(tq[2], tq[3]); *(u32x2*)(Dm + (o + m16) * PB + (o + 16 + 4 * kg) * 2) = wv; } }
            RK_FENCE();
            { f32x16 q = {}; mm32<2>(q, L + O_AAB, 32, Dm, 0, 0, r32, hi); st_T(q, L + O_PT, 0, 32, r32, hi); }
            RK_FENCE();
            { f32x16 tc = {}; mm32<2>(tc, Tm, 32, L + O_PT, 0, 32, r32, hi);
#pragma unroll
              for (int r = 0; r < 16; ++r) *(bf16_t*)(Tm + (32 + crow(r, hi)) * PB + r32 * 2) = f2bf(tc[r]); }
        }
        LDS_BAR(); RKP1(5); RKP0(6);
        if (w < 4) {
            RK_LANE(); f32x16 q = {};
            if (mt) mm32s<4, false, true>(q, L + O_T, mt, L + O_SB, nv, r32, hi); else mm32s<2, false, true>(q, L + O_T, mt, L + O_SB, nv, r32, hi);
            st_T(q, L + O_PT, nv, mt, r32, hi);
        } else {
            RK_LANE(); if (w == 7) mm32s<4, false, true>(yacc, L + O_ARK, mt, L + O_VT, nv, r32, hi);
            f32x16 q = {};
            if (mt) mm32<4>(q, L + O_T, mt, L + O_G1T, nv, 0, r32, hi); else mm32<2>(q, L + O_T, mt, L + O_G1T, nv, 0, r32, hi);
            st_T(q, L + O_UT, nv, mt, r32, hi);
        }
        LDS_BAR(); RKP1(6); RKP0(7);
        {   const size_t ci = (size_t)sid * (SEQ / 64) + c;
            if (w < 4) {
                RK_LANE(); mm32s<4, true, false>(nacc, L + O_BHT, mt, L + O_UT, nv, r32, hi);
                {   bf16_t* NN = (sid < 24 ? (bf16_t*)(p.ws + WS_NN) : (bf16_t*)(g_scr + SCR_NN2) - (size_t)24 * 128 * 4096) + ci * 4096 + ((size_t)(w * 64 + lane)) * 16;
                    u32x4 a, d; a.x = pk2(nacc[0], nacc[1]); a.y = pk2(nacc[2], nacc[3]); a.z = pk2(nacc[4], nacc[5]); a.w = pk2(nacc[6], nacc[7]);
                    d.x = pk2(nacc[8], nacc[9]); d.y = pk2(nacc[10], nacc[11]); d.z = pk2(nacc[12], nacc[13]); d.w = pk2(nacc[14], nacc[15]);
                    *(u32x4*)NN = a; *(u32x4*)(NN + 8) = d; }
                f32x16 mq = {}; mm32s<4, false, true>(mq, L + O_PT, mt, L + O_BHT, nv, r32, hi);
                const int kq = nv + r32; const float gk = ((const float*)(L + O_GAM))[kq];
#pragma unroll
                for (int r = 0; r < 16; ++r) if (mt + crow(r, hi) == kq) mq[r] += gk;
                bf16_t* MM = (bf16_t*)(p.ws + WS_MM) + ci * 4096 + (size_t)kq * 64 + mt + 4 * hi;
#pragma unroll
                for (int g = 0; g < 4; ++g) { u32x2 wv; wv.x = pk2(mq[4 * g], mq[4 * g + 1]); wv.y = pk2(mq[4 * g + 2], mq[4 * g + 3]); *(u32x2*)(MM + 8 * g) = wv; }
            } else {
                RK_LANE(); if (mt) mm32<4>(yacc, L + O_ARB, mt, L + O_UT, nv, 0, r32, hi); else mm32<2>(yacc, L + O_ARB, mt, L + O_UT, nv, 0, r32, hi);
                {
                    bf16_t* yp = wkv + (size_t)c * 4096 + (size_t)((w - 4) * 64 + lane) * 16;
                    u32x4 a_, d_; a_.x = pk2(yacc[0], yacc[1]); a_.y = pk2(yacc[2], yacc[3]); a_.z = pk2(yacc[4], yacc[5]); a_.w = pk2(yacc[6], yacc[7]);
                    d_.x = pk2(yacc[8], yacc[9]); d_.y = pk2(yacc[10], yacc[11]); d_.z = pk2(yacc[12], yacc[13]); d_.w = pk2(yacc[14], yacc[15]);
                    *(u32x4*)yp = a_; *(u32x4*)(yp + 8) = d_; }
                f32x16 qq = {};
                if (nv) mm32<4>(qq, L + O_PT, mt, L + O_ARB, nv, 0, r32, hi); else mm32<2>(qq, L + O_PT, mt, L + O_ARB, nv, 0, r32, hi);
                const int tq = nv + r32;
                bf16_t* QQ = (bf16_t*)(g_scr + SCR_XB) + ci * 4096 + (size_t)tq * 64 + mt + 4 * hi;
#pragma unroll
                for (int g = 0; g < 4; ++g) { const u32x2 rw = *(const u32x2*)(L + O_RT + tq * PB + (mt + 8 * g + 4 * hi) * 2);
                    const float r0 = __uint_as_float(rw.x << 16), r1 = __uint_as_float(rw.x & 0xffff0000u), r2 = __uint_as_float(rw.y << 16), r3 = __uint_as_float(rw.y & 0xffff0000u);
                    u32x2 wv; wv.x = pk2(qq[4 * g] + r0, qq[4 * g + 1] + r1); wv.y = pk2(qq[4 * g + 2] + r2, qq[4 * g + 3] + r3); *(u32x2*)(QQ + 8 * g) = wv; }
            }
        }
        LDS_BAR(); RKP1(7);
    }
#undef RK_LOAD
#undef RK_LANE
    return pacc;
}

__device__ __forceinline__ void chain(const Params& p, const int sid, unsigned char* lds) {
    const int tid = otid(), w = __builtin_amdgcn_readfirstlane(tid >> 6);
    constexpr int C_MT = 0, C_QT = MAT, C_SB = 2 * MAT;
#define RK_LANE() int tq_ = tid; asm volatile("" : "+v"(tq_)); const int lane = tq_ & 63, r32 = lane & 31, hi = lane >> 5, row = tq_ >> 3, c8 = (tq_ & 7) * 8; (void)lane; (void)r32; (void)hi; (void)row; (void)c8
    char* L = (char*)lds;
    const bf16_t* MMg = (const bf16_t*)(p.ws + WS_MM) + (size_t)sid * 128 * 4096; const bf16_t* QQg = (const bf16_t*)(g_scr + SCR_XB) + (size_t)sid * 128 * 4096;
    const bf16_t* NNg = (sid < 24 ? (const bf16_t*)(p.ws + WS_NN) : (const bf16_t*)(g_scr + SCR_NN2) - (size_t)24 * 128 * 4096) + (size_t)sid * 128 * 4096;
    bf16_t* wkv = (bf16_t*)(g_scr + SCR_WKV) + (size_t)sid * SEQ * 64;
    const int mt = (w & 2) ? 32 : 0, nv = (w & 1) ? 32 : 0;
    {   RK_LANE(); unsigned zz = 0u; asm volatile("" : "+v"(zz)); *(u32x4*)(L + C_SB + row * PB + c8 * 2) = (u32x4){zz, zz, zz, zz}; }
    f32x16 sacc = {};
    bf16x8 rm, rq, rn0, rn1;
#define CH_LOAD(c) do { RK_LANE(); rm = *(const bf16x8*)(MMg + (size_t)(c) * 4096 + row * 64 + c8); rq = *(const bf16x8*)(QQg + (size_t)(c) * 4096 + row * 64 + c8); \
        if (w < 4) { const bf16_t* n_ = NNg + (size_t)(c) * 4096 + (size_t)(w * 64 + lane) * 16; rn0 = *(const bf16x8*)n_; rn1 = *(const bf16x8*)(n_ + 8); } \
        else { const bf16_t* y_ = wkv + (size_t)(c) * 4096 + (size_t)((w - 4) * 64 + lane) * 16; rn0 = *(const bf16x8*)y_; rn1 = *(const bf16x8*)(y_ + 8); } } while (0)
    CH_LOAD(0);
#pragma unroll 1
    for (int c = 0; c < SEQ / 64; ++c) {
        {   RK_LANE(); *(bf16x8*)(L + C_MT + row * PB + c8 * 2) = rm; *(bf16x8*)(L + C_QT + row * PB + c8 * 2) = rq; }
        f32x16 acc;
#pragma unroll
        for (int r = 0; r < 8; ++r) { acc[r] = bf2f((bf16_t)rn0[r]); acc[8 + r] = bf2f((bf16_t)rn1[r]); }
        LDS_BAR();
        if (c + 1 < SEQ / 64) CH_LOAD(c + 1);
        {   RK_LANE();
            if (w < 4) { mm32<4>(acc, L + C_MT, mt, L + C_SB, nv, 0, r32, hi); sacc = acc; }
            else { mm32<4>(acc, L + C_QT, mt, L + C_SB, nv, 0, r32, hi);
#pragma unroll
                for (int r = 0; r < 16; ++r) wkv[((size_t)c * 64 + mt + crow(r, hi)) * 64 + nv + r32] = f2bf(acc[r]); } }
        LDS_BAR();
        if (w < 4) { RK_LANE(); st_T(sacc, L + C_SB, nv, mt, r32, hi); }
    }
#undef CH_LOAD
#undef RK_LANE
}

}

namespace sd {
using rk::f32x16; using rk::crow;
constexpr int PW = 272, PN = 144;
constexpr int O_CM = 0, O_BM = 64 * PW, O_HB = 2 * 64 * PW, O_BDT = 3 * 64 * PW, O_XDT = O_BDT + 128 * PN, O_XM = O_XDT + 64 * PN, O_MM = O_XM + 64 * PN, O_DTS = O_MM + 64 * PN, O_ACU = O_DTS + 512, O_END = O_ACU + 512;
template <int NKS, int PA, int PBB, int SA = -1, int SBW = -1> __device__ __forceinline__ void mmx(f32x16& acc, const char* A, int m0, const char* B, int n0, int k0, int r32, int hi) {
    const int ra = m0 + r32, rb = n0 + r32; const int fa = SA >= 0 ? ((ra >> (SA >= 0 ? SA : 0)) & 7) : 0, fb = SBW >= 0 ? ((rb >> (SBW >= 0 ? SBW : 0)) & 7) : 0;
#pragma unroll
    for (int ks = 0; ks < NKS; ++ks) { const int q = (k0 >> 3) + ks * 2 + hi;
        const bf16x8 a = *(const bf16x8*)(A + ra * PA + ((q ^ fa) << 4));
        const bf16x8 b = *(const bf16x8*)(B + rb * PBB + ((q ^ fb) << 4));
        acc = __builtin_amdgcn_mfma_f32_32x32x16_bf16(a, b, acc, 0, 0, 0); }
}
template <int PZ> __device__ __forceinline__ void stT(const f32x16& acc, char* Z, int n0, int m0, int r32, int hi) {
#pragma unroll
    for (int g = 0; g < 4; ++g) { u32x2 w; w.x = pk2(acc[4 * g], acc[4 * g + 1]); w.y = pk2(acc[4 * g + 2], acc[4 * g + 3]);
        *(u32x2*)(Z + (n0 + r32) * PZ + (m0 + 8 * g + 4 * hi) * 2) = w; }
}
__device__ __forceinline__ unsigned long long seq(const Params& p, const int l, const int sid, unsigned char* lds) {
    const int tid = otid(), w = __builtin_amdgcn_readfirstlane(tid >> 6);
    const int h = sid & 7, dir = (sid >> 3) & 1, b = sid >> 4, g = h >> 2;
    unsigned long long pacc = 0, ptt = 0; (void)ptt;
#ifdef PRB_SDIV
#define SDP0(i) do { if ((PRB_SDIV >> (i)) & 1) ptt = __builtin_amdgcn_s_memrealtime(); } while (0)
#define SDP1(i) do { if ((PRB_SDIV >> (i)) & 1) pacc += __builtin_amdgcn_s_memrealtime() - ptt; } while (0)
#else
#define SDP0(i) do {} while (0)
#define SDP1(i) do {} while (0)
#endif
#define SD_LANE() int tq_ = tid; asm volatile("" : "+v"(tq_)); const int lane = tq_ & 63, r32 = lane & 31, hi = lane >> 5, tok = tq_ >> 3, q8 = tq_ & 7; (void)lane; (void)r32; (void)hi; (void)tok; (void)q8
    char* L = (char*)lds;
    const float Ah = -expf(p.in[7][(l * 2 + dir) * 8 + h]), dtb = p.in[8][(l * 2 + dir) * 8 + h], Dh = (dir == 0) ? p.in[9][l * 8 + h] : 0.f;
    const float* dtbuf = (const float*)(g_scr + SCR_DT) + dir * 8 + h;
    const bf16_t* xact = (const bf16_t*)(g_scr + SCR_XACT);
    bf16_t* yout = (bf16_t*)(g_scr + SCR_SSDY) + (size_t)dir * M_TOK * 512 + h * 64;
    {   SD_LANE(); unsigned zz = 0u; asm volatile("" : "+v"(zz));
        for (int i = tid; i < 64 * PW / 16; i += 512) *(u32x4*)(L + O_HB + i * 16) = (u32x4){zz, zz, zz, zz}; }
    f32x16 hacc = {};
    bf16x8 rc[2], rb[2], rx; float dtr = 0.f;
#define SD_LOAD(c) do { SD_LANE(); const int s_ = (c) * 64 + tok; const int t_ = dir ? (SEQ - 1 - s_) : s_; const bf16_t* row_ = xact + ((size_t)b * SEQ + t_) * 1024; \
        rc[0] = *(const bf16x8*)(row_ + 768 + g * 128 + q8 * 16); rc[1] = *(const bf16x8*)(row_ + 768 + g * 128 + q8 * 16 + 8); \
        rb[0] = *(const bf16x8*)(row_ + 512 + g * 128 + q8 * 16); rb[1] = *(const bf16x8*)(row_ + 512 + g * 128 + q8 * 16 + 8); \
        rx = *(const bf16x8*)(row_ + h * 64 + q8 * 8); } while (0)
#define SD_DTLOAD(c) do { SD_LANE(); const int s2_ = (c) * 64 + lane; const int t2_ = dir ? (SEQ - 1 - s2_) : s2_; dtr = dtbuf[((size_t)b * SEQ + t2_) * 16]; } while (0)
#define SD_SCAN(buf) do { SD_LANE(); const float dt_ = softplusf(dtr + dtb); float ac_ = dt_ * Ah; \
        _Pragma("unroll") for (int o_ = 1; o_ < 64; o_ <<= 1) { const float v_ = __shfl_up(ac_, o_); if (lane >= o_) ac_ += v_; } \
        ((float*)(L + O_DTS))[(buf) * 64 + lane] = dt_; ((float*)(L + O_ACU))[(buf) * 64 + lane] = ac_; } while (0)
    SD_LOAD(0);
    if (w == 7) { SD_DTLOAD(0); SD_SCAN(0); SD_DTLOAD(1); }
    LDS_BAR();
    const int nv = (w & 1) ? 32 : 0;
#pragma unroll 1
    for (int c = 0; c < SEQ / 64; ++c) {
        const float* DTS = (const float*)(L + O_DTS) + (c & 1) * 64; const float* ACU = (const float*)(L + O_ACU) + (c & 1) * 64;
        SDP0(1);
        {   SD_LANE(); const float dt = DTS[tok]; const float ac = ACU[tok], ae = ACU[63];
            const float dend = __expf(ae - ac);
            *(bf16x8*)(L + O_CM + tok * PW + q8 * 32) = rc[0]; *(bf16x8*)(L + O_CM + tok * PW + q8 * 32 + 16) = rc[1];
            *(bf16x8*)(L + O_BM + tok * PW + q8 * 32) = rb[0]; *(bf16x8*)(L + O_BM + tok * PW + q8 * 32 + 16) = rb[1];
            *(bf16x8*)(L + O_XM + tok * PN + q8 * 16) = rx;
            const int tsw = ((((tok >> 3) ^ q8) << 3) + (tok & 7)) * 2;
#pragma unroll
            for (int e = 0; e < 8; ++e) { *(bf16_t*)(L + O_BDT + (q8 * 16 + e) * PN + tsw) = f2bf(bf2f((bf16_t)rb[0][e]) * dend); *(bf16_t*)(L + O_BDT + (q8 * 16 + 8 + e) * PN + tsw) = f2bf(bf2f((bf16_t)rb[1][e]) * dend);
                *(bf16_t*)(L + O_XDT + (q8 * 8 + e) * PN + tsw) = f2bf(bf2f((bf16_t)rx[e]) * dt); } }
        LDS_BAR(); SDP1(1); SDP0(2);
        if (c + 1 < SEQ / 64) SD_LOAD(c + 1);
        f32x16 yoff = {};
        const int ml = ((w - 3) & 2) ? 32 : 0, np = ((w - 3) & 1) ? 32 : 0;
        if (w < 3) { SD_LANE(); const int ms = (w == 2) ? 32 : 0, nl = (w >= 1) ? 32 : 0;
            f32x16 gq = {}; mmx<8, PW, PW>(gq, L + O_BM, ms, L + O_CM, nl, 0, r32, hi);
            const int lq = nl + r32; const float al = ACU[lq];
#pragma unroll
            for (int g4 = 0; g4 < 4; ++g4) { const f32x4 as4 = *(const f32x4*)(ACU + ms + 8 * g4 + 4 * hi);
#pragma unroll
                for (int e = 0; e < 4; ++e) { const int s = ms + 8 * g4 + 4 * hi + e; const float d = __expf(fminf(al - as4[e], 0.f)); gq[4 * g4 + e] = (s <= lq) ? gq[4 * g4 + e] * d : 0.f; } }
            stT<PN>(gq, L + O_MM, nl, ms, r32, hi);
        } else if (w < 7) { SD_LANE(); mmx<8, PW, PW>(yoff, L + O_CM, ml, L + O_HB, np, 0, r32, hi); }
        {   SD_LANE(); const float eend = __expf(ACU[63]);
#pragma unroll
            for (int r = 0; r < 16; ++r) hacc[r] *= eend;
            mmx<4, PN, PN, 4, 3>(hacc, L + O_BDT, (w >> 1) * 32, L + O_XDT, nv, 0, r32, hi); }
        if (w == 7 && c + 1 < SEQ / 64) { SD_SCAN((c + 1) & 1); if (c + 2 < SEQ / 64) SD_DTLOAD(c + 2); }
        LDS_BAR(); SDP1(2); SDP0(3);
        {   SD_LANE(); stT<PW>(hacc, L + O_HB, nv, (w >> 1) * 32, r32, hi); }
        if (w >= 3 && w < 7) { SD_LANE(); f32x16 yd = {};
            if (ml) mmx<4, PN, PN, -1, 3>(yd, L + O_MM, ml, L + O_XDT, np, 0, r32, hi); else mmx<2, PN, PN, -1, 3>(yd, L + O_MM, ml, L + O_XDT, np, 0, r32, hi);
            float ea[16], xv[16];
#pragma unroll
            for (int g4 = 0; g4 < 4; ++g4) { const f32x4 a4 = *(const f32x4*)(ACU + ml + 8 * g4 + 4 * hi);
#pragma unroll
                for (int e = 0; e < 4; ++e) { ea[4 * g4 + e] = __expf(a4[e]); xv[4 * g4 + e] = bf2f(*(const bf16_t*)(L + O_XM + (ml + 8 * g4 + 4 * hi + e) * PN + (np + r32) * 2)); } }
#pragma unroll
            for (int r = 0; r < 16; ++r) { const int lq = ml + crow(r, hi); const int s_ = c * 64 + lq; const int t_ = dir ? (SEQ - 1 - s_) : s_;
                yout[((size_t)b * SEQ + t_) * 512 + np + r32] = f2bf(yd[r] + ea[r] * yoff[r] + Dh * xv[r]); } }
        LDS_BAR(); SDP1(3);
    }
#undef SD_LOAD
#undef SD_DTLOAD
#undef SD_SCAN
#undef SD_LANE
    return pacc;
}
}

__device__ __forceinline__ void combine_tokens(const Params& p, const int l, const int m_first, const int m_end, const int m_step) {
    const int tid = otid(), lane = tid & 63;
    const bf16_t* wkv = (const bf16_t*)(g_scr + SCR_WKV); const bf16_t* bon = (const bf16_t*)(g_scr + SCR_BON); const bf16_t* sy = (const bf16_t*)(g_scr + SCR_SSDY);
    const int h = lane >> 3, c8 = (lane & 7) * 8, ch = h * 64 + c8;
    float eps_gn = 64e-5f, eps_rms = NORM_EPS; asm volatile("" : "+v"(eps_gn), "+v"(eps_rms));
    float lnw[8], lnb[8], snw[8];
#pragma unroll
    for (int e = 0; e < 8; ++e) { lnw[e] = p.in[19][l * 512 + ch + e]; lnb[e] = p.in[20][l * 512 + ch + e]; snw[e] = p.in[10][l * 512 + ch + e]; }
    for (int m = m_first; m < m_end; m += m_step) {
        const int bq = m >> 13, tq = m & (SEQ - 1);
        bf16_t* gp = pblk(p.ws, PB_RG + (h >> 1)) + (size_t)m * 128 + (h & 1) * 64 + c8; bf16_t* zp = pblk(p.ws, PB_Z + (h >> 1)) + (size_t)m * 128 + (h & 1) * 64 + c8;
        const bf16x8 vwf = *(const bf16x8*)(wkv + (((size_t)(bq * 16 + h)) * SEQ + tq) * 64 + c8), vwb = *(const bf16x8*)(wkv + (((size_t)(bq * 16 + 8 + h)) * SEQ + (SEQ - 1 - tq)) * 64 + c8);
        const bf16x8 vbf = *(const bf16x8*)(bon + (size_t)m * 512 + ch), vbb = *(const bf16x8*)(bon + (size_t)M_TOK * 512 + (size_t)m * 512 + ch);
        const bf16x8 vg = *(const bf16x8*)gp, vz = *(const bf16x8*)zp;
        const bf16x8 vyf = *(const bf16x8*)(sy + (size_t)m * 512 + ch), vyb = *(const bf16x8*)(sy + (size_t)M_TOK * 512 + (size_t)m * 512 + ch);
        float a[8], bq8[8], x[8], y[8];
        unpack8(vwf, a); unpack8(vwb, bq8); float s = 0.f;
#pragma unroll
        for (int e = 0; e < 8; ++e) { x[e] = a[e] + bq8[e]; s += x[e]; }
        s += __shfl_xor(s, 1); s += __shfl_xor(s, 2); s += __shfl_xor(s, 4);
        const float mean = s * (1.f / 64.f); float v2 = 0.f;
#pragma unroll
        for (int e = 0; e < 8; ++e) { x[e] -= mean; v2 += x[e] * x[e]; }
        v2 += __shfl_xor(v2, 1); v2 += __shfl_xor(v2, 2); v2 += __shfl_xor(v2, 4);
        const float rstd = rsqrtf(v2 * (1.f / 64.f) + eps_gn);
        unpack8(vbf, a); unpack8(vbb, bq8); unpack8(vg, y);
#pragma unroll
        for (int e = 0; e < 8; ++e) x[e] = (x[e] * rstd * lnw[e] + lnb[e] + a[e] + bq8[e]) * siluf(y[e]);
        const u32x4 ob = pack8(x);
        unpack8(vyf, a); unpack8(vyb, bq8); unpack8(vz, y); float ss = 0.f;
#pragma unroll
        for (int e = 0; e < 8; ++e) { x[e] = (a[e] + bq8[e]) * siluf(y[e]); ss += x[e] * x[e]; }
        ss += __shfl_xor(ss, 1); ss += __shfl_xor(ss, 2); ss += __shfl_xor(ss, 4); ss += __shfl_xor(ss, 8); ss += __shfl_xor(ss, 16);
        const float rs = rsqrtf(ss * (1.f / 256.f) + eps_rms);
#pragma unroll
        for (int e = 0; e < 8; ++e) x[e] *= rs * snw[e];
        const u32x4 oa = pack8(x);
        *(u32x4*)gp = ob; *(u32x4*)zp = oa;
    }
}

__device__ __forceinline__ void phase_post(const Params& p, const int l) {
    const int G = gridDim.x, tid = otid(), lane = tid & 63, wave = tid >> 6;
    const float* mix = (const float*)(p.ws + WS_MIX); const float* xin = l == 0 ? p.in[0] : p.out; const float* pw = p.in[2] + l * DMODEL;
    f32x4 wv[4];
#pragma unroll
    for (int j = 0; j < 4; ++j) wv[j] = ((const f32x4*)pw)[lane + 64 * j];
    for (int m0 = (blockIdx.x * 8 + wave) * 2; m0 < M_TOK; m0 += G * 16) {
        f32x4 v[2][4], x[2][4];
#pragma unroll
        for (int q = 0; q < 2; ++q)
#pragma unroll
            for (int j = 0; j < 4; ++j) { v[q][j] = ((const f32x4*)(mix + (size_t)(m0 + q) * DMODEL))[lane + 64 * j]; x[q][j] = ((const f32x4*)(xin + (size_t)(m0 + q) * DMODEL))[lane + 64 * j]; }
#pragma unroll
        for (int q = 0; q < 2; ++q) { float s = 0.f;
#pragma unroll
            for (int j = 0; j < 4; ++j) s += (v[q][j].x * v[q][j].x + v[q][j].y * v[q][j].y) + (v[q][j].z * v[q][j].z + v[q][j].w * v[q][j].w);
            const float rs = rsqrtf(wave_sum(s) * (1.f / DMODEL) + NORM_EPS); float s2 = 0.f;
#pragma unroll
            for (int j = 0; j < 4; ++j) { v[q][j] = x[q][j] + v[q][j] * rs * wv[j]; s2 += (v[q][j].x * v[q][j].x + v[q][j].y * v[q][j].y) + (v[q][j].z * v[q][j].z + v[q][j].w * v[q][j].w); }
            s2 = wave_sum(s2);
            if (lane == 0) ((float*)(g_scr + SCR_RS))[m0 + q] = rsqrtf(s2 * (1.f / DMODEL) + NORM_EPS); }
#pragma unroll
        for (int q = 0; q < 2; ++q) { f32x4* orow = (f32x4*)(p.out + (size_t)(m0 + q) * DMODEL) + lane; u32x2* o8 = (u32x2*)((bf16_t*)(g_scr + SCR_XB) + (size_t)(m0 + q) * DMODEL) + lane;
#pragma unroll
            for (int j = 0; j < 4; ++j) { orow[64 * j] = v[q][j]; u32x2 w; w.x = pk2(v[q][j].x, v[q][j].y); w.y = pk2(v[q][j].z, v[q][j].w); o8[64 * j] = w; } }
    }
}

#define XB_TMO      128
#define XB_XCNT(j)  (256  + 64 * (j))
#define XB_XSUB(j)  (1280 + 64 * (j))
#define XB_XGEN(j)  (2304 + 64 * (j))
#define XB_TOP      3328
#define XB_TOPGEN   3392
#define XCD_BAR_WORDS 3456
#define XB_SPIN_CAP (1u << 18)
#define XLAS __attribute__((address_space(3)))
__device__ __forceinline__ unsigned xb_ld(unsigned* p)              { return __hip_atomic_load(p, __ATOMIC_RELAXED, __HIP_MEMORY_SCOPE_AGENT); }
__device__ __forceinline__ unsigned xb_add(unsigned* p, unsigned v) { return __hip_atomic_fetch_add(p, v, __ATOMIC_RELAXED, __HIP_MEMORY_SCOPE_AGENT); }
__device__ __forceinline__ unsigned xb_xcc_id() { return (unsigned)__builtin_amdgcn_s_getreg((3 << 11) | 20) & 0xFu; }
#define XB_SPIN(cond, bar) do { unsigned _sp = 0; while (cond) { __builtin_amdgcn_s_sleep(1); \
    if ((++_sp & 255u) == 0u) { if (xb_ld(&(bar)[XB_TMO])) break; if (_sp > XB_SPIN_CAP) { atomicAdd(&(bar)[XB_TMO], 1u); break; } } } } while (0)
struct XcdBarrier { unsigned* bar; unsigned x; volatile XLAS unsigned* st; };
__device__ __forceinline__ XcdBarrier xcd_barrier_post(unsigned* bar, volatile XLAS unsigned* st) {
    XcdBarrier b; b.bar = bar; b.x = xb_xcc_id(); b.st = st;
    if (threadIdx.x == 0) (void)xb_add(&bar[XB_XCNT(b.x)], 1u);
    return b;
}
__device__ __forceinline__ void xcd_barrier_complete(unsigned* bar, unsigned x, unsigned& nloc, unsigned& nx) {
    const unsigned G = gridDim.x * gridDim.y * gridDim.z;
    unsigned sum, cnt, mine, sp = 0u;
    for (;;) {
        sum = 0u; cnt = 0u; mine = 0u;
#pragma unroll
        for (unsigned j = 0; j < 16; ++j) { const unsigned c = xb_ld(&bar[XB_XCNT(j)]); sum += c; cnt += (c > 0u) ? 1u : 0u; mine = (j == x) ? c : mine; }
        if (sum == G) break;
        __builtin_amdgcn_s_sleep(1);
        if ((++sp & 255u) == 0u) { if (xb_ld(&bar[XB_TMO])) break; if (sp > XB_SPIN_CAP) { atomicAdd(&bar[XB_TMO], 1u); break; } }
    }
    nloc = mine > 0u ? mine : 1u; nx = cnt > 0u ? cnt : 1u;
}
__device__ __forceinline__ void xcd_barrier(const XcdBarrier& b) {
    asm volatile("s_waitcnt vmcnt(0)" ::: "memory");
    __syncthreads();
    if (threadIdx.x == 0) {
        unsigned* bar = b.bar;
        __builtin_amdgcn_s_waitcnt(0);
        unsigned nloc = b.st[0], nx = b.st[1];
        if (nloc == 0u) { xcd_barrier_complete(bar, b.x, nloc, nx); b.st[0] = nloc; b.st[1] = nx; }
        const unsigned old = xb_add(&bar[XB_XSUB(b.x)], 1u);
        const unsigned gen = old / nloc;
        if (old + 1u == (gen + 1u) * nloc) {
            __builtin_amdgcn_fence(__ATOMIC_RELEASE, "agent");
            asm volatile("s_waitcnt vmcnt(0)" ::: "memory");
            const unsigned og = xb_add(&bar[XB_TOP], 1u);
            const unsigned tg = og / nx;
            if (og + 1u == (tg + 1u) * nx) xb_add(&bar[XB_TOPGEN], 1u);
            else XB_SPIN(xb_ld(&bar[XB_TOPGEN]) == tg, bar);
            __builtin_amdgcn_fence(__ATOMIC_ACQUIRE, "agent");
            xb_add(&bar[XB_XGEN(b.x)], 1u);
            asm volatile("s_waitcnt vmcnt(0)" ::: "memory");
        } else {
            XB_SPIN(xb_ld(&bar[XB_XGEN(b.x)]) == gen, bar);
            __builtin_amdgcn_fence(__ATOMIC_ACQUIRE, "agent");
            asm volatile("s_waitcnt vmcnt(0)" ::: "memory");
        }
    }
    __syncthreads();
}

constexpr int LDS_BYTES = 155648;
static_assert(rk::O_END <= LDS_BYTES, "rwkv LDS map");
__device__ __forceinline__ void phase_gemm_in(const Params& p, const int l, unsigned char* lds) {
    pg8::Gemm g{(const bf16_t*)(g_scr + SCR_XB), (const bf16_t*)(g_scr + SCR_WIN + (size_t)l * 15 * MiB), M_TOK, NPROJ, DMODEL, DMODEL, 128};
    pg8::StaticOrder S; S.init(M_TOK, NPROJ, gridDim.x, blockIdx.x);
    pg8::EpiProj E{(bf16_t*)p.ws, (const float*)(g_scr + SCR_RS), (float*)(g_scr + SCR_DT)};
    pg8::gemm_phase<pg8::EpiProj, pg8::StaticOrder, true, true>((PG8_LAS unsigned char*)lds, g, S, E);
}
__device__ __forceinline__ void phase_gemm_out(const Params& p, const int l, unsigned char* lds) {
    pg8::Gemm g{(const bf16_t*)p.ws, (const bf16_t*)(g_scr + SCR_WOUT + (size_t)l * 4 * MiB), M_TOK, DMODEL, DMIX, 128, PBLK_ELEMS};
    pg8::StaticOrder S; S.init(M_TOK, DMODEL, gridDim.x, blockIdx.x);
    pg8::EpiMix E{(float*)(p.ws + WS_MIX)};
    pg8::gemm_phase<pg8::EpiMix, pg8::StaticOrder, true, true>((PG8_LAS unsigned char*)lds, g, S, E);
}
__device__ __forceinline__ unsigned long long phase_mixers(const Params& p, const int l, unsigned char* lds) {
    unsigned long long pr = 0;
    const int bid = blockIdx.x;
#ifdef PRB_SEQ
    const unsigned long long ts0 = __builtin_amdgcn_s_memrealtime();
#endif
    unsigned* seqdone = (unsigned*)(g_scr + SCR_CTL) + 200 + 8 * l; unsigned* cmbctr = seqdone + 1;
    if (bid < 32) rk::chain(p, bid, lds);
    else if (bid < 64) { const unsigned long long q_ = sd::seq(p, l, bid - 32, lds); (void)q_;
#ifdef PRB_SDIV
        pr = q_;
#endif
    }
    if (bid < 64) {
        asm volatile("s_waitcnt vmcnt(0)" ::: "memory"); __syncthreads();
        if (threadIdx.x == 0) { __builtin_amdgcn_fence(__ATOMIC_RELEASE, "agent"); asm volatile("s_waitcnt vmcnt(0)" ::: "memory"); __hip_atomic_fetch_add(seqdone, 1u, __ATOMIC_RELAXED, __HIP_MEMORY_SCOPE_AGENT); }
    }
#ifdef PRB_SEQ
    pr = __builtin_amdgcn_s_memrealtime() - ts0;
#endif
    unsigned* ctr = (unsigned*)(g_scr + SCR_CTL) + 64 * l;
    unsigned* slot = (unsigned*)(lds + LDS_BYTES - 16);
#ifdef PRB_UNIT
    int nun = 0;
#endif
    const int x0 = (int)(__builtin_amdgcn_s_getreg((3 << 11) | 20) & 7u);
    for (int dx = 0; dx < 8; ++dx) { const int x = (x0 + dx) & 7;
        for (;;) {
            __syncthreads();
            if (threadIdx.x == 0) *slot = atomicAdd(ctr + x, 1u);
            __syncthreads();
            const int j = (int)__builtin_amdgcn_readfirstlane(*slot);
            constexpr int NSPL = 16;
            if (j >= 96 + NSPL) break;
#ifdef PRB_UNIT
            const unsigned long long tu0 = __builtin_amdgcn_s_memrealtime();
#endif
            if (j < 32) gqa_unit(p, l, x * 32 + j, (char*)lds);
            else if (j < 96 - NSPL) diff_unit(p, l, x * 64 + (j - 32), (char*)lds);
            else { const int s = j - (96 - NSPL); diff_unit(p, l, x * 64 + (64 - NSPL) + (s >> 1), (char*)lds, s & 1, x * NSPL + (s >> 1)); }
#ifdef PRB_UNIT
            if (nun == PRB_UNIT) pr = __builtin_amdgcn_s_memrealtime() - tu0;
            if (PRB_UNIT == 99) pr = (unsigned long long)(nun + 1) * 10000ull + (j < 32 ? 1000ull : 0ull);
            ++nun;
#endif
        } }
    {   if (threadIdx.x == 0) { unsigned sp = 0; while (__hip_atomic_load(seqdone, __ATOMIC_RELAXED, __HIP_MEMORY_SCOPE_AGENT) < 64u) { __builtin_amdgcn_s_sleep(8); if (++sp > (1u << 22)) break; } }
        __syncthreads();
        __builtin_amdgcn_fence(__ATOMIC_ACQUIRE, "agent"); asm volatile("s_waitcnt vmcnt(0)" ::: "memory");
        const int wave = otid() >> 6;
        for (;;) {
            __syncthreads();
            if (threadIdx.x == 0) *slot = atomicAdd(cmbctr, 1u);
            __syncthreads();
            const int it = (int)__builtin_amdgcn_readfirstlane(*slot);
            if (it >= M_TOK / 64) break;
            combine_tokens(p, l, it * 64 + wave, it * 64 + 64, 8);
        } }
    return pr;
}
#ifdef PROBE
#define PT0(ph) do { if (l == 0 && (ph) == PRB_PH) pt0 = __builtin_amdgcn_s_memrealtime(); } while (0)
#define PT1(ph, aftersync) do { if (l == 0 && (ph) == PRB_PH && (aftersync) == PRB_SYNC) pd = __builtin_amdgcn_s_memrealtime() - pt0; } while (0)
#else
#define PT0(ph) do {} while (0)
#define PT1(ph, aftersync) do {} while (0)
#endif
__global__ void __launch_bounds__(512) mega(const Params p) {
    extern __shared__ __attribute__((aligned(16))) unsigned char lds[];
    cg::grid_group grid = cg::this_grid();
    unsigned* xbar = (unsigned*)(g_scr + SCR_BAR);
    volatile XLAS unsigned* xst = (volatile XLAS unsigned*)(XLAS unsigned char*)(lds + LDS_BYTES - 32);
    if (blockIdx.x == 0) for (int i = threadIdx.x; i < XCD_BAR_WORDS; i += 512) xbar[i] = 0u;
    if (threadIdx.x < 2) xst[threadIdx.x] = 0u;
#ifdef PROBE
    unsigned long long pt0 = 0, pd = 0;
#endif
#ifdef PROBE
    if (PRB_PH == 7) pt0 = __builtin_amdgcn_s_memrealtime();
#endif
    phase_prologue(p, (float*)lds); grid.sync();
    const XcdBarrier xb = xcd_barrier_post(xbar, xst);
#define GRID_BAR() xcd_barrier(xb)
#ifdef PROBE
    if (PRB_PH == 7) pd = __builtin_amdgcn_s_memrealtime() - pt0;
#endif
#pragma unroll 1
    for (int l = 0; l < 2; ++l) {
        PT0(0); phase_gemm_in(p, l, lds); PT1(0, 0); GRID_BAR(); PT1(0, 1);
        PT0(1); phase_prep(p, l); PT1(1, 0); GRID_BAR(); PT1(1, 1);
        kmax_reduce(l, (float*)lds);
        PT0(6); { const unsigned long long pr_ = rk::pass1(p, l, lds); (void)pr_;
#ifdef PRB_IV
        if (l == 0) pd = pr_;
#endif
        } PT1(6, 0); GRID_BAR(); PT1(6, 1);
        PT0(2); { const unsigned long long pr_ = phase_mixers(p, l, lds); (void)pr_;
#if defined(PRB_SEQ) || defined(PRB_SDIV) || defined(PRB_UNIT)
        if (l == 0) pd = pr_;
#endif
        } PT1(2, 0); GRID_BAR(); PT1(2, 1);
        PT0(4); phase_gemm_out(p, l, lds); PT1(4, 0); GRID_BAR(); PT1(4, 1);
        PT0(5); phase_post(p, l); PT1(5, 0); if (l == 0) { GRID_BAR(); PT1(5, 1); }
    }
#ifdef PROBE
    if (blockIdx.x == PRB_BLK && threadIdx.x == 0) { const unsigned long long d = pd * PRB_K; const unsigned long long t0 = __builtin_amdgcn_s_memrealtime();
        while (__builtin_amdgcn_s_memrealtime() - t0 < d) __builtin_amdgcn_s_sleep(8); }
#endif
}

extern "C" void kernel_launch(void* const* d_in, const int* in_sizes, int n_in, void* d_out, int out_size, void* d_ws, size_t ws_size, hipStream_t stream) {
    static int grid_blocks = 0;
    if (!grid_blocks) {
        int dev = 0, cus = 0, per_cu = 0;
        (void)hipGetDevice(&dev);
        (void)hipDeviceGetAttribute(&cus, hipDeviceAttributeMultiprocessorCount, dev);
        (void)hipFuncSetAttribute((const void*)mega, hipFuncAttributeMaxDynamicSharedMemorySize, LDS_BYTES);
        (void)hipOccupancyMaxActiveBlocksPerMultiprocessor(&per_cu, (const void*)mega, 512, LDS_BYTES);
        if (per_cu < 1) { fprintf(stderr, "kernel_launch: occupancy query says %d blocks/CU\n", per_cu); per_cu = 1; }
        grid_blocks = cus;
    }
    Params p{};
    for (int i = 0; i < 25; ++i) p.in[i] = (const float*)d_in[i];
    p.out = (float*)d_out; p.ws = (unsigned char*)d_ws;
    void* args[] = {&p};
    hipError_t e = hipLaunchCooperativeKernel((const void*)mega, dim3(grid_blocks), dim3(512), args, LDS_BYTES, stream);
    if (e != hipSuccess) fprintf(stderr, "cooperative launch failed: %s (grid %d)\n", hipGetErrorString(e), grid_blocks);
}
```

```cpp
#include <hip/hip_runtime.h>
#include <hip/hip_bf16.h>
#include <hip/hip_cooperative_groups.h>
#include <cstdio>
#include <cstdint>
namespace cg = cooperative_groups;

constexpr int M_TOK = 16384, SEQ = 8192, DMODEL = 1024, NPROJ = 7424, NPB = 58, DIN_ORIG = 7312, DMIX = 2048;
constexpr float NORM_EPS = 1e-6f;
constexpr size_t MiB = 1u << 20;
constexpr int PB_Z = 0, PB_RG = 4, PB_DQ = 8, PB_GQ = 12, PB_XS = 16, PB_BM = 20, PB_CM = 22, PB_R = 24, PB_K = 28, PB_V = 32, PB_WA = 36,
              PB_DK = 37, PB_DV = 41, PB_DG = 45, PB_GK = 49, PB_GV = 51, PB_GG = 53, PB_DT = 57;
constexpr size_t PBLK_ELEMS = (size_t)M_TOK * 128;
constexpr size_t SCR_WIN = 0, SCR_WOUT = 30 * MiB, SCR_ROPE = 38 * MiB, SCR_DT = 40 * MiB, SCR_RS = 41 * MiB, SCR_CTL = 41 * MiB + 512 * 1024,
                 SCR_BAR = 41 * MiB + 768 * 1024, SCR_XB = 42 * MiB, SCR_WKV = 74 * MiB, SCR_BON = 106 * MiB, SCR_SSDY = 138 * MiB, SCR_XACT = 170 * MiB, SCR_NN2 = 202 * MiB, SCR_SPL = 210 * MiB, SCR_BYTES = 228 * MiB;
constexpr size_t SCR_KPART = 41 * MiB + 64 * 1024;
constexpr size_t WS_MM = 16 * PBLK_ELEMS * 2;
constexpr size_t WS_NN = 58 * PBLK_ELEMS * 2;
constexpr size_t WS_MIX = 16 * PBLK_ELEMS * 2;
__device__ __attribute__((aligned(256))) unsigned char g_scr[SCR_BYTES];

typedef unsigned short bf16_t;
typedef short bf16x8 __attribute__((ext_vector_type(8)));
typedef float f32x4 __attribute__((ext_vector_type(4)));
typedef unsigned u32x4 __attribute__((ext_vector_type(4)));
typedef unsigned u32x2 __attribute__((ext_vector_type(2)));

struct Params {
    const float* in[25];
    float* out;
    unsigned char* ws;
};

__device__ __forceinline__ int otid() { int t = threadIdx.x; asm volatile("" : "+v"(t)); return t; }
__device__ __forceinline__ float bf2f(bf16_t v) { return __uint_as_float(((unsigned)v) << 16); }
typedef float f32x2_t __attribute__((ext_vector_type(2))); typedef __bf16 bf16x2_t __attribute__((ext_vector_type(2)));
__device__ __forceinline__ unsigned pk2(float lo, float hi) { f32x2_t v = {lo, hi}; bf16x2_t b = __builtin_convertvector(v, bf16x2_t); return __builtin_bit_cast(unsigned, b); }
__device__ __forceinline__ bf16_t f2bf(float f) { return (bf16_t)(pk2(f, 0.f) & 0xffffu); }
__device__ __forceinline__ float wave_sum(float v) {
#pragma unroll
    for (int o = 1; o < 64; o <<= 1) v += __shfl_xor(v, o);
    return v;
}
__device__ __forceinline__ float siluf(float x) { return x / (1.f + __expf(-x)); }
__device__ __forceinline__ float softplusf(float x) { return fmaxf(x, 0.f) + log1pf(__expf(-fabsf(x))); }
__device__ __forceinline__ bf16_t* pblk(unsigned char* ws, int j) { return (bf16_t*)ws + (size_t)j * PBLK_ELEMS; }

namespace pg8 {
#define PG8_LAS __attribute__((address_space(3)))
constexpr int BM = 256, BK = 64, HALF = 128, HTB = HALF * BK * 2, STAGE_BYTES = 8 * HTB, NXCD = 8, WGM = 8;
__host__ __device__ __forceinline__ int lds_byte(int r, int c) { const int st = (r >> 4) * 2 + (c >> 5), rr = r & 15, cc = c & 31, ob = rr * 64 + cc * 2; return st * 1024 + (ob ^ (((ob >> 9) & 1) << 5)); }
__host__ __device__ __forceinline__ void stage_rc(int b, int& R, int& C) { const int st = b / 1024, sb = b % 1024, swz = sb ^ (((sb >> 9) & 1) << 5); R = (st >> 1) * 16 + swz / 64; C = (st & 1) * 32 + (swz % 64) / 2; }
__host__ __device__ __forceinline__ int perm32(int rho) { const int n = rho >> 4, i = rho & 15; return 8 * (i >> 2) + 4 * n + (i & 3); }
struct Unit { int pm, pn; };
struct Gemm { const bf16_t* A; const bf16_t* Bt; int M, N, K; int lda; size_t abig; };
struct StaticOrder {
    int nM, nN, nwg, G, c;
    __host__ __device__ void init(int M, int N, int G_, int c_) { nM = M / BM; nN = N / BM; nwg = nM * nN; G = G_; c = c_; }
    __host__ __device__ bool next(int i, Unit& u) const {
        const long L = (long)i * G + c; if (L >= nwg) return false;
        int wgid = (int)L; { const int q = nwg / NXCD, r = nwg % NXCD, xcd = wgid % NXCD, off = wgid / NXCD; wgid = (xcd < r ? xcd * (q + 1) : r * (q + 1) + (xcd - r) * q) + off; }
        const int nig = WGM * nN, gid = wgid / nig, fm = gid * WGM, gsz = (nM - fm) < WGM ? (nM - fm) : WGM;
        u.pm = fm + ((wgid % nig) % gsz); u.pn = (wgid % nig) / gsz; return true;
    }
};
template <class Epi, class Sched, bool ALIGN_EPI = false, bool SP2 = false>
__device__ __forceinline__ void gemm_phase(PG8_LAS unsigned char* lds, const Gemm g, const Sched& S, const Epi& E) {
    const int tid = otid(), wid = __builtin_amdgcn_readfirstlane(tid >> 6), lane = tid & 63, wr = wid >> 2, wc = wid & 3, fr = lane & 15, fq = lane >> 4;
    const int K = g.K, nt = K / BK;
    unsigned voffA[2], voffB[2];
#pragma unroll
    for (int i = 0; i < 2; ++i) { int R, C; stage_rc(tid * 16 + i * 8192, R, C); const int Rb = Epi::PERM ? ((R & ~31) + perm32(R & 31)) : R;
        voffA[i] = (unsigned)(R * g.lda + C) * 2u; voffB[i] = (unsigned)(Rb * K + C) * 2u; }
    const size_t kstep = (size_t)(BK * 2);
    const size_t abig = g.abig * 2;
    const size_t hstepA = (size_t)HALF * g.lda * 2, hstepB = (size_t)HALF * K * 2;
    const size_t tstepA = 2 * hstepA, tstepB = 2 * hstepB;
    const unsigned ldsw = (unsigned)wid * 1024u;
    const int aoff = lds_byte(wr * 64 + fr, fq * 8), boff = lds_byte(wc * 32 + fr, fq * 8);
#define PG8_SA(b, h) (((b) * 2 + (h)) * HTB)
#define PG8_SB(b, h) ((4 + (b) * 2 + (h)) * HTB)
#define PG8_STAGE(bufoff, gbase, voff) do { _Pragma("unroll") for (int _i = 0; _i < 2; ++_i) \
        __builtin_amdgcn_global_load_lds((const unsigned*)((const char*)(gbase) + (voff)[_i]), (PG8_LAS unsigned*)(lds + (bufoff) + ldsw + _i * 8192), 16, 0, 0); } while (0)
#define PG8_LDA(dst, b, h) do { _Pragma("unroll") for (int m = 0; m < 4; ++m) _Pragma("unroll") for (int k = 0; k < 2; ++k) dst[m][k] = *(const PG8_LAS bf16x8*)(lds + PG8_SA(b, h) + aoff + m * 2048 + k * 1024); } while (0)
#define PG8_LDB(dst, b, h) do { _Pragma("unroll") for (int n = 0; n < 2; ++n) _Pragma("unroll") for (int k = 0; k < 2; ++k) dst[n][k] = *(const PG8_LAS bf16x8*)(lds + PG8_SB(b, h) + boff + n * 2048 + k * 1024); } while (0)
#define PG8_MMA(ai, bj, At, Bt) do { __builtin_amdgcn_s_setprio(1); _Pragma("unroll") for (int m = 0; m < 4; ++m) _Pragma("unroll") for (int n = 0; n < 2; ++n) _Pragma("unroll") for (int k = 0; k < 2; ++k) \
        acc[ai][bj][m][n] = __builtin_amdgcn_mfma_f32_16x16x32_bf16(Bt[n][k], At[m][k], acc[ai][bj][m][n], 0, 0, 0); __builtin_amdgcn_s_setprio(0); } while (0)
#define PG8_WAIT_V(n) asm volatile("s_waitcnt vmcnt(" #n ")" ::: "memory")
#define PG8_WAIT_L(n) asm volatile("s_waitcnt lgkmcnt(" #n ")" ::: "memory")
#define PG8_BAR __builtin_amdgcn_s_barrier()
#define PG8_SCHED __builtin_amdgcn_sched_barrier(0)
    Unit cur, nxt; int ui = 0;
    if (!S.next(0, cur)) return;
    f32x4 acc[2][2][4][2];
#pragma unroll
    for (int a = 0; a < 2; ++a)
#pragma unroll
        for (int b = 0; b < 2; ++b)
#pragma unroll
            for (int m = 0; m < 4; ++m)
#pragma unroll
                for (int n = 0; n < 2; ++n) acc[a][b][m][n] = (f32x4){0.f, 0.f, 0.f, 0.f};
    bf16x8 At[4][2], B0[2][2], B1[2][2];
    const char* cA = (const char*)g.A + (size_t)cur.pm * tstepA; const char* cB = (const char*)g.Bt + (size_t)cur.pn * tstepB;
    if constexpr (SP2) {
        PG8_STAGE(PG8_SB(0, 0), cB, voffB); PG8_STAGE(PG8_SB(0, 1), cB + hstepB, voffB); PG8_STAGE(PG8_SA(0, 0), cA, voffA); PG8_STAGE(PG8_SA(0, 1), cA + hstepA, voffA);
        if (wr == 1) PG8_BAR;
        PG8_WAIT_V(2); PG8_BAR;
        PG8_STAGE(PG8_SB(1, 0), cB + kstep, voffB); PG8_STAGE(PG8_SA(1, 0), cA + kstep, voffA); PG8_STAGE(PG8_SB(1, 1), cB + hstepB + kstep, voffB);
        PG8_WAIT_V(6); PG8_BAR;
    } else {
        PG8_STAGE(PG8_SB(0, 0), cB, voffB); PG8_STAGE(PG8_SA(0, 0), cA, voffA); PG8_STAGE(PG8_SB(0, 1), cB + hstepB, voffB); PG8_STAGE(PG8_SA(0, 1), cA + hstepA, voffA);
        if (wr == 1) PG8_BAR;
        PG8_WAIT_V(4); PG8_BAR;
        PG8_STAGE(PG8_SB(1, 0), cB + kstep, voffB); PG8_STAGE(PG8_SA(1, 0), cA + kstep, voffA); PG8_STAGE(PG8_SB(1, 1), cB + hstepB + kstep, voffB);
        PG8_WAIT_V(6); PG8_BAR;
    }
    for (;;) {
        const bool has_next = S.next(ui + 1, nxt);
        const char* nA = has_next ? (const char*)g.A + (size_t)nxt.pm * tstepA : cA; const char* nB = has_next ? (const char*)g.Bt + (size_t)nxt.pn * tstepB : cB;
        for (int t = 0; t < nt; t += 2) {
            const bool last = (t == nt - 2);
            const char* a1 = cA + (size_t)(t >> 1) * abig + kstep;
            const char* a2 = last ? nA : cA + (size_t)((t >> 1) + 1) * abig; const char* b2 = last ? nB : cB + (size_t)(t + 2) * kstep;
            const char* a3 = a2 + kstep; const char* b3 = b2 + kstep;
            if constexpr (SP2) {
            PG8_LDB(B0, 0, 0); PG8_LDB(B1, 0, 1); PG8_SCHED; PG8_LDA(At, 0, 0); PG8_STAGE(PG8_SA(1, 1), a1 + hstepA, voffA);
            PG8_WAIT_V(8); PG8_WAIT_L(0); PG8_BAR; PG8_MMA(0, 0, At, B0); PG8_MMA(0, 1, At, B1); PG8_BAR; PG8_SCHED;
            PG8_LDA(At, 0, 1); PG8_STAGE(PG8_SB(0, 0), b2, voffB); PG8_STAGE(PG8_SB(0, 1), b2 + hstepB, voffB); PG8_STAGE(PG8_SA(0, 0), a2, voffA);
            PG8_WAIT_V(8); PG8_WAIT_L(0); PG8_BAR; PG8_MMA(1, 0, At, B0); PG8_MMA(1, 1, At, B1); PG8_BAR; PG8_SCHED;
            PG8_LDB(B0, 1, 0); PG8_LDB(B1, 1, 1); PG8_SCHED; PG8_LDA(At, 1, 0); PG8_STAGE(PG8_SA(0, 1), a2 + hstepA, voffA);
            PG8_WAIT_V(8); PG8_WAIT_L(0); PG8_BAR; PG8_MMA(0, 0, At, B0); PG8_MMA(0, 1, At, B1); PG8_BAR; PG8_SCHED;
            PG8_LDA(At, 1, 1); PG8_STAGE(PG8_SB(1, 0), b3, voffB); PG8_STAGE(PG8_SB(1, 1), b3 + hstepB, voffB); PG8_STAGE(PG8_SA(1, 0), a3, voffA);
            PG8_WAIT_V(8); PG8_WAIT_L(0); PG8_BAR; PG8_MMA(1, 0, At, B0); PG8_MMA(1, 1, At, B1); PG8_BAR; PG8_SCHED;
            } else {
            PG8_LDB(B0, 0, 0); PG8_SCHED; PG8_LDA(At, 0, 0); PG8_STAGE(PG8_SA(1, 1), a1 + hstepA, voffA);
            PG8_WAIT_L(8); PG8_BAR; PG8_WAIT_L(0); PG8_MMA(0, 0, At, B0); PG8_BAR; PG8_SCHED;
            PG8_LDB(B1, 0, 1); PG8_STAGE(PG8_SB(0, 0), b2, voffB);
            PG8_BAR; PG8_WAIT_L(0); PG8_MMA(0, 1, At, B1); PG8_BAR;
            PG8_LDA(At, 0, 1); PG8_STAGE(PG8_SA(0, 0), a2, voffA);
            PG8_BAR; PG8_WAIT_L(0); PG8_MMA(1, 0, At, B0); PG8_BAR; PG8_SCHED;
            PG8_STAGE(PG8_SB(0, 1), b2 + hstepB, voffB);
            PG8_WAIT_V(6); PG8_BAR; PG8_MMA(1, 1, At, B1); PG8_BAR;
            PG8_LDB(B0, 1, 0); PG8_SCHED; PG8_LDA(At, 1, 0); PG8_STAGE(PG8_SA(0, 1), a2 + hstepA, voffA);
            PG8_WAIT_L(8); PG8_BAR; PG8_WAIT_L(0); PG8_MMA(0, 0, At, B0); PG8_BAR; PG8_SCHED;
            PG8_LDB(B1, 1, 1); PG8_STAGE(PG8_SB(1, 0), b3, voffB);
            PG8_BAR; PG8_WAIT_L(0); PG8_MMA(0, 1, At, B1); PG8_BAR;
            PG8_LDA(At, 1, 1); PG8_STAGE(PG8_SA(1, 0), a3, voffA);
            PG8_BAR; PG8_WAIT_L(0); PG8_MMA(1, 0, At, B0); PG8_BAR; PG8_SCHED;
            PG8_STAGE(PG8_SB(1, 1), b3 + hstepB, voffB);
            PG8_WAIT_V(6); PG8_BAR; PG8_MMA(1, 1, At, B1); PG8_BAR;
            }
        }
        if constexpr (ALIGN_EPI) { if (wr == 0) PG8_BAR; }
        E(acc, cur, wr, wc, fr, fq);
        if (!has_next) break;
#pragma unroll
        for (int a = 0; a < 2; ++a)
#pragma unroll
            for (int b = 0; b < 2; ++b)
#pragma unroll
                for (int m = 0; m < 4; ++m)
#pragma unroll
                    for (int n = 0; n < 2; ++n) acc[a][b][m][n] = (f32x4){0.f, 0.f, 0.f, 0.f};
        cur = nxt; cA = nA; cB = nB; ++ui;
        if constexpr (ALIGN_EPI) { if (wr == 1) PG8_BAR; }
    }
    PG8_WAIT_V(0);
    if constexpr (!ALIGN_EPI) { if (wr == 0) PG8_BAR; }
    PG8_BAR;
#undef PG8_SA
#undef PG8_SB
#undef PG8_STAGE
#undef PG8_LDA
#undef PG8_LDB
#undef PG8_MMA
#undef PG8_WAIT_V
#undef PG8_WAIT_L
#undef PG8_BAR
#undef PG8_SCHED
}
struct EpiProj {
    static constexpr bool PERM = true;
    bf16_t* P; const float* rowscale; float* dtbuf;
    __device__ __forceinline__ void operator()(const f32x4 (&acc)[2][2][4][2], const Unit& u, int wr, int wc, int fr, int fq) const {
        const int row0 = u.pm * BM + wr * 64 + fr; const int col = wc * 32 + 8 * fq;
#pragma unroll
        for (int ai = 0; ai < 2; ++ai)
#pragma unroll
            for (int m = 0; m < 4; ++m) { const int row = row0 + ai * HALF + m * 16; const float sc = rowscale[row];
#pragma unroll
                for (int bj = 0; bj < 2; ++bj) { const int blk = u.pn * 2 + bj;
                    const f32x4 v0 = acc[ai][bj][m][0] * sc, v1 = acc[ai][bj][m][1] * sc;
                    u32x4 w; w.x = pk2(v0[0], v0[1]); w.y = pk2(v0[2], v0[3]); w.z = pk2(v1[0], v1[1]); w.w = pk2(v1[2], v1[3]);
                    *(u32x4*)(P + (size_t)blk * PBLK_ELEMS + (size_t)row * 128 + col) = w;
                    if (blk == PB_DT && col < 16) { float* d = dtbuf + (size_t)row * 16 + col; *(f32x4*)d = v0; *(f32x4*)(d + 4) = v1; } } }
    }
};
struct EpiMix {
    static constexpr bool PERM = true;
    float* O;
    __device__ __forceinline__ void operator()(const f32x4 (&acc)[2][2][4][2], const Unit& u, int wr, int wc, int fr, int fq) const {
        const int row0 = u.pm * BM + wr * 64 + fr; const int col0 = u.pn * BM + wc * 32 + 8 * fq;
#pragma unroll
        for (int ai = 0; ai < 2; ++ai)
#pragma unroll
            for (int m = 0; m < 4; ++m) { float* rp = O + (size_t)(row0 + ai * HALF + m * 16) * DMODEL + col0;
#pragma unroll
                for (int bj = 0; bj < 2; ++bj) { *(f32x4*)(rp + bj * HALF) = acc[ai][bj][m][0]; *(f32x4*)(rp + bj * HALF + 4) = acc[ai][bj][m][1]; } }
    }
};
}

__device__ __forceinline__ int orig_col(int n) {
    if (n < 512) return n;
    if (n < 1024) return 3216 + (n - 512);
    if (n < 1536) return 3728 + (n - 1024);
    if (n < 2048) return 5776 + (n - 1536);
    if (n < 3072) return 512 + (n - 2048);
    if (n < 4736) return 1552 + (n - 3072);
    if (n < 5248) return 4240 + (n - 4736);
    if (n < 5760) return 4752 + (n - 5248);
    if (n < 6272) return 5264 + (n - 5760);
    if (n < 6528) return 6288 + (n - 6272);
    if (n < 6784) return 6544 + (n - 6528);
    if (n < 7296) return 6800 + (n - 6784);
    if (n < 7312) return 1536 + (n - 7296);
    return -1;
}
struct TrItem { const float* W; const float* ks; bf16_t* WT; int K, Nsrc, k0, n0; bool mapcol; };
__device__ __forceinline__ TrItem tr_item(const Params& p, int it) {
    constexpr int I_IN = 16 * 29, I_OUT = 32 * 4;
    TrItem t; int r = it; const int l = r / (I_IN + I_OUT); r -= l * (I_IN + I_OUT);
    if (r < I_IN) { t.W = p.in[3] + (size_t)l * DMODEL * DIN_ORIG; t.ks = p.in[1] + l * DMODEL; t.WT = (bf16_t*)(g_scr + SCR_WIN + (size_t)l * 15 * MiB); t.K = DMODEL; t.Nsrc = DIN_ORIG; t.k0 = (r / 29) * 64; t.n0 = (r % 29) * 256; t.mapcol = true; }
    else { r -= I_IN; t.W = p.in[4] + (size_t)l * DMIX * DMODEL; t.ks = nullptr; t.WT = (bf16_t*)(g_scr + SCR_WOUT + (size_t)l * 4 * MiB); t.K = DMIX; t.Nsrc = DMODEL; t.k0 = (r / 4) * 64; t.n0 = (r % 4) * 256; t.mapcol = false; }
    return t;
}
__device__ __forceinline__ void tr_load(const TrItem& t, int tid, float* v) {
    const int nn = tid & 63;
#pragma unroll
    for (int q = 0; q < 4; ++q) { const int n = t.n0 + 64 * q + nn; const int oc = t.mapcol ? orig_col(n) : n;
#pragma unroll
        for (int i = 0; i < 8; ++i) { const int kk = (tid >> 6) + 8 * i; v[q * 8 + i] = (oc >= 0) ? t.W[(size_t)(t.k0 + kk) * t.Nsrc + oc] * (t.ks ? t.ks[t.k0 + kk] : 1.f) : 0.f; } }
}
__device__ __forceinline__ void rope_entry(int idx, float* tab) {
    const int pos = idx >> 5, i = idx & 31;
    const float inv = exp2f(-(float)i * (13.287712379549449f / 32.f));
    const float ang = (float)pos * inv;
    const double rev = (double)ang * 0.15915494309189535; const double fr = rev - floor(rev);
    const float a = (float)(fr * 6.283185307179586);
    tab[idx * 2] = cosf(a); tab[idx * 2 + 1] = sinf(a);
}
__device__ __forceinline__ void xrow_to_bf16(const float* xrow, bf16_t* orow, float* rs, int lane) {
    const f32x4* xr = (const f32x4*)xrow + lane; f32x4 v[4]; float s = 0.f;
#pragma unroll
    for (int j = 0; j < 4; ++j) { v[j] = xr[64 * j]; s += (v[j].x * v[j].x + v[j].y * v[j].y) + (v[j].z * v[j].z + v[j].w * v[j].w); }
    s = wave_sum(s);
    if (lane == 0) *rs = rsqrtf(s * (1.f / DMODEL) + NORM_EPS);
    u32x2* o8 = (u32x2*)orow + lane;
#pragma unroll
    for (int j = 0; j < 4; ++j) { u32x2 w; w.x = pk2(v[j].x, v[j].y); w.y = pk2(v[j].z, v[j].w); o8[64 * j] = w; }
}
__device__ __forceinline__ void phase_prologue(const Params& p, float* lds_f) {
    const int G = gridDim.x, bid = blockIdx.x, tid = otid(), lane = tid & 63, wave = tid >> 6;
    {   constexpr int NIT = 2 * (16 * 29 + 32 * 4);
        float v[32], v2[32]; int it = bid; TrItem cur = tr_item(p, it < NIT ? it : 0);
        if (it < NIT) tr_load(cur, tid, v);
        while (it < NIT) {
            const int nn = tid & 63;
#pragma unroll
            for (int q = 0; q < 4; ++q)
#pragma unroll
                for (int i = 0; i < 8; ++i) lds_f[q * 4160 + ((tid >> 6) + 8 * i) * 65 + nn] = v[q * 8 + i];
            const int nx = it + G; TrItem nxt = tr_item(p, nx < NIT ? nx : 0);
            if (nx < NIT) tr_load(nxt, tid, v2);
            __syncthreads();
#pragma unroll
            for (int q = 0; q < 4; ++q) { const int n = tid >> 3, c = tid & 7; const float* s = lds_f + q * 4160 + (8 * c) * 65 + n;
                u32x4 o; o.x = pk2(s[0], s[65]); o.y = pk2(s[2 * 65], s[3 * 65]); o.z = pk2(s[4 * 65], s[5 * 65]); o.w = pk2(s[6 * 65], s[7 * 65]);
                *(u32x4*)(cur.WT + (size_t)(cur.n0 + 64 * q + n) * cur.K + cur.k0 + 8 * c) = o; }
            __syncthreads();
#pragma unroll
            for (int i = 0; i < 32; ++i) v[i] = v2[i];
            cur = nxt; it = nx;
        }
    }
    if (bid == 0) { ((unsigned*)(g_scr + SCR_CTL))[tid] = 0u; ((unsigned*)(g_scr + SCR_CTL))[512 + tid] = 0u; }
    for (int i = bid * 512 + tid; i < SEQ * 32; i += G * 512) rope_entry(i, (float*)(g_scr + SCR_ROPE));
    for (int m = bid * 8 + wave; m < M_TOK; m += G * 8) xrow_to_bf16(p.in[0] + (size_t)m * DMODEL, (bf16_t*)(g_scr + SCR_XB) + (size_t)m * DMODEL, (float*)(g_scr + SCR_RS) + m, lane);
}

__device__ __forceinline__ void unpack8(const bf16x8 v, float* x) {
#pragma unroll
    for (int e = 0; e < 8; ++e) x[e] = bf2f((bf16_t)v[e]);
}
__device__ __forceinline__ u32x4 pack8(const float* x) { u32x4 o; o.x = pk2(x[0], x[1]); o.y = pk2(x[2], x[3]); o.z = pk2(x[4], x[5]); o.w = pk2(x[6], x[7]); return o; }
__device__ __forceinline__ void rope8(float* x, const float* cs, const bool upper) {
#pragma unroll
    for (int e = 0; e < 8; ++e) { const float o = __shfl_xor(x[e], 4); x[e] = upper ? (x[e] * cs[2 * e] + o * cs[2 * e + 1]) : (x[e] * cs[2 * e] - o * cs[2 * e + 1]); }
}
__device__ __forceinline__ void phase_prep(const Params& p, const int l) {
    const int G = gridDim.x;
    {   const int tid = otid(), lane = tid & 63, wave = tid >> 6;
        bf16x8 cv[5], nv_[5];
#define CONV_LOAD(dst, it_) do { const int m_ = (it_) >> 1, t_ = m_ & (SEQ - 1); const int ch_ = ((it_) & 1) * 512 + lane * 8; const bf16_t* src_ = pblk(p.ws, PB_XS + (ch_ >> 7)) + (ch_ & 127); \
            _Pragma("unroll") for (int jj = 0; jj < 5; ++jj) { const int tt = t_ + jj - 2; const bool ok = tt >= 0 && tt < SEQ; dst[jj] = ok ? *(const bf16x8*)(src_ + ((size_t)(m_ - t_ + tt)) * 128) : (bf16x8){0, 0, 0, 0, 0, 0, 0, 0}; } } while (0)
        int it = blockIdx.x * 8 + wave;
        if (it < M_TOK * 2) CONV_LOAD(cv, it);
        for (; it < M_TOK * 2; it += G * 8) {
            const int m = it >> 1, half = it & 1;
            const int ch = half * 512 + lane * 8;
            const float* cw = p.in[5] + (size_t)l * 5 * 1024 + ch; const float* cb = p.in[6] + (size_t)l * 1024 + ch;
            if (it + G * 8 < M_TOK * 2) CONV_LOAD(nv_, it + G * 8);
            float acc[8]; { const f32x4 b0 = *(const f32x4*)cb, b1 = *(const f32x4*)(cb + 4);
#pragma unroll
              for (int e = 0; e < 4; ++e) { acc[e] = b0[e]; acc[4 + e] = b1[e]; } }
#pragma unroll
            for (int jj = 0; jj < 5; ++jj) { const f32x4 w0 = *(const f32x4*)(cw + jj * 1024), w1 = *(const f32x4*)(cw + jj * 1024 + 4);
#pragma unroll
                for (int e = 0; e < 4; ++e) { acc[e] += w0[e] * bf2f((bf16_t)cv[jj][e]); acc[4 + e] += w1[e] * bf2f((bf16_t)cv[jj][4 + e]); } }
#pragma unroll
            for (int e = 0; e < 8; ++e) acc[e] = siluf(acc[e]);
            *(u32x4*)((bf16_t*)(g_scr + SCR_XACT) + (size_t)m * 1024 + ch) = pack8(acc);
#pragma unroll
            for (int jj = 0; jj < 5; ++jj) cv[jj] = nv_[jj];
        }
#undef CONV_LOAD
    }
    const int tid = otid(), lane = tid & 63, wave = tid >> 6;
    const float* tab = (const float*)(g_scr + SCR_ROPE);
    const int hh = lane >> 4, c16 = lane & 15, j8 = (c16 & 7) * 8, fi = j8 & 31; const bool upper = j8 >= 32, second = c16 >= 8;
    float kw[8];
#pragma unroll
    for (int e = 0; e < 8; ++e) kw[e] = p.in[24][l * 128 + c16 * 8 + e];
    float* kpart = (float*)(g_scr + SCR_KPART); const int gwv = blockIdx.x * 8 + wave;
    float mxd = 0.f, mxg = 0.f; int curb = (blockIdx.x * 8 + wave) >> 13;
    bf16x8 vdk, vgk, ndk, ngk; float cst[16], csa[16], nst[16], nsa[16];
#define QK_LOAD(m_, dk_, gk_, st_, sa_) do { const int t_ = (m_) & (SEQ - 1); const int row_ = t_ >> 6, col_ = t_ & 63; \
        dk_ = *(const bf16x8*)(pblk(p.ws, PB_DK + hh) + (size_t)(m_) * 128 + c16 * 8); gk_ = *(const bf16x8*)(pblk(p.ws, PB_GK + (hh & 1)) + (size_t)(m_) * 128 + c16 * 8); \
        const f32x4* a_ = (const f32x4*)(tab + ((size_t)t_ * 32 + fi) * 2); const f32x4* b_ = (const f32x4*)(tab + ((size_t)(second ? col_ : row_) * 32 + fi) * 2); \
        _Pragma("unroll") for (int i_ = 0; i_ < 4; ++i_) { const f32x4 u_ = a_[i_], v_ = b_[i_]; _Pragma("unroll") for (int e_ = 0; e_ < 4; ++e_) { st_[4 * i_ + e_] = u_[e_]; sa_[4 * i_ + e_] = v_[e_]; } } } while (0)
    {   const int m0 = blockIdx.x * 8 + wave; if (m0 < M_TOK) QK_LOAD(m0, vdk, vgk, cst, csa); }
    for (int m = blockIdx.x * 8 + wave; m < M_TOK; m += G * 8) {
        if ((m >> 13) != curb) {
            if ((lane & 7) == 0) { kpart[((size_t)(l * 2 + curb) * 10 + hh * 2 + (c16 >> 3)) * 2048 + gwv] = mxd; if (lane < 32 && c16 == 0) kpart[((size_t)(l * 2 + curb) * 10 + 8 + hh) * 2048 + gwv] = mxg; }
            mxd = 0.f; mxg = 0.f; curb = m >> 13; }
        bf16_t* pdk = pblk(p.ws, PB_DK + hh) + (size_t)m * 128 + c16 * 8; bf16_t* pgk = pblk(p.ws, PB_GK + (hh & 1)) + (size_t)m * 128 + c16 * 8;
        if (m + G * 8 < M_TOK) QK_LOAD(m + G * 8, ndk, ngk, nst, nsa);
        float x[8];
        unpack8(vdk, x);
        { float s2 = 0.f;
#pragma unroll
          for (int e = 0; e < 8; ++e) s2 += x[e] * x[e];
          s2 += __shfl_xor(s2, 1); s2 += __shfl_xor(s2, 2); s2 += __shfl_xor(s2, 4); mxd = fmaxf(mxd, s2); }
        rope8(x, cst, upper); const u32x4 odk = pack8(x);
        float ss;
        unpack8(vgk, x); ss = 0.f;
#pragma unroll
        for (int e = 0; e < 8; ++e) ss += x[e] * x[e];
        ss += __shfl_xor(ss, 1); ss += __shfl_xor(ss, 2); ss += __shfl_xor(ss, 4); ss += __shfl_xor(ss, 8);
        { const float rs = rsqrtf(ss * (1.f / 128.f) + NORM_EPS);
#pragma unroll
          for (int e = 0; e < 8; ++e) x[e] *= rs * kw[e]; }
        { float s2 = 0.f;
#pragma unroll
          for (int e = 0; e < 8; ++e) s2 += x[e] * x[e];
          s2 += __shfl_xor(s2, 1); s2 += __shfl_xor(s2, 2); s2 += __shfl_xor(s2, 4); s2 += __shfl_xor(s2, 8); mxg = fmaxf(mxg, s2); }
        rope8(x, csa, upper); const u32x4 ogk = pack8(x);
        *(u32x4*)pdk = odk; if (lane < 32) *(u32x4*)pgk = ogk;
        vdk = ndk; vgk = ngk;
#pragma unroll
        for (int e = 0; e < 16; ++e) { cst[e] = nst[e]; csa[e] = nsa[e]; }
    }
#undef QK_LOAD
    if ((lane & 7) == 0) { kpart[((size_t)(l * 2 + curb) * 10 + hh * 2 + (c16 >> 3)) * 2048 + gwv] = mxd; if (lane < 32 && c16 == 0) kpart[((size_t)(l * 2 + curb) * 10 + 8 + hh) * 2048 + gwv] = mxg; }
}

__device__ __forceinline__ void kmax_reduce(const int l, float* lds_f) {
    if (blockIdx.x < 20) {
        const int b = blockIdx.x / 10, slot = blockIdx.x % 10, tid = threadIdx.x;
        const float* src = (const float*)(g_scr + SCR_KPART) + ((size_t)(l * 2 + b) * 10 + slot) * 2048;
        float v = fmaxf(fmaxf(src[tid], src[512 + tid]), fmaxf(src[1024 + tid], src[1536 + tid]));
#pragma unroll
        for (int o = 1; o < 64; o <<= 1) v = fmaxf(v, __shfl_xor(v, o));
        if ((tid & 63) == 0) lds_f[tid >> 6] = v;
        __syncthreads();
        if (tid == 0) { float m = lds_f[0];
#pragma unroll
            for (int i = 1; i < 8; ++i) m = fmaxf(m, lds_f[i]);
            ((float*)(g_scr + SCR_CTL))[256 + 64 * l + (slot < 8 ? b * 8 + slot : 16 + b * 2 + (slot - 8))] = m; }
        __syncthreads();
    }
}

namespace att {
using s16x4 = __attribute__((ext_vector_type(4))) short;
using f32x16 = __attribute__((ext_vector_type(16))) float;
constexpr int D = 128, NW = 8, QBLK = 32, KVBLK = 64, LD = 128;
constexpr float THR = 8.f;
constexpr size_t SHM_V = KVBLK * D * 2, SHM_K = KVBLK * D * 2, SHM_ATTN = 2 * SHM_V + 2 * SHM_K + NW * 64 * 4;
#define KSWZ(row, colB) ((row) * 256 + ((colB) ^ (((row) & 7) << 4)))
#define SBAR() __builtin_amdgcn_sched_barrier(0)
__device__ __forceinline__ int crow(int r, int hi) { return (r & 3) + 8 * (r >> 2) + 4 * hi; }
__device__ __forceinline__ unsigned cvtpk(float lo, float hi) { unsigned r; asm volatile("v_cvt_pk_bf16_f32 %0, %1, %2" : "=v"(r) : "v"(lo), "v"(hi)); return r; }
__device__ __forceinline__ void glds16(const void* gsrc, unsigned lds_dst) {
  __builtin_amdgcn_global_load_lds((const unsigned*)gsrc, (PG8_LAS unsigned*)(uintptr_t)lds_dst, 16, 0, 0); }
template <int DIFF>
__device__ __forceinline__ void partialSM(f32x16& p0, f32x16& p1, const float mnC) {
  _Pragma("unroll") for (int r = 0; r < 16; ++r) p0[r] = __builtin_amdgcn_exp2f(p0[r]);
}
__device__ __forceinline__ void finishSM(f32x16& p0, f32x16& p1, float& l_reg, bf16x8& pa0, bf16x8& pa1, bf16x8& pa2, bf16x8& pa3) {
  _Pragma("unroll") for (int r = 0; r < 16; ++r) p1[r] = __builtin_amdgcn_exp2f(p1[r]);
  float ps = 0; _Pragma("unroll") for (int r = 0; r < 16; ++r) ps += p0[r]; _Pragma("unroll") for (int r = 0; r < 16; ++r) ps += p1[r];
  { auto rr = __builtin_amdgcn_permlane32_swap(__float_as_uint(ps), __float_as_uint(ps), false, false);
    ps = __uint_as_float(rr[0]) + __uint_as_float(rr[1]); }
  l_reg += ps;
#define PK4(P, BASE, OUT) do { unsigned a0 = cvtpk(P[BASE + 0], P[BASE + 1]), a1 = cvtpk(P[BASE + 2], P[BASE + 3]);   \
    unsigned b0 = cvtpk(P[BASE + 4], P[BASE + 5]), b1 = cvtpk(P[BASE + 6], P[BASE + 7]);                              \
    auto r0 = __builtin_amdgcn_permlane32_swap(a0, b0, false, false); auto r1 = __builtin_amdgcn_permlane32_swap(a1, b1, false, false); \
    u32x4 w = {r0[0], r1[0], r0[1], r1[1]}; OUT = *reinterpret_cast<bf16x8*>(&w); } while (0)
  PK4(p0, 0, pa0); PK4(p0, 8, pa1); PK4(p1, 0, pa2); PK4(p1, 8, pa3);
#undef PK4
}
template <int ND0>
__device__ __forceinline__ void qkt(f32x16& p0, f32x16& p1, const bf16_t* Ks, const bf16x8* qr, int r32, int hi, int db0, const f32x16& init) {
  p0 = init; p1 = init;
  _Pragma("unroll") for (int d0 = 0; d0 < ND0; ++d0) { int cb = ((db0 + d0) * 16 + hi * 8) * 2;
    bf16x8 b0 = *reinterpret_cast<const bf16x8*>((const char*)Ks + KSWZ(r32, cb));
    bf16x8 b1 = *reinterpret_cast<const bf16x8*>((const char*)Ks + KSWZ(32 + r32, cb));
    p0 = __builtin_amdgcn_mfma_f32_32x32x16_bf16(b0, qr[d0], p0, 0, 0, 0);
    p1 = __builtin_amdgcn_mfma_f32_32x32x16_bf16(b1, qr[d0], p1, 0, 0, 0); }
}
__device__ __forceinline__ int v_st(int k, int c) { const int kk = (k & ~0xC) | ((k & 4) << 1) | ((k & 8) >> 1); return ((kk >> 3) * 4 + (c >> 5)) * 512 + ((kk & 7) * 32 + (c & 31)) * 2; }
__device__ __forceinline__ int v_rd_base(int lane) { return ((lane & 3) << 3) | (((lane >> 2) & 3) << 6) | (((lane >> 4) & 1) << 5) | (((lane >> 5) & 1) << 8); }
constexpr int v_rd_off(int d0, int ks, int half) { return d0 * 512 + ks * 4096 + half * 2048; }
template <int OFF> __device__ __forceinline__ s16x4 tr_read(int vb) {
  s16x4 r; asm volatile("ds_read_b64_tr_b16 %0, %1 offset:%2" : "=&v"(r) : "v"(vb), "i"(OFF) : "memory"); return r;
}
template <int D0> __device__ __forceinline__ void pv_one(f32x16& od, int vb, bf16x8 pa0, bf16x8 pa1, bf16x8 pa2, bf16x8 pa3) {
  const s16x4 l0 = tr_read<v_rd_off(D0, 0, 0)>(vb), h0 = tr_read<v_rd_off(D0, 0, 1)>(vb), l1 = tr_read<v_rd_off(D0, 1, 0)>(vb), h1 = tr_read<v_rd_off(D0, 1, 1)>(vb);
  const s16x4 l2 = tr_read<v_rd_off(D0, 2, 0)>(vb), h2 = tr_read<v_rd_off(D0, 2, 1)>(vb), l3 = tr_read<v_rd_off(D0, 3, 0)>(vb), h3 = tr_read<v_rd_off(D0, 3, 1)>(vb);
  asm volatile("s_waitcnt lgkmcnt(0)" ::: "memory"); SBAR();
#define PK(L, H) (bf16x8){L[0], L[1], L[2], L[3], H[0], H[1], H[2], H[3]}
  od = __builtin_amdgcn_mfma_f32_32x32x16_bf16(pa0, PK(l0, h0), od, 0, 0, 0);
  od = __builtin_amdgcn_mfma_f32_32x32x16_bf16(pa1, PK(l1, h1), od, 0, 0, 0);
  od = __builtin_amdgcn_mfma_f32_32x32x16_bf16(pa2, PK(l2, h2), od, 0, 0, 0);
  od = __builtin_amdgcn_mfma_f32_32x32x16_bf16(pa3, PK(l3, h3), od, 0, 0, 0);
#undef PK
}
__device__ __forceinline__ void pv_d0(f32x16* o, int vb, bf16x8 pa0, bf16x8 pa1, bf16x8 pa2, bf16x8 pa3) {
  pv_one<0>(o[0], vb, pa0, pa1, pa2, pa3); pv_one<1>(o[1], vb, pa0, pa1, pa2, pa3); pv_one<2>(o[2], vb, pa0, pa1, pa2, pa3); pv_one<3>(o[3], vb, pa0, pa1, pa2, pa3);
}
template <int DIFF>
__device__ __forceinline__ void attn_unit(const bf16_t* Qb, const bf16_t* __restrict__ Kh, const bf16_t* __restrict__ Vh, bf16_t* Ob, const bf16_t* gate,
                                          int seq, char* lds, const float* lamp, int layer, const float* nw, const float* kmax2p, const int tpos0, const float* qnw, unsigned* splc = nullptr, float* splp = nullptr) {
  constexpr int ND0 = DIFF ? 4 : 8;
  constexpr float CQ = (DIFF ? 0.125f : 0.088388347648318440f) * 1.4426950408889634f;
  const int tid = otid(), wid = tid >> 6, lane = tid & 63, r32 = lane & 31, hi = lane >> 5;
  const int wq = DIFF ? (wid & 3) : wid, mapc = DIFF ? (wid >> 2) : 0;
  constexpr int RSTG = 32768, RK = 16384, E_ST = 67584, E_WS = 137216;
  float* li_l = (float*)(lds + E_WS) + wid * 64;
  float l_reg = 0; f32x16 o[4] = {}; bf16x8 qr[ND0];
  const bf16_t* Qw = Qb + (long)(wq * QBLK + r32) * LD + mapc * 64 + hi * 8;
  {
      const float* tab = (const float*)(g_scr + SCR_ROPE);
      const int trow = tpos0 + wq * QBLK + r32;
      float qf[ND0][8];
      _Pragma("unroll") for (int d0 = 0; d0 < ND0; ++d0) { const bf16x8 raw = *reinterpret_cast<const bf16x8*>(Qw + d0 * 16); _Pragma("unroll") for (int e = 0; e < 8; ++e) qf[d0][e] = bf2f((bf16_t)raw[e]) * (DIFF ? CQ : 1.f); }
      if constexpr (!DIFF) {
        float ss = 0.f;
        _Pragma("unroll") for (int d0 = 0; d0 < ND0; ++d0) _Pragma("unroll") for (int e = 0; e < 8; ++e) ss += qf[d0][e] * qf[d0][e];
        { auto rr = __builtin_amdgcn_permlane32_swap(__float_as_uint(ss), __float_as_uint(ss), false, false); ss = __uint_as_float(rr[0]) + __uint_as_float(rr[1]); }
        const float rs = rsqrtf(ss * (1.f / 128.f) + NORM_EPS) * CQ;
        _Pragma("unroll") for (int d0 = 0; d0 < ND0; ++d0) { const f32x4 w0 = *(const f32x4*)(qnw + d0 * 16 + hi * 8), w1 = *(const f32x4*)(qnw + d0 * 16 + hi * 8 + 4);
          _Pragma("unroll") for (int e = 0; e < 4; ++e) { qf[d0][e] *= rs * w0[e]; qf[d0][4 + e] *= rs * w1[e]; } }
      }
      _Pragma("unroll") for (int hb = 0; hb < ND0 / 4; ++hb) {
        const int pos = DIFF ? trow : (hb == 0 ? (trow >> 6) : (trow & 63));
        _Pragma("unroll") for (int dl = 0; dl < 2; ++dl) { const int d0 = hb * 4 + dl; const float* cp = tab + ((size_t)pos * 32 + dl * 16 + hi * 8) * 2; float cs[16];
          _Pragma("unroll") for (int i = 0; i < 4; ++i) { const f32x4 u_ = ((const f32x4*)cp)[i]; _Pragma("unroll") for (int e = 0; e < 4; ++e) cs[4 * i + e] = u_[e]; }
          _Pragma("unroll") for (int e = 0; e < 8; ++e) { const float x1 = qf[d0][e], x2 = qf[d0 + 2][e]; qf[d0][e] = x1 * cs[2 * e] - x2 * cs[2 * e + 1]; qf[d0 + 2][e] = x2 * cs[2 * e] + x1 * cs[2 * e + 1]; } } }
      _Pragma("unroll") for (int d0 = 0; d0 < ND0; ++d0) { u32x4 w_; w_.x = pk2(qf[d0][0], qf[d0][1]); w_.y = pk2(qf[d0][2], qf[d0][3]); w_.z = pk2(qf[d0][4], qf[d0][5]); w_.w = pk2(qf[d0][6], qf[d0][7]); qr[d0] = *reinterpret_cast<bf16x8*>(&w_); }
  }
  float mnC;
  { float qn2 = 0.f;
    _Pragma("unroll") for (int d0 = 0; d0 < ND0; ++d0) _Pragma("unroll") for (int e = 0; e < 8; ++e) { const float q = bf2f((bf16_t)qr[d0][e]); qn2 += q * q; }
    { auto rr = __builtin_amdgcn_permlane32_swap(__float_as_uint(qn2), __float_as_uint(qn2), false, false); qn2 = __uint_as_float(rr[0]) + __uint_as_float(rr[1]); }
    const float km2 = kmax2p[DIFF ? mapc : 0];
    mnC = -(sqrtf(qn2 * km2) * 1.02f + 1e-3f * CQ); }
  f32x16 mnv; _Pragma("unroll") for (int r = 0; r < 16; ++r) mnv[r] = mnC;
  unsigned ksrc[2], vsrc[2];
  _Pragma("unroll") for (int i = 0; i < 2; ++i) { const int pc = 2 * wid + i;
    { const int row = 4 * pc + (lane >> 4); ksrc[i] = (unsigned)(row * 256 + (((lane & 15) ^ (row & 7)) << 4)); }
    { const int st = 2 * pc + (lane >> 5), l5 = lane & 31, kk = (st >> 2) * 8 + (l5 >> 2), k = (kk & ~0xC) | ((kk & 4) << 1) | ((kk & 8) >> 1); vsrc[i] = (unsigned)(k * 256 + ((st & 3) * 32 + (l5 & 3) * 8) * 2); } }
  const unsigned ldsb = (unsigned)(uintptr_t)lds + (unsigned)__builtin_amdgcn_readfirstlane(wid) * 2048u;
  const int vb0 = (int)(uintptr_t)lds + v_rd_base(lane);
#define DMA(k0, so) do { const char* kt_ = (const char*)Kh + (size_t)(k0) * 256; const char* vt_ = (const char*)Vh + (size_t)(k0) * 256; const unsigned d_ = ldsb + (unsigned)(so); \
    glds16(vt_ + vsrc[0], (unsigned)__builtin_amdgcn_readfirstlane(d_)); glds16(vt_ + vsrc[1], (unsigned)__builtin_amdgcn_readfirstlane(d_ + 1024u)); \
    glds16(kt_ + ksrc[0], (unsigned)__builtin_amdgcn_readfirstlane(d_ + (unsigned)RK)); glds16(kt_ + ksrc[1], (unsigned)__builtin_amdgcn_readfirstlane(d_ + (unsigned)RK + 1024u)); } while (0)
#define DWAIT() asm volatile("s_waitcnt vmcnt(0)" ::: "memory")
  f32x16 p0, p1; bf16x8 pa0, pa1, pa2, pa3; int NT = seq / KVBLK; asm volatile("" : "+s"(NT));
  const bool odd = __builtin_amdgcn_readfirstlane(wid) >= 4;
  int kad[4];
  _Pragma("unroll") for (int i = 0; i < 4; ++i) kad[i] = (int)(uintptr_t)lds + RK + KSWZ(r32, ((mapc * 4 + i) * 16 + hi * 8) * 2);
#define BAR() do { SBAR(); __builtin_amdgcn_s_barrier(); SBAR(); } while (0)
#define LWAIT4(N, A, B, C, Dd) asm volatile("s_waitcnt lgkmcnt(%4)" : "+v"(A), "+v"(B), "+v"(C), "+v"(Dd) : "n"(N))
#define LWAIT2(N, A, B) asm volatile("s_waitcnt lgkmcnt(%2)" : "+v"(A), "+v"(B) : "n"(N))
#define PK(L, H) (bf16x8){L[0], L[1], L[2], L[3], H[0], H[1], H[2], H[3]}
#define VRD(N, D0, KP, VB) N##a = tr_read<v_rd_off(D0, 2 * KP, 0)>(VB); N##b = tr_read<v_rd_off(D0, 2 * KP, 1)>(VB); N##c = tr_read<v_rd_off(D0, 2 * KP + 1, 0)>(VB); N##d = tr_read<v_rd_off(D0, 2 * KP + 1, 1)>(VB)
#define VDECL(N) s16x4 N##a, N##b, N##c, N##d
#define VMM(N, D0, PA, PB, W) LWAIT4(W, N##a, N##b, N##c, N##d); o[D0] = __builtin_amdgcn_mfma_f32_32x32x16_bf16(PA, PK(N##a, N##b), o[D0], 0, 0, 0); o[D0] = __builtin_amdgcn_mfma_f32_32x32x16_bf16(PB, PK(N##c, N##d), o[D0], 0, 0, 0); SBAR()
#define KRD(N, DS) bf16x8 N##a, N##b; asm volatile("ds_read_b128 %0, %1 offset:%2" : "=&v"(N##a) : "v"(ka[(DS) & 3]), "i"(((DS) >> 2) * 128) : "memory"); asm volatile("ds_read_b128 %0, %1 offset:%2" : "=&v"(N##b) : "v"(ka[(DS) & 3]), "i"(((DS) >> 2) * 128 + 8192) : "memory")
#define KMM0(N, DS, W) LWAIT2(W, N##a, N##b); p0 = __builtin_amdgcn_mfma_f32_32x32x16_bf16(N##a, qr[DS], mnv, 0, 0, 0); p1 = __builtin_amdgcn_mfma_f32_32x32x16_bf16(N##b, qr[DS], mnv, 0, 0, 0); SBAR()
#define KMM(N, DS, W) LWAIT2(W, N##a, N##b); p0 = __builtin_amdgcn_mfma_f32_32x32x16_bf16(N##a, qr[DS], p0, 0, 0, 0); p1 = __builtin_amdgcn_mfma_f32_32x32x16_bf16(N##b, qr[DS], p1, 0, 0, 0); SBAR()
  VDECL(g0); VDECL(g1); VDECL(g2);
#define PREISSUE(SO) do { const int vb_ = vb0 + (SO); VRD(g0, 0, 0, vb_); VRD(g1, 0, 1, vb_); VRD(g2, 1, 0, vb_); } while (0)
  DMA(0, 0); DMA(KVBLK, RSTG); DMA(2 * KVBLK, 2 * RSTG);
  asm volatile("s_waitcnt vmcnt(8)" ::: "memory"); BAR();
  if (odd) BAR();
  qkt<ND0>(p0, p1, (const bf16_t*)(lds + RK), qr, r32, hi, mapc * 4, mnv);
  asm volatile("s_waitcnt vmcnt(4)" ::: "memory"); SBAR(); BAR();
  partialSM<DIFF>(p0, p1, mnC); finishSM(p0, p1, l_reg, pa0, pa1, pa2, pa3); SBAR();
  PREISSUE(0); BAR();
  _Pragma("unroll 1") for (int j = 0; j + 1 < NT; ++j) {
    const int sV = (j & 3) * RSTG, sK = ((j + 1) & 3) * RSTG, sD = ((j + 3) & 3) * RSTG;
    const bool dma = j + 3 < NT;
    if (dma) DMA((j + 3) * KVBLK, sD);
    SBAR(); __builtin_amdgcn_s_setprio(1); SBAR();
    { const int vb = vb0 + sV; int ka[4];
      _Pragma("unroll") for (int i = 0; i < 4; ++i) ka[i] = kad[i] + sK;
      VDECL(g3); VDECL(g4); VDECL(g5); VDECL(g6); VDECL(g7);
      VRD(g3, 1, 1, vb); VMM(g0, 0, pa0, pa1, 12);
      VRD(g4, 2, 0, vb); VMM(g1, 0, pa2, pa3, 12);
      VRD(g5, 2, 1, vb); VMM(g2, 1, pa0, pa1, 12);
      VRD(g6, 3, 0, vb); VMM(g3, 1, pa2, pa3, 12);
      VRD(g7, 3, 1, vb); VMM(g4, 2, pa0, pa1, 12);
      KRD(k0, 0); VMM(g5, 2, pa2, pa3, 10);
      KRD(k1, 1); VMM(g6, 3, pa0, pa1, 8);
      KRD(k2, 2); VMM(g7, 3, pa2, pa3, 6);
      KRD(k3, 3); KMM0(k0, 0, 6);
      if constexpr (ND0 == 8) {
        KRD(k4, 4); KMM(k1, 1, 6);
        KRD(k5, 5); KMM(k2, 2, 6);
        KRD(k6, 6); KMM(k3, 3, 6);
        KRD(k7, 7); KMM(k4, 4, 6);
        KMM(k5, 5, 4); KMM(k6, 6, 2); KMM(k7, 7, 0);
      } else {
        KMM(k1, 1, 4); KMM(k2, 2, 2); KMM(k3, 3, 0);
      } }
    __builtin_amdgcn_s_setprio(0);
    if (dma) asm volatile("s_waitcnt vmcnt(4)" ::: "memory"); else asm volatile("s_waitcnt vmcnt(0)" ::: "memory");
    SBAR(); BAR();
    partialSM<DIFF>(p0, p1, mnC); finishSM(p0, p1, l_reg, pa0, pa1, pa2, pa3); SBAR(); PREISSUE(sK);
    BAR();
  }
  {
    const int vb = vb0 + ((NT - 1) & 3) * RSTG;
    VDECL(g3); VDECL(g4); VDECL(g5); VDECL(g6); VDECL(g7);
    VRD(g3, 1, 1, vb); VMM(g0, 0, pa0, pa1, 12);
    VRD(g4, 2, 0, vb); VMM(g1, 0, pa2, pa3, 12);
    VRD(g5, 2, 1, vb); VMM(g2, 1, pa0, pa1, 12);
    VRD(g6, 3, 0, vb); VMM(g3, 1, pa2, pa3, 12);
    VRD(g7, 3, 1, vb); VMM(g4, 2, pa0, pa1, 12);
    VMM(g5, 2, pa2, pa3, 8); VMM(g6, 3, pa0, pa1, 4); VMM(g7, 3, pa2, pa3, 0);
  }
  if (!odd) BAR();
#undef PREISSUE
#undef KMM
#undef KMM0
#undef KRD
#undef VMM
#undef VDECL
#undef VRD
#undef PK
#undef LWAIT2
#undef LWAIT4
#undef BAR
#undef DMA
#undef DWAIT
  __syncthreads();
  if (splc) {
    unsigned* xs_ = (unsigned*)(lds + 140000);
    if (threadIdx.x == 0) *xs_ = __hip_atomic_fetch_add(splc, 1u, __ATOMIC_RELAXED, __HIP_MEMORY_SCOPE_AGENT);
    __syncthreads();
    const unsigned ord = *xs_;
    float* mine = splp + (size_t)(wid * 65) * 64 + lane;
    if (ord == 0u) {
      _Pragma("unroll") for (int d0 = 0; d0 < 4; ++d0) _Pragma("unroll") for (int r = 0; r < 16; ++r) mine[(d0 * 16 + r) * 64] = o[d0][r];
      mine[64 * 64] = l_reg;
      asm volatile("s_waitcnt vmcnt(0)" ::: "memory"); __syncthreads();
      if (threadIdx.x == 0) { __builtin_amdgcn_fence(__ATOMIC_RELEASE, "agent"); asm volatile("s_waitcnt vmcnt(0)" ::: "memory"); __hip_atomic_store(splc + 1, 1u, __ATOMIC_RELAXED, __HIP_MEMORY_SCOPE_AGENT); }
      __syncthreads();
      return;
    }
    if (threadIdx.x == 0) { unsigned sp = 0; while (__hip_atomic_load(splc + 1, __ATOMIC_RELAXED, __HIP_MEMORY_SCOPE_AGENT) == 0u) { __builtin_amdgcn_s_sleep(4); if (++sp > (1u << 22)) break; } }
    __syncthreads();
    __builtin_amdgcn_fence(__ATOMIC_ACQUIRE, "agent"); asm volatile("s_waitcnt vmcnt(0)" ::: "memory");
    _Pragma("unroll") for (int d0 = 0; d0 < 4; ++d0) _Pragma("unroll") for (int r = 0; r < 16; ++r) o[d0][r] += mine[(d0 * 16 + r) * 64];
    l_reg += mine[64 * 64];
  }
  if (hi == 0) li_l[r32] = l_reg; asm volatile("s_waitcnt lgkmcnt(0)" ::: "memory");
  float rli[16];
  _Pragma("unroll") for (int r = 0; r < 16; ++r) rli[r] = __builtin_amdgcn_rcpf(li_l[crow(r, hi)]);
  int r32e = r32; asm volatile("" : "+v"(r32e));
  char* ST = lds + E_ST + wid * 8704;
  if constexpr (!DIFF) {
    _Pragma("unroll") for (int r = 0; r < 16; ++r) { const int orow = crow(r, hi);
      _Pragma("unroll") for (int d0 = 0; d0 < 4; ++d0) *(bf16_t*)(ST + orow * 272 + (d0 * 32 + r32e) * 2) = f2bf(o[d0][r] * rli[r]); }
  } else {
    const float s1 = wave_sum(lamp[lane] * lamp[64 + lane]), s2 = wave_sum(lamp[128 + lane] * lamp[192 + lane]);
    int ly = layer; asm volatile("" : "+s"(ly));
    const float lambda_init = 0.8f - 0.6f * expf(-0.3f * (float)ly);
    const float lam = expf(s1) - expf(s2) + lambda_init, osc = 1.f - lambda_init;
    float* X = (float*)lds;
    if (mapc == 1) {
      _Pragma("unroll") for (int r = 0; r < 16; ++r) { const int orow = wq * QBLK + crow(r, hi);
        _Pragma("unroll") for (int d0 = 0; d0 < 4; ++d0) X[orow * 128 + d0 * 32 + r32e] = o[d0][r] * rli[r] * lam; }
    }
    __syncthreads();
    if (mapc == 0) {
      float nwv[4];
      _Pragma("unroll") for (int d0 = 0; d0 < 4; ++d0) nwv[d0] = nw[d0 * 32 + r32e] * osc;
      _Pragma("unroll") for (int r = 0; r < 16; ++r) { const int orow = crow(r, hi); float v[4]; float ss = 0.f;
        _Pragma("unroll") for (int d0 = 0; d0 < 4; ++d0) { v[d0] = o[d0][r] * rli[r] - X[(wq * QBLK + orow) * 128 + d0 * 32 + r32e]; ss += v[d0] * v[d0]; }
        ss += __shfl_xor(ss, 1); ss += __shfl_xor(ss, 2); ss += __shfl_xor(ss, 4); ss += __shfl_xor(ss, 8); ss += __shfl_xor(ss, 16);
        const float rs = rsqrtf(ss * (1.f / 128.f) + NORM_EPS);
        _Pragma("unroll") for (int d0 = 0; d0 < 4; ++d0) *(bf16_t*)(ST + orow * 272 + (d0 * 32 + r32e) * 2) = f2bf(v[d0] * rs * nwv[d0]); }
    }
  }
  if (!DIFF || mapc == 0) {
    asm volatile("s_waitcnt lgkmcnt(0)" ::: "memory");
    bf16_t* Ow = Ob + (long)(wq * QBLK) * LD; const bf16_t* Gw = gate + (long)(wq * QBLK) * LD;
    const int er = lane >> 4, ec = (lane & 15) * 8; bf16x8 gv[8];
    _Pragma("unroll") for (int it = 0; it < 8; ++it) gv[it] = *reinterpret_cast<const bf16x8*>(Gw + (long)(it * 4 + er) * LD + ec);
    _Pragma("unroll") for (int it = 0; it < 8; ++it) { const bf16x8 sv = *reinterpret_cast<const bf16x8*>(ST + (it * 4 + er) * 272 + ec * 2); u32x4 ov;
      float f[8]; _Pragma("unroll") for (int e = 0; e < 8; ++e) f[e] = bf2f((bf16_t)sv[e]) * siluf(bf2f((bf16_t)gv[it][e]));
      ov.x = pk2(f[0], f[1]); ov.y = pk2(f[2], f[3]); ov.z = pk2(f[4], f[5]); ov.w = pk2(f[6], f[7]);
      *reinterpret_cast<u32x4*>(Ow + (long)(it * 4 + er) * LD + ec) = ov; }
  }
  __syncthreads();
}
#undef KSWZ
#undef SBAR
}

__device__ __forceinline__ void gqa_unit(const Params& p, const int l, int u, char* lds, int half = -1, int rec = 0) {
    const int qb = u & 31, hq = (u >> 5) & 3, b = u >> 7; const size_t row0 = (size_t)b * SEQ + (size_t)qb * 256, k0 = (size_t)b * SEQ + (half > 0 ? SEQ / 2 : 0);
    bf16_t* Q = pblk(p.ws, PB_GQ + hq) + row0 * 128;
    att::attn_unit<0>(Q, pblk(p.ws, PB_GK + (hq >> 1)) + k0 * 128, pblk(p.ws, PB_GV + (hq >> 1)) + k0 * 128, Q, pblk(p.ws, PB_GG + hq) + row0 * 128, half >= 0 ? SEQ / 2 : SEQ, lds, nullptr, 0, nullptr,
                      (const float*)(g_scr + SCR_CTL) + 256 + 64 * l + 16 + b * 2 + (hq >> 1),
                      qb * 256, p.in[23] + l * 128,
                      half >= 0 ? (unsigned*)(g_scr + SCR_CTL) + 384 + l * 256 + rec * 2 : nullptr, half >= 0 ? (float*)(g_scr + SCR_SPL + (size_t)rec * 133120) : nullptr);
}
__device__ __forceinline__ void diff_unit(const Params& p, const int l, int u, char* lds, int half = -1, int rec = 0) {
    const int qb = u & 63, h = (u >> 6) & 3, b = u >> 8; const size_t row0 = (size_t)b * SEQ + (size_t)qb * 128, k0 = (size_t)b * SEQ + (half > 0 ? SEQ / 2 : 0);
    bf16_t* Q = pblk(p.ws, PB_DQ + h) + row0 * 128;
    att::attn_unit<1>(Q, pblk(p.ws, PB_DK + h) + k0 * 128, pblk(p.ws, PB_DV + h) + k0 * 128, Q, pblk(p.ws, PB_DG + h) + row0 * 128, half >= 0 ? SEQ / 2 : SEQ, lds, p.in[21] + l * 256, l, p.in[22] + l * 128,
                      (const float*)(g_scr + SCR_CTL) + 256 + 64 * l + b * 8 + h * 2,
                      qb * 128, nullptr,
                      half >= 0 ? (unsigned*)(g_scr + SCR_CTL) + 384 + l * 256 + rec * 2 : nullptr, half >= 0 ? (float*)(g_scr + SCR_SPL + (size_t)rec * 133120) : nullptr);
}

#define LDS_BAR() asm volatile("s_waitcnt lgkmcnt(0)\n\ts_barrier" ::: "memory")
namespace rk {
using f32x16 = __attribute__((ext_vector_type(16))) float;
constexpr int PB = 144, MAT = 64 * PB;
constexpr int O_W2T = 0, O_A2T = MAT, O_SB = 2 * MAT, O_GAM = 3 * MAT, O_CONST = O_GAM + 256,
              O_T = O_CONST + 2560, O_TW = O_T, O_G1T = O_T + MAT, O_AD = O_G1T,
              O_R2 = O_G1T + MAT, O_CL = O_R2, O_AA = O_R2 + 16384, O_ABD = O_R2, O_AAB = O_R2 + 4096, O_AAK = O_AAB + MAT, O_ARB = O_AAK + MAT, O_ARK = O_ARB + MAT,
              O_R3 = O_ARK + MAT, O_AT = O_R3, O_RT = O_AT + MAT, O_BT = O_RT + MAT, O_DT = O_BT, O_UT = O_BT, O_KT = O_BT + MAT, O_PT = O_KT,
              O_BHT = O_KT + MAT, O_KHT = O_BHT + MAT, O_VT = O_KHT + MAT, O_END = O_VT + MAT;
__device__ __forceinline__ int crow(int r, int hi) { return (r & 3) + 8 * (r >> 2) + 4 * hi; }
#define RK_FENCE() do { asm volatile("s_waitcnt lgkmcnt(0)" ::: "memory"); __builtin_amdgcn_wave_barrier(); } while (0)
template <int NKS> __device__ __forceinline__ void mm32(f32x16& acc, const char* A, int m0, const char* B, int n0, int k0, int r32, int hi) {
#pragma unroll
    for (int ks = 0; ks < NKS; ++ks) {
        const bf16x8 a = *(const bf16x8*)(A + (m0 + r32) * PB + (k0 + ks * 16 + hi * 8) * 2);
        const bf16x8 b = *(const bf16x8*)(B + (n0 + r32) * PB + (k0 + ks * 16 + hi * 8) * 2);
        acc = __builtin_amdgcn_mfma_f32_32x32x16_bf16(a, b, acc, 0, 0, 0); }
}
template <int NKS, bool SA, bool SB> __device__ __forceinline__ void mm32s(f32x16& acc, const char* A, int m0, const char* B, int n0, int r32, int hi) {
    const int ra = m0 + r32, rb = n0 + r32; const int fa = SA ? ((ra >> 3) & 7) : 0, fb = SB ? ((rb >> 3) & 7) : 0;
#pragma unroll
    for (int ks = 0; ks < NKS; ++ks) { const int q = ks * 2 + hi;
        const bf16x8 a = *(const bf16x8*)(A + ra * PB + ((q ^ fa) << 4));
        const bf16x8 b = *(const bf16x8*)(B + rb * PB + ((q ^ fb) << 4));
        acc = __builtin_amdgcn_mfma_f32_32x32x16_bf16(a, b, acc, 0, 0, 0); }
}
__device__ __forceinline__ void st_T(const f32x16& acc, char* Z, int n0, int m0, int r32, int hi) {
#pragma unroll
    for (int g = 0; g < 4; ++g) { u32x2 w; w.x = pk2(acc[4 * g], acc[4 * g + 1]); w.y = pk2(acc[4 * g + 2], acc[4 * g + 3]);
        *(u32x2*)(Z + (n0 + r32) * PB + (m0 + 8 * g + 4 * hi) * 2) = w; }
}
__device__ __forceinline__ unsigned long long pass1(const Params& p, const int l, unsigned char* lds) {
    const int sid = blockIdx.x >> 3, c_first = blockIdx.x & 7;
    const int tid = otid(), w = __builtin_amdgcn_readfirstlane(tid >> 6);
    const int h = sid & 7, dir = (sid >> 3) & 1, b = sid >> 4;
    unsigned long long pacc = 0, ptt = 0; (void)ptt;
#ifdef PRB_IV
#define RKP0(i) do { if ((PRB_IV >> (i)) & 1) ptt = __builtin_amdgcn_s_memrealtime(); } while (0)
#define RKP1(i) do { if ((PRB_IV >> (i)) & 1) pacc += __builtin_amdgcn_s_memrealtime() - ptt; } while (0)
#else
#define RKP0(i) do {} while (0)
#define RKP1(i) do {} while (0)
#endif
#define RK_LANE() int tq_ = tid; asm volatile("" : "+v"(tq_)); const int lane = tq_ & 63, r32 = lane & 31, hi = lane >> 5, tok = tq_ >> 3, c8 = (tq_ & 7) * 8; (void)lane; (void)r32; (void)hi; (void)tok; (void)c8
    char* L = (char*)lds; float* CF = (float*)(L + O_CONST);
    {   RK_LANE();
        const float* w2 = p.in[13] + ((size_t)(l * 2 + dir) * 64) * 512 + h * 64; const float* a2 = p.in[15] + ((size_t)l * 64) * 512 + h * 64;
        float t[8], u[8];
#pragma unroll
        for (int e = 0; e < 8; ++e) { t[e] = w2[(size_t)(c8 + e) * 512 + tok]; u[e] = a2[(size_t)(c8 + e) * 512 + tok]; }
        u32x4 ww, aa; ww.x = pk2(t[0], t[1]); ww.y = pk2(t[2], t[3]); ww.z = pk2(t[4], t[5]); ww.w = pk2(t[6], t[7]);
        aa.x = pk2(u[0], u[1]); aa.y = pk2(u[2], u[3]); aa.z = pk2(u[4], u[5]); aa.w = pk2(u[6], u[7]);
        *(u32x4*)(L + O_W2T + tok * PB + c8 * 2) = ww; *(u32x4*)(L + O_A2T + tok * PB + c8 * 2) = aa;
        { unsigned zz = 0u; asm volatile("" : "+v"(zz)); *(u32x4*)(L + O_SB + tok * PB + c8 * 2) = (u32x4){zz, zz, zz, zz}; }
        const float* mu = p.in[11] + (size_t)(l * 2 + dir) * 1664;
        for (int i = tid; i < 640; i += 512) { const int row = i >> 6, j = i & 63; float v;
            if (row == 0) v = p.in[12][(l * 2 + dir) * 512 + h * 64 + j]; else if (row == 1) v = p.in[14][l * 512 + h * 64 + j];
            else if (row == 2) v = p.in[16][l * 512 + h * 64 + j]; else if (row == 3) v = p.in[17][l * 512 + h * 64 + j]; else if (row == 4) v = p.in[18][l * 512 + h * 64 + j];
            else if (row == 5) v = mu[h * 64 + j]; else if (row == 6) v = mu[512 + h * 64 + j]; else if (row == 7) v = mu[1024 + h * 64 + j]; else if (row == 8) v = mu[1536 + j]; else v = mu[1600 + j];
            CF[i] = v; }
    }
    const bf16_t* Pr = pblk(p.ws, PB_R + (h >> 1)) + (h & 1) * 64; const bf16_t* Pk = pblk(p.ws, PB_K + (h >> 1)) + (h & 1) * 64;
    const bf16_t* Pv = pblk(p.ws, PB_V + (h >> 1)) + (h & 1) * 64; const bf16_t* Pw = pblk(p.ws, PB_WA); const bf16_t* Pa = pblk(p.ws, PB_WA) + 64;
    bf16_t* wkv = (bf16_t*)(g_scr + SCR_WKV) + (size_t)sid * SEQ * 64; bf16_t* bon = (bf16_t*)(g_scr + SCR_BON) + (size_t)dir * M_TOK * 512 + h * 64;
    bf16x8 cu[5], pv[5];
#define RK_LOAD(c) do { RK_LANE(); const int s_ = (c) * 64 + tok; const int t_ = dir ? (SEQ - 1 - s_) : s_; const size_t m_ = ((size_t)b * SEQ + t_) * 128 + c8; \
        cu[0] = *(const bf16x8*)(Pr + m_); cu[1] = *(const bf16x8*)(Pk + m_); cu[2] = *(const bf16x8*)(Pv + m_); cu[3] = *(const bf16x8*)(Pw + m_); cu[4] = *(const bf16x8*)(Pa + m_); \
        if (s_ > 0) { const size_t q_ = dir ? m_ + 128 : m_ - 128; pv[0] = *(const bf16x8*)(Pr + q_); pv[1] = *(const bf16x8*)(Pk + q_); pv[2] = *(const bf16x8*)(Pv + q_); pv[3] = *(const bf16x8*)(Pw + q_); pv[4] = *(const bf16x8*)(Pa + q_); } \
        else { _Pragma("unroll") for (int i_ = 0; i_ < 5; ++i_) pv[i_] = (bf16x8){0, 0, 0, 0, 0, 0, 0, 0}; } } while (0)
    RK_LOAD(c_first);
    LDS_BAR();
#pragma unroll 1
    for (int c = c_first; c < SEQ / 64; c += 8) {
        RKP0(1);
        float rr[8], kx[8], vv[8];
        {   RK_LANE(); float tw[8], ad[8];
#pragma unroll
            for (int e = 0; e < 8; ++e) {
                const float x0 = bf2f((bf16_t)cu[0][e]), x1 = bf2f((bf16_t)cu[1][e]), x2 = bf2f((bf16_t)cu[2][e]), x3 = bf2f((bf16_t)cu[3][e]), x4 = bf2f((bf16_t)cu[4][e]);
                const float p0 = bf2f((bf16_t)pv[0][e]), p1 = bf2f((bf16_t)pv[1][e]), p2 = bf2f((bf16_t)pv[2][e]), p3 = bf2f((bf16_t)pv[3][e]), p4 = bf2f((bf16_t)pv[4][e]);
                rr[e] = x0 + (p0 - x0) * CF[5 * 64 + (h * 0) + c8 + e]; kx[e] = x1 + (p1 - x1) * CF[6 * 64 + c8 + e]; vv[e] = x2 + (p2 - x2) * CF[7 * 64 + c8 + e];
                const float wd = x3 + (p3 - x3) * CF[8 * 64 + c8 + e]; ad[e] = x4 + (p4 - x4) * CF[9 * 64 + c8 + e];
                tw[e] = 1.f - 2.f / (1.f + __expf(2.f * wd)); }
            u32x4 a, d; a.x = pk2(tw[0], tw[1]); a.y = pk2(tw[2], tw[3]); a.z = pk2(tw[4], tw[5]); a.w = pk2(tw[6], tw[7]);
            d.x = pk2(ad[0], ad[1]); d.y = pk2(ad[2], ad[3]); d.z = pk2(ad[4], ad[5]); d.w = pk2(ad[6], ad[7]);
            *(u32x4*)(L + O_TW + tok * PB + c8 * 2) = a; *(u32x4*)(L + O_AD + tok * PB + c8 * 2) = d; }
        LDS_BAR(); RKP1(1); RKP0(2);
        {   RK_LANE(); const bool isA = w >= 4; const int mt2 = (w & 2) ? 32 : 0, n0 = (w & 1) * 32;
            const char* Aop = L + (isA ? O_AD : O_TW); const char* Bop = L + (isA ? O_A2T : O_W2T);
            f32x16 x0 = {};
            mm32<4>(x0, Aop, mt2, Bop, n0, 0, r32, hi);
            const int ch = n0 + r32; const float c0 = CF[(isA ? 64 : 0) + ch];
            float* TOT = (float*)(L + O_GAM);
            if (!isA) {
#pragma unroll
                for (int r = 0; r < 16; ++r) x0[r] = -0.6065306597126334f / (1.f + __expf(-(c0 + x0[r])));
                float run = 0.f;
#pragma unroll
                for (int g = 0; g < 4; ++g) { const float gs = (x0[4 * g] + x0[4 * g + 1]) + (x0[4 * g + 2] + x0[4 * g + 3]); const float ps = __shfl_xor(gs, 32);
                    float st = run + (hi ? ps : 0.f); x0[4 * g] += st; x0[4 * g + 1] += x0[4 * g]; x0[4 * g + 2] += x0[4 * g + 1]; x0[4 * g + 3] += x0[4 * g + 2]; run += gs + ps; }
                if (mt2 == 0 && hi == 0) TOT[ch] = run;
            } else {
#pragma unroll
                for (int r = 0; r < 16; ++r) x0[r] = 1.f / (1.f + __expf(-(c0 + x0[r])));
            }
            LDS_BAR();
            if (!isA && mt2) { const float t0 = TOT[ch];
#pragma unroll
                for (int r = 0; r < 16; ++r) x0[r] += t0; }
            float* O = (float*)(L + (isA ? O_AA : O_CL));
#pragma unroll
            for (int r = 0; r < 16; ++r) O[(mt2 + crow(r, hi)) * 64 + ch] = x0[r];
        }
        LDS_BAR(); RKP1(2); RKP0(3);
        {   RK_LANE(); const float* clp = (const float*)(L + O_CL + tok * 256 + c8 * 4); const float* cle = (const float*)(L + O_CL + (tok > 0 ? tok - 1 : 0) * 256 + c8 * 4);
            const float* cln = (const float*)(L + O_CL + 63 * 256 + c8 * 4); const float* aap = (const float*)(L + O_AA + tok * 256 + c8 * 4);
            float kk[8], kp[8]; float ss = 0.f, bs = 0.f;
#pragma unroll
            for (int e = 0; e < 8; ++e) { kk[e] = kx[e] * CF[2 * 64 + c8 + e]; ss += kk[e] * kk[e]; kp[e] = kx[e] * (1.f + (aap[e] - 1.f) * CF[3 * 64 + c8 + e]); bs += rr[e] * kp[e] * CF[4 * 64 + c8 + e]; }
            ss += __shfl_xor(ss, 1); ss += __shfl_xor(ss, 2); ss += __shfl_xor(ss, 4);
            bs += __shfl_xor(bs, 1); bs += __shfl_xor(bs, 2); bs += __shfl_xor(bs, 4);
            const float rn = 1.f / fmaxf(sqrtf(ss), 1e-12f);
            const int tsw = ((((tok >> 3) ^ (c8 >> 3)) << 3) + (tok & 7)) * 2;
#pragma unroll
            for (int e2 = 0; e2 < 4; ++e2) { float At[2], Rt[2], Bt[2], Kt[2];
#pragma unroll
                for (int q = 0; q < 2; ++q) { const int e = 2 * e2 + q; const float cl = clp[e], ce = (tok > 0) ? cle[e] : 0.f, cn = cln[e];
                    const float kn = kk[e] * rn; const float bb = kn * aap[e];
                    const float ein = __expf(cl), eex = __expf(ce), eng = __expf(-cl), een = __expf(cn - cl);
                    At[q] = -kn * eex; Rt[q] = rr[e] * ein; Bt[q] = bb * eng; Kt[q] = kp[e] * eng;
                    *(bf16_t*)(L + O_BHT + (c8 + e) * PB + tsw) = f2bf(bb * een); *(bf16_t*)(L + O_KHT + (c8 + e) * PB + tsw) = f2bf(kp[e] * een); *(bf16_t*)(L + O_VT + (c8 + e) * PB + tsw) = f2bf(vv[e]); *(bf16_t*)(L + O_SB + (c8 + e) * PB + tsw) = f2bf(At[q]);
                    if (tok == 63) ((float*)(L + O_GAM))[c8 + e] = __expf(cn); }
                const int ob = tok * PB + (c8 + 2 * e2) * 2;
                *(unsigned*)(L + O_AT + ob) = pk2(At[0], At[1]); *(unsigned*)(L + O_RT + ob) = pk2(Rt[0], Rt[1]); *(unsigned*)(L + O_BT + ob) = pk2(Bt[0], Bt[1]); *(unsigned*)(L + O_KT + ob) = pk2(Kt[0], Kt[1]); }
            {   const int s_ = c * 64 + tok; const int t_ = dir ? (SEQ - 1 - s_) : s_;
                u32x4 w_; w_.x = pk2(bs * vv[0], bs * vv[1]); w_.y = pk2(bs * vv[2], bs * vv[3]); w_.z = pk2(bs * vv[4], bs * vv[5]); w_.w = pk2(bs * vv[6], bs * vv[7]);
                *(u32x4*)(bon + ((size_t)b * SEQ + t_) * 512 + c8) = w_; }
        }
        LDS_BAR(); RKP1(3); RKP0(4);
        if (c + 8 < SEQ / 64) RK_LOAD(c + 8);
        for (int idx = w; idx < 12; idx += 8) {
            RK_LANE(); const int pr = idx / 3, tl = idx - pr * 3; const int mi = (tl == 2) ? 32 : 0, nt = (tl >= 1) ? 32 : 0;
            const char* X = L + ((pr & 1) ? O_KT : O_BT); const char* Y = L + ((pr >= 2) ? O_RT : O_AT);
            f32x16 acc = {}; mm32<4>(acc, X, mi, Y, nt, 0, r32, hi);
            const int t = nt + r32;
            if (tl != 1) {
#pragma unroll
                for (int r = 0; r < 16; ++r) { const int i = mi + crow(r, hi); const bool keep = (pr < 2) ? (i < t) : (i <= t); if (!keep) acc[r] = 0.f; } }
            char* Z = L + (pr == 0 ? O_AAB : pr == 1 ? O_AAK : pr == 2 ? O_ARB : O_ARK);
            st_T(acc, Z, nt, mi, r32, hi);
            if (pr == 0 && tl != 1) { float* ABD = (float*)(L + O_ABD);
#pragma unroll
                for (int g = 0; g < 4; ++g) if ((g >> 1) == (r32 >> 4)) *(f32x4*)(ABD + (t >> 4) * 256 + (t & 15) * 16 + 8 * (g & 1) + 4 * hi) = (f32x4){acc[4 * g], acc[4 * g + 1], acc[4 * g + 2], acc[4 * g + 3]}; }
        }
        LDS_BAR(); RKP1(4); RKP0(5);
        f32x16 yacc = {}, nacc = {};
        const int mt = (w & 2) ? 32 : 0, nv = (w & 1) ? 32 : 0;
        if (w < 4) {
            RK_LANE(); f32x16 xq = {};
            if (mt) mm32s<4, false, true>(xq, L + O_AAK, mt, L + O_VT, nv, r32, hi); else mm32s<2, false, true>(xq, L + O_AAK, mt, L + O_VT, nv, r32, hi);
            st_T(xq, L + O_G1T, nv, mt, r32, hi);
            mm32s<4, true, true>(nacc, L + O_KHT, mt, L + O_VT, nv, r32, hi);
        } else if (w < 7) {
            RK_LANE(); if (mt) mm32s<4, false, true>(yacc, L + O_ARK, mt, L + O_VT, nv, r32, hi); else mm32s<2, false, true>(yacc, L + O_ARK, mt, L + O_VT, nv, r32, hi);
        } else {
            RK_LANE(); const int blk = lane >> 4, j = lane & 15; const float* A = (const float*)(L + O_ABD) + blk * 256;
            float x[16];
#pragma unroll
            for (int t = 0; t < 16; ++t) { float s = (t == j) ? 1.f : 0.f;
#pragma unroll
                for (int i = 0; i < t; ++i) s += A[t * 16 + i] * x[i];
                x[t] = s; asm volatile("" ::: "memory"); }
            char* Tm = L + O_T; char* Dm = L + O_DT;
#pragma unroll
            for (int t = 0; t < 16; ++t) *(bf16_t*)(Tm + (16 * blk + t) * PB + (16 * blk + j) * 2) = f2bf(x[t]);
            { u32x4 a, d; a.x = pk2(x[0], x[1]); a.y = pk2(x[2], x[3]); a.z = pk2(x[4], x[5]); a.w = pk2(x[6], x[7]); d.x = pk2(x[8], x[9]); d.y = pk2(x[10], x[11]); d.z = pk2(x[12], x[13]); d.w = pk2(x[14], x[15]);
              *(u32x4*)(Dm + (16 * blk + j) * PB + (16 * blk) * 2) = a; *(u32x4*)(Dm + (16 * blk + j) * PB + (16 * blk + 8) * 2) = d; }
            if ((blk & 1) == 0) {
#pragma unroll
                for (int t = 0; t < 16; ++t) *(bf16_t*)(Tm + (16 * blk + t) * PB + (16 * (blk + 1) + j) * 2) = 0;
            } else { *(u32x4*)(Dm + (16 * blk + j) * PB + (16 * (blk - 1)) * 2) = (u32x4){0u, 0u, 0u, 0u}; *(u32x4*)(Dm + (16 * blk + j) * PB + (16 * (blk - 1) + 8) * 2) = (u32x4){0u, 0u, 0u, 0u}; }
            RK_FENCE();
            const int m16 = lane & 15, kg = lane >> 4; const bf16x8 z8 = {0, 0, 0, 0, 0, 0, 0, 0};
#pragma unroll
            for (int pp = 0; pp < 2; ++pp) { const int o = 32 * pp;
                bf16x8 a = z8, bb = z8;
                if (kg < 2) { a = *(const bf16x8*)(L + O_AAB + (o + 16 + m16) * PB + (o + 8 * kg) * 2); bb = *(const bf16x8*)(Dm + (o + m16) * PB + (o + 8 * kg) * 2); }
                f32x4 pq = __builtin_amdgcn_mfma_f32_16x16x32_bf16(a, bb, (f32x4){0.f, 0.f, 0.f, 0.f}, 0, 0, 0);
                { u32x2 wv; wv.x = pk2(pq[0], pq[1]); wv.y = pk2(pq[2], pq[3]); *(u32x2*)(L + O_PT + (o + m16) * PB + (o + 16 + 4 * kg) * 2) = wv; } }
            RK_FENCE();
#pragma unroll
            for (int pp = 0; pp < 2; ++pp) { const int o = 32 * pp;
                bf16x8 a = z8, bb = z8;
                if (kg < 2) { a = *(const bf16x8*)(Tm + (o + 16 + m16) * PB + (o + 16 + 8 * kg) * 2); bb = *(const bf16x8*)(L + O_PT + (o + m16) * PB + (o + 16 + 8 * kg) * 2); }
                f32x4 tq = __builtin_amdgcn_mfma_f32_16x16x32_bf16(a, bb, (f32x4){0.f, 0.f, 0.f, 0.f}, 0, 0, 0);
#pragma unroll
                for (int e = 0; e < 4; ++e) *(bf16_t*)(Tm + (o + 16 + 4 * kg + e) * PB + (o + m16) * 2) = f2bf(tq[e]);
                { u32x2 wv; wv.x = pk2(tq[0], tq[1]); wv.y = pk2(tq[2], tq[3]); *(u32x2*)(Dm + (o + m16) * PB + (o + 16 + 4 * kg) * 2) = wv; } }
            RK_FENCE();
            { f32x16 q = {}; mm32<2>(q, L + O_AAB, 32, Dm, 0, 0, r32, hi); st_T(q, L + O_PT, 0, 32, r32, hi); }
            RK_FENCE();
            { f32x16 tc = {}; mm32<2>(tc, Tm, 32, L + O_PT, 0, 32, r32, hi);
#pragma unroll
              for (int r = 0; r < 16; ++r) *(bf16_t*)(Tm + (32 + crow(r, hi)) * PB + r32 * 2) = f2bf(tc[r]); }
        }
        LDS_BAR(); RKP1(5); RKP0(6);
        if (w < 4) {
            RK_LANE(); f32x16 q = {};
            if (mt) mm32s<4, false, true>(q, L + O_T, mt, L + O_SB, nv, r32, hi); else mm32s<2, false, true>(q, L + O_T, mt, L + O_SB, nv, r32, hi);
            st_T(q, L + O_PT, nv, mt, r32, hi);
        } else {
            RK_LANE(); if (w == 7) mm32s<4, false, true>(yacc, L + O_ARK, mt, L + O_VT, nv, r32, hi);
            f32x16 q = {};
            if (mt) mm32<4>(q, L + O_T, mt, L + O_G1T, nv, 0, r32, hi); else mm32<2>(q, L + O_T, mt, L + O_G1T, nv, 0, r32, hi);
            st_T(q, L + O_UT, nv, mt, r32, hi);
        }
        LDS_BAR(); RKP1(6); RKP0(7);
        {   const size_t ci = (size_t)sid * (SEQ / 64) + c;
            if (w < 4) {
                RK_LANE(); mm32s<4, true, false>(nacc, L + O_BHT, mt, L + O_UT, nv, r32, hi);
                {   bf16_t* NN = (sid < 24 ? (bf16_t*)(p.ws + WS_NN) : (bf16_t*)(g_scr + SCR_NN2) - (size_t)24 * 128 * 4096) + ci * 4096 + ((size_t)(w * 64 + lane)) * 16;
                    u32x4 a, d; a.x = pk2(nacc[0], nacc[1]); a.y = pk2(nacc[2], nacc[3]); a.z = pk2(nacc[4], nacc[5]); a.w = pk2(nacc[6], nacc[7]);
                    d.x = pk2(nacc[8], nacc[9]); d.y = pk2(nacc[10], nacc[11]); d.z = pk2(nacc[12], nacc[13]); d.w = pk2(nacc[14], nacc[15]);
                    *(u32x4*)NN = a; *(u32x4*)(NN + 8) = d; }
                f32x16 mq = {}; mm32s<4, false, true>(mq, L + O_PT, mt, L + O_BHT, nv, r32, hi);
                const int kq = nv + r32; const float gk = ((const float*)(L + O_GAM))[kq];
#pragma unroll
                for (int r = 0; r < 16; ++r) if (mt + crow(r, hi) == kq) mq[r] += gk;
                bf16_t* MM = (bf16_t*)(p.ws + WS_MM) + ci * 4096 + (size_t)kq * 64 + mt + 4 * hi;
#pragma unroll
                for (int g = 0; g < 4; ++g) { u32x2 wv; wv.x = pk2(mq[4 * g], mq[4 * g + 1]); wv.y = pk2(mq[4 * g + 2], mq[4 * g + 3]); *(u32x2*)(MM + 8 * g) = wv; }
            } else {
                RK_LANE(); if (mt) mm32<4>(yacc, L + O_ARB, mt, L + O_UT, nv, 0, r32, hi); else mm32<2>(yacc, L + O_ARB, mt, L + O_UT, nv, 0, r32, hi);
                {
                    bf16_t* yp = wkv + (size_t)c * 4096 + (size_t)((w - 4) * 64 + lane) * 16;
                    u32x4 a_, d_; a_.x = pk2(yacc[0], yacc[1]); a_.y = pk2(yacc[2], yacc[3]); a_.z = pk2(yacc[4], yacc[5]); a_.w = pk2(yacc[6], yacc[7]);
                    d_.x = pk2(yacc[8], yacc[9]); d_.y = pk2(yacc[10], yacc[11]); d_.z = pk2(yacc[12], yacc[13]); d_.w = pk2(yacc[14], yacc[15]);
                    *(u32x4*)yp = a_; *(u32x4*)(yp + 8) = d_; }
                f32x16 qq = {};
                if (nv) mm32<4>(qq, L + O_PT, mt, L + O_ARB, nv, 0, r32, hi); else mm32<2>(qq, L + O_PT, mt, L + O_ARB, nv, 0, r32, hi);
                const int tq = nv + r32;
                bf16_t* QQ = (bf16_t*)(g_scr + SCR_XB) + ci * 4096 + (size_t)tq * 64 + mt + 4 * hi;
#pragma unroll
                for (int g = 0; g < 4; ++g) { const u32x2 rw = *(const u32x2*)(L + O_RT + tq * PB + (mt + 8 * g + 4 * hi) * 2);
                    const float r0 = __uint_as_float(rw.x << 16), r1 = __uint_as_float(rw.x & 0xffff0000u), r2 = __uint_as_float(rw.y << 16), r3 = __uint_as_float(rw.y & 0xffff0000u);
                    u32x2 wv; wv.x = pk2(qq[4 * g] + r0, qq[4 * g + 1] + r1); wv.y = pk2(qq[4 * g + 2] + r2, qq[4 * g + 3] + r3); *(u32x2*)(QQ + 8 * g) = wv; }
            }
        }
        LDS_BAR(); RKP1(7);
    }
#undef RK_LOAD
#undef RK_LANE
    return pacc;
}

__device__ __forceinline__ void chain(const Params& p, const int sid, unsigned char* lds) {
    const int tid = otid(), w = __builtin_amdgcn_readfirstlane(tid >> 6);
    constexpr int C_MT = 0, C_QT = MAT, C_SB = 2 * MAT;
#define RK_LANE() int tq_ = tid; asm volatile("" : "+v"(tq_)); const int lane = tq_ & 63, r32 = lane & 31, hi = lane >> 5, row = tq_ >> 3, c8 = (tq_ & 7) * 8; (void)lane; (void)r32; (void)hi; (void)row; (void)c8
    char* L = (char*)lds;
    const bf16_t* MMg = (const bf16_t*)(p.ws + WS_MM) + (size_t)sid * 128 * 4096; const bf16_t* QQg = (const bf16_t*)(g_scr + SCR_XB) + (size_t)sid * 128 * 4096;
    const bf16_t* NNg = (sid < 24 ? (const bf16_t*)(p.ws + WS_NN) : (const bf16_t*)(g_scr + SCR_NN2) - (size_t)24 * 128 * 4096) + (size_t)sid * 128 * 4096;
    bf16_t* wkv = (bf16_t*)(g_scr + SCR_WKV) + (size_t)sid * SEQ * 64;
    const int mt = (w & 2) ? 32 : 0, nv = (w & 1) ? 32 : 0;
    {   RK_LANE(); unsigned zz = 0u; asm volatile("" : "+v"(zz)); *(u32x4*)(L + C_SB + row * PB + c8 * 2) = (u32x4){zz, zz, zz, zz}; }
    f32x16 sacc = {};
    bf16x8 rm, rq, rn0, rn1;
#define CH_LOAD(c) do { RK_LANE(); rm = *(const bf16x8*)(MMg + (size_t)(c) * 4096 + row * 64 + c8); rq = *(const bf16x8*)(QQg + (size_t)(c) * 4096 + row * 64 + c8); \
        if (w < 4) { const bf16_t* n_ = NNg + (size_t)(c) * 4096 + (size_t)(w * 64 + lane) * 16; rn0 = *(const bf16x8*)n_; rn1 = *(const bf16x8*)(n_ + 8); } \
        else { const bf16_t* y_ = wkv + (size_t)(c) * 4096 + (size_t)((w - 4) * 64 + lane) * 16; rn0 = *(const bf16x8*)y_; rn1 = *(const bf16x8*)(y_ + 8); } } while (0)
    CH_LOAD(0);
#pragma unroll 1
    for (int c = 0; c < SEQ / 64; ++c) {
        {   RK_LANE(); *(bf16x8*)(L + C_MT + row * PB + c8 * 2) = rm; *(bf16x8*)(L + C_QT + row * PB + c8 * 2) = rq; }
        f32x16 acc;
#pragma unroll
        for (int r = 0; r < 8; ++r) { acc[r] = bf2f((bf16_t)rn0[r]); acc[8 + r] = bf2f((bf16_t)rn1[r]); }
        LDS_BAR();
        if (c + 1 < SEQ / 64) CH_LOAD(c + 1);
        {   RK_LANE();
            if (w < 4) { mm32<4>(acc, L + C_MT, mt, L + C_SB, nv, 0, r32, hi); sacc = acc; }
            else { mm32<4>(acc, L + C_QT, mt, L + C_SB, nv, 0, r32, hi);
#pragma unroll
                for (int r = 0; r < 16; ++r) wkv[((size_t)c * 64 + mt + crow(r, hi)) * 64 + nv + r32] = f2bf(acc[r]); } }
        LDS_BAR();
        if (w < 4) { RK_LANE(); st_T(sacc, L + C_SB, nv, mt, r32, hi); }
    }
#undef CH_LOAD
#undef RK_LANE
}

}

namespace sd {
using rk::f32x16; using rk::crow;
constexpr int PW = 272, PN = 144;
constexpr int O_CM = 0, O_BM = 64 * PW, O_HB = 2 * 64 * PW, O_BDT = 3 * 64 * PW, O_XDT = O_BDT + 128 * PN, O_XM = O_XDT + 64 * PN, O_MM = O_XM + 64 * PN, O_DTS = O_MM + 64 * PN, O_ACU = O_DTS + 512, O_END = O_ACU + 512;
template <int NKS, int PA, int PBB, int SA = -1, int SBW = -1> __device__ __forceinline__ void mmx(f32x16& acc, const char* A, int m0, const char* B, int n0, int k0, int r32, int hi) {
    const int ra = m0 + r32, rb = n0 + r32; const int fa = SA >= 0 ? ((ra >> (SA >= 0 ? SA : 0)) & 7) : 0, fb = SBW >= 0 ? ((rb >> (SBW >= 0 ? SBW : 0)) & 7) : 0;
#pragma unroll
    for (int ks = 0; ks < NKS; ++ks) { const int q = (k0 >> 3) + ks * 2 + hi;
        const bf16x8 a = *(const bf16x8*)(A + ra * PA + ((q ^ fa) << 4));
        const bf16x8 b = *(const bf16x8*)(B + rb * PBB + ((q ^ fb) << 4));
        acc = __builtin_amdgcn_mfma_f32_32x32x16_bf16(a, b, acc, 0, 0, 0); }
}
template <int PZ> __device__ __forceinline__ void stT(const f32x16& acc, char* Z, int n0, int m0, int r32, int hi) {
#pragma unroll
    for (int g = 0; g < 4; ++g) { u32x2 w; w.x = pk2(acc[4 * g], acc[4 * g + 1]); w.y = pk2(acc[4 * g + 2], acc[4 * g + 3]);
        *(u32x2*)(Z + (n0 + r32) * PZ + (m0 + 8 * g + 4 * hi) * 2) = w; }
}
__device__ __forceinline__ unsigned long long seq(const Params& p, const int l, const int sid, unsigned char* lds) {
    const int tid = otid(), w = __builtin_amdgcn_readfirstlane(tid >> 6);
    const int h = sid & 7, dir = (sid >> 3) & 1, b = sid >> 4, g = h >> 2;
    unsigned long long pacc = 0, ptt = 0; (void)ptt;
#ifdef PRB_SDIV
#define SDP0(i) do { if ((PRB_SDIV >> (i)) & 1) ptt = __builtin_amdgcn_s_memrealtime(); } while (0)
#define SDP1(i) do { if ((PRB_SDIV >> (i)) & 1) pacc += __builtin_amdgcn_s_memrealtime() - ptt; } while (0)
#else
#define SDP0(i) do {} while (0)
#define SDP1(i) do {} while (0)
#endif
#define SD_LANE() int tq_ = tid; asm volatile("" : "+v"(tq_)); const int lane = tq_ & 63, r32 = lane & 31, hi = lane >> 5, tok = tq_ >> 3, q8 = tq_ & 7; (void)lane; (void)r32; (void)hi; (void)tok; (void)q8
    char* L = (char*)lds;
    const float Ah = -expf(p.in[7][(l * 2 + dir) * 8 + h]), dtb = p.in[8][(l * 2 + dir) * 8 + h], Dh = (dir == 0) ? p.in[9][l * 8 + h] : 0.f;
    const float* dtbuf = (const float*)(g_scr + SCR_DT) + dir * 8 + h;
    const bf16_t* xact = (const bf16_t*)(g_scr + SCR_XACT);
    bf16_t* yout = (bf16_t*)(g_scr + SCR_SSDY) + (size_t)dir * M_TOK * 512 + h * 64;
    {   SD_LANE(); unsigned zz = 0u; asm volatile("" : "+v"(zz));
        for (int i = tid; i < 64 * PW / 16; i += 512) *(u32x4*)(L + O_HB + i * 16) = (u32x4){zz, zz, zz, zz}; }
    f32x16 hacc = {};
    bf16x8 rc[2], rb[2], rx; float dtr = 0.f;
#define SD_LOAD(c) do { SD_LANE(); const int s_ = (c) * 64 + tok; const int t_ = dir ? (SEQ - 1 - s_) : s_; const bf16_t* row_ = xact + ((size_t)b * SEQ + t_) * 1024; \
        rc[0] = *(const bf16x8*)(row_ + 768 + g * 128 + q8 * 16); rc[1] = *(const bf16x8*)(row_ + 768 + g * 128 + q8 * 16 + 8); \
        rb[0] = *(const bf16x8*)(row_ + 512 + g * 128 + q8 * 16); rb[1] = *(const bf16x8*)(row_ + 512 + g * 128 + q8 * 16 + 8); \
        rx = *(const bf16x8*)(row_ + h * 64 + q8 * 8); } while (0)
#define SD_DTLOAD(c) do { SD_LANE(); const int s2_ = (c) * 64 + lane; const int t2_ = dir ? (SEQ - 1 - s2_) : s2_; dtr = dtbuf[((size_t)b * SEQ + t2_) * 16]; } while (0)
#define SD_SCAN(buf) do { SD_LANE(); const float dt_ = softplusf(dtr + dtb); float ac_ = dt_ * Ah; \
        _Pragma("unroll") for (int o_ = 1; o_ < 64; o_ <<= 1) { const float v_ = __shfl_up(ac_, o_); if (lane >= o_) ac_ += v_; } \
        ((float*)(L + O_DTS))[(buf) * 64 + lane] = dt_; ((float*)(L + O_ACU))[(buf) * 64 + lane] = ac_; } while (0)
    SD_LOAD(0);
    if (w == 7) { SD_DTLOAD(0); SD_SCAN(0); SD_DTLOAD(1); }
    LDS_BAR();
    const int nv = (w & 1) ? 32 : 0;
#pragma unroll 1
    for (int c = 0; c < SEQ / 64; ++c) {
        const float* DTS = (const float*)(L + O_DTS) + (c & 1) * 64; const float* ACU = (const float*)(L + O_ACU) + (c & 1) * 64;
        SDP0(1);
        {   SD_LANE(); const float dt = DTS[tok]; const float ac = ACU[tok], ae = ACU[63];
            const float dend = __expf(ae - ac);
            *(bf16x8*)(L + O_CM + tok * PW + q8 * 32) = rc[0]; *(bf16x8*)(L + O_CM + tok * PW + q8 * 32 + 16) = rc[1];
            *(bf16x8*)(L + O_BM + tok * PW + q8 * 32) = rb[0]; *(bf16x8*)(L + O_BM + tok * PW + q8 * 32 + 16) = rb[1];
            *(bf16x8*)(L + O_XM + tok * PN + q8 * 16) = rx;
            const int tsw = ((((tok >> 3) ^ q8) << 3) + (tok & 7)) * 2;
#pragma unroll
            for (int e = 0; e < 8; ++e) { *(bf16_t*)(L + O_BDT + (q8 * 16 + e) * PN + tsw) = f2bf(bf2f((bf16_t)rb[0][e]) * dend); *(bf16_t*)(L + O_BDT + (q8 * 16 + 8 + e) * PN + tsw) = f2bf(bf2f((bf16_t)rb[1][e]) * dend);
                *(bf16_t*)(L + O_XDT + (q8 * 8 + e) * PN + tsw) = f2bf(bf2f((bf16_t)rx[e]) * dt); } }
        LDS_BAR(); SDP1(1); SDP0(2);
        if (c + 1 < SEQ / 64) SD_LOAD(c + 1);
        f32x16 yoff = {};
        const int ml = ((w - 3) & 2) ? 32 : 0, np = ((w - 3) & 1) ? 32 : 0;
        if (w < 3) { SD_LANE(); const int ms = (w == 2) ? 32 : 0, nl = (w >= 1) ? 32 : 0;
            f32x16 gq = {}; mmx<8, PW, PW>(gq, L + O_BM, ms, L + O_CM, nl, 0, r32, hi);
            const int lq = nl + r32; const float al = ACU[lq];
#pragma unroll
            for (int g4 = 0; g4 < 4; ++g4) { const f32x4 as4 = *(const f32x4*)(ACU + ms + 8 * g4 + 4 * hi);
#pragma unroll
                for (int e = 0; e < 4; ++e) { const int s = ms + 8 * g4 + 4 * hi + e; const float d = __expf(fminf(al - as4[e], 0.f)); gq[4 * g4 + e] = (s <= lq) ? gq[4 * g4 + e] * d : 0.f; } }
            stT<PN>(gq, L + O_MM, nl, ms, r32, hi);
        } else if (w < 7) { SD_LANE(); mmx<8, PW, PW>(yoff, L + O_CM, ml, L + O_HB, np, 0, r32, hi); }
        {   SD_LANE(); const float eend = __expf(ACU[63]);
#pragma unroll
            for (int r = 0; r < 16; ++r) hacc[r] *= eend;
            mmx<4, PN, PN, 4, 3>(hacc, L + O_BDT, (w >> 1) * 32, L + O_XDT, nv, 0, r32, hi); }
        if (w == 7 && c + 1 < SEQ / 64) { SD_SCAN((c + 1) & 1); if (c + 2 < SEQ / 64) SD_DTLOAD(c + 2); }
        LDS_BAR(); SDP1(2); SDP0(3);
        {   SD_LANE(); stT<PW>(hacc, L + O_HB, nv, (w >> 1) * 32, r32, hi); }
        if (w >= 3 && w < 7) { SD_LANE(); f32x16 yd = {};
            if (ml) mmx<4, PN, PN, -1, 3>(yd, L + O_MM, ml, L + O_XDT, np, 0, r32, hi); else mmx<2, PN, PN, -1, 3>(yd, L + O_MM, ml, L + O_XDT, np, 0, r32, hi);
            float ea[16], xv[16];
#pragma unroll
            for (int g4 = 0; g4 < 4; ++g4) { const f32x4 a4 = *(const f32x4*)(ACU + ml + 8 * g4 + 4 * hi);
#pragma unroll
                for (int e = 0; e < 4; ++e) { ea[4 * g4 + e] = __expf(a4[e]); xv[4 * g4 + e] = bf2f(*(const bf16_t*)(L + O_XM + (ml + 8 * g4 + 4 * hi + e) * PN + (np + r32) * 2)); } }
#pragma unroll
            for (int r = 0; r < 16; ++r) { const int lq = ml + crow(r, hi); const int s_ = c * 64 + lq; const int t_ = dir ? (SEQ - 1 - s_) : s_;
                yout[((size_t)b * SEQ + t_) * 512 + np + r32] = f2bf(yd[r] + ea[r] * yoff[r] + Dh * xv[r]); } }
        LDS_BAR(); SDP1(3);
    }
#undef SD_LOAD
#undef SD_DTLOAD
#undef SD_SCAN
#undef SD_LANE
    return pacc;
}
}

__device__ __forceinline__ void combine_tokens(const Params& p, const int l, const int m_first, const int m_end, const int m_step) {
    const int tid = otid(), lane = tid & 63;
    const bf16_t* wkv = (const bf16_t*)(g_scr + SCR_WKV); const bf16_t* bon = (const bf16_t*)(g_scr + SCR_BON); const bf16_t* sy = (const bf16_t*)(g_scr + SCR_SSDY);
    const int h = lane >> 3, c8 = (lane & 7) * 8, ch = h * 64 + c8;
    float eps_gn = 64e-5f, eps_rms = NORM_EPS; asm volatile("" : "+v"(eps_gn), "+v"(eps_rms));
    float lnw[8], lnb[8], snw[8];
#pragma unroll
    for (int e = 0; e < 8; ++e) { lnw[e] = p.in[19][l * 512 + ch + e]; lnb[e] = p.in[20][l * 512 + ch + e]; snw[e] = p.in[10][l * 512 + ch + e]; }
    for (int m = m_first; m < m_end; m += m_step) {
        const int bq = m >> 13, tq = m & (SEQ - 1);
        bf16_t* gp = pblk(p.ws, PB_RG + (h >> 1)) + (size_t)m * 128 + (h & 1) * 64 + c8; bf16_t* zp = pblk(p.ws, PB_Z + (h >> 1)) + (size_t)m * 128 + (h & 1) * 64 + c8;
        const bf16x8 vwf = *(const bf16x8*)(wkv + (((size_t)(bq * 16 + h)) * SEQ + tq) * 64 + c8), vwb = *(const bf16x8*)(wkv + (((size_t)(bq * 16 + 8 + h)) * SEQ + (SEQ - 1 - tq)) * 64 + c8);
        const bf16x8 vbf = *(const bf16x8*)(bon + (size_t)m * 512 + ch), vbb = *(const bf16x8*)(bon + (size_t)M_TOK * 512 + (size_t)m * 512 + ch);
        const bf16x8 vg = *(const bf16x8*)gp, vz = *(const bf16x8*)zp;
        const bf16x8 vyf = *(const bf16x8*)(sy + (size_t)m * 512 + ch), vyb = *(const bf16x8*)(sy + (size_t)M_TOK * 512 + (size_t)m * 512 + ch);
        float a[8], bq8[8], x[8], y[8];
        unpack8(vwf, a); unpack8(vwb, bq8); float s = 0.f;
#pragma unroll
        for (int e = 0; e < 8; ++e) { x[e] = a[e] + bq8[e]; s += x[e]; }
        s += __shfl_xor(s, 1); s += __shfl_xor(s, 2); s += __shfl_xor(s, 4);
        const float mean = s * (1.f / 64.f); float v2 = 0.f;
#pragma unroll
        for (int e = 0; e < 8; ++e) { x[e] -= mean; v2 += x[e] * x[e]; }
        v2 += __shfl_xor(v2, 1); v2 += __shfl_xor(v2, 2); v2 += __shfl_xor(v2, 4);
        const float rstd = rsqrtf(v2 * (1.f / 64.f) + eps_gn);
        unpack8(vbf, a); unpack8(vbb, bq8); unpack8(vg, y);
#pragma unroll
        for (int e = 0; e < 8; ++e) x[e] = (x[e] * rstd * lnw[e] + lnb[e] + a[e] + bq8[e]) * siluf(y[e]);
        const u32x4 ob = pack8(x);
        unpack8(vyf, a); unpack8(vyb, bq8); unpack8(vz, y); float ss = 0.f;
#pragma unroll
        for (int e = 0; e < 8; ++e) { x[e] = (a[e] + bq8[e]) * siluf(y[e]); ss += x[e] * x[e]; }
        ss += __shfl_xor(ss, 1); ss += __shfl_xor(ss, 2); ss += __shfl_xor(ss, 4); ss += __shfl_xor(ss, 8); ss += __shfl_xor(ss, 16);
        const float rs = rsqrtf(ss * (1.f / 256.f) + eps_rms);
#pragma unroll
        for (int e = 0; e < 8; ++e) x[e] *= rs * snw[e];
        const u32x4 oa = pack8(x);
        *(u32x4*)gp = ob; *(u32x4*)zp = oa;
    }
}

__device__ __forceinline__ void phase_post(const Params& p, const int l) {
    const int G = gridDim.x, tid = otid(), lane = tid & 63, wave = tid >> 6;
    const float* mix = (const float*)(p.ws + WS_MIX); const float* xin = l == 0 ? p.in[0] : p.out; const float* pw = p.in[2] + l * DMODEL;
    f32x4 wv[4];
#pragma unroll
    for (int j = 0; j < 4; ++j) wv[j] = ((const f32x4*)pw)[lane + 64 * j];
    for (int m0 = (blockIdx.x * 8 + wave) * 2; m0 < M_TOK; m0 += G * 16) {
        f32x4 v[2][4], x[2][4];
#pragma unroll
        for (int q = 0; q < 2; ++q)
#pragma unroll
            for (int j = 0; j < 4; ++j) { v[q][j] = ((const f32x4*)(mix + (size_t)(m0 + q) * DMODEL))[lane + 64 * j]; x[q][j] = ((const f32x4*)(xin + (size_t)(m0 + q) * DMODEL))[lane + 64 * j]; }
#pragma unroll
        for (int q = 0; q < 2; ++q) { float s = 0.f;
#pragma unroll
            for (int j = 0; j < 4; ++j) s += (v[q][j].x * v[q][j].x + v[q][j].y * v[q][j].y) + (v[q][j].z * v[q][j].z + v[q][j].w * v[q][j].w);
            const float rs = rsqrtf(wave_sum(s) * (1.f / DMODEL) + NORM_EPS); float s2 = 0.f;
#pragma unroll
            for (int j = 0; j < 4; ++j) { v[q][j] = x[q][j] + v[q][j] * rs * wv[j]; s2 += (v[q][j].x * v[q][j].x + v[q][j].y * v[q][j].y) + (v[q][j].z * v[q][j].z + v[q][j].w * v[q][j].w); }
            s2 = wave_sum(s2);
            if (lane == 0) ((float*)(g_scr + SCR_RS))[m0 + q] = rsqrtf(s2 * (1.f / DMODEL) + NORM_EPS); }
#pragma unroll
        for (int q = 0; q < 2; ++q) { f32x4* orow = (f32x4*)(p.out + (size_t)(m0 + q) * DMODEL) + lane; u32x2* o8 = (u32x2*)((bf16_t*)(g_scr + SCR_XB) + (size_t)(m0 + q) * DMODEL) + lane;
#pragma unroll
            for (int j = 0; j < 4; ++j) { orow[64 * j] = v[q][j]; u32x2 w; w.x = pk2(v[q][j].x, v[q][j].y); w.y = pk2(v[q][j].z, v[q][j].w); o8[64 * j] = w; } }
    }
}

#define XB_TMO      128
#define XB_XCNT(j)  (256  + 64 * (j))
#define XB_XSUB(j)  (1280 + 64 * (j))
#define XB_XGEN(j)  (2304 + 64 * (j))
#define XB_TOP      3328
#define XB_TOPGEN   3392
#define XCD_BAR_WORDS 3456
#define XB_SPIN_CAP (1u << 18)
#define XLAS __attribute__((address_space(3)))
__device__ __forceinline__ unsigned xb_ld(unsigned* p)              { return __hip_atomic_load(p, __ATOMIC_RELAXED, __HIP_MEMORY_SCOPE_AGENT); }
__device__ __forceinline__ unsigned xb_add(unsigned* p, unsigned v) { return __hip_atomic_fetch_add(p, v, __ATOMIC_RELAXED, __HIP_MEMORY_SCOPE_AGENT); }
__device__ __forceinline__ unsigned xb_xcc_id() { return (unsigned)__builtin_amdgcn_s_getreg((3 << 11) | 20) & 0xFu; }
#define XB_SPIN(cond, bar) do { unsigned _sp = 0; while (cond) { __builtin_amdgcn_s_sleep(1); \
    if ((++_sp & 255u) == 0u) { if (xb_ld(&(bar)[XB_TMO])) break; if (_sp > XB_SPIN_CAP) { atomicAdd(&(bar)[XB_TMO], 1u); break; } } } } while (0)
struct XcdBarrier { unsigned* bar; unsigned x; volatile XLAS unsigned* st; };
__device__ __forceinline__ XcdBarrier xcd_barrier_post(unsigned* bar, volatile XLAS unsigned* st) {
    XcdBarrier b; b.bar = bar; b.x = xb_xcc_id(); b.st = st;
    if (threadIdx.x == 0) (void)xb_add(&bar[XB_XCNT(b.x)], 1u);
    return b;
}
__device__ __forceinline__ void xcd_barrier_complete(unsigned* bar, unsigned x, unsigned& nloc, unsigned& nx) {
    const unsigned G = gridDim.x * gridDim.y * gridDim.z;
    unsigned sum, cnt, mine, sp = 0u;
    for (;;) {
        sum = 0u; cnt = 0u; mine = 0u;
#pragma unroll
        for (unsigned j = 0; j < 16; ++j) { const unsigned c = xb_ld(&bar[XB_XCNT(j)]); sum += c; cnt += (c > 0u) ? 1u : 0u; mine = (j == x) ? c : mine; }
        if (sum == G) break;
        __builtin_amdgcn_s_sleep(1);
        if ((++sp & 255u) == 0u) { if (xb_ld(&bar[XB_TMO])) break; if (sp > XB_SPIN_CAP) { atomicAdd(&bar[XB_TMO], 1u); break; } }
    }
    nloc = mine > 0u ? mine : 1u; nx = cnt > 0u ? cnt : 1u;
}
__device__ __forceinline__ void xcd_barrier(const XcdBarrier& b) {
    asm volatile("s_waitcnt vmcnt(0)" ::: "memory");
    __syncthreads();
    if (threadIdx.x == 0) {
        unsigned* bar = b.bar;
        __builtin_amdgcn_s_waitcnt(0);
        unsigned nloc = b.st[0], nx = b.st[1];
        if (nloc == 0u) { xcd_barrier_complete(bar, b.x, nloc, nx); b.st[0] = nloc; b.st[1] = nx; }
        const unsigned old = xb_add(&bar[XB_XSUB(b.x)], 1u);
        const unsigned gen = old / nloc;
        if (old + 1u == (gen + 1u) * nloc) {
            __builtin_amdgcn_fence(__ATOMIC_RELEASE, "agent");
            asm volatile("s_waitcnt vmcnt(0)" ::: "memory");
            const unsigned og = xb_add(&bar[XB_TOP], 1u);
            const unsigned tg = og / nx;
            if (og + 1u == (tg + 1u) * nx) xb_add(&bar[XB_TOPGEN], 1u);
            else XB_SPIN(xb_ld(&bar[XB_TOPGEN]) == tg, bar);
            __builtin_amdgcn_fence(__ATOMIC_ACQUIRE, "agent");
            xb_add(&bar[XB_XGEN(b.x)], 1u);
            asm volatile("s_waitcnt vmcnt(0)" ::: "memory");
        } else {
            XB_SPIN(xb_ld(&bar[XB_XGEN(b.x)]) == gen, bar);
            __builtin_amdgcn_fence(__ATOMIC_ACQUIRE, "agent");
            asm volatile("s_waitcnt vmcnt(0)" ::: "memory");
        }
    }
    __syncthreads();
}

constexpr int LDS_BYTES = 155648;
static_assert(rk::O_END <= LDS_BYTES, "rwkv LDS map");
__device__ __forceinline__ void phase_gemm_in(const Params& p, const int l, unsigned char* lds) {
    pg8::Gemm g{(const bf16_t*)(g_scr + SCR_XB), (const bf16_t*)(g_scr + SCR_WIN + (size_t)l * 15 * MiB), M_TOK, NPROJ, DMODEL, DMODEL, 128};
    pg8::StaticOrder S; S.init(M_TOK, NPROJ, gridDim.x, blockIdx.x);
    pg8::EpiProj E{(bf16_t*)p.ws, (const float*)(g_scr + SCR_RS), (float*)(g_scr + SCR_DT)};
    pg8::gemm_phase<pg8::EpiProj, pg8::StaticOrder, true, true>((PG8_LAS unsigned char*)lds, g, S, E);
}
__device__ __forceinline__ void phase_gemm_out(const Params& p, const int l, unsigned char* lds) {
    pg8::Gemm g{(const bf16_t*)p.ws, (const bf16_t*)(g_scr + SCR_WOUT + (size_t)l * 4 * MiB), M_TOK, DMODEL, DMIX, 128, PBLK_ELEMS};
    pg8::StaticOrder S; S.init(M_TOK, DMODEL, gridDim.x, blockIdx.x);
    pg8::EpiMix E{(float*)(p.ws + WS_MIX)};
    pg8::gemm_phase<pg8::EpiMix, pg8::StaticOrder, true, true>((PG8_LAS unsigned char*)lds, g, S, E);
}
__device__ __forceinline__ unsigned long long phase_mixers(const Params& p, const int l, unsigned char* lds) {
    unsigned long long pr = 0;
    const int bid = blockIdx.x;
#ifdef PRB_SEQ
    const unsigned long long ts0 = __builtin_amdgcn_s_memrealtime();
#endif
    unsigned* seqdone = (unsigned*)(g_scr + SCR_CTL) + 200 + 8 * l; unsigned* cmbctr = seqdone + 1;
    if (bid < 32) rk::chain(p, bid, lds);
    else if (bid < 64) { const unsigned long long q_ = sd::seq(p, l, bid - 32, lds); (void)q_;
#ifdef PRB_SDIV
        pr = q_;
#endif
    }
    if (bid < 64) {
        asm volatile("s_waitcnt vmcnt(0)" ::: "memory"); __syncthreads();
        if (threadIdx.x == 0) { __builtin_amdgcn_fence(__ATOMIC_RELEASE, "agent"); asm volatile("s_waitcnt vmcnt(0)" ::: "memory"); __hip_atomic_fetch_add(seqdone, 1u, __ATOMIC_RELAXED, __HIP_MEMORY_SCOPE_AGENT); }
    }
#ifdef PRB_SEQ
    pr = __builtin_amdgcn_s_memrealtime() - ts0;
#endif
    unsigned* ctr = (unsigned*)(g_scr + SCR_CTL) + 64 * l;
    unsigned* slot = (unsigned*)(lds + LDS_BYTES - 16);
#ifdef PRB_UNIT
    int nun = 0;
#endif
    const int x0 = (int)(__builtin_amdgcn_s_getreg((3 << 11) | 20) & 7u);
    for (int dx = 0; dx < 8; ++dx) { const int x = (x0 + dx) & 7;
        for (;;) {
            __syncthreads();
            if (threadIdx.x == 0) *slot = atomicAdd(ctr + x, 1u);
            __syncthreads();
            const int j = (int)__builtin_amdgcn_readfirstlane(*slot);
            constexpr int NSPL = 16;
            if (j >= 96 + NSPL) break;
#ifdef PRB_UNIT
            const unsigned long long tu0 = __builtin_amdgcn_s_memrealtime();
#endif
            if (j < 32) gqa_unit(p, l, x * 32 + j, (char*)lds);
            else if (j < 96 - NSPL) diff_unit(p, l, x * 64 + (j - 32), (char*)lds);
            else { const int s = j - (96 - NSPL); diff_unit(p, l, x * 64 + (64 - NSPL) + (s >> 1), (char*)lds, s & 1, x * NSPL + (s >> 1)); }
#ifdef PRB_UNIT
            if (nun == PRB_UNIT) pr = __builtin_amdgcn_s_memrealtime() - tu0;
            if (PRB_UNIT == 99) pr = (unsigned long long)(nun + 1) * 10000ull + (j < 32 ? 1000ull : 0ull);
            ++nun;
#endif
        } }
    {   if (threadIdx.x == 0) { unsigned sp = 0; while (__hip_atomic_load(seqdone, __ATOMIC_RELAXED, __HIP_MEMORY_SCOPE_AGENT) < 64u) { __builtin_amdgcn_s_sleep(8); if (++sp > (1u << 22)) break; } }
        __syncthreads();
        __builtin_amdgcn_fence(__ATOMIC_ACQUIRE, "agent"); asm volatile("s_waitcnt vmcnt(0)" ::: "memory");
        const int wave = otid() >> 6;
        for (;;) {
            __syncthreads();
            if (threadIdx.x == 0) *slot = atomicAdd(cmbctr, 1u);
            __syncthreads();
            const int it = (int)__builtin_amdgcn_readfirstlane(*slot);
            if (it >= M_TOK / 64) break;
            combine_tokens(p, l, it * 64 + wave, it * 64 + 64, 8);
        } }
    return pr;
}
#ifdef PROBE
#define PT0(ph) do { if (l == 0 && (ph) == PRB_PH) pt0 = __builtin_amdgcn_s_memrealtime(); } while (0)
#define PT1(ph, aftersync) do { if (l == 0 && (ph) == PRB_PH && (aftersync) == PRB_SYNC) pd = __builtin_amdgcn_s_memrealtime() - pt0; } while (0)
#else
#define PT0(ph) do {} while (0)
#define PT1(ph, aftersync) do {} while (0)
#endif
__global__ void __launch_bounds__(512) mega(const Params p) {
    extern __shared__ __attribute__((aligned(16))) unsigned char lds[];
    cg::grid_group grid = cg::this_grid();
    unsigned* xbar = (unsigned*)(g_scr + SCR_BAR);
    volatile XLAS unsigned* xst = (volatile XLAS unsigned*)(XLAS unsigned char*)(lds + LDS_BYTES - 32);
    if (blockIdx.x == 0) for (int i = threadIdx.x; i < XCD_BAR_WORDS; i += 512) xbar[i] = 0u;
    if (threadIdx.x < 2) xst[threadIdx.x] = 0u;
#ifdef PROBE
    unsigned long long pt0 = 0, pd = 0;
#endif
#ifdef PROBE
    if (PRB_PH == 7) pt0 = __builtin_amdgcn_s_memrealtime();
#endif
    phase_prologue(p, (float*)lds); grid.sync();
    const XcdBarrier xb = xcd_barrier_post(xbar, xst);
#define GRID_BAR() xcd_barrier(xb)
#ifdef PROBE
    if (PRB_PH == 7) pd = __builtin_amdgcn_s_memrealtime() - pt0;
#endif
#pragma unroll 1
    for (int l = 0; l < 2; ++l) {
        PT0(0); phase_gemm_in(p, l, lds); PT1(0, 0); GRID_BAR(); PT1(0, 1);
        PT0(1); phase_prep(p, l); PT1(1, 0); GRID_BAR(); PT1(1, 1);
        kmax_reduce(l, (float*)lds);
        PT0(6); { const unsigned long long pr_ = rk::pass1(p, l, lds); (void)pr_;
#ifdef PRB_IV
        if (l == 0) pd = pr_;
#endif
        } PT1(6, 0); GRID_BAR(); PT1(6, 1);
        PT0(2); { const unsigned long long pr_ = phase_mixers(p, l, lds); (void)pr_;
#if defined(PRB_SEQ) || defined(PRB_SDIV) || defined(PRB_UNIT)
        if (l == 0) pd = pr_;
#endif
        } PT1(2, 0); GRID_BAR(); PT1(2, 1);
        PT0(4); phase_gemm_out(p, l, lds); PT1(4, 0); GRID_BAR(); PT1(4, 1);
        PT0(5); phase_post(p, l); PT1(5, 0); if (l == 0) { GRID_BAR(); PT1(5, 1); }
    }
#ifdef PROBE
    if (blockIdx.x == PRB_BLK && threadIdx.x == 0) { const unsigned long long d = pd * PRB_K; const unsigned long long t0 = __builtin_amdgcn_s_memrealtime();
        while (__builtin_amdgcn_s_memrealtime() - t0 < d) __builtin_amdgcn_s_sleep(8); }
#endif
}

extern "C" void kernel_launch(void* const* d_in, const int* in_sizes, int n_in, void* d_out, int out_size, void* d_ws, size_t ws_size, hipStream_t stream) {
    static int grid_blocks = 0;
    if (!grid_blocks) {
        int dev = 0, cus = 0, per_cu = 0;
        (void)hipGetDevice(&dev);
        (void)hipDeviceGetAttribute(&cus, hipDeviceAttributeMultiprocessorCount, dev);
        (void)hipFuncSetAttribute((const void*)mega, hipFuncAttributeMaxDynamicSharedMemorySize, LDS_BYTES);
        (void)hipOccupancyMaxActiveBlocksPerMultiprocessor(&per_cu, (const void*)mega, 512, LDS_BYTES);
        if (per_cu < 1) { fprintf(stderr, "kernel_launch: occupancy query says %d blocks/CU\n", per_cu); per_cu = 1; }
        grid_blocks = cus;
    }
    Params p{};
    for (int i = 0; i < 25; ++i) p.in[i] = (const float*)d_in[i];
    p.out = (float*)d_out; p.ws = (unsigned char*)d_ws;
    void* args[] = {&p};
    hipError_t e = hipLaunchCooperativeKernel((const void*)mega, dim3(grid_blocks), dim3(512), args, LDS_BYTES, stream);
    if (e != hipSuccess) fprintf(stderr, "cooperative launch failed: %s (grid %d)\n", hipGetErrorString(e), grid_blocks);
}
```

```cpp
#include <hip/hip_runtime.h>
#include <hip/hip_bf16.h>
#include <hip/hip_cooperative_groups.h>
#include <cstdio>
#include <cstdint>
namespace cg = cooperative_groups;

constexpr int M_TOK = 16384, SEQ = 8192, DMODEL = 1024, NPROJ = 7424, NPB = 58, DIN_ORIG = 7312, DMIX = 2048;
constexpr float NORM_EPS = 1e-6f;
constexpr size_t MiB = 1u << 20;
constexpr int PB_Z = 0, PB_RG = 4, PB_DQ = 8, PB_GQ = 12, PB_XS = 16, PB_BM = 20, PB_CM = 22, PB_R = 24, PB_K = 28, PB_V = 32, PB_WA = 36,
              PB_DK = 37, PB_DV = 41, PB_DG = 45, PB_GK = 49, PB_GV = 51, PB_GG = 53, PB_DT = 57;
constexpr size_t PBLK_ELEMS = (size_t)M_TOK * 128;
constexpr size_t SCR_WIN = 0, SCR_WOUT = 30 * MiB, SCR_ROPE = 38 * MiB, SCR_DT = 40 * MiB, SCR_RS = 41 * MiB, SCR_CTL = 41 * MiB + 512 * 1024,
                 SCR_BAR = 41 * MiB + 768 * 1024, SCR_XB = 42 * MiB, SCR_WKV = 74 * MiB, SCR_BON = 106 * MiB, SCR_SSDY = 138 * MiB, SCR_XACT = 170 * MiB, SCR_NN2 = 202 * MiB, SCR_SPL = 210 * MiB, SCR_BYTES = 228 * MiB;
constexpr size_t SCR_KPART = 41 * MiB + 64 * 1024;
constexpr size_t WS_MM = 16 * PBLK_ELEMS * 2;
constexpr size_t WS_NN = 58 * PBLK_ELEMS * 2;
constexpr size_t WS_MIX = 16 * PBLK_ELEMS * 2;
__device__ __attribute__((aligned(256))) unsigned char g_scr[SCR_BYTES];

typedef unsigned short bf16_t;
typedef short bf16x8 __attribute__((ext_vector_type(8)));
typedef float f32x4 __attribute__((ext_vector_type(4)));
typedef unsigned u32x4 __attribute__((ext_vector_type(4)));
typedef unsigned u32x2 __attribute__((ext_vector_type(2)));

struct Params {
    const float* in[25];
    float* out;
    unsigned char* ws;
};

__device__ __forceinline__ int otid() { int t = threadIdx.x; asm volatile("" : "+v"(t)); return t; }
__device__ __forceinline__ float bf2f(bf16_t v) { return __uint_as_float(((unsigned)v) << 16); }
typedef float f32x2_t __attribute__((ext_vector_type(2))); typedef __bf16 bf16x2_t __attribute__((ext_vector_type(2)));
__device__ __forceinline__ unsigned pk2(float lo, float hi) { f32x2_t v = {lo, hi}; bf16x2_t b = __builtin_convertvector(v, bf16x2_t); return __builtin_bit_cast(unsigned, b); }
__device__ __forceinline__ bf16_t f2bf(float f) { return (bf16_t)(pk2(f, 0.f) & 0xffffu); }
__device__ __forceinline__ float wave_sum(float v) {
#pragma unroll
    for (int o = 1; o < 64; o <<= 1) v += __shfl_xor(v, o);
    return v;
}
__device__ __forceinline__ float siluf(float x) { return x / (1.f + __expf(-x)); }
__device__ __forceinline__ float softplusf(float x) { return fmaxf(x, 0.f) + log1pf(__expf(-fabsf(x))); }
__device__ __forceinline__ bf16_t* pblk(unsigned char* ws, int j) { return (bf16_t*)ws + (size_t)j * PBLK_ELEMS; }

namespace pg8 {
#define PG8_LAS __attribute__((address_space(3)))
constexpr int BM = 256, BK = 64, HALF = 128, HTB = HALF * BK * 2, STAGE_BYTES = 8 * HTB, NXCD = 8, WGM = 8;
__host__ __device__ __forceinline__ int lds_byte(int r, int c) { const int st = (r >> 4) * 2 + (c >> 5), rr = r & 15, cc = c & 31, ob = rr * 64 + cc * 2; return st * 1024 + (ob ^ (((ob >> 9) & 1) << 5)); }
__host__ __device__ __forceinline__ void stage_rc(int b, int& R, int& C) { const int st = b / 1024, sb = b % 1024, swz = sb ^ (((sb >> 9) & 1) << 5); R = (st >> 1) * 16 + swz / 64; C = (st & 1) * 32 + (swz % 64) / 2; }
__host__ __device__ __forceinline__ int perm32(int rho) { const int n = rho >> 4, i = rho & 15; return 8 * (i >> 2) + 4 * n + (i & 3); }
struct Unit { int pm, pn; };
struct Gemm { const bf16_t* A; const bf16_t* Bt; int M, N, K; int lda; size_t abig; };
struct StaticOrder {
    int nM, nN, nwg, G, c;
    __host__ __device__ void init(int M, int N, int G_, int c_) { nM = M / BM; nN = N / BM; nwg = nM * nN; G = G_; c = c_; }
    __host__ __device__ bool next(int i, Unit& u) const {
        const long L = (long)i * G + c; if (L >= nwg) return false;
        int wgid = (int)L; { const int q = nwg / NXCD, r = nwg % NXCD, xcd = wgid % NXCD, off = wgid / NXCD; wgid = (xcd < r ? xcd * (q + 1) : r * (q + 1) + (xcd - r) * q) + off; }
        const int nig = WGM * nN, gid = wgid / nig, fm = gid * WGM, gsz = (nM - fm) < WGM ? (nM - fm) : WGM;
        u.pm = fm + ((wgid % nig) % gsz); u.pn = (wgid % nig) / gsz; return true;
    }
};
template <class Epi, class Sched, bool ALIGN_EPI = false, bool SP2 = false>
__device__ __forceinline__ void gemm_phase(PG8_LAS unsigned char* lds, const Gemm g, const Sched& S, const Epi& E) {
    const int tid = otid(), wid = __builtin_amdgcn_readfirstlane(tid >> 6), lane = tid & 63, wr = wid >> 2, wc = wid & 3, fr = lane & 15, fq = lane >> 4;
    const int K = g.K, nt = K / BK;
    unsigned voffA[2], voffB[2];
#pragma unroll
    for (int i = 0; i < 2; ++i) { int R, C; stage_rc(tid * 16 + i * 8192, R, C); const int Rb = Epi::PERM ? ((R & ~31) + perm32(R & 31)) : R;
        voffA[i] = (unsigned)(R * g.lda + C) * 2u; voffB[i] = (unsigned)(Rb * K + C) * 2u; }
    const size_t kstep = (size_t)(BK * 2);
    const size_t abig = g.abig * 2;
    const size_t hstepA = (size_t)HALF * g.lda * 2, hstepB = (size_t)HALF * K * 2;
    const size_t tstepA = 2 * hstepA, tstepB = 2 * hstepB;
    const unsigned ldsw = (unsigned)wid * 1024u;
    const int aoff = lds_byte(wr * 64 + fr, fq * 8), boff = lds_byte(wc * 32 + fr, fq * 8);
#define PG8_SA(b, h) (((b) * 2 + (h)) * HTB)
#define PG8_SB(b, h) ((4 + (b) * 2 + (h)) * HTB)
#define PG8_STAGE(bufoff, gbase, voff) do { _Pragma("unroll") for (int _i = 0; _i < 2; ++_i) \
        __builtin_amdgcn_global_load_lds((const unsigned*)((const char*)(gbase) + (voff)[_i]), (PG8_LAS unsigned*)(lds + (bufoff) + ldsw + _i * 8192), 16, 0, 0); } while (0)
#define PG8_LDA(dst, b, h) do { _Pragma("unroll") for (int m = 0; m < 4; ++m) _Pragma("unroll") for (int k = 0; k < 2; ++k) dst[m][k] = *(const PG8_LAS bf16x8*)(lds + PG8_SA(b, h) + aoff + m * 2048 + k * 1024); } while (0)
#define PG8_LDB(dst, b, h) do { _Pragma("unroll") for (int n = 0; n < 2; ++n) _Pragma("unroll") for (int k = 0; k < 2; ++k) dst[n][k] = *(const PG8_LAS bf16x8*)(lds + PG8_SB(b, h) + boff + n * 2048 + k * 1024); } while (0)
#define PG8_MMA(ai, bj, At, Bt) do { __builtin_amdgcn_s_setprio(1); _Pragma("unroll") for (int m = 0; m < 4; ++m) _Pragma("unroll") for (int n = 0; n < 2; ++n) _Pragma("unroll") for (int k = 0; k < 2; ++k) \
        acc[ai][bj][m][n] = __builtin_amdgcn_mfma_f32_16x16x32_bf16(Bt[n][k], At[m][k], acc[ai][bj][m][n], 0, 0, 0); __builtin_amdgcn_s_setprio(0); } while (0)
#define PG8_WAIT_V(n) asm volatile("s_waitcnt vmcnt(" #n ")" ::: "memory")
#define PG8_WAIT_L(n) asm volatile("s_waitcnt lgkmcnt(" #n ")" ::: "memory")
#define PG8_BAR __builtin_amdgcn_s_barrier()
#define PG8_SCHED __builtin_amdgcn_sched_barrier(0)
    Unit cur, nxt; int ui = 0;
    if (!S.next(0, cur)) return;
    f32x4 acc[2][2][4][2];
#pragma unroll
    for (int a = 0; a < 2; ++a)
#pragma unroll
        for (int b = 0; b < 2; ++b)
#pragma unroll
            for (int m = 0; m < 4; ++m)
#pragma unroll
                for (int n = 0; n < 2; ++n) acc[a][b][m][n] = (f32x4){0.f, 0.f, 0.f, 0.f};
    bf16x8 At[4][2], B0[2][2], B1[2][2];
    const char* cA = (const char*)g.A + (size_t)cur.pm * tstepA; const char* cB = (const char*)g.Bt + (size_t)cur.pn * tstepB;
    if constexpr (SP2) {
        PG8_STAGE(PG8_SB(0, 0), cB, voffB); PG8_STAGE(PG8_SB(0, 1), cB + hstepB, voffB); PG8_STAGE(PG8_SA(0, 0), cA, voffA); PG8_STAGE(PG8_SA(0, 1), cA + hstepA, voffA);
        if (wr == 1) PG8_BAR;
        PG8_WAIT_V(2); PG8_BAR;
        PG8_STAGE(PG8_SB(1, 0), cB + kstep, voffB); PG8_STAGE(PG8_SA(1, 0), cA + kstep, voffA); PG8_STAGE(PG8_SB(1, 1), cB + hstepB + kstep, voffB);
        PG8_WAIT_V(6); PG8_BAR;
    } else {
        PG8_STAGE(PG8_SB(0, 0), cB, voffB); PG8_STAGE(PG8_SA(0, 0), cA, voffA); PG8_STAGE(PG8_SB(0, 1), cB + hstepB, voffB); PG8_STAGE(PG8_SA(0, 1), cA + hstepA, voffA);
        if (wr == 1) PG8_BAR;
        PG8_WAIT_V(4); PG8_BAR;
        PG8_STAGE(PG8_SB(1, 0), cB + kstep, voffB); PG8_STAGE(PG8_SA(1, 0), cA + kstep, voffA); PG8_STAGE(PG8_SB(1, 1), cB + hstepB + kstep, voffB);
        PG8_WAIT_V(6); PG8_BAR;
    }
    for (;;) {
        const bool has_next = S.next(ui + 1, nxt);
        const char* nA = has_next ? (const char*)g.A + (size_t)nxt.pm * tstepA : cA; const char* nB = has_next ? (const char*)g.Bt + (size_t)nxt.pn * tstepB : cB;
        for (int t = 0; t < nt; t += 2) {
            const bool last = (t == nt - 2);
            const char* a1 = cA + (size_t)(t >> 1) * abig + kstep;
            const char* a2 = last ? nA : cA + (size_t)((t >> 1) + 1) * abig; const char* b2 = last ? nB : cB + (size_t)(t + 2) * kstep;
            const char* a3 = a2 + kstep; const char* b3 = b2 + kstep;
            if constexpr (SP2) {
            PG8_LDB(B0, 0, 0); PG8_LDB(B1, 0, 1); PG8_SCHED; PG8_LDA(At, 0, 0); PG8_STAGE(PG8_SA(1, 1), a1 + hstepA, voffA);
            PG8_WAIT_V(8); PG8_WAIT_L(0); PG8_BAR; PG8_MMA(0, 0, At, B0); PG8_MMA(0, 1, At, B1); PG8_BAR; PG8_SCHED;
            PG8_LDA(At, 0, 1); PG8_STAGE(PG8_SB(0, 0), b2, voffB); PG8_STAGE(PG8_SB(0, 1), b2 + hstepB, voffB); PG8_STAGE(PG8_SA(0, 0), a2, voffA);
            PG8_WAIT_V(8); PG8_WAIT_L(0); PG8_BAR; PG8_MMA(1, 0, At, B0); PG8_MMA(1, 1, At, B1); PG8_BAR; PG8_SCHED;
            PG8_LDB(B0, 1, 0); PG8_LDB(B1, 1, 1); PG8_SCHED; PG8_LDA(At, 1, 0); PG8_STAGE(PG8_SA(0, 1), a2 + hstepA, voffA);
            PG8_WAIT_V(8); PG8_WAIT_L(0); PG8_BAR; PG8_MMA(0, 0, At, B0); PG8_MMA(0, 1, At, B1); PG8_BAR; PG8_SCHED;
            PG8_LDA(At, 1, 1); PG8_STAGE(PG8_SB(1, 0), b3, voffB); PG8_STAGE(PG8_SB(1, 1), b3 + hstepB, voffB); PG8_STAGE(PG8_SA(1, 0), a3, voffA);
            PG8_WAIT_V(8); PG8_WAIT_L(0); PG8_BAR; PG8_MMA(1, 0, At, B0); PG8_MMA(1, 1, At, B1); PG8_BAR; PG8_SCHED;
            } else {
            PG8_LDB(B0, 0, 0); PG8_SCHED; PG8_LDA(At, 0, 0); PG8_STAGE(PG8_SA(1, 1), a1 + hstepA, voffA);
            PG8_WAIT_L(8); PG8_BAR; PG8_WAIT_L(0); PG8_MMA(0, 0, At, B0); PG8_BAR; PG8_SCHED;
            PG8_LDB(B1, 0, 1); PG8_STAGE(PG8_SB(0, 0), b2, voffB);
            PG8_BAR; PG8_WAIT_L(0); PG8_MMA(0, 1, At, B1); PG8_BAR;
            PG8_LDA(At, 0, 1); PG8_STAGE(PG8_SA(0, 0), a2, voffA);
            PG8_BAR; PG8_WAIT_L(0); PG8_MMA(1, 0, At, B0); PG8_BAR; PG8_SCHED;
            PG8_STAGE(PG8_SB(0, 1), b2 + hstepB, voffB);
            PG8_WAIT_V(6); PG8_BAR; PG8_MMA(1, 1, At, B1); PG8_BAR;
            PG8_LDB(B0, 1, 0); PG8_SCHED; PG8_LDA(At, 1, 0); PG8_STAGE(PG8_SA(0, 1), a2 + hstepA, voffA);
            PG8_WAIT_L(8); PG8_BAR; PG8_WAIT_L(0); PG8_MMA(0, 0, At, B0); PG8_BAR; PG8_SCHED;
            PG8_LDB(B1, 1, 1); PG8_STAGE(PG8_SB(1, 0), b3, voffB);
            PG8_BAR; PG8_WAIT_L(0); PG8_MMA(0, 1, At, B1); PG8_BAR;
            PG8_LDA(At, 1, 1); PG8_STAGE(PG8_SA(1, 0), a3, voffA);
            PG8_BAR; PG8_WAIT_L(0); PG8_MMA(1, 0, At, B0); PG8_BAR; PG8_SCHED;
            PG8_STAGE(PG8_SB(1, 1), b3 + hstepB, voffB);
            PG8_WAIT_V(6); PG8_BAR; PG8_MMA(1, 1, At, B1); PG8_BAR;
            }
        }
        if constexpr (ALIGN_EPI) { if (wr == 0) PG8_BAR; }
        E(acc, cur, wr, wc, fr, fq);
        if (!has_next) break;
#pragma unroll
        for (int a = 0; a < 2; ++a)
#pragma unroll
            for (int b = 0; b < 2; ++b)
#pragma unroll
                for (int m = 0; m < 4; ++m)
#pragma unroll
                    for (int n = 0; n < 2; ++n) acc[a][b][m][n] = (f32x4){0.f, 0.f, 0.f, 0.f};
        cur = nxt; cA = nA; cB = nB; ++ui;
        if constexpr (ALIGN_EPI) { if (wr == 1) PG8_BAR; }
    }
    PG8_WAIT_V(0);
    if constexpr (!ALIGN_EPI) { if (wr == 0) PG8_BAR; }
    PG8_BAR;
#undef PG8_SA
#undef PG8_SB
#undef PG8_STAGE
#undef PG8_LDA
#undef PG8_LDB
#undef PG8_MMA
#undef PG8_WAIT_V
#undef PG8_WAIT_L
#undef PG8_BAR
#undef PG8_SCHED
}
struct EpiProj {
    static constexpr bool PERM = true;
    bf16_t* P; const float* rowscale; float* dtbuf;
    __device__ __forceinline__ void operator()(const f32x4 (&acc)[2][2][4][2], const Unit& u, int wr, int wc, int fr, int fq) const {
        const int row0 = u.pm * BM + wr * 64 + fr; const int col = wc * 32 + 8 * fq;
#pragma unroll
        for (int ai = 0; ai < 2; ++ai)
#pragma unroll
            for (int m = 0; m < 4; ++m) { const int row = row0 + ai * HALF + m * 16; const float sc = rowscale[row];
#pragma unroll
                for (int bj = 0; bj < 2; ++bj) { const int blk = u.pn * 2 + bj;
                    const f32x4 v0 = acc[ai][bj][m][0] * sc, v1 = acc[ai][bj][m][1] * sc;
                    u32x4 w; w.x = pk2(v0[0], v0[1]); w.y = pk2(v0[2], v0[3]); w.z = pk2(v1[0], v1[1]); w.w = pk2(v1[2], v1[3]);
                    *(u32x4*)(P + (size_t)blk * PBLK_ELEMS + (size_t)row * 128 + col) = w;
                    if (blk == PB_DT && col < 16) { float* d = dtbuf + (size_t)row * 16 + col; *(f32x4*)d = v0; *(f32x4*)(d + 4) = v1; } } }
    }
};
struct EpiMix {
    static constexpr bool PERM = true;
    bf16_t* O;
    __device__ __forceinline__ void operator()(const f32x4 (&acc)[2][2][4][2], const Unit& u, int wr, int wc, int fr, int fq) const {
        const int row0 = u.pm * BM + wr * 64 + fr; const int col0 = u.pn * BM + wc * 32 + 8 * fq;
#pragma unroll
        for (int ai = 0; ai < 2; ++ai)
#pragma unroll
            for (int m = 0; m < 4; ++m) { bf16_t* rp = O + (size_t)(row0 + ai * HALF + m * 16) * DMODEL + col0;
#pragma unroll
                for (int bj = 0; bj < 2; ++bj) { const f32x4 a = acc[ai][bj][m][0], b = acc[ai][bj][m][1]; u32x4 w; w.x = pk2(a.x, a.y); w.y = pk2(a.z, a.w); w.z = pk2(b.x, b.y); w.w = pk2(b.z, b.w);
                    *(u32x4*)(rp + bj * HALF) = w; } }
    }
};
}

__device__ __forceinline__ int orig_col(int n) {
    if (n < 512) return n;
    if (n < 1024) return 3216 + (n - 512);
    if (n < 1536) return 3728 + (n - 1024);
    if (n < 2048) return 5776 + (n - 1536);
    if (n < 3072) return 512 + (n - 2048);
    if (n < 4736) return 1552 + (n - 3072);
    if (n < 5248) return 4240 + (n - 4736);
    if (n < 5760) return 4752 + (n - 5248);
    if (n < 6272) return 5264 + (n - 5760);
    if (n < 6528) return 6288 + (n - 6272);
    if (n < 6784) return 6544 + (n - 6528);
    if (n < 7296) return 6800 + (n - 6784);
    if (n < 7312) return 1536 + (n - 7296);
    return -1;
}
struct TrItem { const float* W; const float* ks; bf16_t* WT; int K, Nsrc, k0, n0; bool mapcol; };
__device__ __forceinline__ TrItem tr_item(const Params& p, int it) {
    constexpr int I_IN = 16 * 29, I_OUT = 32 * 4;
    TrItem t; int r = it; const int l = r / (I_IN + I_OUT); r -= l * (I_IN + I_OUT);
    if (r < I_IN) { t.W = p.in[3] + (size_t)l * DMODEL * DIN_ORIG; t.ks = p.in[1] + l * DMODEL; t.WT = (bf16_t*)(g_scr + SCR_WIN + (size_t)l * 15 * MiB); t.K = DMODEL; t.Nsrc = DIN_ORIG; t.k0 = (r / 29) * 64; t.n0 = (r % 29) * 256; t.mapcol = true; }
    else { r -= I_IN; t.W = p.in[4] + (size_t)l * DMIX * DMODEL; t.ks = nullptr; t.WT = (bf16_t*)(g_scr + SCR_WOUT + (size_t)l * 4 * MiB); t.K = DMIX; t.Nsrc = DMODEL; t.k0 = (r / 4) * 64; t.n0 = (r % 4) * 256; t.mapcol = false; }
    return t;
}
__device__ __forceinline__ void tr_load(const TrItem& t, int tid, float* v, float* sc, int& okm) {
    const int nn = tid & 63; int occ[4]; bool ok[4];
#pragma unroll
    for (int i = 0; i < 8; ++i) { const int kk = (tid >> 6) + 8 * i; sc[i] = t.ks ? t.ks[t.k0 + kk] : 1.f; }
#pragma unroll
    for (int q = 0; q < 4; ++q) { const int n = t.n0 + 64 * q + nn; const int oc = t.mapcol ? orig_col(n) : n; ok[q] = oc >= 0; occ[q] = oc >= 0 ? oc : 0; }
#pragma unroll
    for (int q = 0; q < 4; ++q)
#pragma unroll
        for (int i = 0; i < 8; ++i) { const int kk = (tid >> 6) + 8 * i; v[q * 8 + i] = t.W[(size_t)(t.k0 + kk) * t.Nsrc + occ[q]]; }
    okm = (ok[0] ? 1 : 0) | (ok[1] ? 2 : 0) | (ok[2] ? 4 : 0) | (ok[3] ? 8 : 0);
}
__device__ __forceinline__ void rope_entry(int idx, float* tab) {
    const int pos = idx >> 5, i = idx & 31;
    const float inv = exp2f(-(float)i * (13.287712379549449f / 32.f));
    const float ang = (float)pos * inv;
    const double rev = (double)ang * 0.15915494309189535; const double fr = rev - floor(rev);
    const float a = (float)(fr * 6.283185307179586);
    tab[idx * 2] = cosf(a); tab[idx * 2 + 1] = sinf(a);
}
__device__ __forceinline__ void xrow_to_bf16(const float* xrow, bf16_t* orow, float* rs, int lane) {
    const f32x4* xr = (const f32x4*)xrow + lane; f32x4 v[4]; float s = 0.f;
#pragma unroll
    for (int j = 0; j < 4; ++j) { v[j] = xr[64 * j]; s += (v[j].x * v[j].x + v[j].y * v[j].y) + (v[j].z * v[j].z + v[j].w * v[j].w); }
    s = wave_sum(s);
    if (lane == 0) *rs = rsqrtf(s * (1.f / DMODEL) + NORM_EPS);
    u32x2* o8 = (u32x2*)orow + lane;
#pragma unroll
    for (int j = 0; j < 4; ++j) { u32x2 w; w.x = pk2(v[j].x, v[j].y); w.y = pk2(v[j].z, v[j].w); o8[64 * j] = w; }
}
__device__ __forceinline__ void phase_prologue(const Params& p, float* lds_f) {
    const int G = gridDim.x, bid = blockIdx.x, tid = otid(), lane = tid & 63, wave = tid >> 6;
    {   constexpr int NIT = 2 * (16 * 29 + 32 * 4);
        float va[32], vb[32], vc[32], sa[8], sb[8], scc[8]; int oa = 0, ob = 0, oc = 0;
        const int nn = tid & 63;
#define W_LDSW(V, SC, OK) _Pragma("unroll") for (int q = 0; q < 4; ++q) _Pragma("unroll") for (int i = 0; i < 8; ++i) lds_f[q * 4160 + ((tid >> 6) + 8 * i) * 65 + nn] = ((OK >> q) & 1) ? V[q * 8 + i] * SC[i] : 0.f
#define W_STORE(C) _Pragma("unroll") for (int q = 0; q < 4; ++q) { const int n = tid >> 3, c = tid & 7; const float* s_ = lds_f + q * 4160 + (8 * c) * 65 + n; \
                u32x4 o; o.x = pk2(s_[0], s_[65]); o.y = pk2(s_[2 * 65], s_[3 * 65]); o.z = pk2(s_[4 * 65], s_[5 * 65]); o.w = pk2(s_[6 * 65], s_[7 * 65]); \
                *(u32x4*)(C.WT + (size_t)(C.n0 + 64 * q + n) * C.K + C.k0 + 8 * c) = o; }
#define W_STEP(VC, SC, OK, VL, SL, OL, S) { const int it_ = bid + (S) * G; if (it_ < NIT) { const TrItem c_ = tr_item(p, it_); W_LDSW(VC, SC, OK); const int n2_ = it_ + 2 * G; \
            if (n2_ < NIT) { const TrItem t2_ = tr_item(p, n2_); tr_load(t2_, tid, VL, SL, OL); } __syncthreads(); W_STORE(c_) __syncthreads(); } }
        if (bid < NIT) { const TrItem t0_ = tr_item(p, bid); tr_load(t0_, tid, va, sa, oa); }
        if (bid + G < NIT) { const TrItem t1_ = tr_item(p, bid + G); tr_load(t1_, tid, vb, sb, ob); }
        W_STEP(va, sa, oa, vc, scc, oc, 0) W_STEP(vb, sb, ob, va, sa, oa, 1) W_STEP(vc, scc, oc, vb, sb, ob, 2) W_STEP(va, sa, oa, vc, scc, oc, 3) W_STEP(vb, sb, ob, va, sa, oa, 4) W_STEP(vc, scc, oc, vb, sb, ob, 5)
        for (int it = bid + 6 * G; it < NIT; it += G) { const TrItem c_ = tr_item(p, it); tr_load(c_, tid, va, sa, oa); W_LDSW(va, sa, oa); __syncthreads(); W_STORE(c_) __syncthreads(); }
#undef W_STEP
#undef W_STORE
#undef W_LDSW
    }
    if (bid == 0) { ((unsigned*)(g_scr + SCR_CTL))[tid] = 0u; ((unsigned*)(g_scr + SCR_CTL))[512 + tid] = 0u; }
    for (int i = bid * 512 + tid; i < SEQ * 32; i += G * 512) rope_entry(i, (float*)(g_scr + SCR_ROPE));
    for (int m0 = bid * 8 + wave; m0 < M_TOK; m0 += G * 8 * 4) {
        f32x4 v[4][4];
#pragma unroll
        for (int r = 0; r < 4; ++r) { const int m = m0 + r * G * 8; if (m < M_TOK) { const f32x4* xr = (const f32x4*)(p.in[0] + (size_t)m * DMODEL) + lane;
#pragma unroll
            for (int j = 0; j < 4; ++j) v[r][j] = xr[64 * j]; } }
#pragma unroll
        for (int r = 0; r < 4; ++r) { const int m = m0 + r * G * 8; if (m < M_TOK) { float s = 0.f;
#pragma unroll
            for (int j = 0; j < 4; ++j) s += (v[r][j].x * v[r][j].x + v[r][j].y * v[r][j].y) + (v[r][j].z * v[r][j].z + v[r][j].w * v[r][j].w);
            s = wave_sum(s);
            if (lane == 0) ((float*)(g_scr + SCR_RS))[m] = rsqrtf(s * (1.f / DMODEL) + NORM_EPS);
            u32x2* o8 = (u32x2*)((bf16_t*)(g_scr + SCR_XB) + (size_t)m * DMODEL) + lane;
#pragma unroll
            for (int j = 0; j < 4; ++j) { u32x2 w; w.x = pk2(v[r][j].x, v[r][j].y); w.y = pk2(v[r][j].z, v[r][j].w); o8[64 * j] = w; } } }
    }
}

__device__ __forceinline__ void unpack8(const bf16x8 v, float* x) {
#pragma unroll
    for (int e = 0; e < 8; ++e) x[e] = bf2f((bf16_t)v[e]);
}
__device__ __forceinline__ u32x4 pack8(const float* x) { u32x4 o; o.x = pk2(x[0], x[1]); o.y = pk2(x[2], x[3]); o.z = pk2(x[4], x[5]); o.w = pk2(x[6], x[7]); return o; }
__device__ __forceinline__ void rope8(float* x, const float* cs, const bool upper) {
#pragma unroll
    for (int e = 0; e < 8; ++e) { const float o = __shfl_xor(x[e], 4); x[e] = upper ? (x[e] * cs[2 * e] + o * cs[2 * e + 1]) : (x[e] * cs[2 * e] - o * cs[2 * e + 1]); }
}
__device__ __forceinline__ void phase_prep(const Params& p, const int l) {
    const int G = gridDim.x;
    {   const int tid = otid(), lane = tid & 63, wave = tid >> 6;
        bf16x8 cv[5], nv_[5];
#define CONV_LOAD(dst, it_) do { const int m_ = (it_) >> 1, t_ = m_ & (SEQ - 1); const int ch_ = ((it_) & 1) * 512 + lane * 8; const bf16_t* src_ = pblk(p.ws, PB_XS + (ch_ >> 7)) + (ch_ & 127); \
            _Pragma("unroll") for (int jj = 0; jj < 5; ++jj) { const int tt = t_ + jj - 2; const bool ok = tt >= 0 && tt < SEQ; dst[jj] = ok ? *(const bf16x8*)(src_ + ((size_t)(m_ - t_ + tt)) * 128) : (bf16x8){0, 0, 0, 0, 0, 0, 0, 0}; } } while (0)
        int it = blockIdx.x * 8 + wave;
        if (it < M_TOK * 2) CONV_LOAD(cv, it);
        for (; it < M_TOK * 2; it += G * 8) {
            const int m = it >> 1, half = it & 1;
            const int ch = half * 512 + lane * 8;
            const float* cw = p.in[5] + (size_t)l * 5 * 1024 + ch; const float* cb = p.in[6] + (size_t)l * 1024 + ch;
            if (it + G * 8 < M_TOK * 2) CONV_LOAD(nv_, it + G * 8);
            float acc[8]; { const f32x4 b0 = *(const f32x4*)cb, b1 = *(const f32x4*)(cb + 4);
#pragma unroll
              for (int e = 0; e < 4; ++e) { acc[e] = b0[e]; acc[4 + e] = b1[e]; } }
#pragma unroll
            for (int jj = 0; jj < 5; ++jj) { const f32x4 w0 = *(const f32x4*)(cw + jj * 1024), w1 = *(const f32x4*)(cw + jj * 1024 + 4);
#pragma unroll
                for (int e = 0; e < 4; ++e) { acc[e] += w0[e] * bf2f((bf16_t)cv[jj][e]); acc[4 + e] += w1[e] * bf2f((bf16_t)cv[jj][4 + e]); } }
#pragma unroll
            for (int e = 0; e < 8; ++e) acc[e] = siluf(acc[e]);
            *(u32x4*)((bf16_t*)(g_scr + SCR_XACT) + (size_t)m * 1024 + ch) = pack8(acc);
#pragma unroll
            for (int jj = 0; jj < 5; ++jj) cv[jj] = nv_[jj];
        }
#undef CONV_LOAD
    }
    const int tid = otid(), lane = tid & 63, wave = tid >> 6;
    const float* tab = (const float*)(g_scr + SCR_ROPE);
    const int hh = lane >> 4, c16 = lane & 15, j8 = (c16 & 7) * 8, fi = j8 & 31; const bool upper = j8 >= 32, second = c16 >= 8;
    float kw[8];
#pragma unroll
    for (int e = 0; e < 8; ++e) kw[e] = p.in[24][l * 128 + c16 * 8 + e];
    float* kpart = (float*)(g_scr + SCR_KPART); const int gwv = blockIdx.x * 8 + wave;
    float mxd = 0.f, mxg = 0.f; int curb = (blockIdx.x * 8 + wave) >> 13;
    bf16x8 vdk, vgk, ndk, ngk; float cst[16], csa[16], nst[16], nsa[16];
#define QK_LOAD(m_, dk_, gk_, st_, sa_) do { const int t_ = (m_) & (SEQ - 1); const int row_ = t_ >> 6, col_ = t_ & 63; \
        dk_ = *(const bf16x8*)(pblk(p.ws, PB_DK + hh) + (size_t)(m_) * 128 + c16 * 8); gk_ = *(const bf16x8*)(pblk(p.ws, PB_GK + (hh & 1)) + (size_t)(m_) * 128 + c16 * 8); \
        const f32x4* a_ = (const f32x4*)(tab + ((size_t)t_ * 32 + fi) * 2); const f32x4* b_ = (const f32x4*)(tab + ((size_t)(second ? col_ : row_) * 32 + fi) * 2); \
        _Pragma("unroll") for (int i_ = 0; i_ < 4; ++i_) { const f32x4 u_ = a_[i_], v_ = b_[i_]; _Pragma("unroll") for (int e_ = 0; e_ < 4; ++e_) { st_[4 * i_ + e_] = u_[e_]; sa_[4 * i_ + e_] = v_[e_]; } } } while (0)
    {   const int m0 = blockIdx.x * 8 + wave; if (m0 < M_TOK) QK_LOAD(m0, vdk, vgk, cst, csa); }
    for (int m = blockIdx.x * 8 + wave; m < M_TOK; m += G * 8) {
        if ((m >> 13) != curb) {
            if ((lane & 7) == 0) { kpart[((size_t)(l * 2 + curb) * 10 + hh * 2 + (c16 >> 3)) * 2048 + gwv] = mxd; if (lane < 32 && c16 == 0) kpart[((size_t)(l * 2 + curb) * 10 + 8 + hh) * 2048 + gwv] = mxg; }
            mxd = 0.f; mxg = 0.f; curb = m >> 13; }
        bf16_t* pdk = pblk(p.ws, PB_DK + hh) + (size_t)m * 128 + c16 * 8; bf16_t* pgk = pblk(p.ws, PB_GK + (hh & 1)) + (size_t)m * 128 + c16 * 8;
        if (m + G * 8 < M_TOK) QK_LOAD(m + G * 8, ndk, ngk, nst, nsa);
        float x[8];
        unpack8(vdk, x);
        { float s2 = 0.f;
#pragma unroll
          for (int e = 0; e < 8; ++e) s2 += x[e] * x[e];
          s2 += __shfl_xor(s2, 1); s2 += __shfl_xor(s2, 2); s2 += __shfl_xor(s2, 4); mxd = fmaxf(mxd, s2); }
        rope8(x, cst, upper); const u32x4 odk = pack8(x);
        float ss;
        unpack8(vgk, x); ss = 0.f;
#pragma unroll
        for (int e = 0; e < 8; ++e) ss += x[e] * x[e];
        ss += __shfl_xor(ss, 1); ss += __shfl_xor(ss, 2); ss += __shfl_xor(ss, 4); ss += __shfl_xor(ss, 8);
        { const float rs = rsqrtf(ss * (1.f / 128.f) + NORM_EPS);
#pragma unroll
          for (int e = 0; e < 8; ++e) x[e] *= rs * kw[e]; }
        { float s2 = 0.f;
#pragma unroll
          for (int e = 0; e < 8; ++e) s2 += x[e] * x[e];
          s2 += __shfl_xor(s2, 1); s2 += __shfl_xor(s2, 2); s2 += __shfl_xor(s2, 4); s2 += __shfl_xor(s2, 8); mxg = fmaxf(mxg, s2); }
        rope8(x, csa, upper); const u32x4 ogk = pack8(x);
        *(u32x4*)pdk = odk; if (lane < 32) *(u32x4*)pgk = ogk;
        vdk = ndk; vgk = ngk;
#pragma unroll
        for (int e = 0; e < 16; ++e) { cst[e] = nst[e]; csa[e] = nsa[e]; }
    }
#undef QK_LOAD
    if ((lane & 7) == 0) { kpart[((size_t)(l * 2 + curb) * 10 + hh * 2 + (c16 >> 3)) * 2048 + gwv] = mxd; if (lane < 32 && c16 == 0) kpart[((size_t)(l * 2 + curb) * 10 + 8 + hh) * 2048 + gwv] = mxg; }
}

__device__ __forceinline__ void kmax_reduce(const int l, float* lds_f) {
    if (blockIdx.x < 20) {
        const int b = blockIdx.x / 10, slot = blockIdx.x % 10, tid = threadIdx.x;
        const float* src = (const float*)(g_scr + SCR_KPART) + ((size_t)(l * 2 + b) * 10 + slot) * 2048;
        float v = fmaxf(fmaxf(src[tid], src[512 + tid]), fmaxf(src[1024 + tid], src[1536 + tid]));
#pragma unroll
        for (int o = 1; o < 64; o <<= 1) v = fmaxf(v, __shfl_xor(v, o));
        if ((tid & 63) == 0) lds_f[tid >> 6] = v;
        __syncthreads();
        if (tid == 0) { float m = lds_f[0];
#pragma unroll
            for (int i = 1; i < 8; ++i) m = fmaxf(m, lds_f[i]);
            ((float*)(g_scr + SCR_CTL))[256 + 64 * l + (slot < 8 ? b * 8 + slot : 16 + b * 2 + (slot - 8))] = m; }
        __syncthreads();
    }
}

namespace att {
using s16x4 = __attribute__((ext_vector_type(4))) short;
using f32x16 = __attribute__((ext_vector_type(16))) float;
constexpr int D = 128, NW = 8, QBLK = 32, KVBLK = 64, LD = 128;
constexpr float THR = 8.f;
constexpr size_t SHM_V = KVBLK * D * 2, SHM_K = KVBLK * D * 2, SHM_ATTN = 2 * SHM_V + 2 * SHM_K + NW * 64 * 4;
#define KSWZ(row, colB) ((row) * 256 + ((colB) ^ (((row) & 15) << 4)))
#define SBAR() __builtin_amdgcn_sched_barrier(0)
__device__ __forceinline__ int crow(int r, int hi) { return (r & 3) + 8 * (r >> 2) + 4 * hi; }
__device__ __forceinline__ unsigned cvtpk(float lo, float hi) { unsigned r; asm volatile("v_cvt_pk_bf16_f32 %0, %1, %2" : "=v"(r) : "v"(lo), "v"(hi)); return r; }
__device__ __forceinline__ void glds16(const void* gsrc, unsigned lds_dst) {
  __builtin_amdgcn_global_load_lds((const unsigned*)gsrc, (PG8_LAS unsigned*)(uintptr_t)lds_dst, 16, 0, 0); }
template <int DIFF>
__device__ __forceinline__ void partialSM(f32x16& p0, f32x16& p1, const float mnC) {
  _Pragma("unroll") for (int r = 0; r < 16; ++r) p0[r] = __builtin_amdgcn_exp2f(p0[r]);
}
__device__ __forceinline__ void finishSM(f32x16& p0, f32x16& p1, float& l_reg, bf16x8& pa0, bf16x8& pa1, bf16x8& pa2, bf16x8& pa3) {
  _Pragma("unroll") for (int r = 0; r < 16; ++r) p1[r] = __builtin_amdgcn_exp2f(p1[r]);
  float ps = 0; _Pragma("unroll") for (int r = 0; r < 16; ++r) ps += p0[r]; _Pragma("unroll") for (int r = 0; r < 16; ++r) ps += p1[r];
  { auto rr = __builtin_amdgcn_permlane32_swap(__float_as_uint(ps), __float_as_uint(ps), false, false);
    ps = __uint_as_float(rr[0]) + __uint_as_float(rr[1]); }
  l_reg += ps;
#define PK4(P, BASE, OUT) do { unsigned a0 = cvtpk(P[BASE + 0], P[BASE + 1]), a1 = cvtpk(P[BASE + 2], P[BASE + 3]);   \
    unsigned b0 = cvtpk(P[BASE + 4], P[BASE + 5]), b1 = cvtpk(P[BASE + 6], P[BASE + 7]);                              \
    auto r0 = __builtin_amdgcn_permlane32_swap(a0, b0, false, false); auto r1 = __builtin_amdgcn_permlane32_swap(a1, b1, false, false); \
    u32x4 w = {r0[0], r1[0], r0[1], r1[1]}; OUT = *reinterpret_cast<bf16x8*>(&w); } while (0)
  PK4(p0, 0, pa0); PK4(p0, 8, pa1); PK4(p1, 0, pa2); PK4(p1, 8, pa3);
#undef PK4
}
template <int ND0>
__device__ __forceinline__ void qkt(f32x16& p0, f32x16& p1, const bf16_t* Ks, const bf16x8* qr, int r32, int hi, int db0, const f32x16& init) {
  p0 = init; p1 = init;
  _Pragma("unroll") for (int d0 = 0; d0 < ND0; ++d0) { int cb = ((db0 + d0) * 16 + hi * 8) * 2;
    bf16x8 b0 = *reinterpret_cast<const bf16x8*>((const char*)Ks + KSWZ(r32, cb));
    bf16x8 b1 = *reinterpret_cast<const bf16x8*>((const char*)Ks + KSWZ(32 + r32, cb));
    p0 = __builtin_amdgcn_mfma_f32_32x32x16_bf16(b0, qr[d0], p0, 0, 0, 0);
    p1 = __builtin_amdgcn_mfma_f32_32x32x16_bf16(b1, qr[d0], p1, 0, 0, 0); }
}
__device__ __forceinline__ int v_st(int k, int c) { const int kk = (k & ~0xC) | ((k & 4) << 1) | ((k & 8) >> 1); return ((kk >> 3) * 4 + (c >> 5)) * 512 + ((kk & 7) * 32 + (c & 31)) * 2; }
__device__ __forceinline__ int v_rd_base(int lane) { return ((lane & 3) << 3) | (((lane >> 2) & 3) << 6) | (((lane >> 4) & 1) << 5) | (((lane >> 5) & 1) << 8); }
constexpr int v_rd_off(int d0, int ks, int half) { return d0 * 512 + ks * 4096 + half * 2048; }
template <int OFF> __device__ __forceinline__ s16x4 tr_read(int vb) {
  s16x4 r; asm volatile("ds_read_b64_tr_b16 %0, %1 offset:%2" : "=&v"(r) : "v"(vb), "i"(OFF) : "memory"); return r;
}
template <int D0> __device__ __forceinline__ void pv_one(f32x16& od, int vb, bf16x8 pa0, bf16x8 pa1, bf16x8 pa2, bf16x8 pa3) {
  const s16x4 l0 = tr_read<v_rd_off(D0, 0, 0)>(vb), h0 = tr_read<v_rd_off(D0, 0, 1)>(vb), l1 = tr_read<v_rd_off(D0, 1, 0)>(vb), h1 = tr_read<v_rd_off(D0, 1, 1)>(vb);
  const s16x4 l2 = tr_read<v_rd_off(D0, 2, 0)>(vb), h2 = tr_read<v_rd_off(D0, 2, 1)>(vb), l3 = tr_read<v_rd_off(D0, 3, 0)>(vb), h3 = tr_read<v_rd_off(D0, 3, 1)>(vb);
  asm volatile("s_waitcnt lgkmcnt(0)" ::: "memory"); SBAR();
#define PK(L, H) (bf16x8){L[0], L[1], L[2], L[3], H[0], H[1], H[2], H[3]}
  od = __builtin_amdgcn_mfma_f32_32x32x16_bf16(pa0, PK(l0, h0), od, 0, 0, 0);
  od = __builtin_amdgcn_mfma_f32_32x32x16_bf16(pa1, PK(l1, h1), od, 0, 0, 0);
  od = __builtin_amdgcn_mfma_f32_32x32x16_bf16(pa2, PK(l2, h2), od, 0, 0, 0);
  od = __builtin_amdgcn_mfma_f32_32x32x16_bf16(pa3, PK(l3, h3), od, 0, 0, 0);
#undef PK
}
__device__ __forceinline__ void pv_d0(f32x16* o, int vb, bf16x8 pa0, bf16x8 pa1, bf16x8 pa2, bf16x8 pa3) {
  pv_one<0>(o[0], vb, pa0, pa1, pa2, pa3); pv_one<1>(o[1], vb, pa0, pa1, pa2, pa3); pv_one<2>(o[2], vb, pa0, pa1, pa2, pa3); pv_one<3>(o[3], vb, pa0, pa1, pa2, pa3);
}
template <int DIFF>
__device__ __forceinline__ void attn_unit(const bf16_t* Qb, const bf16_t* __restrict__ Kh, const bf16_t* __restrict__ Vh, bf16_t* Ob, const bf16_t* gate,
                                          int seq, char* lds, const float* lamp, int layer, const float* nw, const float* kmax2p, const int tpos0, const float* qnw, unsigned* splc = nullptr, float* splp = nullptr) {
  constexpr int ND0 = DIFF ? 4 : 8;
  constexpr float CQ = (DIFF ? 0.125f : 0.088388347648318440f) * 1.4426950408889634f;
  const int tid = otid(), wid = tid >> 6, lane = tid & 63, r32 = lane & 31, hi = lane >> 5;
  const int wq = DIFF ? (wid & 3) : wid, mapc = DIFF ? (wid >> 2) : 0;
  constexpr int RSTG = 32768, RK = 16384, E_ST = 67584, E_WS = 137216;
  float* li_l = (float*)(lds + E_WS) + wid * 64;
  float l_reg = 0; f32x16 o[4] = {}; bf16x8 qr[ND0];
  const bf16_t* Qw = Qb + (long)(wq * QBLK + r32) * LD + mapc * 64 + hi * 8;
  {
      const float* tab = (const float*)(g_scr + SCR_ROPE);
      const int trow = tpos0 + wq * QBLK + r32;
      float qf[ND0][8];
      _Pragma("unroll") for (int d0 = 0; d0 < ND0; ++d0) { const bf16x8 raw = *reinterpret_cast<const bf16x8*>(Qw + d0 * 16); _Pragma("unroll") for (int e = 0; e < 8; ++e) qf[d0][e] = bf2f((bf16_t)raw[e]) * (DIFF ? CQ : 1.f); }
      if constexpr (!DIFF) {
        float ss = 0.f;
        _Pragma("unroll") for (int d0 = 0; d0 < ND0; ++d0) _Pragma("unroll") for (int e = 0; e < 8; ++e) ss += qf[d0][e] * qf[d0][e];
        { auto rr = __builtin_amdgcn_permlane32_swap(__float_as_uint(ss), __float_as_uint(ss), false, false); ss = __uint_as_float(rr[0]) + __uint_as_float(rr[1]); }
        const float rs = rsqrtf(ss * (1.f / 128.f) + NORM_EPS) * CQ;
        _Pragma("unroll") for (int d0 = 0; d0 < ND0; ++d0) { const f32x4 w0 = *(const f32x4*)(qnw + d0 * 16 + hi * 8), w1 = *(const f32x4*)(qnw + d0 * 16 + hi * 8 + 4);
          _Pragma("unroll") for (int e = 0; e < 4; ++e) { qf[d0][e] *= rs * w0[e]; qf[d0][4 + e] *= rs * w1[e]; } }
      }
      _Pragma("unroll") for (int hb = 0; hb < ND0 / 4; ++hb) {
        const int pos = DIFF ? trow : (hb == 0 ? (trow >> 6) : (trow & 63));
        _Pragma("unroll") for (int dl = 0; dl < 2; ++dl) { const int d0 = hb * 4 + dl; const float* cp = tab + ((size_t)pos * 32 + dl * 16 + hi * 8) * 2; float cs[16];
          _Pragma("unroll") for (int i = 0; i < 4; ++i) { const f32x4 u_ = ((const f32x4*)cp)[i]; _Pragma("unroll") for (int e = 0; e < 4; ++e) cs[4 * i + e] = u_[e]; }
          _Pragma("unroll") for (int e = 0; e < 8; ++e) { const float x1 = qf[d0][e], x2 = qf[d0 + 2][e]; qf[d0][e] = x1 * cs[2 * e] - x2 * cs[2 * e + 1]; qf[d0 + 2][e] = x2 * cs[2 * e] + x1 * cs[2 * e + 1]; } } }
      _Pragma("unroll") for (int d0 = 0; d0 < ND0; ++d0) { u32x4 w_; w_.x = pk2(qf[d0][0], qf[d0][1]); w_.y = pk2(qf[d0][2], qf[d0][3]); w_.z = pk2(qf[d0][4], qf[d0][5]); w_.w = pk2(qf[d0][6], qf[d0][7]); qr[d0] = *reinterpret_cast<bf16x8*>(&w_); }
  }
  float mnC;
  { float qn2 = 0.f;
    _Pragma("unroll") for (int d0 = 0; d0 < ND0; ++d0) _Pragma("unroll") for (int e = 0; e < 8; ++e) { const float q = bf2f((bf16_t)qr[d0][e]); qn2 += q * q; }
    { auto rr = __builtin_amdgcn_permlane32_swap(__float_as_uint(qn2), __float_as_uint(qn2), false, false); qn2 = __uint_as_float(rr[0]) + __uint_as_float(rr[1]); }
    const float km2 = kmax2p[DIFF ? mapc : 0];
    mnC = -(sqrtf(qn2 * km2) * 1.02f + 1e-3f * CQ); }
  f32x16 mnv; _Pragma("unroll") for (int r = 0; r < 16; ++r) mnv[r] = mnC;
  unsigned ksrc[2], vsrc[2];
  _Pragma("unroll") for (int i = 0; i < 2; ++i) { const int pc = 2 * wid + i;
    { const int row = 4 * pc + (lane >> 4); ksrc[i] = (unsigned)(row * 256 + (((lane & 15) ^ (row & 15)) << 4)); }
    { const int st = 2 * pc + (lane >> 5), l5 = lane & 31, kk = (st >> 2) * 8 + (l5 >> 2), k = (kk & ~0xC) | ((kk & 4) << 1) | ((kk & 8) >> 1); vsrc[i] = (unsigned)(k * 256 + ((st & 3) * 32 + (l5 & 3) * 8) * 2); } }
  const unsigned ldsb = (unsigned)(uintptr_t)lds + (unsigned)__builtin_amdgcn_readfirstlane(wid) * 2048u;
  const int vb0 = (int)(uintptr_t)lds + v_rd_base(lane);
  const __amdgpu_buffer_rsrc_t srdK = __builtin_amdgcn_make_buffer_rsrc((void*)Kh, (short)0, seq * 256, 0x00020000);
  const __amdgpu_buffer_rsrc_t srdV = __builtin_amdgcn_make_buffer_rsrc((void*)Vh, (short)0, seq * 256, 0x00020000);
#define BLDS(SRD, VOFF, SOFF, DST) asm volatile("s_mov_b32 m0, %0\n\ts_nop 0\n\tbuffer_load_dwordx4 %1, %2, %3 offen lds" :: "s"(DST), "v"(VOFF), "s"(SRD), "s"(SOFF) : "m0", "memory")
#define DMA(k0, so) do { const unsigned so_ = (unsigned)__builtin_amdgcn_readfirstlane((unsigned)(k0) * 256u); const unsigned d_ = (unsigned)__builtin_amdgcn_readfirstlane(ldsb + (unsigned)(so)); \
    BLDS(srdV, vsrc[0], so_, d_); BLDS(srdV, vsrc[1], so_, d_ + 1024u); BLDS(srdK, ksrc[0], so_, d_ + (unsigned)RK); BLDS(srdK, ksrc[1], so_, d_ + (unsigned)RK + 1024u); } while (0)
#define DWAIT() asm volatile("s_waitcnt vmcnt(0)" ::: "memory")
  f32x16 p0, p1; bf16x8 pa0, pa1, pa2, pa3; int NT = seq / KVBLK; asm volatile("" : "+s"(NT));
  const bool odd = __builtin_amdgcn_readfirstlane(wid) >= 4;
  int kad[ND0];
  _Pragma("unroll") for (int i = 0; i < ND0; ++i) kad[i] = (int)(uintptr_t)lds + RK + KSWZ(r32, ((mapc * 4 + i) * 16 + hi * 8) * 2);
#define BAR() do { SBAR(); __builtin_amdgcn_s_barrier(); SBAR(); } while (0)
#define LWAIT4(N, A, B, C, Dd) asm volatile("s_waitcnt lgkmcnt(%4)" : "+v"(A), "+v"(B), "+v"(C), "+v"(Dd) : "n"(N))
#define LWAIT2(N, A, B) asm volatile("s_waitcnt lgkmcnt(%2)" : "+v"(A), "+v"(B) : "n"(N))
#define PK(L, H) (bf16x8){L[0], L[1], L[2], L[3], H[0], H[1], H[2], H[3]}
#define VRD(N, D0, KP, VB) N##a = tr_read<v_rd_off(D0, 2 * KP, 0)>(VB); N##b = tr_read<v_rd_off(D0, 2 * KP, 1)>(VB); N##c = tr_read<v_rd_off(D0, 2 * KP + 1, 0)>(VB); N##d = tr_read<v_rd_off(D0, 2 * KP + 1, 1)>(VB)
#define VDECL(N) s16x4 N##a, N##b, N##c, N##d
#define VMM(N, D0, PA, PB, W) LWAIT4(W, N##a, N##b, N##c, N##d); o[D0] = __builtin_amdgcn_mfma_f32_32x32x16_bf16(PA, PK(N##a, N##b), o[D0], 0, 0, 0); o[D0] = __builtin_amdgcn_mfma_f32_32x32x16_bf16(PB, PK(N##c, N##d), o[D0], 0, 0, 0); SBAR()
#define KRD(N, DS) bf16x8 N##a, N##b; asm volatile("ds_read_b128 %0, %1" : "=&v"(N##a) : "v"(ka[DS]) : "memory"); asm volatile("ds_read_b128 %0, %1 offset:8192" : "=&v"(N##b) : "v"(ka[DS]) : "memory")
#define KMM0(N, DS, W) LWAIT2(W, N##a, N##b); p0 = __builtin_amdgcn_mfma_f32_32x32x16_bf16(N##a, qr[DS], mnv, 0, 0, 0); p1 = __builtin_amdgcn_mfma_f32_32x32x16_bf16(N##b, qr[DS], mnv, 0, 0, 0); SBAR()
#define KMM(N, DS, W) LWAIT2(W, N##a, N##b); p0 = __builtin_amdgcn_mfma_f32_32x32x16_bf16(N##a, qr[DS], p0, 0, 0, 0); p1 = __builtin_amdgcn_mfma_f32_32x32x16_bf16(N##b, qr[DS], p1, 0, 0, 0); SBAR()
  VDECL(g0); VDECL(g1); VDECL(g2);
#define PREISSUE(SO) do { const int vb_ = vb0 + (SO); VRD(g0, 0, 0, vb_); VRD(g1, 0, 1, vb_); VRD(g2, 1, 0, vb_); } while (0)
  DMA(0, 0); DMA(KVBLK, RSTG); DMA(2 * KVBLK, 2 * RSTG);
  asm volatile("s_waitcnt vmcnt(8)" ::: "memory"); BAR();
  if (odd) BAR();
  qkt<ND0>(p0, p1, (const bf16_t*)(lds + RK), qr, r32, hi, mapc * 4, mnv);
  asm volatile("s_waitcnt vmcnt(4)" ::: "memory"); SBAR(); BAR();
  partialSM<DIFF>(p0, p1, mnC); finishSM(p0, p1, l_reg, pa0, pa1, pa2, pa3); SBAR();
  PREISSUE(0); BAR();
  _Pragma("unroll 1") for (int j = 0; j + 1 < NT; ++j) {
    const int sV = (j & 3) * RSTG, sK = ((j + 1) & 3) * RSTG, sD = ((j + 3) & 3) * RSTG;
    const bool dma = j + 3 < NT;
    SBAR(); __builtin_amdgcn_s_setprio(1); SBAR();
    if (dma) DMA((j + 3) * KVBLK, sD);
    SBAR();
    { const int vb = vb0 + sV; int ka[ND0];
      _Pragma("unroll") for (int i = 0; i < ND0; ++i) ka[i] = kad[i] + sK;
      VDECL(g3); VDECL(g4); VDECL(g5); VDECL(g6); VDECL(g7);
      VRD(g3, 1, 1, vb); VMM(g0, 0, pa0, pa1, 12);
      VRD(g4, 2, 0, vb); VMM(g1, 0, pa2, pa3, 12);
      VRD(g5, 2, 1, vb); VMM(g2, 1, pa0, pa1, 12);
      VRD(g6, 3, 0, vb); VMM(g3, 1, pa2, pa3, 12);
      VRD(g7, 3, 1, vb); VMM(g4, 2, pa0, pa1, 12);
      KRD(k0, 0); VMM(g5, 2, pa2, pa3, 10);
      KRD(k1, 1); VMM(g6, 3, pa0, pa1, 8);
      KRD(k2, 2); VMM(g7, 3, pa2, pa3, 6);
      KRD(k3, 3); KMM0(k0, 0, 6);
      if constexpr (ND0 == 8) {
        KRD(k4, 4); KMM(k1, 1, 6);
        KRD(k5, 5); KMM(k2, 2, 6);
        KRD(k6, 6); KMM(k3, 3, 6);
        KRD(k7, 7); KMM(k4, 4, 6);
        KMM(k5, 5, 4); KMM(k6, 6, 2); KMM(k7, 7, 0);
      } else {
        KMM(k1, 1, 4); KMM(k2, 2, 2); KMM(k3, 3, 0);
      } }
    __builtin_amdgcn_s_setprio(0);
    if (dma) asm volatile("s_waitcnt vmcnt(4)" ::: "memory"); else asm volatile("s_waitcnt vmcnt(0)" ::: "memory");
    SBAR(); BAR();
    partialSM<DIFF>(p0, p1, mnC); finishSM(p0, p1, l_reg, pa0, pa1, pa2, pa3); SBAR(); PREISSUE(sK);
    BAR();
  }
  {
    const int vb = vb0 + ((NT - 1) & 3) * RSTG;
    VDECL(g3); VDECL(g4); VDECL(g5); VDECL(g6); VDECL(g7);
    VRD(g3, 1, 1, vb); VMM(g0, 0, pa0, pa1, 12);
    VRD(g4, 2, 0, vb); VMM(g1, 0, pa2, pa3, 12);
    VRD(g5, 2, 1, vb); VMM(g2, 1, pa0, pa1, 12);
    VRD(g6, 3, 0, vb); VMM(g3, 1, pa2, pa3, 12);
    VRD(g7, 3, 1, vb); VMM(g4, 2, pa0, pa1, 12);
    VMM(g5, 2, pa2, pa3, 8); VMM(g6, 3, pa0, pa1, 4); VMM(g7, 3, pa2, pa3, 0);
  }
  if (!odd) BAR();
#undef PREISSUE
#undef KMM
#undef KMM0
#undef KRD
#undef VMM
#undef VDECL
#undef VRD
#undef PK
#undef LWAIT2
#undef LWAIT4
#undef BAR
#undef DMA
#undef BLDS
#undef DWAIT
  __syncthreads();
  if (splc) {
    unsigned* xs_ = (unsigned*)(lds + 140000);
    if (threadIdx.x == 0) *xs_ = __hip_atomic_fetch_add(splc, 1u, __ATOMIC_RELAXED, __HIP_MEMORY_SCOPE_AGENT);
    __syncthreads();
    const unsigned ord = *xs_;
    float* mine = splp + (size_t)(wid * 65) * 64 + lane;
    if (ord == 0u) {
      _Pragma("unroll") for (int d0 = 0; d0 < 4; ++d0) _Pragma("unroll") for (int r = 0; r < 16; ++r) mine[(d0 * 16 + r) * 64] = o[d0][r];
      mine[64 * 64] = l_reg;
      asm volatile("s_waitcnt vmcnt(0)" ::: "memory"); __syncthreads();
      if (threadIdx.x == 0) { __builtin_amdgcn_fence(__ATOMIC_RELEASE, "agent"); asm volatile("s_waitcnt vmcnt(0)" ::: "memory"); __hip_atomic_store(splc + 1, 1u, __ATOMIC_RELAXED, __HIP_MEMORY_SCOPE_AGENT); }
      __syncthreads();
      return;
    }
    if (threadIdx.x == 0) { unsigned sp = 0; while (__hip_atomic_load(splc + 1, __ATOMIC_RELAXED, __HIP_MEMORY_SCOPE_AGENT) == 0u) { __builtin_amdgcn_s_sleep(4); if (++sp > (1u << 22)) break; } }
    __syncthreads();
    __builtin_amdgcn_fence(__ATOMIC_ACQUIRE, "agent"); asm volatile("s_waitcnt vmcnt(0)" ::: "memory");
    _Pragma("unroll") for (int d0 = 0; d0 < 4; ++d0) _Pragma("unroll") for (int r = 0; r < 16; ++r) o[d0][r] += mine[(d0 * 16 + r) * 64];
    l_reg += mine[64 * 64];
  }
  if (hi == 0) li_l[r32] = l_reg; asm volatile("s_waitcnt lgkmcnt(0)" ::: "memory");
  float rli[16];
  _Pragma("unroll") for (int r = 0; r < 16; ++r) rli[r] = __builtin_amdgcn_rcpf(li_l[crow(r, hi)]);
  int r32e = r32; asm volatile("" : "+v"(r32e));
  char* ST = lds + E_ST + wid * 8704;
  if constexpr (!DIFF) {
    _Pragma("unroll") for (int r = 0; r < 16; ++r) { const int orow = crow(r, hi);
      _Pragma("unroll") for (int d0 = 0; d0 < 4; ++d0) *(bf16_t*)(ST + orow * 272 + (d0 * 32 + r32e) * 2) = f2bf(o[d0][r] * rli[r]); }
  } else {
    const float s1 = wave_sum(lamp[lane] * lamp[64 + lane]), s2 = wave_sum(lamp[128 + lane] * lamp[192 + lane]);
    int ly = layer; asm volatile("" : "+s"(ly));
    const float lambda_init = 0.8f - 0.6f * expf(-0.3f * (float)ly);
    const float lam = expf(s1) - expf(s2) + lambda_init, osc = 1.f - lambda_init;
    float* X = (float*)lds;
    if (mapc == 1) {
      _Pragma("unroll") for (int r = 0; r < 16; ++r) { const int orow = wq * QBLK + crow(r, hi);
        _Pragma("unroll") for (int d0 = 0; d0 < 4; ++d0) X[orow * 128 + d0 * 32 + r32e] = o[d0][r] * rli[r] * lam; }
    }
    __syncthreads();
    if (mapc == 0) {
      float nwv[4];
      _Pragma("unroll") for (int d0 = 0; d0 < 4; ++d0) nwv[d0] = nw[d0 * 32 + r32e] * osc;
      _Pragma("unroll") for (int r = 0; r < 16; ++r) { const int orow = crow(r, hi); float v[4]; float ss = 0.f;
        _Pragma("unroll") for (int d0 = 0; d0 < 4; ++d0) { v[d0] = o[d0][r] * rli[r] - X[(wq * QBLK + orow) * 128 + d0 * 32 + r32e]; ss += v[d0] * v[d0]; }
        ss += __shfl_xor(ss, 1); ss += __shfl_xor(ss, 2); ss += __shfl_xor(ss, 4); ss += __shfl_xor(ss, 8); ss += __shfl_xor(ss, 16);
        const float rs = rsqrtf(ss * (1.f / 128.f) + NORM_EPS);
        _Pragma("unroll") for (int d0 = 0; d0 < 4; ++d0) *(bf16_t*)(ST + orow * 272 + (d0 * 32 + r32e) * 2) = f2bf(v[d0] * rs * nwv[d0]); }
    }
  }
  if (!DIFF || mapc == 0) {
    asm volatile("s_waitcnt lgkmcnt(0)" ::: "memory");
    bf16_t* Ow = Ob + (long)(wq * QBLK) * LD; const bf16_t* Gw = gate + (long)(wq * QBLK) * LD;
    const int er = lane >> 4, ec = (lane & 15) * 8; bf16x8 gv[8];
    _Pragma("unroll") for (int it = 0; it < 8; ++it) gv[it] = *reinterpret_cast<const bf16x8*>(Gw + (long)(it * 4 + er) * LD + ec);
    _Pragma("unroll") for (int it = 0; it < 8; ++it) { const bf16x8 sv = *reinterpret_cast<const bf16x8*>(ST + (it * 4 + er) * 272 + ec * 2); u32x4 ov;
      float f[8]; _Pragma("unroll") for (int e = 0; e < 8; ++e) f[e] = bf2f((bf16_t)sv[e]) * siluf(bf2f((bf16_t)gv[it][e]));
      ov.x = pk2(f[0], f[1]); ov.y = pk2(f[2], f[3]); ov.z = pk2(f[4], f[5]); ov.w = pk2(f[6], f[7]);
      *reinterpret_cast<u32x4*>(Ow + (long)(it * 4 + er) * LD + ec) = ov; }
  }
  __syncthreads();
}
#undef KSWZ
#undef SBAR
}

__device__ __forceinline__ void gqa_unit(const Params& p, const int l, int u, char* lds, int half = -1, int rec = 0) {
    const int qb = u & 31, hq = (u >> 5) & 3, b = u >> 7; const size_t row0 = (size_t)b * SEQ + (size_t)qb * 256, k0 = (size_t)b * SEQ + (half > 0 ? SEQ / 2 : 0);
    bf16_t* Q = pblk(p.ws, PB_GQ + hq) + row0 * 128;
    att::attn_unit<0>(Q, pblk(p.ws, PB_GK + (hq >> 1)) + k0 * 128, pblk(p.ws, PB_GV + (hq >> 1)) + k0 * 128, Q, pblk(p.ws, PB_GG + hq) + row0 * 128, half >= 0 ? SEQ / 2 : SEQ, lds, nullptr, 0, nullptr,
                      (const float*)(g_scr + SCR_CTL) + 256 + 64 * l + 16 + b * 2 + (hq >> 1),
                      qb * 256, p.in[23] + l * 128,
                      half >= 0 ? (unsigned*)(g_scr + SCR_CTL) + 384 + l * 256 + rec * 2 : nullptr, half >= 0 ? (float*)(g_scr + SCR_SPL + (size_t)rec * 133120) : nullptr);
}
__device__ __forceinline__ void diff_unit(const Params& p, const int l, int u, char* lds, int half = -1, int rec = 0) {
    const int qb = u & 63, h = (u >> 6) & 3, b = u >> 8; const size_t row0 = (size_t)b * SEQ + (size_t)qb * 128, k0 = (size_t)b * SEQ + (half > 0 ? SEQ / 2 : 0);
    bf16_t* Q = pblk(p.ws, PB_DQ + h) + row0 * 128;
    att::attn_unit<1>(Q, pblk(p.ws, PB_DK + h) + k0 * 128, pblk(p.ws, PB_DV + h) + k0 * 128, Q, pblk(p.ws, PB_DG + h) + row0 * 128, half >= 0 ? SEQ / 2 : SEQ, lds, p.in[21] + l * 256, l, p.in[22] + l * 128,
                      (const float*)(g_scr + SCR_CTL) + 256 + 64 * l + b * 8 + h * 2,
                      qb * 128, nullptr,
                      half >= 0 ? (unsigned*)(g_scr + SCR_CTL) + 384 + l * 256 + rec * 2 : nullptr, half >= 0 ? (float*)(g_scr + SCR_SPL + (size_t)rec * 133120) : nullptr);
}

#define LDS_BAR() asm volatile("s_waitcnt lgkmcnt(0)\n\ts_barrier" ::: "memory")
namespace rk {
using f32x16 = __attribute__((ext_vector_type(16))) float;
constexpr int PB = 144, MAT = 64 * PB;
constexpr int O_W2T = 0, O_A2T = MAT, O_SB = 2 * MAT, O_GAM = 3 * MAT, O_CONST = O_GAM + 256,
              O_T = O_CONST + 2560, O_TW = O_T, O_G1T = O_T + MAT, O_AD = O_G1T,
              O_R2 = O_G1T + MAT, O_CL = O_R2, O_AA = O_R2 + 16384, O_ABD = O_R2, O_AAB = O_R2 + 4096, O_AAK = O_AAB + MAT, O_ARB = O_AAK + MAT, O_ARK = O_ARB + MAT,
              O_R3 = O_ARK + MAT, O_AT = O_R3, O_RT = O_AT + MAT, O_BT = O_RT + MAT, O_DT = O_BT, O_UT = O_BT, O_KT = O_BT + MAT, O_PT = O_KT,
              O_BHT = O_KT + MAT, O_KHT = O_BHT + MAT, O_VT = O_KHT + MAT, O_END = O_VT + MAT;
__device__ __forceinline__ int crow(int r, int hi) { return (r & 3) + 8 * (r >> 2) + 4 * hi; }
#define RK_FENCE() do { asm volatile("s_waitcnt lgkmcnt(0)" ::: "memory"); __builtin_amdgcn_wave_barrier(); } while (0)
template <int NKS> __device__ __forceinline__ void mm32(f32x16& acc, const char* A, int m0, const char* B, int n0, int k0, int r32, int hi) {
#pragma unroll
    for (int ks = 0; ks < NKS; ++ks) {
        const bf16x8 a = *(const bf16x8*)(A + (m0 + r32) * PB + (k0 + ks * 16 + hi * 8) * 2);
        const bf16x8 b = *(const bf16x8*)(B + (n0 + r32) * PB + (k0 + ks * 16 + hi * 8) * 2);
        acc = __builtin_amdgcn_mfma_f32_32x32x16_bf16(a, b, acc, 0, 0, 0); }
}
template <int NKS, bool SA, bool SB> __device__ __forceinline__ void mm32s(f32x16& acc, const char* A, int m0, const char* B, int n0, int r32, int hi) {
    const int ra = m0 + r32, rb = n0 + r32; const int fa = SA ? ((ra >> 3) & 7) : 0, fb = SB ? ((rb >> 3) & 7) : 0;
#pragma unroll
    for (int ks = 0; ks < NKS; ++ks) { const int q = ks * 2 + hi;
        const bf16x8 a = *(const bf16x8*)(A + ra * PB + ((q ^ fa) << 4));
        const bf16x8 b = *(const bf16x8*)(B + rb * PB + ((q ^ fb) << 4));
        acc = __builtin_amdgcn_mfma_f32_32x32x16_bf16(a, b, acc, 0, 0, 0); }
}
__device__ __forceinline__ void st_T(const f32x16& acc, char* Z, int n0, int m0, int r32, int hi) {
#pragma unroll
    for (int g = 0; g < 4; ++g) { u32x2 w; w.x = pk2(acc[4 * g], acc[4 * g + 1]); w.y = pk2(acc[4 * g + 2], acc[4 * g + 3]);
        *(u32x2*)(Z + (n0 + r32) * PB + (m0 + 8 * g + 4 * hi) * 2) = w; }
}
__device__ __forceinline__ unsigned long long pass1(const Params& p, const int l, unsigned char* lds) {
    const int sid = blockIdx.x >> 3, c_first = blockIdx.x & 7;
    const int tid = otid(), w = __builtin_amdgcn_readfirstlane(tid >> 6);
    const int h = sid & 7, dir = (sid >> 3) & 1, b = sid >> 4;
    unsigned long long pacc = 0, ptt = 0; (void)ptt;
#ifdef PRB_IV
#define RKP0(i) do { if ((PRB_IV >> (i)) & 1) ptt = __builtin_amdgcn_s_memrealtime(); } while (0)
#define RKP1(i) do { if ((PRB_IV >> (i)) & 1) pacc += __builtin_amdgcn_s_memrealtime() - ptt; } while (0)
#else
#define RKP0(i) do {} while (0)
#define RKP1(i) do {} while (0)
#endif
#define RK_LANE() int tq_ = tid; asm volatile("" : "+v"(tq_)); const int lane = tq_ & 63, r32 = lane & 31, hi = lane >> 5, tok = tq_ >> 3, c8 = (tq_ & 7) * 8; (void)lane; (void)r32; (void)hi; (void)tok; (void)c8
    char* L = (char*)lds; float* CF = (float*)(L + O_CONST);
    {   RK_LANE();
        const float* w2 = p.in[13] + ((size_t)(l * 2 + dir) * 64) * 512 + h * 64; const float* a2 = p.in[15] + ((size_t)l * 64) * 512 + h * 64;
        float t[8], u[8];
#pragma unroll
        for (int e = 0; e < 8; ++e) { t[e] = w2[(size_t)(c8 + e) * 512 + tok]; u[e] = a2[(size_t)(c8 + e) * 512 + tok]; }
        u32x4 ww, aa; ww.x = pk2(t[0], t[1]); ww.y = pk2(t[2], t[3]); ww.z = pk2(t[4], t[5]); ww.w = pk2(t[6], t[7]);
        aa.x = pk2(u[0], u[1]); aa.y = pk2(u[2], u[3]); aa.z = pk2(u[4], u[5]); aa.w = pk2(u[6], u[7]);
        *(u32x4*)(L + O_W2T + tok * PB + c8 * 2) = ww; *(u32x4*)(L + O_A2T + tok * PB + c8 * 2) = aa;
        { unsigned zz = 0u; asm volatile("" : "+v"(zz)); *(u32x4*)(L + O_SB + tok * PB + c8 * 2) = (u32x4){zz, zz, zz, zz}; }
        const float* mu = p.in[11] + (size_t)(l * 2 + dir) * 1664;
        for (int i = tid; i < 640; i += 512) { const int row = i >> 6, j = i & 63; float v;
            if (row == 0) v = p.in[12][(l * 2 + dir) * 512 + h * 64 + j]; else if (row == 1) v = p.in[14][l * 512 + h * 64 + j];
            else if (row == 2) v = p.in[16][l * 512 + h * 64 + j]; else if (row == 3) v = p.in[17][l * 512 + h * 64 + j]; else if (row == 4) v = p.in[18][l * 512 + h * 64 + j];
            else if (row == 5) v = mu[h * 64 + j]; else if (row == 6) v = mu[512 + h * 64 + j]; else if (row == 7) v = mu[1024 + h * 64 + j]; else if (row == 8) v = mu[1536 + j]; else v = mu[1600 + j];
            CF[i] = v; }
    }
    const bf16_t* Pr = pblk(p.ws, PB_R + (h >> 1)) + (h & 1) * 64; const bf16_t* Pk = pblk(p.ws, PB_K + (h >> 1)) + (h & 1) * 64;
    const bf16_t* Pv = pblk(p.ws, PB_V + (h >> 1)) + (h & 1) * 64; const bf16_t* Pw = pblk(p.ws, PB_WA); const bf16_t* Pa = pblk(p.ws, PB_WA) + 64;
    bf16_t* wkv = (bf16_t*)(g_scr + SCR_WKV) + (size_t)sid * SEQ * 64; bf16_t* bon = (bf16_t*)(g_scr + SCR_BON) + (size_t)dir * M_TOK * 512 + h * 64;
    bf16x8 cu[5], pv[5];
#define RK_LOAD(c) do { RK_LANE(); const int s_ = (c) * 64 + tok; const int t_ = dir ? (SEQ - 1 - s_) : s_; const size_t m_ = ((size_t)b * SEQ + t_) * 128 + c8; \
        cu[0] = *(const bf16x8*)(Pr + m_); cu[1] = *(const bf16x8*)(Pk + m_); cu[2] = *(const bf16x8*)(Pv + m_); cu[3] = *(const bf16x8*)(Pw + m_); cu[4] = *(const bf16x8*)(Pa + m_); \
        if (s_ > 0) { const size_t q_ = dir ? m_ + 128 : m_ - 128; pv[0] = *(const bf16x8*)(Pr + q_); pv[1] = *(const bf16x8*)(Pk + q_); pv[2] = *(const bf16x8*)(Pv + q_); pv[3] = *(const bf16x8*)(Pw + q_); pv[4] = *(const bf16x8*)(Pa + q_); } \
        else { _Pragma("unroll") for (int i_ = 0; i_ < 5; ++i_) pv[i_] = (bf16x8){0, 0, 0, 0, 0, 0, 0, 0}; } } while (0)
    RK_LOAD(c_first);
    LDS_BAR();
#pragma unroll 1
    for (int c = c_first; c < SEQ / 64; c += 8) {
        RKP0(1);
        float rr[8], kx[8], vv[8];
        {   RK_LANE(); float tw[8], ad[8];
#pragma unroll
            for (int e = 0; e < 8; ++e) {
                const float x0 = bf2f((bf16_t)cu[0][e]), x1 = bf2f((bf16_t)cu[1][e]), x2 = bf2f((bf16_t)cu[2][e]), x3 = bf2f((bf16_t)cu[3][e]), x4 = bf2f((bf16_t)cu[4][e]);
                const float p0 = bf2f((bf16_t)pv[0][e]), p1 = bf2f((bf16_t)pv[1][e]), p2 = bf2f((bf16_t)pv[2][e]), p3 = bf2f((bf16_t)pv[3][e]), p4 = bf2f((bf16_t)pv[4][e]);
                rr[e] = x0 + (p0 - x0) * CF[5 * 64 + (h * 0) + c8 + e]; kx[e] = x1 + (p1 - x1) * CF[6 * 64 + c8 + e]; vv[e] = x2 + (p2 - x2) * CF[7 * 64 + c8 + e];
                const float wd = x3 + (p3 - x3) * CF[8 * 64 + c8 + e]; ad[e] = x4 + (p4 - x4) * CF[9 * 64 + c8 + e];
                tw[e] = 1.f - 2.f / (1.f + __expf(2.f * wd)); }
            u32x4 a, d; a.x = pk2(tw[0], tw[1]); a.y = pk2(tw[2], tw[3]); a.z = pk2(tw[4], tw[5]); a.w = pk2(tw[6], tw[7]);
            d.x = pk2(ad[0], ad[1]); d.y = pk2(ad[2], ad[3]); d.z = pk2(ad[4], ad[5]); d.w = pk2(ad[6], ad[7]);
            *(u32x4*)(L + O_TW + tok * PB + c8 * 2) = a; *(u32x4*)(L + O_AD + tok * PB + c8 * 2) = d; }
        LDS_BAR(); RKP1(1); RKP0(2);
        {   RK_LANE(); const bool isA = w >= 4; const int mt2 = (w & 2) ? 32 : 0, n0 = (w & 1) * 32;
            const char* Aop = L + (isA ? O_AD : O_TW); const char* Bop = L + (isA ? O_A2T : O_W2T);
            f32x16 x0 = {};
            mm32<4>(x0, Aop, mt2, Bop, n0, 0, r32, hi);
            const int ch = n0 + r32; const float c0 = CF[(isA ? 64 : 0) + ch];
            float* TOT = (float*)(L + O_GAM);
            if (!isA) {
#pragma unroll
                for (int r = 0; r < 16; ++r) x0[r] = -0.6065306597126334f / (1.f + __expf(-(c0 + x0[r])));
                float run = 0.f;
#pragma unroll
                for (int g = 0; g < 4; ++g) { const float gs = (x0[4 * g] + x0[4 * g + 1]) + (x0[4 * g + 2] + x0[4 * g + 3]); const float ps = __shfl_xor(gs, 32);
                    float st = run + (hi ? ps : 0.f); x0[4 * g] += st; x0[4 * g + 1] += x0[4 * g]; x0[4 * g + 2] += x0[4 * g + 1]; x0[4 * g + 3] += x0[4 * g + 2]; run += gs + ps; }
                if (mt2 == 0 && hi == 0) TOT[ch] = run;
            } else {
#pragma unroll
                for (int r = 0; r < 16; ++r) x0[r] = 1.f / (1.f + __expf(-(c0 + x0[r])));
            }
            LDS_BAR();
            if (!isA && mt2) { const float t0 = TOT[ch];
#pragma unroll
                for (int r = 0; r < 16; ++r) x0[r] += t0; }
            float* O = (float*)(L + (isA ? O_AA : O_CL));
#pragma unroll
            for (int r = 0; r < 16; ++r) O[(mt2 + crow(r, hi)) * 64 + ch] = x0[r];
        }
        LDS_BAR(); RKP1(2); RKP0(3);
        {   RK_LANE(); const float* clp = (const float*)(L + O_CL + tok * 256 + c8 * 4); const float* cle = (const float*)(L + O_CL + (tok > 0 ? tok - 1 : 0) * 256 + c8 * 4);
            const float* cln = (const float*)(L + O_CL + 63 * 256 + c8 * 4); const float* aap = (const float*)(L + O_AA + tok * 256 + c8 * 4);
            float kk[8], kp[8]; float ss = 0.f, bs = 0.f;
#pragma unroll
            for (int e = 0; e < 8; ++e) { kk[e] = kx[e] * CF[2 * 64 + c8 + e]; ss += kk[e] * kk[e]; kp[e] = kx[e] * (1.f + (aap[e] - 1.f) * CF[3 * 64 + c8 + e]); bs += rr[e] * kp[e] * CF[4 * 64 + c8 + e]; }
            ss += __shfl_xor(ss, 1); ss += __shfl_xor(ss, 2); ss += __shfl_xor(ss, 4);
            bs += __shfl_xor(bs, 1); bs += __shfl_xor(bs, 2); bs += __shfl_xor(bs, 4);
            const float rn = 1.f / fmaxf(sqrtf(ss), 1e-12f);
            const int tsw = ((((tok >> 3) ^ (c8 >> 3)) << 3) + (tok & 7)) * 2;
#pragma unroll
            for (int e2 = 0; e2 < 4; ++e2) { float At[2], Rt[2], Bt[2], Kt[2];
#pragma unroll
                for (int q = 0; q < 2; ++q) { const int e = 2 * e2 + q; const float cl = clp[e], ce = (tok > 0) ? cle[e] : 0.f, cn = cln[e];
                    const float kn = kk[e] * rn; const float bb = kn * aap[e];
                    const float ein = __expf(cl), eex = __expf(ce), eng = __expf(-cl), een = __expf(cn - cl);
                    At[q] = -kn * eex; Rt[q] = rr[e] * ein; Bt[q] = bb * eng; Kt[q] = kp[e] * eng;
                    *(bf16_t*)(L + O_BHT + (c8 + e) * PB + tsw) = f2bf(bb * een); *(bf16_t*)(L + O_KHT + (c8 + e) * PB + tsw) = f2bf(kp[e] * een); *(bf16_t*)(L + O_VT + (c8 + e) * PB + tsw) = f2bf(vv[e]); *(bf16_t*)(L + O_SB + (c8 + e) * PB + tsw) = f2bf(At[q]);
                    if (tok == 63) ((float*)(L + O_GAM))[c8 + e] = __expf(cn); }
                const int ob = tok * PB + (c8 + 2 * e2) * 2;
                *(unsigned*)(L + O_AT + ob) = pk2(At[0], At[1]); *(unsigned*)(L + O_RT + ob) = pk2(Rt[0], Rt[1]); *(unsigned*)(L + O_BT + ob) = pk2(Bt[0], Bt[1]); *(unsigned*)(L + O_KT + ob) = pk2(Kt[0], Kt[1]); }
            {   const int s_ = c * 64 + tok; const int t_ = dir ? (SEQ - 1 - s_) : s_;
                u32x4 w_; w_.x = pk2(bs * vv[0], bs * vv[1]); w_.y = pk2(bs * vv[2], bs * vv[3]); w_.z = pk2(bs * vv[4], bs * vv[5]); w_.w = pk2(bs * vv[6], bs * vv[7]);
                *(u32x4*)(bon + ((size_t)b * SEQ + t_) * 512 + c8) = w_; }
        }
        LDS_BAR(); RKP1(3); RKP0(4);
        if (c + 8 < SEQ / 64) RK_LOAD(c + 8);
        for (int idx = w; idx < 12; idx += 8) {
            RK_LANE(); const int pr = idx / 3, tl = idx - pr * 3; const int mi = (tl == 2) ? 32 : 0, nt = (tl >= 1) ? 32 : 0;
            const char* X = L + ((pr & 1) ? O_KT : O_BT); const char* Y = L + ((pr >= 2) ? O_RT : O_AT);
            f32x16 acc = {}; mm32<4>(acc, X, mi, Y, nt, 0, r32, hi);
            const int t = nt + r32;
            if (tl != 1) {
#pragma unroll
                for (int r = 0; r < 16; ++r) { const int i = mi + crow(r, hi); const bool keep = (pr < 2) ? (i < t) : (i <= t); if (!keep) acc[r] = 0.f; } }
            char* Z = L + (pr == 0 ? O_AAB : pr == 1 ? O_AAK : pr == 2 ? O_ARB : O_ARK);
            st_T(acc, Z, nt, mi, r32, hi);
            if (pr == 0 && tl != 1) { float* ABD = (float*)(L + O_ABD);
#pragma unroll
                for (int g = 0; g < 4; ++g) if ((g >> 1) == (r32 >> 4)) *(f32x4*)(ABD + (t >> 4) * 256 + (t & 15) * 16 + 8 * (g & 1) + 4 * hi) = (f32x4){acc[4 * g], acc[4 * g + 1], acc[4 * g + 2], acc[4 * g + 3]}; }
        }
        LDS_BAR(); RKP1(4); RKP0(5);
        f32x16 yacc = {}, nacc = {};
        const int mt = (w & 2) ? 32 : 0, nv = (w & 1) ? 32 : 0;
        if (w < 4) {
            RK_LANE(); f32x16 xq = {};
            if (mt) mm32s<4, false, true>(xq, L + O_AAK, mt, L + O_VT, nv, r32, hi); else mm32s<2, false, true>(xq, L + O_AAK, mt, L + O_VT, nv, r32, hi);
            st_T(xq, L + O_G1T, nv, mt, r32, hi);
            mm32s<4, true, true>(nacc, L + O_KHT, mt, L + O_VT, nv, r32, hi);
        } else if (w < 7) {
            RK_LANE(); if (mt) mm32s<4, false, true>(yacc, L + O_ARK, mt, L + O_VT, nv, r32, hi); else mm32s<2, false, true>(yacc, L + O_ARK, mt, L + O_VT, nv, r32, hi);
        } else {
            RK_LANE(); const int blk = lane >> 4, j = lane & 15; const float* A = (const float*)(L + O_ABD) + blk * 256;
            float x[16];
#pragma unroll
            for (int t = 0; t < 16; ++t) { float s = (t == j) ? 1.f : 0.f;
#pragma unroll
                for (int i = 0; i < t; ++i) s += A[t * 16 + i] * x[i];
                x[t] = s; asm volatile("" ::: "memory"); }
            char* Tm = L + O_T; char* Dm = L + O_DT;
#pragma unroll
            for (int t = 0; t < 16; ++t) *(bf16_t*)(Tm + (16 * blk + t) * PB + (16 * blk + j) * 2) = f2bf(x[t]);
            { u32x4 a, d; a.x = pk2(x[0], x[1]); a.y = pk2(x[2], x[3]); a.z = pk2(x[4], x[5]); a.w = pk2(x[6], x[7]); d.x = pk2(x[8], x[9]); d.y = pk2(x[10], x[11]); d.z = pk2(x[12], x[13]); d.w = pk2(x[14], x[15]);
              *(u32x4*)(Dm + (16 * blk + j) * PB + (16 * blk) * 2) = a; *(u32x4*)(Dm + (16 * blk + j) * PB + (16 * blk + 8) * 2) = d; }
            if ((blk & 1) == 0) {
#pragma unroll
                for (int t = 0; t < 16; ++t) *(bf16_t*)(Tm + (16 * blk + t) * PB + (16 * (blk + 1) + j) * 2) = 0;
            } else { *(u32x4*)(Dm + (16 * blk + j) * PB + (16 * (blk - 1)) * 2) = (u32x4){0u, 0u, 0u, 0u}; *(u32x4*)(Dm + (16 * blk + j) * PB + (16 * (blk - 1) + 8) * 2) = (u32x4){0u, 0u, 0u, 0u}; }
            RK_FENCE();
            const int m16 = lane & 15, kg = lane >> 4; const bf16x8 z8 = {0, 0, 0, 0, 0, 0, 0, 0};
#pragma unroll
            for (int pp = 0; pp < 2; ++pp) { const int o = 32 * pp;
                bf16x8 a = z8, bb = z8;
                if (kg < 2) { a = *(const bf16x8*)(L + O_AAB + (o + 16 + m16) * PB + (o + 8 * kg) * 2); bb = *(const bf16x8*)(Dm + (o + m16) * PB + (o + 8 * kg) * 2); }
                f32x4 pq = __builtin_amdgcn_mfma_f32_16x16x32_bf16(a, bb, (f32x4){0.f, 0.f, 0.f, 0.f}, 0, 0, 0);
                { u32x2 wv; wv.x = pk2(pq[0], pq[1]); wv.y = pk2(pq[2], pq[3]); *(u32x2*)(L + O_PT + (o + m16) * PB + (o + 16 + 4 * kg) * 2) = wv; } }
            RK_FENCE();
#pragma unroll
            for (int pp = 0; pp < 2; ++pp) { const int o = 32 * pp;
                bf16x8 a = z8, bb = z8;
                if (kg < 2) { a = *(const bf16x8*)(Tm + (o + 16 + m16) * PB + (o + 16 + 8 * kg) * 2); bb = *(const bf16x8*)(L + O_PT + (o + m16) * PB + (o + 16 + 8 * kg) * 2); }
                f32x4 tq = __builtin_amdgcn_mfma_f32_16x16x32_bf16(a, bb, (f32x4){0.f, 0.f, 0.f, 0.f}, 0, 0, 0);
#pragma unroll
                for (int e = 0; e < 4; ++e) *(bf16_t*)(Tm + (o + 16 + 4 * kg + e) * PB + (o + m16) * 2) = f2bf(tq[e]);
                { u32x2 wv; wv.x = pk2(tq[0], tq[1]); wv.y = pk2(tq[2], tq[3]); *(u32x2*)(Dm + (o + m16) * PB + (o + 16 + 4 * kg) * 2) = wv; } }
            RK_FENCE();
            { f32x16 q = {}; mm32<2>(q, L + O_AAB, 32, Dm, 0, 0, r32, hi); st_T(q, L + O_PT, 0, 32, r32, hi); }
            RK_FENCE();
            { f32x16 tc = {}; mm32<2>(tc, Tm, 32, L + O_PT, 0, 32, r32, hi);
#pragma unroll
              for (int r = 0; r < 16; ++r) *(bf16_t*)(Tm + (32 + crow(r, hi)) * PB + r32 * 2) = f2bf(tc[r]); }
        }
        LDS_BAR(); RKP1(5); RKP0(6);
        if (w < 4) {
            RK_LANE(); f32x16 q = {};
            if (mt) mm32s<4, false, true>(q, L + O_T, mt, L + O_SB, nv, r32, hi); else mm32s<2, false, true>(q, L + O_T, mt, L + O_SB, nv, r32, hi);
            st_T(q, L + O_PT, nv, mt, r32, hi);
        } else {
            RK_LANE(); if (w == 7) mm32s<4, false, true>(yacc, L + O_ARK, mt, L + O_VT, nv, r32, hi);
            f32x16 q = {};
            if (mt) mm32<4>(q, L + O_T, mt, L + O_G1T, nv, 0, r32, hi); else mm32<2>(q, L + O_T, mt, L + O_G1T, nv, 0, r32, hi);
            st_T(q, L + O_UT, nv, mt, r32, hi);
        }
        LDS_BAR(); RKP1(6); RKP0(7);
        {   const size_t ci = (size_t)sid * (SEQ / 64) + c;
            if (w < 4) {
                RK_LANE(); mm32s<4, true, false>(nacc, L + O_BHT, mt, L + O_UT, nv, r32, hi);
                {   bf16_t* NN = (sid < 24 ? (bf16_t*)(p.ws + WS_NN) : (bf16_t*)(g_scr + SCR_NN2) - (size_t)24 * 128 * 4096) + ci * 4096 + ((size_t)(w * 64 + lane)) * 16;
                    u32x4 a, d; a.x = pk2(nacc[0], nacc[1]); a.y = pk2(nacc[2], nacc[3]); a.z = pk2(nacc[4], nacc[5]); a.w = pk2(nacc[6], nacc[7]);
                    d.x = pk2(nacc[8], nacc[9]); d.y = pk2(nacc[10], nacc[11]); d.z = pk2(nacc[12], nacc[13]); d.w = pk2(nacc[14], nacc[15]);
                    *(u32x4*)NN = a; *(u32x4*)(NN + 8) = d; }
                f32x16 mq = {}; mm32s<4, false, true>(mq, L + O_PT, mt, L + O_BHT, nv, r32, hi);
                const int kq = nv + r32; const float gk = ((const float*)(L + O_GAM))[kq];
#pragma unroll
                for (int r = 0; r < 16; ++r) if (mt + crow(r, hi) == kq) mq[r] += gk;
                bf16_t* MM = (bf16_t*)(p.ws + WS_MM) + ci * 4096 + (size_t)kq * 64 + mt + 4 * hi;
#pragma unroll
                for (int g = 0; g < 4; ++g) { u32x2 wv; wv.x = pk2(mq[4 * g], mq[4 * g + 1]); wv.y = pk2(mq[4 * g + 2], mq[4 * g + 3]); *(u32x2*)(MM + 8 * g) = wv; }
            } else {
                RK_LANE(); if (mt) mm32<4>(yacc, L + O_ARB, mt, L + O_UT, nv, 0, r32, hi); else mm32<2>(yacc, L + O_ARB, mt, L + O_UT, nv, 0, r32, hi);
                {
                    bf16_t* yp = wkv + (size_t)c * 4096 + (size_t)((w - 4) * 64 + lane) * 16;
                    u32x4 a_, d_; a_.x = pk2(yacc[0], yacc[1]); a_.y = pk2(yacc[2], yacc[3]); a_.z = pk2(yacc[4], yacc[5]); a_.w = pk2(yacc[6], yacc[7]);
                    d_.x = pk2(yacc[8], yacc[9]); d_.y = pk2(yacc[10], yacc[11]); d_.z = pk2(yacc[12], yacc[13]); d_.w = pk2(yacc[14], yacc[15]);
                    *(u32x4*)yp = a_; *(u32x4*)(yp + 8) = d_; }
                f32x16 qq = {};
                if (nv) mm32<4>(qq, L + O_PT, mt, L + O_ARB, nv, 0, r32, hi); else mm32<2>(qq, L + O_PT, mt, L + O_ARB, nv, 0, r32, hi);
                const int tq = nv + r32;
                bf16_t* QQ = (bf16_t*)(g_scr + SCR_XB) + ci * 4096 + (size_t)tq * 64 + mt + 4 * hi;
#pragma unroll
                for (int g = 0; g < 4; ++g) { const u32x2 rw = *(const u32x2*)(L + O_RT + tq * PB + (mt + 8 * g + 4 * hi) * 2);
                    const float r0 = __uint_as_float(rw.x << 16), r1 = __uint_as_float(rw.x & 0xffff0000u), r2 = __uint_as_float(rw.y << 16), r3 = __uint_as_float(rw.y & 0xffff0000u);
                    u32x2 wv; wv.x = pk2(qq[4 * g] + r0, qq[4 * g + 1] + r1); wv.y = pk2(qq[4 * g + 2] + r2, qq[4 * g + 3] + r3); *(u32x2*)(QQ + 8 * g) = wv; }
            }
        }
        LDS_BAR(); RKP1(7);
    }
#undef RK_LOAD
#undef RK_LANE
    return pacc;
}

__device__ __forceinline__ void chain(const Params& p, const int sid, unsigned char* lds) {
    const int tid = otid(), w = __builtin_amdgcn_readfirstlane(tid >> 6);
    constexpr int C_MT = 0, C_QT = MAT, C_SB = 2 * MAT;
#define RK_LANE() int tq_ = tid; asm volatile("" : "+v"(tq_)); const int lane = tq_ & 63, r32 = lane & 31, hi = lane >> 5, row = tq_ >> 3, c8 = (tq_ & 7) * 8; (void)lane; (void)r32; (void)hi; (void)row; (void)c8
    char* L = (char*)lds;
    const bf16_t* MMg = (const bf16_t*)(p.ws + WS_MM) + (size_t)sid * 128 * 4096; const bf16_t* QQg = (const bf16_t*)(g_scr + SCR_XB) + (size_t)sid * 128 * 4096;
    const bf16_t* NNg = (sid < 24 ? (const bf16_t*)(p.ws + WS_NN) : (const bf16_t*)(g_scr + SCR_NN2) - (size_t)24 * 128 * 4096) + (size_t)sid * 128 * 4096;
    bf16_t* wkv = (bf16_t*)(g_scr + SCR_WKV) + (size_t)sid * SEQ * 64;
    const int mt = (w & 2) ? 32 : 0, nv = (w & 1) ? 32 : 0;
    {   RK_LANE(); unsigned zz = 0u; asm volatile("" : "+v"(zz)); *(u32x4*)(L + C_SB + row * PB + c8 * 2) = (u32x4){zz, zz, zz, zz}; }
    f32x16 sacc = {};
    bf16x8 rm, rq, rn0, rn1;
#define CH_LOAD(c) do { RK_LANE(); rm = *(const bf16x8*)(MMg + (size_t)(c) * 4096 + row * 64 + c8); rq = *(const bf16x8*)(QQg + (size_t)(c) * 4096 + row * 64 + c8); \
        if (w < 4) { const bf16_t* n_ = NNg + (size_t)(c) * 4096 + (size_t)(w * 64 + lane) * 16; rn0 = *(const bf16x8*)n_; rn1 = *(const bf16x8*)(n_ + 8); } \
        else { const bf16_t* y_ = wkv + (size_t)(c) * 4096 + (size_t)((w - 4) * 64 + lane) * 16; rn0 = *(const bf16x8*)y_; rn1 = *(const bf16x8*)(y_ + 8); } } while (0)
    CH_LOAD(0);
#pragma unroll 1
    for (int c = 0; c < SEQ / 64; ++c) {
        {   RK_LANE(); *(bf16x8*)(L + C_MT + row * PB + c8 * 2) = rm; *(bf16x8*)(L + C_QT + row * PB + c8 * 2) = rq; }
        f32x16 acc;
#pragma unroll
        for (int r = 0; r < 8; ++r) { acc[r] = bf2f((bf16_t)rn0[r]); acc[8 + r] = bf2f((bf16_t)rn1[r]); }
        LDS_BAR();
        if (c + 1 < SEQ / 64) CH_LOAD(c + 1);
        {   RK_LANE();
            if (w < 4) { mm32<4>(acc, L + C_MT, mt, L + C_SB, nv, 0, r32, hi); sacc = acc; }
            else { mm32<4>(acc, L + C_QT, mt, L + C_SB, nv, 0, r32, hi);
#pragma unroll
                for (int r = 0; r < 16; ++r) wkv[((size_t)c * 64 + mt + crow(r, hi)) * 64 + nv + r32] = f2bf(acc[r]); } }
        LDS_BAR();
        if (w < 4) { RK_LANE(); st_T(sacc, L + C_SB, nv, mt, r32, hi); }
    }
#undef CH_LOAD
#undef RK_LANE
}

}

namespace sd {
using rk::f32x16; using rk::crow;
constexpr int PW = 272, PN = 144;
constexpr int O_CM = 0, O_BM = 64 * PW, O_HB = 2 * 64 * PW, O_BDT = 3 * 64 * PW, O_XDT = O_BDT + 128 * PN, O_XM = O_XDT + 64 * PN, O_MM = O_XM + 64 * PN, O_DTS = O_MM + 64 * PN, O_ACU = O_DTS + 512, O_END = O_ACU + 512;
template <int NKS, int PA, int PBB, int SA = -1, int SBW = -1> __device__ __forceinline__ void mmx(f32x16& acc, const char* A, int m0, const char* B, int n0, int k0, int r32, int hi) {
    const int ra = m0 + r32, rb = n0 + r32; const int fa = SA >= 0 ? ((ra >> (SA >= 0 ? SA : 0)) & 7) : 0, fb = SBW >= 0 ? ((rb >> (SBW >= 0 ? SBW : 0)) & 7) : 0;
#pragma unroll
    for (int ks = 0; ks < NKS; ++ks) { const int q = (k0 >> 3) + ks * 2 + hi;
        const bf16x8 a = *(const bf16x8*)(A + ra * PA + ((q ^ fa) << 4));
        const bf16x8 b = *(const bf16x8*)(B + rb * PBB + ((q ^ fb) << 4));
        acc = __builtin_amdgcn_mfma_f32_32x32x16_bf16(a, b, acc, 0, 0, 0); }
}
template <int PZ> __device__ __forceinline__ void stT(const f32x16& acc, char* Z, int n0, int m0, int r32, int hi) {
#pragma unroll
    for (int g = 0; g < 4; ++g) { u32x2 w; w.x = pk2(acc[4 * g], acc[4 * g + 1]); w.y = pk2(acc[4 * g + 2], acc[4 * g + 3]);
        *(u32x2*)(Z + (n0 + r32) * PZ + (m0 + 8 * g + 4 * hi) * 2) = w; }
}
__device__ __forceinline__ unsigned long long seq(const Params& p, const int l, const int sid, unsigned char* lds) {
    const int tid = otid(), w = __builtin_amdgcn_readfirstlane(tid >> 6);
    const int h = sid & 7, dir = (sid >> 3) & 1, b = sid >> 4, g = h >> 2;
    unsigned long long pacc = 0, ptt = 0; (void)ptt;
#ifdef PRB_SDIV
#define SDP0(i) do { if ((PRB_SDIV >> (i)) & 1) ptt = __builtin_amdgcn_s_memrealtime(); } while (0)
#define SDP1(i) do { if ((PRB_SDIV >> (i)) & 1) pacc += __builtin_amdgcn_s_memrealtime() - ptt; } while (0)
#else
#define SDP0(i) do {} while (0)
#define SDP1(i) do {} while (0)
#endif
#define SD_LANE() int tq_ = tid; asm volatile("" : "+v"(tq_)); const int lane = tq_ & 63, r32 = lane & 31, hi = lane >> 5, tok = tq_ >> 3, q8 = tq_ & 7; (void)lane; (void)r32; (void)hi; (void)tok; (void)q8
    char* L = (char*)lds;
    const float Ah = -expf(p.in[7][(l * 2 + dir) * 8 + h]), dtb = p.in[8][(l * 2 + dir) * 8 + h], Dh = (dir == 0) ? p.in[9][l * 8 + h] : 0.f;
    const float* dtbuf = (const float*)(g_scr + SCR_DT) + dir * 8 + h;
    const bf16_t* xact = (const bf16_t*)(g_scr + SCR_XACT);
    bf16_t* yout = (bf16_t*)(g_scr + SCR_SSDY) + (size_t)dir * M_TOK * 512 + h * 64;
    {   SD_LANE(); unsigned zz = 0u; asm volatile("" : "+v"(zz));
        for (int i = tid; i < 64 * PW / 16; i += 512) *(u32x4*)(L + O_HB + i * 16) = (u32x4){zz, zz, zz, zz}; }
    f32x16 hacc = {};
    bf16x8 rc[2], rb[2], rx; float dtr = 0.f;
#define SD_LOAD(c) do { SD_LANE(); const int s_ = (c) * 64 + tok; const int t_ = dir ? (SEQ - 1 - s_) : s_; const bf16_t* row_ = xact + ((size_t)b * SEQ + t_) * 1024; \
        rc[0] = *(const bf16x8*)(row_ + 768 + g * 128 + q8 * 16); rc[1] = *(const bf16x8*)(row_ + 768 + g * 128 + q8 * 16 + 8); \
        rb[0] = *(const bf16x8*)(row_ + 512 + g * 128 + q8 * 16); rb[1] = *(const bf16x8*)(row_ + 512 + g * 128 + q8 * 16 + 8); \
        rx = *(const bf16x8*)(row_ + h * 64 + q8 * 8); } while (0)
#define SD_DTLOAD(c) do { SD_LANE(); const int s2_ = (c) * 64 + lane; const int t2_ = dir ? (SEQ - 1 - s2_) : s2_; dtr = dtbuf[((size_t)b * SEQ + t2_) * 16]; } while (0)
#define SD_SCAN(buf) do { SD_LANE(); const float dt_ = softplusf(dtr + dtb); float ac_ = dt_ * Ah; \
        _Pragma("unroll") for (int o_ = 1; o_ < 64; o_ <<= 1) { const float v_ = __shfl_up(ac_, o_); if (lane >= o_) ac_ += v_; } \
        ((float*)(L + O_DTS))[(buf) * 64 + lane] = dt_; ((float*)(L + O_ACU))[(buf) * 64 + lane] = ac_; } while (0)
    SD_LOAD(0);
    if (w == 7) { SD_DTLOAD(0); SD_SCAN(0); SD_DTLOAD(1); }
    LDS_BAR();
    const int nv = (w & 1) ? 32 : 0;
#pragma unroll 1
    for (int c = 0; c < SEQ / 64; ++c) {
        const float* DTS = (const float*)(L + O_DTS) + (c & 1) * 64; const float* ACU = (const float*)(L + O_ACU) + (c & 1) * 64;
        SDP0(1);
        {   SD_LANE(); const float dt = DTS[tok]; const float ac = ACU[tok], ae = ACU[63];
            const float dend = __expf(ae - ac);
            *(bf16x8*)(L + O_CM + tok * PW + q8 * 32) = rc[0]; *(bf16x8*)(L + O_CM + tok * PW + q8 * 32 + 16) = rc[1];
            *(bf16x8*)(L + O_BM + tok * PW + q8 * 32) = rb[0]; *(bf16x8*)(L + O_BM + tok * PW + q8 * 32 + 16) = rb[1];
            *(bf16x8*)(L + O_XM + tok * PN + q8 * 16) = rx;
            const int tsw = ((((tok >> 3) ^ q8) << 3) + (tok & 7)) * 2;
#pragma unroll
            for (int e = 0; e < 8; ++e) { *(bf16_t*)(L + O_BDT + (q8 * 16 + e) * PN + tsw) = f2bf(bf2f((bf16_t)rb[0][e]) * dend); *(bf16_t*)(L + O_BDT + (q8 * 16 + 8 + e) * PN + tsw) = f2bf(bf2f((bf16_t)rb[1][e]) * dend);
                *(bf16_t*)(L + O_XDT + (q8 * 8 + e) * PN + tsw) = f2bf(bf2f((bf16_t)rx[e]) * dt); } }
        LDS_BAR(); SDP1(1); SDP0(2);
        if (c + 1 < SEQ / 64) SD_LOAD(c + 1);
        f32x16 yoff = {};
        const int ml = ((w - 3) & 2) ? 32 : 0, np = ((w - 3) & 1) ? 32 : 0;
        if (w < 3) { SD_LANE(); const int ms = (w == 2) ? 32 : 0, nl = (w >= 1) ? 32 : 0;
            f32x16 gq = {}; mmx<8, PW, PW>(gq, L + O_BM, ms, L + O_CM, nl, 0, r32, hi);
            const int lq = nl + r32; const float al = ACU[lq];
#pragma unroll
            for (int g4 = 0; g4 < 4; ++g4) { const f32x4 as4 = *(const f32x4*)(ACU + ms + 8 * g4 + 4 * hi);
#pragma unroll
                for (int e = 0; e < 4; ++e) { const int s = ms + 8 * g4 + 4 * hi + e; const float d = __expf(fminf(al - as4[e], 0.f)); gq[4 * g4 + e] = (s <= lq) ? gq[4 * g4 + e] * d : 0.f; } }
            stT<PN>(gq, L + O_MM, nl, ms, r32, hi);
        } else if (w < 7) { SD_LANE(); mmx<8, PW, PW>(yoff, L + O_CM, ml, L + O_HB, np, 0, r32, hi); }
        {   SD_LANE(); const float eend = __expf(ACU[63]);
#pragma unroll
            for (int r = 0; r < 16; ++r) hacc[r] *= eend;
            mmx<4, PN, PN, 4, 3>(hacc, L + O_BDT, (w >> 1) * 32, L + O_XDT, nv, 0, r32, hi); }
        if (w == 7 && c + 1 < SEQ / 64) { SD_SCAN((c + 1) & 1); if (c + 2 < SEQ / 64) SD_DTLOAD(c + 2); }
        LDS_BAR(); SDP1(2); SDP0(3);
        {   SD_LANE(); stT<PW>(hacc, L + O_HB, nv, (w >> 1) * 32, r32, hi); }
        if (w >= 3 && w < 7) { SD_LANE(); f32x16 yd = {};
            if (ml) mmx<4, PN, PN, -1, 3>(yd, L + O_MM, ml, L + O_XDT, np, 0, r32, hi); else mmx<2, PN, PN, -1, 3>(yd, L + O_MM, ml, L + O_XDT, np, 0, r32, hi);
            float ea[16], xv[16];
#pragma unroll
            for (int g4 = 0; g4 < 4; ++g4) { const f32x4 a4 = *(const f32x4*)(ACU + ml + 8 * g4 + 4 * hi);
#pragma unroll
                for (int e = 0; e < 4; ++e) { ea[4 * g4 + e] = __expf(a4[e]); xv[4 * g4 + e] = bf2f(*(const bf16_t*)(L + O_XM + (ml + 8 * g4 + 4 * hi + e) * PN + (np + r32) * 2)); } }
#pragma unroll
            for (int r = 0; r < 16; ++r) { const int lq = ml + crow(r, hi); const int s_ = c * 64 + lq; const int t_ = dir ? (SEQ - 1 - s_) : s_;
                yout[((size_t)b * SEQ + t_) * 512 + np + r32] = f2bf(yd[r] + ea[r] * yoff[r] + Dh * xv[r]); } }
        LDS_BAR(); SDP1(3);
    }
#undef SD_LOAD
#undef SD_DTLOAD
#undef SD_SCAN
#undef SD_LANE
    return pacc;
}
}

__device__ __forceinline__ void combine_tokens(const Params& p, const int l, const int m_first, const int m_end, const int m_step) {
    const int tid = otid(), lane = tid & 63;
    const bf16_t* wkv = (const bf16_t*)(g_scr + SCR_WKV); const bf16_t* bon = (const bf16_t*)(g_scr + SCR_BON); const bf16_t* sy = (const bf16_t*)(g_scr + SCR_SSDY);
    const int h = lane >> 3, c8 = (lane & 7) * 8, ch = h * 64 + c8;
    float eps_gn = 64e-5f, eps_rms = NORM_EPS; asm volatile("" : "+v"(eps_gn), "+v"(eps_rms));
    float lnw[8], lnb[8], snw[8];
#pragma unroll
    for (int e = 0; e < 8; ++e) { lnw[e] = p.in[19][l * 512 + ch + e]; lnb[e] = p.in[20][l * 512 + ch + e]; snw[e] = p.in[10][l * 512 + ch + e]; }
    for (int m = m_first; m < m_end; m += m_step) {
        const int bq = m >> 13, tq = m & (SEQ - 1);
        bf16_t* gp = pblk(p.ws, PB_RG + (h >> 1)) + (size_t)m * 128 + (h & 1) * 64 + c8; bf16_t* zp = pblk(p.ws, PB_Z + (h >> 1)) + (size_t)m * 128 + (h & 1) * 64 + c8;
        const bf16x8 vwf = *(const bf16x8*)(wkv + (((size_t)(bq * 16 + h)) * SEQ + tq) * 64 + c8), vwb = *(const bf16x8*)(wkv + (((size_t)(bq * 16 + 8 + h)) * SEQ + (SEQ - 1 - tq)) * 64 + c8);
        const bf16x8 vbf = *(const bf16x8*)(bon + (size_t)m * 512 + ch), vbb = *(const bf16x8*)(bon + (size_t)M_TOK * 512 + (size_t)m * 512 + ch);
        const bf16x8 vg = *(const bf16x8*)gp, vz = *(const bf16x8*)zp;
        const bf16x8 vyf = *(const bf16x8*)(sy + (size_t)m * 512 + ch), vyb = *(const bf16x8*)(sy + (size_t)M_TOK * 512 + (size_t)m * 512 + ch);
        float a[8], bq8[8], x[8], y[8];
        unpack8(vwf, a); unpack8(vwb, bq8); float s = 0.f;
#pragma unroll
        for (int e = 0; e < 8; ++e) { x[e] = a[e] + bq8[e]; s += x[e]; }
        s += __shfl_xor(s, 1); s += __shfl_xor(s, 2); s += __shfl_xor(s, 4);
        const float mean = s * (1.f / 64.f); float v2 = 0.f;
#pragma unroll
        for (int e = 0; e < 8; ++e) { x[e] -= mean; v2 += x[e] * x[e]; }
        v2 += __shfl_xor(v2, 1); v2 += __shfl_xor(v2, 2); v2 += __shfl_xor(v2, 4);
        const float rstd = rsqrtf(v2 * (1.f / 64.f) + eps_gn);
        unpack8(vbf, a); unpack8(vbb, bq8); unpack8(vg, y);
#pragma unroll
        for (int e = 0; e < 8; ++e) x[e] = (x[e] * rstd * lnw[e] + lnb[e] + a[e] + bq8[e]) * siluf(y[e]);
        const u32x4 ob = pack8(x);
        unpack8(vyf, a); unpack8(vyb, bq8); unpack8(vz, y); float ss = 0.f;
#pragma unroll
        for (int e = 0; e < 8; ++e) { x[e] = (a[e] + bq8[e]) * siluf(y[e]); ss += x[e] * x[e]; }
        ss += __shfl_xor(ss, 1); ss += __shfl_xor(ss, 2); ss += __shfl_xor(ss, 4); ss += __shfl_xor(ss, 8); ss += __shfl_xor(ss, 16);
        const float rs = rsqrtf(ss * (1.f / 256.f) + eps_rms);
#pragma unroll
        for (int e = 0; e < 8; ++e) x[e] *= rs * snw[e];
        const u32x4 oa = pack8(x);
        *(u32x4*)gp = ob; *(u32x4*)zp = oa;
    }
}

__device__ __forceinline__ void phase_post(const Params& p, const int l) {
    const int G = gridDim.x, tid = otid(), lane = tid & 63, wave = tid >> 6;
    const bf16_t* mix = (const bf16_t*)(p.ws + WS_MIX); const float* xin = l == 0 ? p.in[0] : p.out; const float* pw = p.in[2] + l * DMODEL;
    f32x4 wv[4];
#pragma unroll
    for (int j = 0; j < 4; ++j) wv[j] = ((const f32x4*)pw)[lane + 64 * j];
    for (int m0 = (blockIdx.x * 8 + wave) * 2; m0 < M_TOK; m0 += G * 16) {
        f32x4 v[2][4], x[2][4];
#pragma unroll
        for (int q = 0; q < 2; ++q)
#pragma unroll
            for (int j = 0; j < 4; ++j) { const u32x2 mb = ((const u32x2*)(mix + (size_t)(m0 + q) * DMODEL))[lane + 64 * j]; v[q][j].x = __uint_as_float(mb.x << 16); v[q][j].y = __uint_as_float(mb.x & 0xffff0000u); v[q][j].z = __uint_as_float(mb.y << 16); v[q][j].w = __uint_as_float(mb.y & 0xffff0000u);
                x[q][j] = ((const f32x4*)(xin + (size_t)(m0 + q) * DMODEL))[lane + 64 * j]; }
#pragma unroll
        for (int q = 0; q < 2; ++q) { float s = 0.f;
#pragma unroll
            for (int j = 0; j < 4; ++j) s += (v[q][j].x * v[q][j].x + v[q][j].y * v[q][j].y) + (v[q][j].z * v[q][j].z + v[q][j].w * v[q][j].w);
            const float rs = rsqrtf(wave_sum(s) * (1.f / DMODEL) + NORM_EPS); float s2 = 0.f;
#pragma unroll
            for (int j = 0; j < 4; ++j) { v[q][j] = x[q][j] + v[q][j] * rs * wv[j]; s2 += (v[q][j].x * v[q][j].x + v[q][j].y * v[q][j].y) + (v[q][j].z * v[q][j].z + v[q][j].w * v[q][j].w); }
            s2 = wave_sum(s2);
            if (lane == 0 && l + 1 < 2) ((float*)(g_scr + SCR_RS))[m0 + q] = rsqrtf(s2 * (1.f / DMODEL) + NORM_EPS); }
#pragma unroll
        for (int q = 0; q < 2; ++q) { f32x4* orow = (f32x4*)(p.out + (size_t)(m0 + q) * DMODEL) + lane; u32x2* o8 = (u32x2*)((bf16_t*)(g_scr + SCR_XB) + (size_t)(m0 + q) * DMODEL) + lane;
#pragma unroll
            for (int j = 0; j < 4; ++j) { orow[64 * j] = v[q][j]; if (l + 1 < 2) { u32x2 w; w.x = pk2(v[q][j].x, v[q][j].y); w.y = pk2(v[q][j].z, v[q][j].w); o8[64 * j] = w; } } }
    }
}

#define XB_TMO      128
#define XB_XCNT(j)  (256  + 64 * (j))
#define XB_XSUB(j)  (1280 + 64 * (j))
#define XB_XGEN(j)  (2304 + 64 * (j))
#define XB_TOP      3328
#define XB_TOPGEN   3392
#define XCD_BAR_WORDS 3456
#define XB_SPIN_CAP (1u << 18)
#define XLAS __attribute__((address_space(3)))
__device__ __forceinline__ unsigned xb_ld(unsigned* p)              { return __hip_atomic_load(p, __ATOMIC_RELAXED, __HIP_MEMORY_SCOPE_AGENT); }
__device__ __forceinline__ unsigned xb_add(unsigned* p, unsigned v) { return __hip_atomic_fetch_add(p, v, __ATOMIC_RELAXED, __HIP_MEMORY_SCOPE_AGENT); }
__device__ __forceinline__ unsigned xb_xcc_id() { return (unsigned)__builtin_amdgcn_s_getreg((3 << 11) | 20) & 0xFu; }
#define XB_SPIN(cond, bar) do { unsigned _sp = 0; while (cond) { __builtin_amdgcn_s_sleep(1); \
    if ((++_sp & 255u) == 0u) { if (xb_ld(&(bar)[XB_TMO])) break; if (_sp > XB_SPIN_CAP) { atomicAdd(&(bar)[XB_TMO], 1u); break; } } } } while (0)
struct XcdBarrier { unsigned* bar; unsigned x; volatile XLAS unsigned* st; };
__device__ __forceinline__ XcdBarrier xcd_barrier_post(unsigned* bar, volatile XLAS unsigned* st) {
    XcdBarrier b; b.bar = bar; b.x = xb_xcc_id(); b.st = st;
    if (threadIdx.x == 0) (void)xb_add(&bar[XB_XCNT(b.x)], 1u);
    return b;
}
__device__ __forceinline__ void xcd_barrier_complete(unsigned* bar, unsigned x, unsigned& nloc, unsigned& nx) {
    const unsigned G = gridDim.x * gridDim.y * gridDim.z;
    unsigned sum, cnt, mine, sp = 0u;
    for (;;) {
        sum = 0u; cnt = 0u; mine = 0u;
#pragma unroll
        for (unsigned j = 0; j < 16; ++j) { const unsigned c = xb_ld(&bar[XB_XCNT(j)]); sum += c; cnt += (c > 0u) ? 1u : 0u; mine = (j == x) ? c : mine; }
        if (sum == G) break;
        __builtin_amdgcn_s_sleep(1);
        if ((++sp & 255u) == 0u) { if (xb_ld(&bar[XB_TMO])) break; if (sp > XB_SPIN_CAP) { atomicAdd(&bar[XB_TMO], 1u); break; } }
    }
    nloc = mine > 0u ? mine : 1u; nx = cnt > 0u ? cnt : 1u;
}
__device__ __forceinline__ void xcd_barrier(const XcdBarrier& b) {
    asm volatile("s_waitcnt vmcnt(0)" ::: "memory");
    __syncthreads();
    if (threadIdx.x == 0) {
        unsigned* bar = b.bar;
        __builtin_amdgcn_s_waitcnt(0);
        unsigned nloc = b.st[0], nx = b.st[1];
        if (nloc == 0u) { xcd_barrier_complete(bar, b.x, nloc, nx); b.st[0] = nloc; b.st[1] = nx; }
        const unsigned old = xb_add(&bar[XB_XSUB(b.x)], 1u);
        const unsigned gen = old / nloc;
        if (old + 1u == (gen + 1u) * nloc) {
            __builtin_amdgcn_fence(__ATOMIC_RELEASE, "agent");
            asm volatile("s_waitcnt vmcnt(0)" ::: "memory");
            const unsigned og = xb_add(&bar[XB_TOP], 1u);
            const unsigned tg = og / nx;
            if (og + 1u == (tg + 1u) * nx) xb_add(&bar[XB_TOPGEN], 1u);
            else XB_SPIN(xb_ld(&bar[XB_TOPGEN]) == tg, bar);
            __builtin_amdgcn_fence(__ATOMIC_ACQUIRE, "agent");
            xb_add(&bar[XB_XGEN(b.x)], 1u);
            asm volatile("s_waitcnt vmcnt(0)" ::: "memory");
        } else {
            XB_SPIN(xb_ld(&bar[XB_XGEN(b.x)]) == gen, bar);
            __builtin_amdgcn_fence(__ATOMIC_ACQUIRE, "agent");
            asm volatile("s_waitcnt vmcnt(0)" ::: "memory");
        }
    }
    __syncthreads();
}

constexpr int LDS_BYTES = 155648;
static_assert(rk::O_END <= LDS_BYTES, "rwkv LDS map");
__device__ __forceinline__ void phase_gemm_in(const Params& p, const int l, unsigned char* lds) {
    pg8::Gemm g{(const bf16_t*)(g_scr + SCR_XB), (const bf16_t*)(g_scr + SCR_WIN + (size_t)l * 15 * MiB), M_TOK, NPROJ, DMODEL, DMODEL, 128};
    pg8::StaticOrder S; S.init(M_TOK, NPROJ, gridDim.x, blockIdx.x);
    pg8::EpiProj E{(bf16_t*)p.ws, (const float*)(g_scr + SCR_RS), (float*)(g_scr + SCR_DT)};
    pg8::gemm_phase<pg8::EpiProj, pg8::StaticOrder, true, true>((PG8_LAS unsigned char*)lds, g, S, E);
}
__device__ __forceinline__ void phase_gemm_out(const Params& p, const int l, unsigned char* lds) {
    pg8::Gemm g{(const bf16_t*)p.ws, (const bf16_t*)(g_scr + SCR_WOUT + (size_t)l * 4 * MiB), M_TOK, DMODEL, DMIX, 128, PBLK_ELEMS};
    pg8::StaticOrder S; S.init(M_TOK, DMODEL, gridDim.x, blockIdx.x);
    pg8::EpiMix E{(bf16_t*)(p.ws + WS_MIX)};
    pg8::gemm_phase<pg8::EpiMix, pg8::StaticOrder, true, true>((PG8_LAS unsigned char*)lds, g, S, E);
}
__device__ __forceinline__ unsigned long long phase_mixers(const Params& p, const int l, unsigned char* lds) {
    unsigned long long pr = 0;
    const int bid = blockIdx.x;
#ifdef PRB_SEQ
    const unsigned long long ts0 = __builtin_amdgcn_s_memrealtime();
#endif
    unsigned* seqdone = (unsigned*)(g_scr + SCR_CTL) + 200 + 8 * l; unsigned* cmbctr = seqdone + 1;
    if (bid < 32) rk::chain(p, bid, lds);
    else if (bid < 64) { const unsigned long long q_ = sd::seq(p, l, bid - 32, lds); (void)q_;
#ifdef PRB_SDIV
        pr = q_;
#endif
    }
    if (bid < 64) {
        asm volatile("s_waitcnt vmcnt(0)" ::: "memory"); __syncthreads();
        if (threadIdx.x == 0) { __builtin_amdgcn_fence(__ATOMIC_RELEASE, "agent"); asm volatile("s_waitcnt vmcnt(0)" ::: "memory"); __hip_atomic_fetch_add(seqdone, 1u, __ATOMIC_RELAXED, __HIP_MEMORY_SCOPE_AGENT); }
    }
#ifdef PRB_SEQ
    pr = __builtin_amdgcn_s_memrealtime() - ts0;
#endif
    unsigned* ctr = (unsigned*)(g_scr + SCR_CTL) + 64 * l;
    unsigned* slot = (unsigned*)(lds + LDS_BYTES - 16);
#ifdef PRB_UNIT
    int nun = 0;
#endif
    const int x0 = (int)(__builtin_amdgcn_s_getreg((3 << 11) | 20) & 7u);
    for (int dx = 0; dx < 8; ++dx) { const int x = (x0 + dx) & 7;
        for (;;) {
            __syncthreads();
            if (threadIdx.x == 0) *slot = atomicAdd(ctr + x, 1u);
            __syncthreads();
            const int j = (int)__builtin_amdgcn_readfirstlane(*slot);
            constexpr int NSPL = 16;
            if (j >= 96 + NSPL) break;
#ifdef PRB_UNIT
            const unsigned long long tu0 = __builtin_amdgcn_s_memrealtime();
#endif
            if (j < 32) gqa_unit(p, l, x * 32 + j, (char*)lds);
            else if (j < 96 - NSPL) diff_unit(p, l, x * 64 + (j - 32), (char*)lds);
            else { const int s = j - (96 - NSPL); diff_unit(p, l, x * 64 + (64 - NSPL) + (s >> 1), (char*)lds, s & 1, x * NSPL + (s >> 1)); }
#ifdef PRB_UNIT
            if (nun == PRB_UNIT) pr = __builtin_amdgcn_s_memrealtime() - tu0;
            if (PRB_UNIT == 99) pr = (unsigned long long)(nun + 1) * 10000ull + (j < 32 ? 1000ull : 0ull);
            ++nun;
#endif
        } }
    {   if (threadIdx.x == 0) { unsigned sp = 0; while (__hip_atomic_load(seqdone, __ATOMIC_RELAXED, __HIP_MEMORY_SCOPE_AGENT) < 64u) { __builtin_amdgcn_s_sleep(8); if (++sp > (1u << 22)) break; } }
        __syncthreads();
        __builtin_amdgcn_fence(__ATOMIC_ACQUIRE, "agent"); asm volatile("s_waitcnt vmcnt(0)" ::: "memory");
        const int wave = otid() >> 6;
        for (;;) {
            __syncthreads();
            if (threadIdx.x == 0) *slot = atomicAdd(cmbctr, 1u);
            __syncthreads();
            const int it = (int)__builtin_amdgcn_readfirstlane(*slot);
            if (it >= M_TOK / 64) break;
            combine_tokens(p, l, it * 64 + wave, it * 64 + 64, 8);
        } }
    return pr;
}
#ifdef PROBE
#define PT0(ph) do { if (l == 0 && (ph) == PRB_PH) pt0 = __builtin_amdgcn_s_memrealtime(); } while (0)
#define PT1(ph, aftersync) do { if (l == 0 && (ph) == PRB_PH && (aftersync) == PRB_SYNC) pd = __builtin_amdgcn_s_memrealtime() - pt0; } while (0)
#else
#define PT0(ph) do {} while (0)
#define PT1(ph, aftersync) do {} while (0)
#endif
__global__ void __launch_bounds__(512) mega(const Params p) {
    extern __shared__ __attribute__((aligned(16))) unsigned char lds[];
    cg::grid_group grid = cg::this_grid();
    unsigned* xbar = (unsigned*)(g_scr + SCR_BAR);
    volatile XLAS unsigned* xst = (volatile XLAS unsigned*)(XLAS unsigned char*)(lds + LDS_BYTES - 32);
    if (blockIdx.x == 0) for (int i = threadIdx.x; i < XCD_BAR_WORDS; i += 512) xbar[i] = 0u;
    if (threadIdx.x < 2) xst[threadIdx.x] = 0u;
#ifdef PROBE
    unsigned long long pt0 = 0, pd = 0;
#endif
#ifdef PROBE
    if (PRB_PH == 7) pt0 = __builtin_amdgcn_s_memrealtime();
#endif
    phase_prologue(p, (float*)lds); grid.sync();
    const XcdBarrier xb = xcd_barrier_post(xbar, xst);
#define GRID_BAR() xcd_barrier(xb)
#ifdef PROBE
    if (PRB_PH == 7) pd = __builtin_amdgcn_s_memrealtime() - pt0;
#endif
#pragma unroll 1
    for (int l = 0; l < 2; ++l) {
        PT0(0); phase_gemm_in(p, l, lds); PT1(0, 0); GRID_BAR(); PT1(0, 1);
        PT0(1); phase_prep(p, l); PT1(1, 0); GRID_BAR(); PT1(1, 1);
        kmax_reduce(l, (float*)lds);
        PT0(6); { const unsigned long long pr_ = rk::pass1(p, l, lds); (void)pr_;
#ifdef PRB_IV
        if (l == 0) pd = pr_;
#endif
        } PT1(6, 0); GRID_BAR(); PT1(6, 1);
        PT0(2); { const unsigned long long pr_ = phase_mixers(p, l, lds); (void)pr_;
#if defined(PRB_SEQ) || defined(PRB_SDIV) || defined(PRB_UNIT)
        if (l == 0) pd = pr_;
#endif
        } PT1(2, 0); GRID_BAR(); PT1(2, 1);
        PT0(4); phase_gemm_out(p, l, lds); PT1(4, 0); GRID_BAR(); PT1(4, 1);
        PT0(5); phase_post(p, l); PT1(5, 0); if (l == 0) { GRID_BAR(); PT1(5, 1); }
    }
#ifdef PROBE
    if (blockIdx.x == PRB_BLK && threadIdx.x == 0) { const unsigned long long d = pd * PRB_K; const unsigned long long t0 = __builtin_amdgcn_s_memrealtime();
        while (__builtin_amdgcn_s_memrealtime() - t0 < d) __builtin_amdgcn_s_sleep(8); }
#endif
}

extern "C" void kernel_launch(void* const* d_in, const int* in_sizes, int n_in, void* d_out, int out_size, void* d_ws, size_t ws_size, hipStream_t stream) {
    static int grid_blocks = 0;
    if (!grid_blocks) {
        int dev = 0, cus = 0, per_cu = 0;
        (void)hipGetDevice(&dev);
        (void)hipDeviceGetAttribute(&cus, hipDeviceAttributeMultiprocessorCount, dev);
        (void)hipFuncSetAttribute((const void*)mega, hipFuncAttributeMaxDynamicSharedMemorySize, LDS_BYTES);
        (void)hipOccupancyMaxActiveBlocksPerMultiprocessor(&per_cu, (const void*)mega, 512, LDS_BYTES);
        if (per_cu < 1) { fprintf(stderr, "kernel_launch: occupancy query says %d blocks/CU\n", per_cu); per_cu = 1; }
        grid_blocks = cus;
    }
    Params p{};
    for (int i = 0; i < 25; ++i) p.in[i] = (const float*)d_in[i];
    p.out = (float*)d_out; p.ws = (unsigned char*)d_ws;
    void* args[] = {&p};
    hipError_t e = hipLaunchCooperativeKernel((const void*)mega, dim3(grid_blocks), dim3(512), args, LDS_BYTES, stream);
    if (e != hipSuccess) fprintf(stderr, "cooperative launch failed: %s (grid %d)\n", hipGetErrorString(e), grid_blocks);
}
```
